# Optimizing an MI355X kernel written in HIP

```python
import math
import jax, jax.numpy as jnp
from jax import lax
import numpy as np

D_MODEL = 1024
BATCH = 32
SEQ = 2048
DEPTH = 1

D_MIX = D_MODEL
HEAD_DIM = 64
N_MLA_HEADS = D_MIX // 2 // HEAD_DIM
N_DIL_HEADS = D_MIX // 2 // HEAD_DIM
MLA_NOPE_DIM = HEAD_DIM
MLA_ROPE_DIM = HEAD_DIM // 2
MLA_V_DIM = HEAD_DIM
MLA_Q_LORA = 3 * D_MODEL // 8
MLA_KV_LORA = D_MODEL // 4
D_MLA_OUT = N_MLA_HEADS * MLA_V_DIM
D_DIL_OUT = N_DIL_HEADS * HEAD_DIM
D_IN_PROJ = MLA_Q_LORA + MLA_KV_LORA + MLA_ROPE_DIM + 3 * D_DIL_OUT
IN_SPLITS = (MLA_Q_LORA, MLA_Q_LORA + MLA_KV_LORA, MLA_Q_LORA + MLA_KV_LORA + MLA_ROPE_DIM)
DIL_PAIRS = ((128, 1), (512, 4), (2048, 16))
PARTIAL_ROT_DIM = HEAD_DIM // 4
ROPE_THETA = 500000.0
D_FF = ((8 * D_MODEL // 3 + 255) // 256) * 256
Q_BLOCK = 128
NORM_EPS = 1e-6
MASK_VALUE = -1e30

kernel_name = "hybrid_mla_dilated_macaron_encoder"


def rms_norm(x, g):
    xf = x.astype(jnp.float32)
    y = xf * lax.rsqrt(jnp.mean(xf * xf, axis=-1, keepdims=True) + NORM_EPS)
    return (y * g.astype(jnp.float32)).astype(x.dtype)


def swiglu(x, w_gate, w_up, w_down):
    return (jax.nn.silu(x @ w_gate) * (x @ w_up)) @ w_down


def rope_tables(seq, rot_dim, dtype):
    half = rot_dim // 2
    inv_freq = ROPE_THETA ** (-jnp.arange(half, dtype=jnp.float32) * (2.0 / rot_dim))
    ang = jnp.arange(seq, dtype=jnp.float32)[:, None] * inv_freq[None, :]
    return jnp.cos(ang).astype(dtype), jnp.sin(ang).astype(dtype)


def apply_rope(x, cos, sin):
    half = cos.shape[-1]
    c = cos[:, None, :]
    s = sin[:, None, :]
    x1 = x[..., :half]
    x2 = x[..., half:2 * half]
    return jnp.concatenate([x1 * c - x2 * s, x2 * c + x1 * s, x[..., 2 * half:]], axis=-1)


def dense_attention(q, k, v):
    b, s, h, dk = q.shape
    nb = s // Q_BLOCK
    scale = dk ** -0.5
    qb = q.reshape(b, nb, Q_BLOCK, h, dk).transpose(1, 0, 2, 3, 4)

    def one_block(qblk):
        sc = jnp.einsum('bqhd,bkhd->bhqk', qblk, k, preferred_element_type=jnp.float32) * scale
        p = jax.nn.softmax(sc, axis=-1)
        return jnp.einsum('bhqk,bkhd->bqhd', p.astype(v.dtype), v)

    out = lax.map(one_block, qb)
    return out.transpose(1, 0, 2, 3, 4).reshape(b, s, h, v.shape[-1])


def banded_attention(q, k, v, half):
    L, dh = q.shape[-2], q.shape[-1]
    lead = q.shape[:-2]
    blk = min(Q_BLOCK, L)
    nb = -(-L // blk)
    lp = nb * blk
    span = blk + 2 * half
    pad_lead = [(0, 0)] * len(lead)
    qp = jnp.pad(q, pad_lead + [(0, lp - L), (0, 0)])
    kp = jnp.pad(k, pad_lead + [(half, lp - L + half), (0, 0)])
    vp = jnp.pad(v, pad_lead + [(half, lp - L + half), (0, 0)])
    idx = np.arange(nb)[:, None] * blk + np.arange(span)[None, :]
    kb = jnp.take(kp, idx, axis=-2)
    vb = jnp.take(vp, idx, axis=-2)
    qb = qp.reshape(*lead, nb, blk, dh)
    sc = jnp.einsum('...nqd,...nkd->...nqk', qb, kb, preferred_element_type=jnp.float32) * (dh ** -0.5)
    key_pos = idx - half
    t = np.arange(span)[None, :]
    qi = np.arange(blk)[:, None]
    band = (t >= qi) & (t <= qi + 2 * half)
    valid = (key_pos >= 0) & (key_pos < L)
    mask = band[None, :, :] & valid[:, None, :]
    sc = jnp.where(mask, sc, MASK_VALUE)
    m = jnp.max(sc, axis=-1, keepdims=True)
    p = jnp.exp(sc - m)
    denom = jnp.sum(p, axis=-1, keepdims=True)
    o = jnp.einsum('...nqk,...nkd->...nqd', (p / denom).astype(v.dtype), vb)
    lse = (m + jnp.log(denom))[..., 0]
    o = o.reshape(*lead, lp, dh)[..., :L, :]
    lse = lse.reshape(*lead, lp)[..., :L]
    return o, lse


def dilated_attention(q, k, v):
    b, s, h, dh = q.shape
    outs, lses = [], []
    for window, dil in DIL_PAIRS:
        L = s // dil

        def strided(t):
            return t.reshape(b, L, dil, h, dh).transpose(0, 2, 3, 1, 4)

        o, lse = banded_attention(strided(q), strided(k), strided(v), window // (2 * dil))
        outs.append(o.transpose(0, 3, 1, 2, 4).reshape(b, s, h, dh))
        lses.append(lse.transpose(0, 3, 1, 2).reshape(b, s, h))
    w = jax.nn.softmax(jnp.stack(lses, axis=0), axis=0)
    return jnp.einsum('nbsh,nbshd->bshd', w.astype(q.dtype), jnp.stack(outs, axis=0))


def _dense(key, fan_in, fan_out):
    return jax.random.normal(key, (DEPTH, fan_in, fan_out), jnp.float32) * fan_in ** -0.5


def _gain(key, dim):
    return 1.0 + 0.02 * jax.random.normal(key, (DEPTH, dim), jnp.float32)


def setup_inputs(seed: int = 0) -> dict:
    key = jax.random.key(seed)
    ks = jax.random.split(key, 20)
    return {
        "x": jax.random.normal(ks[0], (BATCH, SEQ, D_MODEL), jnp.float32),
        "ffn1_norm": _gain(ks[1], D_MODEL),
        "ffn1_w_gate": _dense(ks[2], D_MODEL, D_FF),
        "ffn1_w_up": _dense(ks[3], D_MODEL, D_FF),
        "ffn1_w_down": _dense(ks[4], D_FF, D_MODEL),
        "mix_norm": _gain(ks[5], D_MODEL),
        "w_in": _dense(ks[6], D_MODEL, D_IN_PROJ),
        "mla_q_norm": _gain(ks[7], MLA_Q_LORA),
        "mla_w_uq": _dense(ks[8], MLA_Q_LORA, N_MLA_HEADS * (MLA_NOPE_DIM + MLA_ROPE_DIM)),
        "mla_kv_norm": _gain(ks[9], MLA_KV_LORA),
        "mla_w_ukv": _dense(ks[10], MLA_KV_LORA, N_MLA_HEADS * (MLA_NOPE_DIM + MLA_V_DIM)),
        "mla_out_norm": _gain(ks[11], D_MLA_OUT),
        "dil_out_norm": _gain(ks[12], D_DIL_OUT),
        "w_out": _dense(ks[13], D_MIX, D_MODEL),
        "ffn2_norm": _gain(ks[14], D_MODEL),
        "ffn2_w_gate": _dense(ks[15], D_MODEL, D_FF),
        "ffn2_w_up": _dense(ks[16], D_MODEL, D_FF),
        "ffn2_w_down": _dense(ks[17], D_FF, D_MODEL),
        "final_norm": 1.0 + 0.02 * jax.random.normal(ks[18], (D_MODEL,), jnp.float32),
    }


def reference(x, ffn1_norm, ffn1_w_gate, ffn1_w_up, ffn1_w_down, mix_norm, w_in,
              mla_q_norm, mla_w_uq, mla_kv_norm, mla_w_ukv, mla_out_norm, dil_out_norm,
              w_out, ffn2_norm, ffn2_w_gate, ffn2_w_up, ffn2_w_down, final_norm):
    b, s, _ = x.shape
    cos_p, sin_p = rope_tables(s, PARTIAL_ROT_DIM, x.dtype)
    cos_m, sin_m = rope_tables(s, MLA_ROPE_DIM, x.dtype)
    for l in range(DEPTH):
        x = x + 0.5 * swiglu(rms_norm(x, ffn1_norm[l]), ffn1_w_gate[l], ffn1_w_up[l], ffn1_w_down[l])

        h = rms_norm(x, mix_norm[l])
        proj = h @ w_in[l]
        c_q, c_kv, k_rope, qkv_dil = jnp.split(proj, IN_SPLITS, axis=-1)

        q = (rms_norm(c_q, mla_q_norm[l]) @ mla_w_uq[l]).reshape(b, s, N_MLA_HEADS, MLA_NOPE_DIM + MLA_ROPE_DIM)
        q_mla = jnp.concatenate([q[..., :MLA_NOPE_DIM], apply_rope(q[..., MLA_NOPE_DIM:], cos_m, sin_m)], axis=-1)
        kv = (rms_norm(c_kv, mla_kv_norm[l]) @ mla_w_ukv[l]).reshape(b, s, N_MLA_HEADS, MLA_NOPE_DIM + MLA_V_DIM)
        k_nope = kv[..., :MLA_NOPE_DIM]
        v_mla = kv[..., MLA_NOPE_DIM:]
        k_r = apply_rope(k_rope[:, :, None, :], cos_m, sin_m)
        k_mla = jnp.concatenate([k_nope, jnp.broadcast_to(k_r, (b, s, N_MLA_HEADS, MLA_ROPE_DIM))], axis=-1)
        o_mla = dense_attention(q_mla, k_mla, v_mla).reshape(b, s, D_MLA_OUT)

        qkv = qkv_dil.reshape(b, s, 3, N_DIL_HEADS, HEAD_DIM)
        q_d = apply_rope(qkv[:, :, 0], cos_p, sin_p)
        k_d = apply_rope(qkv[:, :, 1], cos_p, sin_p)
        v_d = qkv[:, :, 2]
        o_dil = dilated_attention(q_d, k_d, v_d).reshape(b, s, D_DIL_OUT)

        mixed = jnp.concatenate([rms_norm(o_mla, mla_out_norm[l]), rms_norm(o_dil, dil_out_norm[l])], axis=-1)
        x = x + mixed @ w_out[l]

        x = x + 0.5 * swiglu(rms_norm(x, ffn2_norm[l]), ffn2_w_gate[l], ffn2_w_up[l], ffn2_w_down[l])
    return rms_norm(x, final_norm)
```

```cpp
#include <hip/hip_runtime.h>
#include <hip/hip_cooperative_groups.h>
#include <cmath>
#include <cstdio>
#include <cstdint>
namespace pg8 {
#define PG8_LAS __attribute__((address_space(3)))
typedef unsigned short bf16_t;
typedef short bf16x8 __attribute__((ext_vector_type(8)));
typedef float f32x4 __attribute__((ext_vector_type(4)));
typedef unsigned u32x4 __attribute__((ext_vector_type(4)));
constexpr int BM = 256, BK = 64, HALF = 128, HTB = HALF * BK * 2  , STAGE_BYTES = 8 * HTB, NXCD = 8, WGM = 8;

__host__ __device__ __forceinline__ int lds_byte(int r, int c) { const int st = (r >> 4) * 2 + (c >> 5), rr = r & 15, cc = c & 31, ob = rr * 64 + cc * 2; return st * 1024 + (ob ^ (((ob >> 9) & 1) << 5)); }
__host__ __device__ __forceinline__ void stage_rc(int b, int& R, int& C) { const int st = b / 1024, sb = b % 1024, swz = sb ^ (((sb >> 9) & 1) << 5); R = (st >> 1) * 16 + swz / 64; C = (st & 1) * 32 + (swz % 64) / 2; }
__host__ __device__ __forceinline__ int perm32(int rho) { const int n = rho >> 4, i = rho & 15; return 8 * (i >> 2) + 4 * n + (i & 3); }

struct Unit { int pm, pn; };
struct Gemm { const bf16_t* A; const bf16_t* Bt; int M, N, K; };

struct StaticOrder {
    int nM, nN, nwg, G, c;
    __host__ __device__ void init(int M, int N, int G_, int c_) { nM = M / BM; nN = N / BM; nwg = nM * nN; G = G_; c = c_; }
    __host__ __device__ bool next(int i, Unit& u) const {
        const long L = (long)i * G + c; if (L >= nwg) return false;
        int wgid = (int)L; { const int q = nwg / NXCD, r = nwg % NXCD, xcd = wgid % NXCD, off = wgid / NXCD; wgid = (xcd < r ? xcd * (q + 1) : r * (q + 1) + (xcd - r) * q) + off; }
        const int nig = WGM * nN, gid = wgid / nig, fm = gid * WGM, gsz = (nM - fm) < WGM ? (nM - fm) : WGM;
        u.pm = fm + ((wgid % nig) % gsz); u.pn = (wgid % nig) / gsz; return true;
    }
    __device__ __forceinline__ void a_ready(const Unit&) const {}
    __device__ __forceinline__ void done(const Unit&) const {}
};

__device__ __forceinline__ unsigned cvt_pk_bf16(float lo, float hi) { unsigned r; asm volatile("v_cvt_pk_bf16_f32 %0, %1, %2" : "=v"(r) : "v"(lo), "v"(hi)); return r; }

template <class Epi, class Sched, bool ALIGN_EPI = false, bool SP2 = false>
__device__ __forceinline__ void gemm_phase(PG8_LAS unsigned char* lds, const Gemm g, const Sched& S, const Epi& E) {
    int tid_ = threadIdx.x; asm volatile("" : "+v"(tid_));
    const int tid = tid_, wid = __builtin_amdgcn_readfirstlane(tid >> 6), lane = tid & 63, wr = wid >> 2, wc = wid & 3, fr = lane & 15, fq = lane >> 4;
    const int K = g.K, nt = K / BK;
    unsigned voffA[2], voffB[2];
#pragma unroll
    for (int i = 0; i < 2; ++i) { int R, C; stage_rc(tid * 16 + i * 8192, R, C); const int Rb = Epi::PERM ? ((R & ~31) + perm32(R & 31)) : R;
        voffA[i] = (unsigned)(R * K + C) * 2u; voffB[i] = (unsigned)(Rb * K + C) * 2u; }
    const size_t kstep = (size_t)(BK * 2);
    const size_t hstep = (size_t)HALF * K * 2;
    const size_t tstep = 2 * hstep;
    const unsigned ldsw = (unsigned)wid * 1024u;
    const int aoff = lds_byte(wr * 64 + fr, fq * 8), boff = lds_byte(wc * 32 + fr, fq * 8);
#define PG8_SA(b, h) (((b) * 2 + (h)) * HTB)
#define PG8_SB(b, h) ((4 + (b) * 2 + (h)) * HTB)
#define PG8_STAGE(bufoff, gbase, voff) do { _Pragma("unroll") for (int _i = 0; _i < 2; ++_i) \
        __builtin_amdgcn_global_load_lds((const unsigned*)((const char*)(gbase) + (voff)[_i]), (PG8_LAS unsigned*)(lds + (bufoff) + ldsw + _i * 8192), 16, 0, 0); } while (0)
#define PG8_LDA(dst, b, h) do { _Pragma("unroll") for (int m = 0; m < 4; ++m) _Pragma("unroll") for (int k = 0; k < 2; ++k) dst[m][k] = *(const PG8_LAS bf16x8*)(lds + PG8_SA(b, h) + aoff + m * 2048 + k * 1024); } while (0)
#define PG8_LDB(dst, b, h) do { _Pragma("unroll") for (int n = 0; n < 2; ++n) _Pragma("unroll") for (int k = 0; k < 2; ++k) dst[n][k] = *(const PG8_LAS bf16x8*)(lds + PG8_SB(b, h) + boff + n * 2048 + k * 1024); } while (0)
#define PG8_MMA(ai, bj, At, Bt) do { __builtin_amdgcn_s_setprio(1); _Pragma("unroll") for (int m = 0; m < 4; ++m) _Pragma("unroll") for (int n = 0; n < 2; ++n) _Pragma("unroll") for (int k = 0; k < 2; ++k) \
        acc[ai][bj][m][n] = __builtin_amdgcn_mfma_f32_16x16x32_bf16(Bt[n][k], At[m][k], acc[ai][bj][m][n], 0, 0, 0); __builtin_amdgcn_s_setprio(0); } while (0)
#define PG8_WAIT_V(n) asm volatile("s_waitcnt vmcnt(" #n ")" ::: "memory")
#define PG8_WAIT_L(n) asm volatile("s_waitcnt lgkmcnt(" #n ")" ::: "memory")
#define PG8_BAR __builtin_amdgcn_s_barrier()
#define PG8_SCHED __builtin_amdgcn_sched_barrier(0)
    Unit cur, nxt; int ui = 0;
    if (!S.next(0, cur)) return;
    f32x4 acc[2][2][4][2];
#pragma unroll
    for (int a = 0; a < 2; ++a)
#pragma unroll
        for (int b = 0; b < 2; ++b)
#pragma unroll
            for (int m = 0; m < 4; ++m)
#pragma unroll
                for (int n = 0; n < 2; ++n) acc[a][b][m][n] = (f32x4){0.f, 0.f, 0.f, 0.f};
    bf16x8 At[4][2], B0[2][2], B1[2][2];
    const char* cA = (const char*)g.A + (size_t)cur.pm * tstep; const char* cB = (const char*)g.Bt + (size_t)cur.pn * tstep;
    S.a_ready(cur);
    if constexpr (SP2) {
        PG8_STAGE(PG8_SB(0, 0), cB, voffB); PG8_STAGE(PG8_SB(0, 1), cB + hstep, voffB); PG8_STAGE(PG8_SA(0, 0), cA, voffA); PG8_STAGE(PG8_SA(0, 1), cA + hstep, voffA);
        if (wr == 1) PG8_BAR;
        PG8_WAIT_V(2); PG8_BAR;
        PG8_STAGE(PG8_SB(1, 0), cB + kstep, voffB); PG8_STAGE(PG8_SA(1, 0), cA + kstep, voffA); PG8_STAGE(PG8_SB(1, 1), cB + hstep + kstep, voffB);
        PG8_WAIT_V(6); PG8_BAR;
    } else {
        PG8_STAGE(PG8_SB(0, 0), cB, voffB); PG8_STAGE(PG8_SA(0, 0), cA, voffA); PG8_STAGE(PG8_SB(0, 1), cB + hstep, voffB); PG8_STAGE(PG8_SA(0, 1), cA + hstep, voffA);
        if (wr == 1) PG8_BAR;
        PG8_WAIT_V(4); PG8_BAR;
        PG8_STAGE(PG8_SB(1, 0), cB + kstep, voffB); PG8_STAGE(PG8_SA(1, 0), cA + kstep, voffA); PG8_STAGE(PG8_SB(1, 1), cB + hstep + kstep, voffB);
        PG8_WAIT_V(6); PG8_BAR;
    }
    for (;;) {
        const bool has_next = S.next(ui + 1, nxt);
        const char* nA = has_next ? (const char*)g.A + (size_t)nxt.pm * tstep : cA; const char* nB = has_next ? (const char*)g.Bt + (size_t)nxt.pn * tstep : cB;
        for (int t = 0; t < nt; t += 2) {
            const bool last = (t == nt - 2);
            const char* a1 = cA + (size_t)(t + 1) * kstep;
            const char* a2 = last ? nA : cA + (size_t)(t + 2) * kstep; const char* b2 = last ? nB : cB + (size_t)(t + 2) * kstep;
            const char* a3 = a2 + kstep; const char* b3 = b2 + kstep;
            if (last && has_next) S.a_ready(nxt);
            if constexpr (SP2) {
            PG8_LDB(B0, 0, 0); PG8_LDB(B1, 0, 1); PG8_SCHED; PG8_LDA(At, 0, 0); PG8_STAGE(PG8_SA(1, 1), a1 + hstep, voffA);
            PG8_WAIT_V(8); PG8_WAIT_L(0); PG8_BAR; PG8_MMA(0, 0, At, B0); PG8_MMA(0, 1, At, B1); PG8_BAR; PG8_SCHED;
            PG8_LDA(At, 0, 1); PG8_STAGE(PG8_SB(0, 0), b2, voffB); PG8_STAGE(PG8_SB(0, 1), b2 + hstep, voffB); PG8_STAGE(PG8_SA(0, 0), a2, voffA);
            PG8_WAIT_V(8); PG8_WAIT_L(0); PG8_BAR; PG8_MMA(1, 0, At, B0); PG8_MMA(1, 1, At, B1); PG8_BAR; PG8_SCHED;
            PG8_LDB(B0, 1, 0); PG8_LDB(B1, 1, 1); PG8_SCHED; PG8_LDA(At, 1, 0); PG8_STAGE(PG8_SA(0, 1), a2 + hstep, voffA);
            PG8_WAIT_V(8); PG8_WAIT_L(0); PG8_BAR; PG8_MMA(0, 0, At, B0); PG8_MMA(0, 1, At, B1); PG8_BAR; PG8_SCHED;
            PG8_LDA(At, 1, 1); PG8_STAGE(PG8_SB(1, 0), b3, voffB); PG8_STAGE(PG8_SB(1, 1), b3 + hstep, voffB); PG8_STAGE(PG8_SA(1, 0), a3, voffA);
            PG8_WAIT_V(8); PG8_WAIT_L(0); PG8_BAR; PG8_MMA(1, 0, At, B0); PG8_MMA(1, 1, At, B1); PG8_BAR; PG8_SCHED;
            } else {
            PG8_LDB(B0, 0, 0); PG8_SCHED; PG8_LDA(At, 0, 0); PG8_STAGE(PG8_SA(1, 1), a1 + hstep, voffA);
            PG8_WAIT_L(8); PG8_BAR; PG8_WAIT_L(0); PG8_MMA(0, 0, At, B0); PG8_BAR; PG8_SCHED;
            PG8_LDB(B1, 0, 1); PG8_STAGE(PG8_SB(0, 0), b2, voffB);
            PG8_BAR; PG8_WAIT_L(0); PG8_MMA(0, 1, At, B1); PG8_BAR;
            PG8_LDA(At, 0, 1); PG8_STAGE(PG8_SA(0, 0), a2, voffA);
            PG8_BAR; PG8_WAIT_L(0); PG8_MMA(1, 0, At, B0); PG8_BAR; PG8_SCHED;
            PG8_STAGE(PG8_SB(0, 1), b2 + hstep, voffB);
            PG8_WAIT_V(6); PG8_BAR; PG8_MMA(1, 1, At, B1); PG8_BAR;
            PG8_LDB(B0, 1, 0); PG8_SCHED; PG8_LDA(At, 1, 0); PG8_STAGE(PG8_SA(0, 1), a2 + hstep, voffA);
            PG8_WAIT_L(8); PG8_BAR; PG8_WAIT_L(0); PG8_MMA(0, 0, At, B0); PG8_BAR; PG8_SCHED;
            PG8_LDB(B1, 1, 1); PG8_STAGE(PG8_SB(1, 0), b3, voffB);
            PG8_BAR; PG8_WAIT_L(0); PG8_MMA(0, 1, At, B1); PG8_BAR;
            PG8_LDA(At, 1, 1); PG8_STAGE(PG8_SA(1, 0), a3, voffA);
            PG8_BAR; PG8_WAIT_L(0); PG8_MMA(1, 0, At, B0); PG8_BAR; PG8_SCHED;
            PG8_STAGE(PG8_SB(1, 1), b3 + hstep, voffB);
            PG8_WAIT_V(6); PG8_BAR; PG8_MMA(1, 1, At, B1); PG8_BAR;
            }
        }
        if constexpr (ALIGN_EPI) { if (wr == 0) PG8_BAR; }
        if constexpr (!Epi::AFTER_DRAIN) { E(acc, cur, wr, wc, fr, fq); S.done(cur); }
        if (!has_next) break;
#pragma unroll
        for (int a = 0; a < 2; ++a)
#pragma unroll
            for (int b = 0; b < 2; ++b)
#pragma unroll
                for (int m = 0; m < 4; ++m)
#pragma unroll
                    for (int n = 0; n < 2; ++n) acc[a][b][m][n] = (f32x4){0.f, 0.f, 0.f, 0.f};
        cur = nxt; cA = nA; cB = nB; ++ui;
        if constexpr (ALIGN_EPI) { if (wr == 1) PG8_BAR; }
    }
    PG8_WAIT_V(0);
    if constexpr (!ALIGN_EPI) { if (wr == 0) PG8_BAR; }
    PG8_BAR;
    if constexpr (Epi::AFTER_DRAIN) { E.fused(acc, cur, wr, wc, fr, fq, lds, wid, lane); S.done(cur); }
#undef PG8_SA
#undef PG8_SB
#undef PG8_STAGE
#undef PG8_LDA
#undef PG8_LDB
#undef PG8_MMA
#undef PG8_WAIT_V
#undef PG8_WAIT_L
#undef PG8_BAR
#undef PG8_SCHED
}
}

namespace cg = cooperative_groups;

#define LAS __attribute__((address_space(3)))
typedef unsigned short bf16_t;
typedef float f32x4 __attribute__((ext_vector_type(4)));
typedef float f32x16 __attribute__((ext_vector_type(16)));
typedef short bf16x8 __attribute__((ext_vector_type(8)));
typedef short s16x4 __attribute__((ext_vector_type(4)));
typedef unsigned u32x2 __attribute__((ext_vector_type(2)));
typedef unsigned u32x4 __attribute__((ext_vector_type(4)));
using pg8::Unit;
using pg8::cvt_pk_bf16;

constexpr int NT = 65536, SEQ = 2048, DM = 1024, FF = 2816, NWAVES = 8;
constexpr float EPS = 1e-6f, LOG2E = 1.4426950408889634f;
constexpr float QSCALE_D = 0.125f * LOG2E;
constexpr float QSCALE_M = 0.10206207261596577f * LOG2E;

constexpr size_t MiB = 1u << 20;
constexpr size_t WS_W1GU = 0, WS_W1D = 11 * MiB, WS_W2GU = 17 * MiB, WS_W2D = 28 * MiB, WS_WIN = 34 * MiB, WS_WUQ = 39 * MiB, WS_WUKV = 40 * MiB, WS_WOUT = 41 * MiB;
constexpr size_t WS_ROPE = 43 * MiB;
constexpr size_t WS_SS0 = 44 * MiB, WS_SS1 = 48 * MiB, WS_SS2 = 52 * MiB, WS_SS3 = 56 * MiB, WS_SSQ = 60 * MiB, WS_SSKV = 62 * MiB;
constexpr size_t WS_XB = 64 * MiB;
constexpr size_t WS_KVM = WS_XB;
constexpr size_t WS_H = 192 * MiB;
constexpr size_t WS_OD0 = 192 * MiB, WS_OD1 = 256 * MiB, WS_OD2 = 320 * MiB, WS_OMIX = 384 * MiB, WS_LSE = 512 * MiB;
constexpr size_t WS_QD = 544 * MiB, WS_KD = 608 * MiB, WS_VD = 672 * MiB, WS_CQ = 736 * MiB, WS_CKV = 784 * MiB, WS_KR = 816 * MiB, WS_QM = 820 * MiB, WS_END = 916 * MiB;

__device__ __forceinline__ float fast_exp2(float x) { return __builtin_amdgcn_exp2f(x); }
__device__ __forceinline__ float fast_rcp(float x) { return __builtin_amdgcn_rcpf(x); }
__device__ __forceinline__ float bf2f(unsigned short b) { return __uint_as_float((unsigned)b << 16); }
__device__ __forceinline__ float sum4(f32x4 a) { return (a[0] + a[1]) + (a[2] + a[3]); }
__device__ __forceinline__ float sq4(f32x4 a) { return (a[0] * a[0] + a[1] * a[1]) + (a[2] * a[2] + a[3] * a[3]); }
__device__ __forceinline__ float rstd_parts16(const float* ss, int row, float invn) {
    const f32x4* p = (const f32x4*)(ss + (size_t)row * 16);
    const float s = (sum4(p[0]) + sum4(p[1])) + (sum4(p[2]) + sum4(p[3]));
    return rsqrtf(s * invn + EPS);
}

#define EPI_RELANE() int fr, fq; { int t_ = threadIdx.x; asm volatile("" : "+v"(t_)); fr = t_ & 15; fq = (t_ >> 4) & 3; }
struct EpiGateUp {
    static constexpr bool PERM = true, AFTER_DRAIN = false;
    bf16_t* H; const float* ss;
    __device__ __forceinline__ void operator()(const f32x4 (&acc)[2][2][4][2], const Unit& u, int wr, int wc, int fr_in, int fq_in) const {
        EPI_RELANE();
        const int row0 = u.pm * 256 + wr * 64 + fr, col = u.pn * 128 + wc * 32 + 8 * fq;
#pragma unroll
        for (int ai = 0; ai < 2; ++ai)
#pragma unroll
            for (int m = 0; m < 4; ++m) {
                const int row = row0 + ai * 128 + m * 16;
                const float rs = rstd_parts16(ss, row, 1.0f / 1024.0f);
                float o[8];
#pragma unroll
                for (int n = 0; n < 2; ++n)
#pragma unroll
                    for (int j = 0; j < 4; ++j) {
                        const float g = acc[ai][0][m][n][j] * rs, up = acc[ai][1][m][n][j] * rs;
                        o[4 * n + j] = g * fast_rcp(1.0f + fast_exp2(-g * LOG2E)) * up;
                    }
                u32x4 w; w.x = cvt_pk_bf16(o[0], o[1]); w.y = cvt_pk_bf16(o[2], o[3]); w.z = cvt_pk_bf16(o[4], o[5]); w.w = cvt_pk_bf16(o[6], o[7]);
                *(u32x4*)(H + (size_t)row * FF + col) = w;
            }
    }
};
struct EpiResid {
    static constexpr bool PERM = false, AFTER_DRAIN = false;
    const float* base; float* out; bf16_t* xb; float* ss; float alpha;
    __device__ __forceinline__ void operator()(const f32x4 (&acc)[2][2][4][2], const Unit& u, int wr, int wc, int fr_in, int fq_in) const {
        EPI_RELANE();
        const int row0 = u.pm * 256 + wr * 64 + fr, col0 = u.pn * 256 + wc * 32 + 4 * fq;
#pragma unroll
        for (int ai = 0; ai < 2; ++ai)
#pragma unroll
            for (int m = 0; m < 4; ++m) {
                const int row = row0 + ai * 128 + m * 16; float sq = 0.f;
#pragma unroll
                for (int bj = 0; bj < 2; ++bj)
#pragma unroll
                    for (int n = 0; n < 2; ++n) {
                        const size_t off = (size_t)row * DM + col0 + bj * 128 + n * 16;
                        const f32x4 b = *(const f32x4*)(base + off);
                        const f32x4 v = b + acc[ai][bj][m][n] * alpha;
                        *(f32x4*)(out + off) = v; sq += sq4(v);
                        if (xb) { u32x2 w; w.x = cvt_pk_bf16(v[0], v[1]); w.y = cvt_pk_bf16(v[2], v[3]); *(u32x2*)(xb + off) = w; }
                    }
                sq += __shfl_xor(sq, 16); sq += __shfl_xor(sq, 32);
                if (fq == 0) ss[(size_t)row * 16 + u.pn * 4 + wc] = sq;
            }
    }
};
struct EpiInProj {
    static constexpr bool PERM = false, AFTER_DRAIN = false;
    const float* ss1; bf16_t *QD, *KD, *VD, *CQ, *CKV, *KR; float *SSQ, *SSKV; const float *cosm, *sinm, *cosp, *sinp;
    __device__ __forceinline__ void operator()(const f32x4 (&acc)[2][2][4][2], const Unit& u, int wr, int wc, int fr_in, int fq_in) const {
        EPI_RELANE();
        const int row0 = u.pm * 256 + wr * 64 + fr, pn = u.pn;
#pragma unroll
        for (int ai = 0; ai < 2; ++ai)
#pragma unroll
            for (int m = 0; m < 4; ++m) {
                const int row = row0 + ai * 128 + m * 16, pos = row & (SEQ - 1);
                const float rs = rstd_parts16(ss1, row, 1.0f / 1024.0f);
                if (pn < 6) {
                    bf16_t* dst = QD + (size_t)(pn >> 1) * ((size_t)NT * 512) + (size_t)row * 512 + (pn & 1) * 256 + wc * 32 + 4 * fq;
                    const float sc = pn < 2 ? rs * QSCALE_D : rs;
                    const bool rope = (pn < 4) && ((wc & 1) == 0);
#pragma unroll
                    for (int bj = 0; bj < 2; ++bj)
#pragma unroll
                        for (int n = 0; n < 2; ++n) {
                            f32x4 v = acc[ai][bj][m][n] * sc;
                            if (n == 0 && rope) {
                                f32x4 pv; pv[0] = __shfl_xor(v[0], 32); pv[1] = __shfl_xor(v[1], 32); pv[2] = __shfl_xor(v[2], 32); pv[3] = __shfl_xor(v[3], 32);
                                const f32x4 c = *(const f32x4*)(cosp + pos * 8 + 4 * (fq & 1)), s = *(const f32x4*)(sinp + pos * 8 + 4 * (fq & 1));
                                v = (fq < 2) ? (v * c - pv * s) : (v * c + pv * s);
                            }
                            u32x2 w; w.x = cvt_pk_bf16(v[0], v[1]); w.y = cvt_pk_bf16(v[2], v[3]);
                            *(u32x2*)(dst + bj * 128 + n * 16) = w;
                        }
                } else if (pn == 6 || pn == 8) {
                    bf16_t* dst = CQ + (pn == 6 ? (size_t)row * 384 : (size_t)NT * 384 + (size_t)row * 256) + wc * 32 + 4 * fq; float sq = 0.f;
#pragma unroll
                    for (int bj = 0; bj < 2; ++bj)
#pragma unroll
                        for (int n = 0; n < 2; ++n) {
                            const f32x4 v = acc[ai][bj][m][n] * rs; sq += sq4(v);
                            u32x2 w; w.x = cvt_pk_bf16(v[0], v[1]); w.y = cvt_pk_bf16(v[2], v[3]);
                            *(u32x2*)(dst + bj * 128 + n * 16) = w;
                        }
                    sq += __shfl_xor(sq, 16); sq += __shfl_xor(sq, 32);
                    if (fq == 0) SSQ[(pn == 6 ? (size_t)row * 8 : (size_t)NT * 8 + (size_t)row * 4) + wc] = sq;
                } else {
                    bf16_t* dst = CQ + (size_t)row * 384 + 256 + wc * 32 + 4 * fq; float sq = 0.f;
#pragma unroll
                    for (int n = 0; n < 2; ++n) {
                        const f32x4 v = acc[ai][0][m][n] * rs; sq += sq4(v);
                        u32x2 w; w.x = cvt_pk_bf16(v[0], v[1]); w.y = cvt_pk_bf16(v[2], v[3]);
                        *(u32x2*)(dst + n * 16) = w;
                    }
                    sq += __shfl_xor(sq, 16); sq += __shfl_xor(sq, 32);
                    if (fq == 0) SSQ[(size_t)row * 8 + 4 + wc] = sq;
                    if (wc == 0) {
                        const f32x4 x1 = acc[ai][1][m][0] * rs, x2 = acc[ai][1][m][1] * rs;
                        const f32x4 c = *(const f32x4*)(cosm + pos * 16 + 4 * fq), s = *(const f32x4*)(sinm + pos * 16 + 4 * fq);
                        const f32x4 o1 = x1 * c - x2 * s, o2 = x2 * c + x1 * s;
                        u32x2 w1, w2; w1.x = cvt_pk_bf16(o1[0], o1[1]); w1.y = cvt_pk_bf16(o1[2], o1[3]); w2.x = cvt_pk_bf16(o2[0], o2[1]); w2.y = cvt_pk_bf16(o2[2], o2[3]);
                        *(u32x2*)(KR + (size_t)row * 32 + 4 * fq) = w1; *(u32x2*)(KR + (size_t)row * 32 + 16 + 4 * fq) = w2;
                    }
                }
            }
    }
};
struct EpiQ {
    static constexpr bool PERM = false, AFTER_DRAIN = false;
    const float* ssq; bf16_t* QM; const float *cosm, *sinm;
    __device__ __forceinline__ void operator()(const f32x4 (&acc)[2][2][4][2], const Unit& u, int wr, int wc, int fr_in, int fq_in) const {
        EPI_RELANE();
        const int row0 = u.pm * 256 + wr * 64 + fr;
#pragma unroll
        for (int ai = 0; ai < 2; ++ai)
#pragma unroll
            for (int m = 0; m < 4; ++m) {
                const int row = row0 + ai * 128 + m * 16, pos = row & (SEQ - 1);
                const f32x4* p = (const f32x4*)(ssq + (size_t)row * 8);
                const float rs = rsqrtf((sum4(p[0]) + sum4(p[1])) * (1.0f / 384.0f) + EPS) * QSCALE_M;
#pragma unroll
                for (int bj = 0; bj < 2; ++bj) {
                    const int g32 = 8 * u.pn + 4 * bj + wc;
                    bf16_t* dst = QM + (size_t)row * 768 + 32 * g32 + 4 * fq;
                    f32x4 v0 = acc[ai][bj][m][0] * rs, v1 = acc[ai][bj][m][1] * rs;
                    if (g32 % 3 == 2) {
                        const f32x4 c = *(const f32x4*)(cosm + pos * 16 + 4 * fq), s = *(const f32x4*)(sinm + pos * 16 + 4 * fq);
                        const f32x4 o1 = v0 * c - v1 * s, o2 = v1 * c + v0 * s; v0 = o1; v1 = o2;
                    }
                    u32x2 w0, w1; w0.x = cvt_pk_bf16(v0[0], v0[1]); w0.y = cvt_pk_bf16(v0[2], v0[3]); w1.x = cvt_pk_bf16(v1[0], v1[1]); w1.y = cvt_pk_bf16(v1[2], v1[3]);
                    *(u32x2*)dst = w0; *(u32x2*)(dst + 16) = w1;
                }
            }
    }
};
struct EpiKV {
    static constexpr bool PERM = true, AFTER_DRAIN = false;
    const float* sskv; bf16_t* KVM;
    __device__ __forceinline__ void operator()(const f32x4 (&acc)[2][2][4][2], const Unit& u, int wr, int wc, int fr_in, int fq_in) const {
        EPI_RELANE();
        const int row0 = u.pm * 256 + wr * 64 + fr, col = u.pn * 256 + wc * 32 + 8 * fq;
#pragma unroll
        for (int ai = 0; ai < 2; ++ai)
#pragma unroll
            for (int m = 0; m < 4; ++m) {
                const int row = row0 + ai * 128 + m * 16;
                const float rs = rsqrtf(sum4(*(const f32x4*)(sskv + (size_t)row * 4)) * (1.0f / 256.0f) + EPS);
#pragma unroll
                for (int bj = 0; bj < 2; ++bj) {
                    const f32x4 v0 = acc[ai][bj][m][0] * rs, v1 = acc[ai][bj][m][1] * rs;
                    u32x4 w; w.x = cvt_pk_bf16(v0[0], v0[1]); w.y = cvt_pk_bf16(v0[2], v0[3]); w.z = cvt_pk_bf16(v1[0], v1[1]); w.w = cvt_pk_bf16(v1[2], v1[3]);
                    *(u32x4*)(KVM + (size_t)row * 1024 + col + bj * 128) = w;
                }
            }
    }
};

constexpr int ATT_VS = 144;
constexpr int ATT_TILE = 64 * 208 + 64 * ATT_VS;
constexpr int ATT_OST = 2 * ATT_TILE, ATT_WSC = ATT_OST + NWAVES * 4096;
static_assert(ATT_WSC + NWAVES * 256 <= 131072, "attention LDS");
static_assert(WS_KD == WS_QD + (size_t)NT * 512 * 2 && WS_VD == WS_KD + (size_t)NT * 512 * 2 && WS_CKV == WS_CQ + (size_t)NT * 384 * 2 && WS_SSKV == WS_SSQ + (size_t)NT * 8 * 4, "buffers addressed relative to each other");
__device__ __forceinline__ int crow(int r, int hi) { return (r & 3) + 8 * (r >> 2) + 4 * hi; }
__device__ __forceinline__ bf16x8 pack8(const f32x16& p, int b) {
    u32x4 w; w.x = cvt_pk_bf16(p[b], p[b + 1]); w.y = cvt_pk_bf16(p[b + 2], p[b + 3]); w.z = cvt_pk_bf16(p[b + 4], p[b + 5]); w.w = cvt_pk_bf16(p[b + 6], p[b + 7]);
    return __builtin_bit_cast(bf16x8, w);
}
typedef short v4i16_t __attribute__((ext_vector_type(4)));
__device__ __forceinline__ s16x4 vtr(LAS const unsigned char* p) { return __builtin_bit_cast(s16x4, __builtin_amdgcn_ds_read_tr16_b64_v4i16((LAS v4i16_t*)p)); }

struct AttnIO {
    const bf16_t *QM, *KVM, *KR; bf16_t* OMIX;
    const bf16_t *QD, *KD, *VD; bf16_t* OD; float* LSE;
};

template <bool DIL>
__device__ __forceinline__ void attn_unit(LAS unsigned char* lds, const AttnIO& io, int unit) {
    constexpr int DK = DIL ? 64 : 96, KS = DK * 2 + 16, NKS = DK / 16;
    int tid_ = threadIdx.x; asm volatile("" : "+v"(tid_));
    const int tid = tid_, lane = tid & 63, wid = __builtin_amdgcn_readfirstlane(tid >> 6), r32 = lane & 31, hi = lane >> 5;
    int b, h, ntiles, tlo, thi, kofs = 0, L = SEQ, dil = 1, res = 0, resu = 0, br = 0, q0 = 0, pq;
    if constexpr (!DIL) {
        const int bh = unit >> 3, qb = unit & 7; b = bh >> 3; h = bh & 7; ntiles = 32; tlo = 0; thi = 32; q0 = qb * 256; pq = q0 + wid * 32 + r32;
    } else {
        const int bh = unit / 24, k = unit % 24, j = k & 7; br = k >> 3; b = bh >> 3; h = bh & 7;
        if (br == 0) { dil = 1; L = 2048; resu = 0; q0 = 256 * j; }
        else if (br == 1) { dil = 4; L = 512; resu = j >> 1; q0 = 256 * (j & 1); }
        else { dil = 16; L = 128; resu = 2 * j; q0 = 0; }
        if (br < 2) { ntiles = 6; tlo = wid >> 1; thi = tlo + 3; kofs = q0 - 64; pq = q0 + wid * 32 + r32; res = resu; }
        else { const int hw = wid >> 2; ntiles = 4; tlo = 2 * hw; thi = tlo + 2; kofs = -128 * hw; pq = (wid & 3) * 32 + r32; res = resu + hw; }
    }
    const size_t kb = (size_t)b * SEQ;
    bf16x8 qf[NKS];
    {
        const bf16_t* qp = DIL ? io.QD + (kb + (size_t)pq * dil + res) * 512 + h * 64 : io.QM + (kb + pq) * 768 + h * 96;
#pragma unroll
        for (int ks = 0; ks < NKS; ++ks) qf[ks] = *(const bf16x8*)(qp + ks * 16 + hi * 8);
    }
    const int lrow = tid >> 3, lch = tid & 7, rrow = (tid >> 2) & 63, rch = tid & 3;
    u32x4 gk, gv, gr;
#define ATT_GLOAD(t) do { \
        if constexpr (!DIL) { \
            const size_t key_ = kb + 64 * (t) + lrow; \
            gk = *(const u32x4*)(io.KVM + key_ * 1024 + h * 128 + lch * 8); \
            gv = *(const u32x4*)(io.KVM + key_ * 1024 + h * 128 + 64 + lch * 8); \
            if (tid < 256) gr = *(const u32x4*)(io.KR + (kb + 64 * (t) + rrow) * 32 + rch * 8); \
        } else { \
            const int s_ = 64 * (t) + lrow; size_t tok_; \
            if (br < 2) { int p_ = q0 - 64 + s_; p_ = p_ < 0 ? 0 : (p_ > L - 1 ? L - 1 : p_); tok_ = kb + (size_t)p_ * dil + resu; } \
            else { tok_ = kb + (size_t)(s_ & 127) * 16 + (size_t)(resu + (s_ >> 7)); } \
            gk = *(const u32x4*)(io.KD + tok_ * 512 + h * 64 + lch * 8); \
            gv = *(const u32x4*)(io.VD + tok_ * 512 + h * 64 + lch * 8); \
        } } while (0)
#define ATT_LSTORE(buf) do { \
        LAS unsigned char* Kb_ = lds + (buf) * ATT_TILE; LAS unsigned char* Vb_ = Kb_ + 64 * KS; \
        *(LAS u32x4*)(Kb_ + lrow * KS + lch * 16) = gk; \
        *(LAS u32x4*)(Vb_ + lrow * ATT_VS + lch * 16) = gv; \
        if constexpr (!DIL) { if (tid < 256) *(LAS u32x4*)(Kb_ + rrow * KS + 128 + rch * 16) = gr; } \
    } while (0)
    LAS float* wsc = (LAS float*)(lds + ATT_WSC + wid * 256);
    f32x16 o0 = {}, o1 = {};
    float mrun = -1e30f, lrun = 0.f;
    const int krow = (r32 & 19) | ((r32 & 4) << 1) | ((r32 & 8) >> 1);
    const int i16 = lane & 15, g16 = lane >> 4;
    const int voff = (8 * hi + (i16 >> 2)) * ATT_VS + (16 * (g16 & 1) + 4 * (i16 & 3)) * 2;
    gr = (u32x4){0u, 0u, 0u, 0u};
    ATT_GLOAD(0); ATT_LSTORE(0); __syncthreads();
    for (int t = 0; t < ntiles; ++t) {
        const int cur = t & 1;
        if (t + 1 < ntiles) ATT_GLOAD(t + 1);
        if (t >= tlo && t < thi) {
            LAS const unsigned char* Kb = lds + cur * ATT_TILE; LAS const unsigned char* Vb = Kb + 64 * KS;
            f32x16 s0 = {}, s1 = {};
#pragma unroll
            for (int ks = 0; ks < NKS; ++ks) {
                const bf16x8 a0 = *(LAS const bf16x8*)(Kb + krow * KS + ks * 32 + hi * 16);
                const bf16x8 a1 = *(LAS const bf16x8*)(Kb + (32 + krow) * KS + ks * 32 + hi * 16);
                s0 = __builtin_amdgcn_mfma_f32_32x32x16_bf16(a0, qf[ks], s0, 0, 0, 0);
                s1 = __builtin_amdgcn_mfma_f32_32x32x16_bf16(a1, qf[ks], s1, 0, 0, 0);
            }
            if constexpr (DIL) {
                const int base = 64 * t + 8 * hi + kofs;
#pragma unroll
                for (int r = 0; r < 16; ++r) {
                    const int pk0 = base + 16 * (r >> 3) + (r & 7), pk1 = pk0 + 32;
                    const bool ok0 = ((unsigned)pk0 < (unsigned)L) && ((unsigned)(pk0 - pq + 64) <= 128u);
                    const bool ok1 = ((unsigned)pk1 < (unsigned)L) && ((unsigned)(pk1 - pq + 64) <= 128u);
                    s0[r] = ok0 ? s0[r] : -INFINITY; s1[r] = ok1 ? s1[r] : -INFINITY;
                }
            }
            float mx = fmaxf(s0[0], s1[0]);
#pragma unroll
            for (int r = 1; r < 16; ++r) mx = fmaxf(mx, fmaxf(s0[r], s1[r]));
            mx = fmaxf(mx, __shfl_xor(mx, 32));
            const float mnew = fmaxf(mrun, mx), alpha = fast_exp2(mrun - mnew);
            mrun = mnew;
            float ps = 0.f;
#pragma unroll
            for (int r = 0; r < 16; ++r) { s0[r] = fast_exp2(s0[r] - mnew); s1[r] = fast_exp2(s1[r] - mnew); ps += s0[r] + s1[r]; }
            lrun = lrun * alpha + ps;
            if (__any(alpha != 1.0f)) {
                if (hi == 0) wsc[r32] = alpha;
#pragma unroll
                for (int g = 0; g < 4; ++g) {
                    const f32x4 av = *(LAS const f32x4*)(wsc + 8 * g + 4 * hi);
#pragma unroll
                    for (int e = 0; e < 4; ++e) { o0[4 * g + e] *= av[e]; o1[4 * g + e] *= av[e]; }
                }
            }
            const bf16x8 pa0 = pack8(s0, 0), pa1 = pack8(s0, 8), pa2 = pack8(s1, 0), pa3 = pack8(s1, 8);
#pragma unroll
            for (int j = 0; j < 4; ++j) {
                const bf16x8 pa = j == 0 ? pa0 : (j == 1 ? pa1 : (j == 2 ? pa2 : pa3));
                LAS const unsigned char* vp = Vb + voff + j * 16 * ATT_VS;
                const s16x4 a = vtr(vp), bq = vtr(vp + 4 * ATT_VS), c = vtr(vp + 64), d = vtr(vp + 64 + 4 * ATT_VS);
                const bf16x8 vf0 = (bf16x8){a[0], a[1], a[2], a[3], bq[0], bq[1], bq[2], bq[3]};
                const bf16x8 vf1 = (bf16x8){c[0], c[1], c[2], c[3], d[0], d[1], d[2], d[3]};
                o0 = __builtin_amdgcn_mfma_f32_32x32x16_bf16(pa, vf0, o0, 0, 0, 0);
                o1 = __builtin_amdgcn_mfma_f32_32x32x16_bf16(pa, vf1, o1, 0, 0, 0);
            }
        }
        if (t + 1 < ntiles) ATT_LSTORE(cur ^ 1);
        __syncthreads();
    }
    const float ltot = lrun + __shfl_xor(lrun, 32);
    if (hi == 0) wsc[r32] = fast_rcp(ltot);
    LAS bf16_t* stg = (LAS bf16_t*)(lds + ATT_OST + wid * 4096);
#pragma unroll
    for (int g = 0; g < 4; ++g) {
        const f32x4 iv = *(LAS const f32x4*)(wsc + 8 * g + 4 * hi);
#pragma unroll
        for (int e = 0; e < 4; ++e) {
            const int r = 4 * g + e, orow = crow(r, hi);
            stg[orow * 64 + r32] = (bf16_t)(cvt_pk_bf16(o0[r] * iv[e], 0.f) & 0xffffu);
            stg[orow * 64 + 32 + r32] = (bf16_t)(cvt_pk_bf16(o1[r] * iv[e], 0.f) & 0xffffu);
        }
    }
    const int wq0 = DIL ? (br < 2 ? q0 + wid * 32 : (wid & 3) * 32) : q0 + wid * 32;
#pragma unroll
    for (int it = 0; it < 4; ++it) {
        const int row = it * 8 + (lane >> 3), ch = lane & 7;
        const u32x4 v = *(LAS const u32x4*)(stg + row * 64 + ch * 8);
        if constexpr (DIL) { const size_t tok = kb + (size_t)(wq0 + row) * dil + res; *(u32x4*)(io.OD + (size_t)br * NT * 512 + tok * 512 + h * 64 + ch * 8) = v; }
        else *(u32x4*)(io.OMIX + (kb + wq0 + row) * 1024 + h * 64 + ch * 8) = v;
    }
    if constexpr (DIL) { if (hi == 0) { const size_t tok = kb + (size_t)pq * dil + res; io.LSE[((size_t)br * NT + tok) * 8 + h] = mrun + __builtin_amdgcn_logf(ltot); } }
}
#undef ATT_GLOAD
#undef ATT_LSTORE

__device__ __forceinline__ float wave_sum(float v) {
#pragma unroll
    for (int o = 1; o < 64; o <<= 1) v += __shfl_xor(v, o);
    return v;
}
__device__ __forceinline__ void tr_block(const float* W, int K, int N, const float* gain, bf16_t* WT, int k0, int n0, int dst_row0, LAS float* scr, int lane) {
#pragma unroll 8
    for (int i = 0; i < 32; ++i) {
        const int kk = 2 * i + (lane >> 5);
        float v = W[(size_t)(k0 + kk) * N + n0 + (lane & 31)];
        if (gain) v *= gain[k0 + kk];
        scr[kk * 33 + (lane & 31)] = v;
    }
    asm volatile("s_waitcnt lgkmcnt(0)" ::: "memory");
    const int c = lane & 7;
#pragma unroll
    for (int j = 0; j < 4; ++j) {
        const int n = (lane >> 3) + 8 * j; const LAS float* s = scr + (8 * c) * 33 + n;
        u32x4 o; o.x = cvt_pk_bf16(s[0 * 33], s[1 * 33]); o.y = cvt_pk_bf16(s[2 * 33], s[3 * 33]); o.z = cvt_pk_bf16(s[4 * 33], s[5 * 33]); o.w = cvt_pk_bf16(s[6 * 33], s[7 * 33]);
        *(u32x4*)(WT + (size_t)(dst_row0 + n) * K + k0 + 8 * c) = o;
    }
    asm volatile("s_waitcnt lgkmcnt(0)" ::: "memory");
}

struct Args {
    const float* in[19]; float* out; unsigned char* ws;
};

__global__ void __launch_bounds__(NWAVES * 64) mk_fwd(Args a) {
    extern __shared__ __attribute__((aligned(16))) unsigned char lds_raw[];
    LAS unsigned char* lds = (LAS unsigned char*)lds_raw;
    cg::grid_group grid = cg::this_grid();
    const int tid = threadIdx.x, lane = tid & 63, wave = __builtin_amdgcn_readfirstlane(tid >> 6);
    const int G = gridDim.x, bx = blockIdx.x;
    const int gw = bx * NWAVES + wave, NGW = G * NWAVES;
    unsigned char* ws = a.ws;
    const float* x = a.in[0];
    const float *g_ffn1 = a.in[1], *w1g = a.in[2], *w1u = a.in[3], *w1d = a.in[4], *g_mix = a.in[5], *w_in = a.in[6], *g_q = a.in[7], *w_uq = a.in[8], *g_kv = a.in[9], *w_ukv = a.in[10],
                *g_mo = a.in[11], *g_do = a.in[12], *w_out = a.in[13], *g_ffn2 = a.in[14], *w2g = a.in[15], *w2u = a.in[16], *w2d = a.in[17], *g_fin = a.in[18];
    float* X = a.out;
    bf16_t *W1GU = (bf16_t*)(ws + WS_W1GU), *W1D = (bf16_t*)(ws + WS_W1D), *W2GU = (bf16_t*)(ws + WS_W2GU), *W2D = (bf16_t*)(ws + WS_W2D), *WIN = (bf16_t*)(ws + WS_WIN),
           *WUQ = (bf16_t*)(ws + WS_WUQ), *WUKV = (bf16_t*)(ws + WS_WUKV), *WOUT = (bf16_t*)(ws + WS_WOUT);
    float *COSM = (float*)(ws + WS_ROPE), *SINM = COSM + 2048 * 16, *COSP = SINM + 2048 * 16, *SINP = COSP + 2048 * 8;
    float *SS0 = (float*)(ws + WS_SS0), *SS1 = (float*)(ws + WS_SS1), *SS2 = (float*)(ws + WS_SS2), *SS3 = (float*)(ws + WS_SS3), *SSQ = (float*)(ws + WS_SSQ), *SSKV = (float*)(ws + WS_SSKV);
    bf16_t *XB = (bf16_t*)(ws + WS_XB), *KVM = (bf16_t*)(ws + WS_KVM), *HB = (bf16_t*)(ws + WS_H), *OD = (bf16_t*)(ws + WS_OD0), *OMIX = (bf16_t*)(ws + WS_OMIX);
    float* LSE = (float*)(ws + WS_LSE);
    bf16_t *QD = (bf16_t*)(ws + WS_QD), *KD = (bf16_t*)(ws + WS_KD), *VD = (bf16_t*)(ws + WS_VD), *CQ = (bf16_t*)(ws + WS_CQ), *CKV = (bf16_t*)(ws + WS_CKV), *KR = (bf16_t*)(ws + WS_KR), *QM = (bf16_t*)(ws + WS_QM);

    {
        LAS float* scr = (LAS float*)(lds + wave * 16384);
        constexpr int I_GU = 16 * 88, I_D = 44 * 32, I_IN = 16 * 69, I_UQ = 6 * 24, I_UKV = 4 * 32, I_OUT = 16 * 32;
        constexpr int NITEMS = 2 * (2 * I_GU + I_D) + I_IN + I_UQ + I_UKV + I_OUT;
        for (int it = gw; it < NITEMS; it += NGW) {
            int r = it;
            if (r < 2 * (2 * I_GU + I_D)) {
                const int f = r / (2 * I_GU + I_D); r -= f * (2 * I_GU + I_D);
                const float* gg = f ? g_ffn2 : g_ffn1; const float* wg = f ? w2g : w1g; const float* wu = f ? w2u : w1u; const float* wd = f ? w2d : w1d;
                bf16_t* GU = f ? W2GU : W1GU; bf16_t* DD = f ? W2D : W1D;
                if (r < 2 * I_GU) { const int s = r >= I_GU; const int q = s ? r - I_GU : r; const int kb_ = q / 88, nb = q % 88, n0 = 32 * nb;
                    tr_block(s ? wu : wg, 1024, FF, gg, GU, 64 * kb_, n0, 256 * (n0 >> 7) + 128 * s + (n0 & 127), scr, lane); }
                else { r -= 2 * I_GU; const int kb_ = r / 32, nb = r % 32; tr_block(wd, FF, 1024, nullptr, DD, 64 * kb_, 32 * nb, 32 * nb, scr, lane); }
                continue;
            }
            r -= 2 * (2 * I_GU + I_D);
            if (r < I_IN) { const int kb_ = r / 69, nb = r % 69, n0 = 32 * nb;
                int dst;
                if (n0 < 384) dst = 1536 + n0; else if (n0 < 640) dst = 2048 + (n0 - 384); else if (n0 < 672) dst = 1920 + (n0 - 640);
                else if (n0 < 1184) dst = n0 - 672; else if (n0 < 1696) dst = 512 + (n0 - 1184); else dst = 1024 + (n0 - 1696);
                tr_block(w_in, 1024, 2208, g_mix, WIN, 64 * kb_, n0, dst, scr, lane); continue; }
            r -= I_IN;
            if (r < I_UQ) { const int kb_ = r / 24, nb = r % 24; tr_block(w_uq, 384, 768, g_q, WUQ, 64 * kb_, 32 * nb, 32 * nb, scr, lane); continue; }
            r -= I_UQ;
            if (r < I_UKV) { const int kb_ = r / 32, nb = r % 32; tr_block(w_ukv, 256, 1024, g_kv, WUKV, 64 * kb_, 32 * nb, 32 * nb, scr, lane); continue; }
            r -= I_UKV;
            { const int kb_ = r / 32, nb = r % 32, k0 = 64 * kb_; tr_block(w_out, 1024, 1024, k0 < 512 ? g_mo : g_do - 512, WOUT, k0, 32 * nb, 32 * nb, scr, lane); }
        }
        for (int i = bx * 512 + tid; i < 96 * 1024 / 8; i += G * 512) *(u32x4*)(WIN + (size_t)1952 * 1024 + (size_t)i * 8) = (u32x4){0u, 0u, 0u, 0u};
        for (int i = bx * 512 + tid; i < 2048 * 24; i += G * 512) {
            int pos, fi; float invf; float *cdst, *sdst;
            if (i < 2048 * 16) { pos = i >> 4; fi = i & 15; invf = exp2f(-(float)fi * (1.0f / 16.0f) * 18.931568569324174f); cdst = COSM + i; sdst = SINM + i; }
            else { const int k = i - 2048 * 16; pos = k >> 3; fi = k & 7; invf = exp2f(-(float)fi * (1.0f / 8.0f) * 18.931568569324174f); cdst = COSP + k; sdst = SINP + k; }
            const float ang = (float)pos * invf;
            const double rev = (double)ang * 0.15915494309189535; const float fr_ = (float)(rev - floor(rev));
            *cdst = __builtin_amdgcn_cosf(fr_); *sdst = __builtin_amdgcn_sinf(fr_);
        }
        for (int row = gw; row < NT; row += NGW) {
            const f32x4* xr = (const f32x4*)(x + (size_t)row * DM) + lane; float s = 0.f;
            unsigned long long* o8 = (unsigned long long*)(XB + (size_t)row * DM) + lane;
#pragma unroll
            for (int j = 0; j < 4; ++j) { const f32x4 v = xr[64 * j]; s += sq4(v); o8[64 * j] = (unsigned long long)cvt_pk_bf16(v[0], v[1]) | ((unsigned long long)cvt_pk_bf16(v[2], v[3]) << 32); }
            s = wave_sum(s);
            if (lane < 16) SS0[(size_t)row * 16 + lane] = lane == 0 ? s : 0.f;
        }
    }
    grid.sync();
    {
        pg8::Gemm g{XB, W1GU, NT, 2 * FF, DM}; pg8::StaticOrder S; S.init(NT, 2 * FF, G, bx);
        EpiGateUp E{HB, SS0};
        pg8::gemm_phase<EpiGateUp, pg8::StaticOrder, true, true>(lds, g, S, E);
    }
    grid.sync();
    {
        pg8::Gemm g{HB, W1D, NT, DM, FF}; pg8::StaticOrder S; S.init(NT, DM, G, bx);
        EpiResid E{x, X, XB, SS1, 0.5f};
        pg8::gemm_phase<EpiResid, pg8::StaticOrder, true, true>(lds, g, S, E);
    }
    grid.sync();
    {
        pg8::Gemm g{XB, WIN, NT, 2304, DM}; pg8::StaticOrder S; S.init(NT, 2304, G, bx);
        EpiInProj E{SS1, QD, KD, VD, CQ, CKV, KR, SSQ, SSKV, COSM, SINM, COSP, SINP};
        pg8::gemm_phase<EpiInProj, pg8::StaticOrder, true, true>(lds, g, S, E);
    }
    grid.sync();
    {
        { pg8::Gemm g{CQ, WUQ, NT, 768, 384}; pg8::StaticOrder S; S.init(NT, 768, G, bx); EpiQ E{SSQ, QM, COSM, SINM};
          pg8::gemm_phase<EpiQ, pg8::StaticOrder, true, true>(lds, g, S, E); }
        { pg8::Gemm g{CKV, WUKV, NT, 1024, 256}; pg8::StaticOrder S; S.init(NT, 1024, G, bx); EpiKV E{SSKV, KVM};
          pg8::gemm_phase<EpiKV, pg8::StaticOrder, true, true>(lds, g, S, E); }
        __syncthreads();
        AttnIO io{QM, KVM, KR, OMIX, QD, KD, VD, OD, LSE};
        for (int u = bx; u < 256 * 24; u += G) attn_unit<true>(lds, io, u);
    }
    grid.sync();
    {
        AttnIO io{QM, KVM, KR, OMIX, QD, KD, VD, OD, LSE};
        for (int u = bx; u < 256 * 8; u += G) attn_unit<false>(lds, io, u);
    }
    grid.sync();
    for (int row = gw; row < NT; row += NGW) {
        {
            u32x4* p = (u32x4*)(OMIX + (size_t)row * 1024 + lane * 8); const u32x4 w = *p; float v[8];
#pragma unroll
            for (int e = 0; e < 4; ++e) { v[2 * e] = __uint_as_float(w[e] << 16); v[2 * e + 1] = __uint_as_float(w[e] & 0xffff0000u); }
            float s = 0.f;
#pragma unroll
            for (int e = 0; e < 8; ++e) s += v[e] * v[e];
            const float rs = rsqrtf(wave_sum(s) * (1.0f / 512.0f) + EPS);
            u32x4 o; o.x = cvt_pk_bf16(v[0] * rs, v[1] * rs); o.y = cvt_pk_bf16(v[2] * rs, v[3] * rs); o.z = cvt_pk_bf16(v[4] * rs, v[5] * rs); o.w = cvt_pk_bf16(v[6] * rs, v[7] * rs);
            *p = o;
        }
        {
            const int hd = lane >> 3;
            const float l0 = LSE[((size_t)0 * NT + row) * 8 + hd], l1 = LSE[((size_t)1 * NT + row) * 8 + hd], l2 = LSE[((size_t)2 * NT + row) * 8 + hd];
            const float mx = fmaxf(l0, fmaxf(l1, l2));
            float w0 = fast_exp2(l0 - mx), w1 = fast_exp2(l1 - mx), w2 = fast_exp2(l2 - mx);
            const float inv = 1.0f / (w0 + w1 + w2); w0 *= inv; w1 *= inv; w2 *= inv;
            float v[8];
#pragma unroll
            for (int e = 0; e < 8; ++e) v[e] = 0.f;
#pragma unroll
            for (int n = 0; n < 3; ++n) {
                const u32x4 w = *(const u32x4*)(OD + (size_t)n * NT * 512 + (size_t)row * 512 + lane * 8); const float wn = n == 0 ? w0 : (n == 1 ? w1 : w2);
#pragma unroll
                for (int e = 0; e < 4; ++e) { v[2 * e] += wn * __uint_as_float(w[e] << 16); v[2 * e + 1] += wn * __uint_as_float(w[e] & 0xffff0000u); }
            }
            float s = 0.f;
#pragma unroll
            for (int e = 0; e < 8; ++e) s += v[e] * v[e];
            const float rs = rsqrtf(wave_sum(s) * (1.0f / 512.0f) + EPS);
            u32x4 o; o.x = cvt_pk_bf16(v[0] * rs, v[1] * rs); o.y = cvt_pk_bf16(v[2] * rs, v[3] * rs); o.z = cvt_pk_bf16(v[4] * rs, v[5] * rs); o.w = cvt_pk_bf16(v[6] * rs, v[7] * rs);
            *(u32x4*)(OMIX + (size_t)row * 1024 + 512 + lane * 8) = o;
        }
    }
    grid.sync();
    {
        pg8::Gemm g{OMIX, WOUT, NT, DM, DM}; pg8::StaticOrder S; S.init(NT, DM, G, bx);
        EpiResid E{X, X, XB, SS2, 1.0f};
        pg8::gemm_phase<EpiResid, pg8::StaticOrder, true, true>(lds, g, S, E);
    }
    grid.sync();
    {
        pg8::Gemm g{XB, W2GU, NT, 2 * FF, DM}; pg8::StaticOrder S; S.init(NT, 2 * FF, G, bx);
        EpiGateUp E{HB, SS2};
        pg8::gemm_phase<EpiGateUp, pg8::StaticOrder, true, true>(lds, g, S, E);
    }
    grid.sync();
    {
        pg8::Gemm g{HB, W2D, NT, DM, FF}; pg8::StaticOrder S; S.init(NT, DM, G, bx);
        EpiResid E{X, X, nullptr, SS3, 0.5f};
        pg8::gemm_phase<EpiResid, pg8::StaticOrder, true, true>(lds, g, S, E);
    }
    grid.sync();
    for (int row = gw; row < NT; row += NGW) {
        const float rs = rstd_parts16(SS3, row, 1.0f / 1024.0f);
        f32x4* xr = (f32x4*)(X + (size_t)row * DM) + lane; const f32x4* gr = (const f32x4*)g_fin + lane;
#pragma unroll
        for (int j = 0; j < 4; ++j) { const f32x4 v = xr[64 * j] * rs * gr[64 * j]; xr[64 * j] = v; }
    }
}

extern "C" void kernel_launch(void* const* d_in, const int* in_sizes, int n_in, void* d_out, int out_size, void* d_ws, size_t ws_size, hipStream_t stream) {
    constexpr int LDS_BYTES = 131072;
    static int grid = 0;
    if (grid == 0) {
        if (n_in != 19 || in_sizes[0] != NT * DM || out_size != NT * DM || ws_size < WS_END) {
            fprintf(stderr, "kernel_launch: unexpected problem geometry (n_in %d, in0 %d, out %d, ws %zu); nothing launched\n", n_in, n_in > 0 ? in_sizes[0] : -1, out_size, ws_size); grid = -1; return; }
        int dev = 0, cus = 0, per_cu = 0;
        hipGetDevice(&dev); hipDeviceGetAttribute(&cus, hipDeviceAttributeMultiprocessorCount, dev);
        if (hipFuncSetAttribute((const void*)mk_fwd, hipFuncAttributeMaxDynamicSharedMemorySize, LDS_BYTES) != hipSuccess) { fprintf(stderr, "kernel_launch: hipFuncSetAttribute failed\n"); grid = -1; return; }
        if (hipOccupancyMaxActiveBlocksPerMultiprocessor(&per_cu, (const void*)mk_fwd, NWAVES * 64, LDS_BYTES) != hipSuccess || per_cu < 1) { fprintf(stderr, "kernel_launch: occupancy query says %d blocks per CU\n", per_cu); per_cu = 1; }
        (void)hipGetLastError();
        grid = cus;
    }
    if (grid < 0) return;
    Args a{};
    for (int i = 0; i < 19; ++i) a.in[i] = (const float*)d_in[i];
    a.out = (float*)d_out; a.ws = (unsigned char*)d_ws;
    void* args[] = {&a};
    hipError_t e = hipLaunchCooperativeKernel((const void*)mk_fwd, dim3(grid), dim3(NWAVES * 64), args, LDS_BYTES, stream);
    if (e != hipSuccess) fprintf(stderr, "kernel_launch: cooperative launch failed: %s (grid %d)\n", hipGetErrorString(e), grid);
}
```

```cpp
#include <hip/hip_runtime.h>
#include <hip/hip_cooperative_groups.h>
#include <cmath>
#include <cstdio>
#include <cstdint>
namespace pg8 {
#define PG8_LAS __attribute__((address_space(3)))
typedef unsigned short bf16_t;
typedef short bf16x8 __attribute__((ext_vector_type(8)));
typedef float f32x4 __attribute__((ext_vector_type(4)));
typedef unsigned u32x4 __attribute__((ext_vector_type(4)));
constexpr int BM = 256, BK = 64, HALF = 128, HTB = HALF * BK * 2  , STAGE_BYTES = 8 * HTB, NXCD = 8, WGM = 8;

__host__ __device__ __forceinline__ int lds_byte(int r, int c) { const int st = (r >> 4) * 2 + (c >> 5), rr = r & 15, cc = c & 31, ob = rr * 64 + cc * 2; return st * 1024 + (ob ^ (((ob >> 9) & 1) << 5)); }
__host__ __device__ __forceinline__ void stage_rc(int b, int& R, int& C) { const int st = b / 1024, sb = b % 1024, swz = sb ^ (((sb >> 9) & 1) << 5); R = (st >> 1) * 16 + swz / 64; C = (st & 1) * 32 + (swz % 64) / 2; }
__host__ __device__ __forceinline__ int perm32(int rho) { const int n = rho >> 4, i = rho & 15; return 8 * (i >> 2) + 4 * n + (i & 3); }

struct Unit { int pm, pn; };
struct Gemm { const bf16_t* A; const bf16_t* Bt; int M, N, K; };

struct StaticOrder {
    int nM, nN, nwg, G, c;
    __host__ __device__ void init(int M, int N, int G_, int c_) { nM = M / BM; nN = N / BM; nwg = nM * nN; G = G_; c = c_; }
    __host__ __device__ bool next(int i, Unit& u) const {
        const long L = (long)i * G + c; if (L >= nwg) return false;
        int wgid = (int)L; { const int q = nwg / NXCD, r = nwg % NXCD, xcd = wgid % NXCD, off = wgid / NXCD; wgid = (xcd < r ? xcd * (q + 1) : r * (q + 1) + (xcd - r) * q) + off; }
        const int nig = WGM * nN, gid = wgid / nig, fm = gid * WGM, gsz = (nM - fm) < WGM ? (nM - fm) : WGM;
        u.pm = fm + ((wgid % nig) % gsz); u.pn = (wgid % nig) / gsz; return true;
    }
    __device__ __forceinline__ void a_ready(const Unit&) const {}
    __device__ __forceinline__ void done(const Unit&) const {}
};

__device__ __forceinline__ unsigned cvt_pk_bf16(float lo, float hi) { unsigned r; asm volatile("v_cvt_pk_bf16_f32 %0, %1, %2" : "=v"(r) : "v"(lo), "v"(hi)); return r; }

template <class Epi, class Sched, bool ALIGN_EPI = false, bool SP2 = false>
__device__ __forceinline__ void gemm_phase(PG8_LAS unsigned char* lds, const Gemm g, const Sched& S, const Epi& E) {
    int tid_ = threadIdx.x; asm volatile("" : "+v"(tid_));
    const int tid = tid_, wid = __builtin_amdgcn_readfirstlane(tid >> 6), lane = tid & 63, wr = wid >> 2, wc = wid & 3, fr = lane & 15, fq = lane >> 4;
    const int K = g.K, nt = K / BK;
    unsigned voffA[2], voffB[2];
#pragma unroll
    for (int i = 0; i < 2; ++i) { int R, C; stage_rc(tid * 16 + i * 8192, R, C); const int Rb = Epi::PERM ? ((R & ~31) + perm32(R & 31)) : R;
        voffA[i] = (unsigned)(R * K + C) * 2u; voffB[i] = (unsigned)(Rb * K + C) * 2u; }
    const size_t kstep = (size_t)(BK * 2);
    const size_t hstep = (size_t)HALF * K * 2;
    const size_t tstep = 2 * hstep;
    const unsigned ldsw = (unsigned)wid * 1024u;
    const int aoff = lds_byte(wr * 64 + fr, fq * 8), boff = lds_byte(wc * 32 + fr, fq * 8);
#define PG8_SA(b, h) (((b) * 2 + (h)) * HTB)
#define PG8_SB(b, h) ((4 + (b) * 2 + (h)) * HTB)
#define PG8_STAGE(bufoff, gbase, voff) do { _Pragma("unroll") for (int _i = 0; _i < 2; ++_i) \
        __builtin_amdgcn_global_load_lds((const unsigned*)((const char*)(gbase) + (voff)[_i]), (PG8_LAS unsigned*)(lds + (bufoff) + ldsw + _i * 8192), 16, 0, 0); } while (0)
#define PG8_LDA(dst, b, h) do { _Pragma("unroll") for (int m = 0; m < 4; ++m) _Pragma("unroll") for (int k = 0; k < 2; ++k) dst[m][k] = *(const PG8_LAS bf16x8*)(lds + PG8_SA(b, h) + aoff + m * 2048 + k * 1024); } while (0)
#define PG8_LDB(dst, b, h) do { _Pragma("unroll") for (int n = 0; n < 2; ++n) _Pragma("unroll") for (int k = 0; k < 2; ++k) dst[n][k] = *(const PG8_LAS bf16x8*)(lds + PG8_SB(b, h) + boff + n * 2048 + k * 1024); } while (0)
#define PG8_MMA(ai, bj, At, Bt) do { __builtin_amdgcn_s_setprio(1); _Pragma("unroll") for (int m = 0; m < 4; ++m) _Pragma("unroll") for (int n = 0; n < 2; ++n) _Pragma("unroll") for (int k = 0; k < 2; ++k) \
        acc[ai][bj][m][n] = __builtin_amdgcn_mfma_f32_16x16x32_bf16(Bt[n][k], At[m][k], acc[ai][bj][m][n], 0, 0, 0); __builtin_amdgcn_s_setprio(0); } while (0)
#define PG8_WAIT_V(n) asm volatile("s_waitcnt vmcnt(" #n ")" ::: "memory")
#define PG8_WAIT_L(n) asm volatile("s_waitcnt lgkmcnt(" #n ")" ::: "memory")
#define PG8_BAR __builtin_amdgcn_s_barrier()
#define PG8_SCHED __builtin_amdgcn_sched_barrier(0)
    Unit cur, nxt; int ui = 0;
    if (!S.next(0, cur)) return;
    f32x4 acc[2][2][4][2];
#pragma unroll
    for (int a = 0; a < 2; ++a)
#pragma unroll
        for (int b = 0; b < 2; ++b)
#pragma unroll
            for (int m = 0; m < 4; ++m)
#pragma unroll
                for (int n = 0; n < 2; ++n) acc[a][b][m][n] = (f32x4){0.f, 0.f, 0.f, 0.f};
    bf16x8 At[4][2], B0[2][2], B1[2][2];
    const char* cA = (const char*)g.A + (size_t)cur.pm * tstep; const char* cB = (const char*)g.Bt + (size_t)cur.pn * tstep;
    S.a_ready(cur);
    if constexpr (SP2) {
        PG8_STAGE(PG8_SB(0, 0), cB, voffB); PG8_STAGE(PG8_SB(0, 1), cB + hstep, voffB); PG8_STAGE(PG8_SA(0, 0), cA, voffA); PG8_STAGE(PG8_SA(0, 1), cA + hstep, voffA);
        if (wr == 1) PG8_BAR;
        PG8_WAIT_V(2); PG8_BAR;
        PG8_STAGE(PG8_SB(1, 0), cB + kstep, voffB); PG8_STAGE(PG8_SA(1, 0), cA + kstep, voffA); PG8_STAGE(PG8_SB(1, 1), cB + hstep + kstep, voffB);
        PG8_WAIT_V(6); PG8_BAR;
    } else {
        PG8_STAGE(PG8_SB(0, 0), cB, voffB); PG8_STAGE(PG8_SA(0, 0), cA, voffA); PG8_STAGE(PG8_SB(0, 1), cB + hstep, voffB); PG8_STAGE(PG8_SA(0, 1), cA + hstep, voffA);
        if (wr == 1) PG8_BAR;
        PG8_WAIT_V(4); PG8_BAR;
        PG8_STAGE(PG8_SB(1, 0), cB + kstep, voffB); PG8_STAGE(PG8_SA(1, 0), cA + kstep, voffA); PG8_STAGE(PG8_SB(1, 1), cB + hstep + kstep, voffB);
        PG8_WAIT_V(6); PG8_BAR;
    }
    for (;;) {
        const bool has_next = S.next(ui + 1, nxt);
        const char* nA = has_next ? (const char*)g.A + (size_t)nxt.pm * tstep : cA; const char* nB = has_next ? (const char*)g.Bt + (size_t)nxt.pn * tstep : cB;
        for (int t = 0; t < nt; t += 2) {
            const bool last = (t == nt - 2);
            const char* a1 = cA + (size_t)(t + 1) * kstep;
            const char* a2 = last ? nA : cA + (size_t)(t + 2) * kstep; const char* b2 = last ? nB : cB + (size_t)(t + 2) * kstep;
            const char* a3 = a2 + kstep; const char* b3 = b2 + kstep;
            if (last && has_next) S.a_ready(nxt);
            if constexpr (SP2) {
            PG8_LDB(B0, 0, 0); PG8_LDB(B1, 0, 1); PG8_SCHED; PG8_LDA(At, 0, 0); PG8_STAGE(PG8_SA(1, 1), a1 + hstep, voffA);
            PG8_WAIT_V(8); PG8_WAIT_L(0); PG8_BAR; PG8_MMA(0, 0, At, B0); PG8_MMA(0, 1, At, B1); PG8_BAR; PG8_SCHED;
            PG8_LDA(At, 0, 1); PG8_STAGE(PG8_SB(0, 0), b2, voffB); PG8_STAGE(PG8_SB(0, 1), b2 + hstep, voffB); PG8_STAGE(PG8_SA(0, 0), a2, voffA);
            PG8_WAIT_V(8); PG8_WAIT_L(0); PG8_BAR; PG8_MMA(1, 0, At, B0); PG8_MMA(1, 1, At, B1); PG8_BAR; PG8_SCHED;
            PG8_LDB(B0, 1, 0); PG8_LDB(B1, 1, 1); PG8_SCHED; PG8_LDA(At, 1, 0); PG8_STAGE(PG8_SA(0, 1), a2 + hstep, voffA);
            PG8_WAIT_V(8); PG8_WAIT_L(0); PG8_BAR; PG8_MMA(0, 0, At, B0); PG8_MMA(0, 1, At, B1); PG8_BAR; PG8_SCHED;
            PG8_LDA(At, 1, 1); PG8_STAGE(PG8_SB(1, 0), b3, voffB); PG8_STAGE(PG8_SB(1, 1), b3 + hstep, voffB); PG8_STAGE(PG8_SA(1, 0), a3, voffA);
            PG8_WAIT_V(8); PG8_WAIT_L(0); PG8_BAR; PG8_MMA(1, 0, At, B0); PG8_MMA(1, 1, At, B1); PG8_BAR; PG8_SCHED;
            } else {
            PG8_LDB(B0, 0, 0); PG8_SCHED; PG8_LDA(At, 0, 0); PG8_STAGE(PG8_SA(1, 1), a1 + hstep, voffA);
            PG8_WAIT_L(8); PG8_BAR; PG8_WAIT_L(0); PG8_MMA(0, 0, At, B0); PG8_BAR; PG8_SCHED;
            PG8_LDB(B1, 0, 1); PG8_STAGE(PG8_SB(0, 0), b2, voffB);
            PG8_BAR; PG8_WAIT_L(0); PG8_MMA(0, 1, At, B1); PG8_BAR;
            PG8_LDA(At, 0, 1); PG8_STAGE(PG8_SA(0, 0), a2, voffA);
            PG8_BAR; PG8_WAIT_L(0); PG8_MMA(1, 0, At, B0); PG8_BAR; PG8_SCHED;
            PG8_STAGE(PG8_SB(0, 1), b2 + hstep, voffB);
            PG8_WAIT_V(6); PG8_BAR; PG8_MMA(1, 1, At, B1); PG8_BAR;
            PG8_LDB(B0, 1, 0); PG8_SCHED; PG8_LDA(At, 1, 0); PG8_STAGE(PG8_SA(0, 1), a2 + hstep, voffA);
            PG8_WAIT_L(8); PG8_BAR; PG8_WAIT_L(0); PG8_MMA(0, 0, At, B0); PG8_BAR; PG8_SCHED;
            PG8_LDB(B1, 1, 1); PG8_STAGE(PG8_SB(1, 0), b3, voffB);
            PG8_BAR; PG8_WAIT_L(0); PG8_MMA(0, 1, At, B1); PG8_BAR;
            PG8_LDA(At, 1, 1); PG8_STAGE(PG8_SA(1, 0), a3, voffA);
            PG8_BAR; PG8_WAIT_L(0); PG8_MMA(1, 0, At, B0); PG8_BAR; PG8_SCHED;
            PG8_STAGE(PG8_SB(1, 1), b3 + hstep, voffB);
            PG8_WAIT_V(6); PG8_BAR; PG8_MMA(1, 1, At, B1); PG8_BAR;
            }
        }
        if constexpr (ALIGN_EPI) { if (wr == 0) PG8_BAR; }
        if constexpr (!Epi::AFTER_DRAIN) { E(acc, cur, wr, wc, fr, fq); S.done(cur); }
        if (!has_next) break;
#pragma unroll
        for (int a = 0; a < 2; ++a)
#pragma unroll
            for (int b = 0; b < 2; ++b)
#pragma unroll
                for (int m = 0; m < 4; ++m)
#pragma unroll
                    for (int n = 0; n < 2; ++n) acc[a][b][m][n] = (f32x4){0.f, 0.f, 0.f, 0.f};
        cur = nxt; cA = nA; cB = nB; ++ui;
        if constexpr (ALIGN_EPI) { if (wr == 1) PG8_BAR; }
    }
    PG8_WAIT_V(0);
    if constexpr (!ALIGN_EPI) { if (wr == 0) PG8_BAR; }
    PG8_BAR;
    if constexpr (Epi::AFTER_DRAIN) { E.fused(acc, cur, wr, wc, fr, fq, lds, wid, lane); S.done(cur); }
#undef PG8_SA
#undef PG8_SB
#undef PG8_STAGE
#undef PG8_LDA
#undef PG8_LDB
#undef PG8_MMA
#undef PG8_WAIT_V
#undef PG8_WAIT_L
#undef PG8_BAR
#undef PG8_SCHED
}
}

namespace cg = cooperative_groups;

#define LAS __attribute__((address_space(3)))
typedef unsigned short bf16_t;
typedef float f32x4 __attribute__((ext_vector_type(4)));
typedef float f32x16 __attribute__((ext_vector_type(16)));
typedef short bf16x8 __attribute__((ext_vector_type(8)));
typedef short s16x4 __attribute__((ext_vector_type(4)));
typedef unsigned u32x2 __attribute__((ext_vector_type(2)));
typedef unsigned u32x4 __attribute__((ext_vector_type(4)));
using pg8::Unit;
typedef float f32x2_t __attribute__((ext_vector_type(2))); typedef __bf16 bf16x2_t __attribute__((ext_vector_type(2)));
__device__ __forceinline__ unsigned cvt_pk_bf16(float lo, float hi) { const f32x2_t v = {lo, hi}; const bf16x2_t b = __builtin_convertvector(v, bf16x2_t); return __builtin_bit_cast(unsigned, b); }

constexpr int NT = 65536, SEQ = 2048, DM = 1024, FF = 2816, NWAVES = 8;
constexpr float EPS = 1e-6f, LOG2E = 1.4426950408889634f;
constexpr float QSCALE_D = 0.125f * LOG2E;
constexpr float QSCALE_M = 0.10206207261596577f * LOG2E;

constexpr size_t MiB = 1u << 20;
constexpr size_t WS_W1GU = 0, WS_W1D = 11 * MiB, WS_W2GU = 17 * MiB, WS_W2D = 28 * MiB, WS_WIN = 34 * MiB, WS_WUQ = 39 * MiB, WS_WUKV = 40 * MiB, WS_WOUT = 41 * MiB;
constexpr size_t WS_ROPE = 43 * MiB;
constexpr size_t WS_SS0 = 44 * MiB, WS_SS1 = 48 * MiB, WS_SS2 = 52 * MiB, WS_SS3 = 56 * MiB, WS_SSQ = 60 * MiB, WS_SSKV = 62 * MiB;
constexpr size_t WS_XB = 64 * MiB;
constexpr size_t WS_KVM = WS_XB;
constexpr size_t WS_H = 192 * MiB;
constexpr size_t WS_OD0 = 192 * MiB, WS_OD1 = 256 * MiB, WS_OD2 = 320 * MiB, WS_OMIX = 384 * MiB, WS_LSE = 512 * MiB;
constexpr size_t WS_QD = 544 * MiB, WS_KD = 608 * MiB, WS_VD = 672 * MiB, WS_CQ = 736 * MiB, WS_CKV = 784 * MiB, WS_KR = 816 * MiB, WS_QM = 820 * MiB, WS_END = 916 * MiB;

__device__ __forceinline__ float fast_exp2(float x) { return __builtin_amdgcn_exp2f(x); }
__device__ __forceinline__ float fast_rcp(float x) { return __builtin_amdgcn_rcpf(x); }
__device__ __forceinline__ float bf2f(unsigned short b) { return __uint_as_float((unsigned)b << 16); }
__device__ __forceinline__ float sum4(f32x4 a) { return (a[0] + a[1]) + (a[2] + a[3]); }
__device__ __forceinline__ float sq4(f32x4 a) { return (a[0] * a[0] + a[1] * a[1]) + (a[2] * a[2] + a[3] * a[3]); }
__device__ __forceinline__ float rstd_parts16(const float* ss, int row, float invn) {
    const f32x4* p = (const f32x4*)(ss + (size_t)row * 16);
    const float s = (sum4(p[0]) + sum4(p[1])) + (sum4(p[2]) + sum4(p[3]));
    return rsqrtf(s * invn + EPS);
}

#define EPI_RELANE() int fr, fq; { int t_ = threadIdx.x; asm volatile("" : "+v"(t_)); fr = t_ & 15; fq = (t_ >> 4) & 3; }
struct EpiGateUp {
    static constexpr bool PERM = true, AFTER_DRAIN = false;
    bf16_t* H; const float* ss;
    __device__ __forceinline__ void operator()(const f32x4 (&acc)[2][2][4][2], const Unit& u, int wr, int wc, int fr_in, int fq_in) const {
        EPI_RELANE();
        const int row0 = u.pm * 256 + wr * 64 + fr, col = u.pn * 128 + wc * 32 + 8 * fq;
#pragma unroll
        for (int ai = 0; ai < 2; ++ai)
#pragma unroll
            for (int m = 0; m < 4; ++m) {
                const int row = row0 + ai * 128 + m * 16;
                const float rs = rstd_parts16(ss, row, 1.0f / 1024.0f);
                float o[8];
#pragma unroll
                for (int n = 0; n < 2; ++n)
#pragma unroll
                    for (int j = 0; j < 4; ++j) {
                        const float g = acc[ai][0][m][n][j] * rs, up = acc[ai][1][m][n][j] * rs;
                        o[4 * n + j] = g * fast_rcp(1.0f + fast_exp2(-g * LOG2E)) * up;
                    }
                u32x4 w; w.x = cvt_pk_bf16(o[0], o[1]); w.y = cvt_pk_bf16(o[2], o[3]); w.z = cvt_pk_bf16(o[4], o[5]); w.w = cvt_pk_bf16(o[6], o[7]);
                *(u32x4*)(H + (size_t)row * FF + col) = w;
            }
    }
};
struct EpiResid {
    static constexpr bool PERM = false, AFTER_DRAIN = false;
    const float* base; float* out; bf16_t* xb; float* ss; float alpha;
    __device__ __forceinline__ void operator()(const f32x4 (&acc)[2][2][4][2], const Unit& u, int wr, int wc, int fr_in, int fq_in) const {
        EPI_RELANE();
        const int row0 = u.pm * 256 + wr * 64 + fr, col0 = u.pn * 256 + wc * 32 + 4 * fq;
#pragma unroll
        for (int ai = 0; ai < 2; ++ai)
#pragma unroll
            for (int m = 0; m < 4; ++m) {
                const int row = row0 + ai * 128 + m * 16; float sq = 0.f;
#pragma unroll
                for (int bj = 0; bj < 2; ++bj)
#pragma unroll
                    for (int n = 0; n < 2; ++n) {
                        const size_t off = (size_t)row * DM + col0 + bj * 128 + n * 16;
                        const f32x4 b = *(const f32x4*)(base + off);
                        const f32x4 v = b + acc[ai][bj][m][n] * alpha;
                        *(f32x4*)(out + off) = v; sq += sq4(v);
                        if (xb) { u32x2 w; w.x = cvt_pk_bf16(v[0], v[1]); w.y = cvt_pk_bf16(v[2], v[3]); *(u32x2*)(xb + off) = w; }
                    }
                sq += __shfl_xor(sq, 16); sq += __shfl_xor(sq, 32);
                if (fq == 0) ss[(size_t)row * 16 + u.pn * 4 + wc] = sq;
            }
    }
};
struct EpiInProj {
    static constexpr bool PERM = false, AFTER_DRAIN = false;
    const float* ss1; bf16_t *QD, *KD, *VD, *CQ, *CKV, *KR; float *SSQ, *SSKV; const float *cosm, *sinm, *cosp, *sinp;
    __device__ __forceinline__ void operator()(const f32x4 (&acc)[2][2][4][2], const Unit& u, int wr, int wc, int fr_in, int fq_in) const {
        EPI_RELANE();
        const int row0 = u.pm * 256 + wr * 64 + fr, pn = u.pn;
#pragma unroll
        for (int ai = 0; ai < 2; ++ai)
#pragma unroll
            for (int m = 0; m < 4; ++m) {
                const int row = row0 + ai * 128 + m * 16, pos = row & (SEQ - 1);
                const float rs = rstd_parts16(ss1, row, 1.0f / 1024.0f);
                if (pn < 6) {
                    bf16_t* dst = QD + (size_t)(pn >> 1) * ((size_t)NT * 512) + (size_t)row * 512 + (pn & 1) * 256 + wc * 32 + 4 * fq;
                    const float sc = pn < 2 ? rs * QSCALE_D : rs;
                    const bool rope = (pn < 4) && ((wc & 1) == 0);
#pragma unroll
                    for (int bj = 0; bj < 2; ++bj)
#pragma unroll
                        for (int n = 0; n < 2; ++n) {
                            f32x4 v = acc[ai][bj][m][n] * sc;
                            if (n == 0 && rope) {
                                f32x4 pv; pv[0] = __shfl_xor(v[0], 32); pv[1] = __shfl_xor(v[1], 32); pv[2] = __shfl_xor(v[2], 32); pv[3] = __shfl_xor(v[3], 32);
                                const f32x4 c = *(const f32x4*)(cosp + pos * 8 + 4 * (fq & 1)), s = *(const f32x4*)(sinp + pos * 8 + 4 * (fq & 1));
                                v = (fq < 2) ? (v * c - pv * s) : (v * c + pv * s);
                            }
                            u32x2 w; w.x = cvt_pk_bf16(v[0], v[1]); w.y = cvt_pk_bf16(v[2], v[3]);
                            *(u32x2*)(dst + bj * 128 + n * 16) = w;
                        }
                } else if (pn == 6 || pn == 8) {
                    bf16_t* dst = CQ + (pn == 6 ? (size_t)row * 384 : (size_t)NT * 384 + (size_t)row * 256) + wc * 32 + 4 * fq; float sq = 0.f;
#pragma unroll
                    for (int bj = 0; bj < 2; ++bj)
#pragma unroll
                        for (int n = 0; n < 2; ++n) {
                            const f32x4 v = acc[ai][bj][m][n] * rs; sq += sq4(v);
                            u32x2 w; w.x = cvt_pk_bf16(v[0], v[1]); w.y = cvt_pk_bf16(v[2], v[3]);
                            *(u32x2*)(dst + bj * 128 + n * 16) = w;
                        }
                    sq += __shfl_xor(sq, 16); sq += __shfl_xor(sq, 32);
                    if (fq == 0) SSQ[(pn == 6 ? (size_t)row * 8 : (size_t)NT * 8 + (size_t)row * 4) + wc] = sq;
                } else {
                    bf16_t* dst = CQ + (size_t)row * 384 + 256 + wc * 32 + 4 * fq; float sq = 0.f;
#pragma unroll
                    for (int n = 0; n < 2; ++n) {
                        const f32x4 v = acc[ai][0][m][n] * rs; sq += sq4(v);
                        u32x2 w; w.x = cvt_pk_bf16(v[0], v[1]); w.y = cvt_pk_bf16(v[2], v[3]);
                        *(u32x2*)(dst + n * 16) = w;
                    }
                    sq += __shfl_xor(sq, 16); sq += __shfl_xor(sq, 32);
                    if (fq == 0) SSQ[(size_t)row * 8 + 4 + wc] = sq;
                    if (wc == 0) {
                        const f32x4 x1 = acc[ai][1][m][0] * rs, x2 = acc[ai][1][m][1] * rs;
                        const f32x4 c = *(const f32x4*)(cosm + pos * 16 + 4 * fq), s = *(const f32x4*)(sinm + pos * 16 + 4 * fq);
                        const f32x4 o1 = x1 * c - x2 * s, o2 = x2 * c + x1 * s;
                        u32x2 w1, w2; w1.x = cvt_pk_bf16(o1[0], o1[1]); w1.y = cvt_pk_bf16(o1[2], o1[3]); w2.x = cvt_pk_bf16(o2[0], o2[1]); w2.y = cvt_pk_bf16(o2[2], o2[3]);
                        *(u32x2*)(KR + (size_t)row * 32 + 4 * fq) = w1; *(u32x2*)(KR + (size_t)row * 32 + 16 + 4 * fq) = w2;
                    }
                }
            }
    }
};
struct EpiQ {
    static constexpr bool PERM = false, AFTER_DRAIN = false;
    const float* ssq; bf16_t* QM; const float *cosm, *sinm;
    __device__ __forceinline__ void operator()(const f32x4 (&acc)[2][2][4][2], const Unit& u, int wr, int wc, int fr_in, int fq_in) const {
        EPI_RELANE();
        const int row0 = u.pm * 256 + wr * 64 + fr;
#pragma unroll
        for (int ai = 0; ai < 2; ++ai)
#pragma unroll
            for (int m = 0; m < 4; ++m) {
                const int row = row0 + ai * 128 + m * 16, pos = row & (SEQ - 1);
                const f32x4* p = (const f32x4*)(ssq + (size_t)row * 8);
                const float rs = rsqrtf((sum4(p[0]) + sum4(p[1])) * (1.0f / 384.0f) + EPS) * QSCALE_M;
#pragma unroll
                for (int bj = 0; bj < 2; ++bj) {
                    const int g32 = 8 * u.pn + 4 * bj + wc;
                    bf16_t* dst = QM + (size_t)row * 768 + 32 * g32 + 4 * fq;
                    f32x4 v0 = acc[ai][bj][m][0] * rs, v1 = acc[ai][bj][m][1] * rs;
                    if (g32 % 3 == 2) {
                        const f32x4 c = *(const f32x4*)(cosm + pos * 16 + 4 * fq), s = *(const f32x4*)(sinm + pos * 16 + 4 * fq);
                        const f32x4 o1 = v0 * c - v1 * s, o2 = v1 * c + v0 * s; v0 = o1; v1 = o2;
                    }
                    u32x2 w0, w1; w0.x = cvt_pk_bf16(v0[0], v0[1]); w0.y = cvt_pk_bf16(v0[2], v0[3]); w1.x = cvt_pk_bf16(v1[0], v1[1]); w1.y = cvt_pk_bf16(v1[2], v1[3]);
                    *(u32x2*)dst = w0; *(u32x2*)(dst + 16) = w1;
                }
            }
    }
};
struct EpiKV {
    static constexpr bool PERM = true, AFTER_DRAIN = false;
    const float* sskv; bf16_t* KVM;
    __device__ __forceinline__ void operator()(const f32x4 (&acc)[2][2][4][2], const Unit& u, int wr, int wc, int fr_in, int fq_in) const {
        EPI_RELANE();
        const int row0 = u.pm * 256 + wr * 64 + fr, col = u.pn * 256 + wc * 32 + 8 * fq;
#pragma unroll
        for (int ai = 0; ai < 2; ++ai)
#pragma unroll
            for (int m = 0; m < 4; ++m) {
                const int row = row0 + ai * 128 + m * 16;
                const float rs = rsqrtf(sum4(*(const f32x4*)(sskv + (size_t)row * 4)) * (1.0f / 256.0f) + EPS);
#pragma unroll
                for (int bj = 0; bj < 2; ++bj) {
                    const f32x4 v0 = acc[ai][bj][m][0] * rs, v1 = acc[ai][bj][m][1] * rs;
                    u32x4 w; w.x = cvt_pk_bf16(v0[0], v0[1]); w.y = cvt_pk_bf16(v0[2], v0[3]); w.z = cvt_pk_bf16(v1[0], v1[1]); w.w = cvt_pk_bf16(v1[2], v1[3]);
                    *(u32x4*)(KVM + (size_t)row * 1024 + col + bj * 128) = w;
                }
            }
    }
};

constexpr int ATT_VS = 144;
constexpr int ATT_TILE = 64 * 208 + 64 * ATT_VS;
constexpr int ATT_OST = 2 * ATT_TILE, ATT_WSC = ATT_OST + NWAVES * 4096;
static_assert(ATT_WSC + NWAVES * 256 <= 131072, "attention LDS");
static_assert(WS_KD == WS_QD + (size_t)NT * 512 * 2 && WS_VD == WS_KD + (size_t)NT * 512 * 2 && WS_CKV == WS_CQ + (size_t)NT * 384 * 2 && WS_SSKV == WS_SSQ + (size_t)NT * 8 * 4, "buffers addressed relative to each other");
__device__ __forceinline__ int crow(int r, int hi) { return (r & 3) + 8 * (r >> 2) + 4 * hi; }
__device__ __forceinline__ bf16x8 pack8(const f32x16& p, int b) {
    u32x4 w; w.x = cvt_pk_bf16(p[b], p[b + 1]); w.y = cvt_pk_bf16(p[b + 2], p[b + 3]); w.z = cvt_pk_bf16(p[b + 4], p[b + 5]); w.w = cvt_pk_bf16(p[b + 6], p[b + 7]);
    return __builtin_bit_cast(bf16x8, w);
}
typedef short v4i16_t __attribute__((ext_vector_type(4)));
__device__ __forceinline__ s16x4 vtr(LAS const unsigned char* p) { return __builtin_bit_cast(s16x4, __builtin_amdgcn_ds_read_tr16_b64_v4i16((LAS v4i16_t*)p)); }

struct AttnIO {
    const bf16_t *QM, *KVM, *KR; bf16_t* OMIX;
    const bf16_t *QD, *KD, *VD; bf16_t* OD; float* LSE;
};

template <bool DIL>
__device__ __forceinline__ void attn_unit(LAS unsigned char* lds, const AttnIO& io, int unit) {
    constexpr int DK = DIL ? 64 : 96, KS = DK * 2 + 16, NKS = DK / 16;
    int tid_ = threadIdx.x; asm volatile("" : "+v"(tid_));
    const int tid = tid_, lane = tid & 63, wid = __builtin_amdgcn_readfirstlane(tid >> 6), r32 = lane & 31, hi = lane >> 5;
    int b, h, ntiles, tlo, thi, kofs = 0, L = SEQ, dil = 1, res = 0, resu = 0, br = 0, q0 = 0, pq;
    if constexpr (!DIL) {
        const int bh = unit >> 3, qb = unit & 7; b = bh >> 3; h = bh & 7; ntiles = 32; tlo = 0; thi = 32; q0 = qb * 256; pq = q0 + wid * 32 + r32;
    } else {
        const int bh = unit / 24, k = unit % 24, j = k & 7; br = k >> 3; b = bh >> 3; h = bh & 7;
        if (br == 0) { dil = 1; L = 2048; resu = 0; q0 = 256 * j; }
        else if (br == 1) { dil = 4; L = 512; resu = j >> 1; q0 = 256 * (j & 1); }
        else { dil = 16; L = 128; resu = 2 * j; q0 = 0; }
        if (br < 2) { ntiles = 6; tlo = wid >> 1; thi = tlo + 3; kofs = q0 - 64; pq = q0 + wid * 32 + r32; res = resu; }
        else { const int hw = wid >> 2; ntiles = 4; tlo = 2 * hw; thi = tlo + 2; kofs = -128 * hw; pq = (wid & 3) * 32 + r32; res = resu + hw; }
    }
    const int pq0 = pq - r32;
    const size_t kb = (size_t)b * SEQ;
    bf16x8 qf[NKS];
    {
        const bf16_t* qp = DIL ? io.QD + (kb + (size_t)pq * dil + res) * 512 + h * 64 : io.QM + (kb + pq) * 768 + h * 96;
#pragma unroll
        for (int ks = 0; ks < NKS; ++ks) qf[ks] = *(const bf16x8*)(qp + ks * 16 + hi * 8);
    }
    const int lrow = tid >> 3, lch = tid & 7, rrow = (tid >> 2) & 63, rch = tid & 3;
    u32x4 gk, gv, gr = (u32x4){0u, 0u, 0u, 0u};
#define ATT_TOK(t) \
        const int s_ = 64 * (t) + lrow; size_t tok_; \
        if (br < 2) { int p_ = q0 - 64 + s_; p_ = p_ < 0 ? 0 : (p_ > L - 1 ? L - 1 : p_); tok_ = kb + (size_t)p_ * dil + resu; } \
        else { tok_ = kb + (size_t)(s_ & 127) * 16 + (size_t)(resu + (s_ >> 7)); }
#define ATT_GLOADK(t, GK, GR) do { \
        if constexpr (!DIL) { \
            GK = *(const u32x4*)(io.KVM + (kb + 64 * (t) + lrow) * 1024 + h * 128 + lch * 8); \
            if (tid < 256) GR = *(const u32x4*)(io.KR + (kb + 64 * (t) + rrow) * 32 + rch * 8); \
        } else { ATT_TOK(t) GK = *(const u32x4*)(io.KD + tok_ * 512 + h * 64 + lch * 8); } } while (0)
#define ATT_GLOADV(t) do { \
        if constexpr (!DIL) { gv = *(const u32x4*)(io.KVM + (kb + 64 * (t) + lrow) * 1024 + h * 128 + 64 + lch * 8); } \
        else { ATT_TOK(t) gv = *(const u32x4*)(io.VD + tok_ * 512 + h * 64 + lch * 8); } } while (0)
#define ATT_LSTOREK(buf, GK, GR) do { \
        LAS unsigned char* Kb_ = lds + (buf) * ATT_TILE; \
        *(LAS u32x4*)(Kb_ + lrow * KS + lch * 16) = GK; \
        if constexpr (!DIL) { if (tid < 256) *(LAS u32x4*)(Kb_ + rrow * KS + 128 + rch * 16) = GR; } } while (0)
#define ATT_LSTOREV(buf) do { *(LAS u32x4*)(lds + (buf) * ATT_TILE + 64 * KS + lrow * ATT_VS + lch * 16) = gv; } while (0)
#define ATT_SB() __builtin_amdgcn_sched_barrier(0)
    LAS float* wsc = (LAS float*)(lds + ATT_WSC + wid * 256);
    f32x16 o0 = {}, o1 = {}, negm = {};
    float mref = 0.f, lrun = 0.f; bool started = false;
    const int krow = (r32 & 19) | ((r32 & 4) << 1) | ((r32 & 8) >> 1);
    const int koff = krow * KS + hi * 16;
    const int i16 = lane & 15, g16 = lane >> 4;
    const int voff = 64 * KS + (8 * hi + (i16 >> 2)) * ATT_VS + (16 * (g16 & 1) + 4 * (i16 & 3)) * 2;
    { u32x4 gk1, gr1 = (u32x4){0u, 0u, 0u, 0u}; ATT_GLOADK(0, gk, gr); ATT_GLOADV(0); ATT_GLOADK(1, gk1, gr1); ATT_LSTOREK(0, gk, gr); ATT_LSTOREV(0); ATT_LSTOREK(1, gk1, gr1); }
    __syncthreads();
    f32x16 c0, c1;
    if (tlo == 0) {
        c0 = negm; c1 = negm;
#pragma unroll
        for (int ks = 0; ks < NKS; ++ks) {
            const bf16x8 a0 = *(LAS const bf16x8*)(lds + koff + ks * 32), a1 = *(LAS const bf16x8*)(lds + koff + 32 * KS + ks * 32);
            c0 = __builtin_amdgcn_mfma_f32_32x32x16_bf16(a0, qf[ks], c0, 0, 0, 0); c1 = __builtin_amdgcn_mfma_f32_32x32x16_bf16(a1, qf[ks], c1, 0, 0, 0);
        }
    } else { c0 = negm; c1 = negm; }
    __syncthreads();
    for (int t = 0; t < ntiles; ++t) {
        if (t + 2 < ntiles) ATT_GLOADK(t + 2, gk, gr);
        if (t + 1 < ntiles) ATT_GLOADV(t + 1);
        const bool doP = (t >= tlo) && (t < thi), doS = (t + 1 >= tlo) && (t + 1 < thi);
        LAS const unsigned char* Kn = lds + ((t + 1) & 1) * ATT_TILE + koff;
        LAS const unsigned char* Vc = lds + (t & 1) * ATT_TILE + voff;
        f32x16 n0 = negm, n1 = negm;
        if (doP) {
            if constexpr (DIL) {
                const int P0 = 64 * t + kofs;
                const bool full = (P0 >= pq0 - 33) && (P0 + 63 <= pq0 + 64) && (P0 >= 0) && (P0 + 63 < L);
                if (!full) {
                    const int lo = max(pq - 64, 0) - P0 - 8 * hi, span = min(pq + 64, L - 1) - max(pq - 64, 0);
#pragma unroll
                    for (int r = 0; r < 16; ++r) {
                        const int i0 = 16 * (r >> 3) + (r & 7);
                        c0[r] = ((unsigned)(i0 - lo) <= (unsigned)span) ? c0[r] : -INFINITY;
                        c1[r] = ((unsigned)(i0 + 32 - lo) <= (unsigned)span) ? c1[r] : -INFINITY;
                    }
                }
            }
            float ma = fmaxf(fmaxf(c0[0], c0[1]), c1[0]), mb = fmaxf(fmaxf(c0[2], c0[3]), c1[1]);
            ma = fmaxf(fmaxf(ma, c1[2]), c1[3]);
#pragma unroll
            for (int r = 4; r < 16; r += 4) { ma = fmaxf(fmaxf(ma, c0[r]), c0[r + 1]); mb = fmaxf(fmaxf(mb, c0[r + 2]), c0[r + 3]); ma = fmaxf(fmaxf(ma, c1[r]), c1[r + 1]); mb = fmaxf(fmaxf(mb, c1[r + 2]), c1[r + 3]); }
            float rm = fmaxf(ma, mb);
            { auto rr = __builtin_amdgcn_permlane32_swap(__float_as_uint(rm), __float_as_uint(rm), false, false); rm = fmaxf(__uint_as_float(rr[0]), __uint_as_float(rr[1])); }
            const float dl = (rm > -1e30f && (!started || rm > 8.f)) ? rm : 0.f;
            started = started || (rm > -1e30f);
            const bool resc = __any(dl != 0.f);
            if (resc) {
                mref += dl;
#pragma unroll
                for (int r = 0; r < 16; ++r) { c0[r] -= dl; c1[r] -= dl; }
#pragma unroll
                for (int r = 0; r < 16; ++r) negm[r] = -mref;
                const float f = fast_exp2(-fmaxf(dl, 0.f)); lrun *= f;
                if (hi == 0) wsc[r32] = f;
                n0 = negm; n1 = negm;
            }
            float ps0 = 0.f, ps1 = 0.f;
            u32x4 pw0, pw1, pw2, pw3;
#define ATT_EXPU(u) do { c0[u] = fast_exp2(c0[u]); c1[u] = fast_exp2(c1[u]); ps0 += c0[u]; ps1 += c1[u]; } while (0)
#define ATT_PK(u) do { const unsigned x0_ = cvt_pk_bf16(c0[u - 1], c0[u]), x1_ = cvt_pk_bf16(c1[u - 1], c1[u]); \
            if ((u) < 8) { pw0[((u) >> 1) & 3] = x0_; pw2[((u) >> 1) & 3] = x1_; } else { pw1[((u) >> 1) & 3] = x0_; pw3[((u) >> 1) & 3] = x1_; } } while (0)
            if (doS) {
                bf16x8 a0 = *(LAS const bf16x8*)(Kn), a1 = *(LAS const bf16x8*)(Kn + 32 * KS);
#pragma unroll
                for (int ks = 0; ks < NKS; ++ks) {
                    bf16x8 b0 = a0, b1 = a1;
                    if (ks + 1 < NKS) { b0 = *(LAS const bf16x8*)(Kn + (ks + 1) * 32); b1 = *(LAS const bf16x8*)(Kn + 32 * KS + (ks + 1) * 32); }
                    n0 = __builtin_amdgcn_mfma_f32_32x32x16_bf16(a0, qf[ks], n0, 0, 0, 0);
                    n1 = __builtin_amdgcn_mfma_f32_32x32x16_bf16(a1, qf[ks], n1, 0, 0, 0);
                    a0 = b0; a1 = b1;
                    const int u_lo = (16 * ks) / NKS, u_hi = (16 * (ks + 1)) / NKS;
#pragma unroll
                    for (int u = u_lo; u < u_hi; ++u) { ATT_EXPU(u); if (u & 1) ATT_PK(u); }
                    ATT_SB();
                }
            } else {
#pragma unroll
                for (int u = 0; u < 16; ++u) { ATT_EXPU(u); if (u & 1) ATT_PK(u); }
            }
            lrun += ps0 + ps1;
            if (resc) {
#pragma unroll
                for (int g = 0; g < 4; ++g) {
                    const f32x4 av = *(LAS const f32x4*)(wsc + 8 * g + 4 * hi);
#pragma unroll
                    for (int e = 0; e < 4; ++e) { o0[4 * g + e] *= av[e]; o1[4 * g + e] *= av[e]; }
                }
            }
            {
                s16x4 va = vtr(Vc), vb = vtr(Vc + 4 * ATT_VS), vc = vtr(Vc + 64), vd = vtr(Vc + 64 + 4 * ATT_VS);
#pragma unroll
                for (int j = 0; j < 4; ++j) {
                    const bf16x8 pa = __builtin_bit_cast(bf16x8, j == 0 ? pw0 : (j == 1 ? pw1 : (j == 2 ? pw2 : pw3)));
                    const bf16x8 vf0 = (bf16x8){va[0], va[1], va[2], va[3], vb[0], vb[1], vb[2], vb[3]};
                    const bf16x8 vf1 = (bf16x8){vc[0], vc[1], vc[2], vc[3], vd[0], vd[1], vd[2], vd[3]};
                    if (j + 1 < 4) { LAS const unsigned char* vp = Vc + (j + 1) * 16 * ATT_VS; va = vtr(vp); vb = vtr(vp + 4 * ATT_VS); vc = vtr(vp + 64); vd = vtr(vp + 64 + 4 * ATT_VS); }
                    o0 = __builtin_amdgcn_mfma_f32_32x32x16_bf16(pa, vf0, o0, 0, 0, 0);
                    o1 = __builtin_amdgcn_mfma_f32_32x32x16_bf16(pa, vf1, o1, 0, 0, 0);
                }
            }
        } else if (doS) {
#pragma unroll
            for (int ks = 0; ks < NKS; ++ks) {
                const bf16x8 a0 = *(LAS const bf16x8*)(Kn + ks * 32), a1 = *(LAS const bf16x8*)(Kn + 32 * KS + ks * 32);
                n0 = __builtin_amdgcn_mfma_f32_32x32x16_bf16(a0, qf[ks], n0, 0, 0, 0); n1 = __builtin_amdgcn_mfma_f32_32x32x16_bf16(a1, qf[ks], n1, 0, 0, 0);
            }
        }
        c0 = n0; c1 = n1;
        if (t + 2 < ntiles) ATT_LSTOREK(t & 1, gk, gr);
        if (t + 1 < ntiles) ATT_LSTOREV((t + 1) & 1);
        __syncthreads();
    }
    float ltot;
    { auto rr = __builtin_amdgcn_permlane32_swap(__float_as_uint(lrun), __float_as_uint(lrun), false, false); ltot = __uint_as_float(rr[0]) + __uint_as_float(rr[1]); }
    if (hi == 0) wsc[r32] = fast_rcp(ltot);
    LAS bf16_t* stg = (LAS bf16_t*)(lds + ATT_OST + wid * 4096);
#pragma unroll
    for (int g = 0; g < 4; ++g) {
        const f32x4 iv = *(LAS const f32x4*)(wsc + 8 * g + 4 * hi);
#pragma unroll
        for (int e = 0; e < 4; ++e) {
            const int r = 4 * g + e, orow = crow(r, hi);
            stg[orow * 64 + r32] = (bf16_t)(cvt_pk_bf16(o0[r] * iv[e], 0.f) & 0xffffu);
            stg[orow * 64 + 32 + r32] = (bf16_t)(cvt_pk_bf16(o1[r] * iv[e], 0.f) & 0xffffu);
        }
    }
#pragma unroll
    for (int it = 0; it < 4; ++it) {
        const int row = it * 8 + (lane >> 3), ch = lane & 7;
        const u32x4 v = *(LAS const u32x4*)(stg + row * 64 + ch * 8);
        if constexpr (DIL) { const size_t tok = kb + (size_t)(pq0 + row) * dil + res; *(u32x4*)(io.OD + (size_t)br * NT * 512 + tok * 512 + h * 64 + ch * 8) = v; }
        else *(u32x4*)(io.OMIX + (kb + pq0 + row) * 1024 + h * 64 + ch * 8) = v;
    }
    if constexpr (DIL) { if (hi == 0) { const size_t tok = kb + (size_t)pq * dil + res; io.LSE[((size_t)br * NT + tok) * 8 + h] = mref + __builtin_amdgcn_logf(ltot); } }
}
#undef ATT_TOK
#undef ATT_GLOADK
#undef ATT_GLOADV
#undef ATT_LSTOREK
#undef ATT_LSTOREV
#undef ATT_SB
#undef ATT_EXPU
#undef ATT_PK

__device__ __forceinline__ float wave_sum(float v) {
#pragma unroll
    for (int o = 1; o < 64; o <<= 1) v += __shfl_xor(v, o);
    return v;
}
__device__ __forceinline__ void tr_block(const float* W, int K, int N, const float* gain, bf16_t* WT, int k0, int n0, int dst_row0, LAS float* scr, int lane) {
#pragma unroll 8
    for (int i = 0; i < 32; ++i) {
        const int kk = 2 * i + (lane >> 5);
        float v = W[(size_t)(k0 + kk) * N + n0 + (lane & 31)];
        if (gain) v *= gain[k0 + kk];
        scr[kk * 33 + (lane & 31)] = v;
    }
    asm volatile("s_waitcnt lgkmcnt(0)" ::: "memory");
    const int c = lane & 7;
#pragma unroll
    for (int j = 0; j < 4; ++j) {
        const int n = (lane >> 3) + 8 * j; const LAS float* s = scr + (8 * c) * 33 + n;
        u32x4 o; o.x = cvt_pk_bf16(s[0 * 33], s[1 * 33]); o.y = cvt_pk_bf16(s[2 * 33], s[3 * 33]); o.z = cvt_pk_bf16(s[4 * 33], s[5 * 33]); o.w = cvt_pk_bf16(s[6 * 33], s[7 * 33]);
        *(u32x4*)(WT + (size_t)(dst_row0 + n) * K + k0 + 8 * c) = o;
    }
    asm volatile("s_waitcnt lgkmcnt(0)" ::: "memory");
}

struct Args {
    const float* in[19]; float* out; unsigned char* ws;
};

__global__ void __launch_bounds__(NWAVES * 64) mk_fwd(Args a) {
    extern __shared__ __attribute__((aligned(16))) unsigned char lds_raw[];
    LAS unsigned char* lds = (LAS unsigned char*)lds_raw;
    cg::grid_group grid = cg::this_grid();
    const int tid = threadIdx.x, lane = tid & 63, wave = __builtin_amdgcn_readfirstlane(tid >> 6);
    const int G = gridDim.x, bx = blockIdx.x;
    const int gw = bx * NWAVES + wave, NGW = G * NWAVES;
    unsigned char* ws = a.ws;
    const float* x = a.in[0];
    const float *g_ffn1 = a.in[1], *w1g = a.in[2], *w1u = a.in[3], *w1d = a.in[4], *g_mix = a.in[5], *w_in = a.in[6], *g_q = a.in[7], *w_uq = a.in[8], *g_kv = a.in[9], *w_ukv = a.in[10],
                *g_mo = a.in[11], *g_do = a.in[12], *w_out = a.in[13], *g_ffn2 = a.in[14], *w2g = a.in[15], *w2u = a.in[16], *w2d = a.in[17], *g_fin = a.in[18];
    float* X = a.out;
    bf16_t *W1GU = (bf16_t*)(ws + WS_W1GU), *W1D = (bf16_t*)(ws + WS_W1D), *W2GU = (bf16_t*)(ws + WS_W2GU), *W2D = (bf16_t*)(ws + WS_W2D), *WIN = (bf16_t*)(ws + WS_WIN),
           *WUQ = (bf16_t*)(ws + WS_WUQ), *WUKV = (bf16_t*)(ws + WS_WUKV), *WOUT = (bf16_t*)(ws + WS_WOUT);
    float *COSM = (float*)(ws + WS_ROPE), *SINM = COSM + 2048 * 16, *COSP = SINM + 2048 * 16, *SINP = COSP + 2048 * 8;
    float *SS0 = (float*)(ws + WS_SS0), *SS1 = (float*)(ws + WS_SS1), *SS2 = (float*)(ws + WS_SS2), *SS3 = (float*)(ws + WS_SS3), *SSQ = (float*)(ws + WS_SSQ), *SSKV = (float*)(ws + WS_SSKV);
    bf16_t *XB = (bf16_t*)(ws + WS_XB), *KVM = (bf16_t*)(ws + WS_KVM), *HB = (bf16_t*)(ws + WS_H), *OD = (bf16_t*)(ws + WS_OD0), *OMIX = (bf16_t*)(ws + WS_OMIX);
    float* LSE = (float*)(ws + WS_LSE);
    bf16_t *QD = (bf16_t*)(ws + WS_QD), *KD = (bf16_t*)(ws + WS_KD), *VD = (bf16_t*)(ws + WS_VD), *CQ = (bf16_t*)(ws + WS_CQ), *CKV = (bf16_t*)(ws + WS_CKV), *KR = (bf16_t*)(ws + WS_KR), *QM = (bf16_t*)(ws + WS_QM);

    {
        LAS float* scr = (LAS float*)(lds + wave * 16384);
        constexpr int I_GU = 16 * 88, I_D = 44 * 32, I_IN = 16 * 69, I_UQ = 6 * 24, I_UKV = 4 * 32, I_OUT = 16 * 32;
        constexpr int NITEMS = 2 * (2 * I_GU + I_D) + I_IN + I_UQ + I_UKV + I_OUT;
        for (int it = gw; it < NITEMS; it += NGW) {
            int r = it;
            if (r < 2 * (2 * I_GU + I_D)) {
                const int f = r / (2 * I_GU + I_D); r -= f * (2 * I_GU + I_D);
                const float* gg = f ? g_ffn2 : g_ffn1; const float* wg = f ? w2g : w1g; const float* wu = f ? w2u : w1u; const float* wd = f ? w2d : w1d;
                bf16_t* GU = f ? W2GU : W1GU; bf16_t* DD = f ? W2D : W1D;
                if (r < 2 * I_GU) { const int s = r >= I_GU; const int q = s ? r - I_GU : r; const int kb_ = q / 88, nb = q % 88, n0 = 32 * nb;
                    tr_block(s ? wu : wg, 1024, FF, gg, GU, 64 * kb_, n0, 256 * (n0 >> 7) + 128 * s + (n0 & 127), scr, lane); }
                else { r -= 2 * I_GU; const int kb_ = r / 32, nb = r % 32; tr_block(wd, FF, 1024, nullptr, DD, 64 * kb_, 32 * nb, 32 * nb, scr, lane); }
                continue;
            }
            r -= 2 * (2 * I_GU + I_D);
            if (r < I_IN) { const int kb_ = r / 69, nb = r % 69, n0 = 32 * nb;
                int dst;
                if (n0 < 384) dst = 1536 + n0; else if (n0 < 640) dst = 2048 + (n0 - 384); else if (n0 < 672) dst = 1920 + (n0 - 640);
                else if (n0 < 1184) dst = n0 - 672; else if (n0 < 1696) dst = 512 + (n0 - 1184); else dst = 1024 + (n0 - 1696);
                tr_block(w_in, 1024, 2208, g_mix, WIN, 64 * kb_, n0, dst, scr, lane); continue; }
            r -= I_IN;
            if (r < I_UQ) { const int kb_ = r / 24, nb = r % 24; tr_block(w_uq, 384, 768, g_q, WUQ, 64 * kb_, 32 * nb, 32 * nb, scr, lane); continue; }
            r -= I_UQ;
            if (r < I_UKV) { const int kb_ = r / 32, nb = r % 32; tr_block(w_ukv, 256, 1024, g_kv, WUKV, 64 * kb_, 32 * nb, 32 * nb, scr, lane); continue; }
            r -= I_UKV;
            { const int kb_ = r / 32, nb = r % 32, k0 = 64 * kb_; tr_block(w_out, 1024, 1024, k0 < 512 ? g_mo : g_do - 512, WOUT, k0, 32 * nb, 32 * nb, scr, lane); }
        }
        for (int i = bx * 512 + tid; i < 96 * 1024 / 8; i += G * 512) *(u32x4*)(WIN + (size_t)1952 * 1024 + (size_t)i * 8) = (u32x4){0u, 0u, 0u, 0u};
        for (int i = bx * 512 + tid; i < 2048 * 24; i += G * 512) {
            int pos, fi; float invf; float *cdst, *sdst;
            if (i < 2048 * 16) { pos = i >> 4; fi = i & 15; invf = exp2f(-(float)fi * (1.0f / 16.0f) * 18.931568569324174f); cdst = COSM + i; sdst = SINM + i; }
            else { const int k = i - 2048 * 16; pos = k >> 3; fi = k & 7; invf = exp2f(-(float)fi * (1.0f / 8.0f) * 18.931568569324174f); cdst = COSP + k; sdst = SINP + k; }
            const float ang = (float)pos * invf;
            const double rev = (double)ang * 0.15915494309189535; const float fr_ = (float)(rev - floor(rev));
            *cdst = __builtin_amdgcn_cosf(fr_); *sdst = __builtin_amdgcn_sinf(fr_);
        }
        for (int row = gw; row < NT; row += NGW) {
            const f32x4* xr = (const f32x4*)(x + (size_t)row * DM) + lane; float s = 0.f;
            unsigned long long* o8 = (unsigned long long*)(XB + (size_t)row * DM) + lane;
#pragma unroll
            for (int j = 0; j < 4; ++j) { const f32x4 v = xr[64 * j]; s += sq4(v); o8[64 * j] = (unsigned long long)cvt_pk_bf16(v[0], v[1]) | ((unsigned long long)cvt_pk_bf16(v[2], v[3]) << 32); }
            s = wave_sum(s);
            if (lane < 16) SS0[(size_t)row * 16 + lane] = lane == 0 ? s : 0.f;
        }
    }
    grid.sync();
    {
        pg8::Gemm g{XB, W1GU, NT, 2 * FF, DM}; pg8::StaticOrder S; S.init(NT, 2 * FF, G, bx);
        EpiGateUp E{HB, SS0};
        pg8::gemm_phase<EpiGateUp, pg8::StaticOrder, true, true>(lds, g, S, E);
    }
    grid.sync();
    {
        pg8::Gemm g{HB, W1D, NT, DM, FF}; pg8::StaticOrder S; S.init(NT, DM, G, bx);
        EpiResid E{x, X, XB, SS1, 0.5f};
        pg8::gemm_phase<EpiResid, pg8::StaticOrder, true, true>(lds, g, S, E);
    }
    grid.sync();
    {
        pg8::Gemm g{XB, WIN, NT, 2304, DM}; pg8::StaticOrder S; S.init(NT, 2304, G, bx);
        EpiInProj E{SS1, QD, KD, VD, CQ, CKV, KR, SSQ, SSKV, COSM, SINM, COSP, SINP};
        pg8::gemm_phase<EpiInProj, pg8::StaticOrder, true, true>(lds, g, S, E);
    }
    grid.sync();
    {
        { pg8::Gemm g{CQ, WUQ, NT, 768, 384}; pg8::StaticOrder S; S.init(NT, 768, G, bx); EpiQ E{SSQ, QM, COSM, SINM};
          pg8::gemm_phase<EpiQ, pg8::StaticOrder, true, true>(lds, g, S, E); }
        { pg8::Gemm g{CKV, WUKV, NT, 1024, 256}; pg8::StaticOrder S; S.init(NT, 1024, G, bx); EpiKV E{SSKV, KVM};
          pg8::gemm_phase<EpiKV, pg8::StaticOrder, true, true>(lds, g, S, E); }
        __syncthreads();
        AttnIO io{QM, KVM, KR, OMIX, QD, KD, VD, OD, LSE};
        for (int u = bx; u < 256 * 24; u += G) attn_unit<true>(lds, io, u);
    }
    grid.sync();
    {
        AttnIO io{QM, KVM, KR, OMIX, QD, KD, VD, OD, LSE};
        for (int u = bx; u < 256 * 8; u += G) attn_unit<false>(lds, io, u);
    }
    grid.sync();
    for (int row = gw; row < NT; row += NGW) {
        {
            u32x4* p = (u32x4*)(OMIX + (size_t)row * 1024 + lane * 8); const u32x4 w = *p; float v[8];
#pragma unroll
            for (int e = 0; e < 4; ++e) { v[2 * e] = __uint_as_float(w[e] << 16); v[2 * e + 1] = __uint_as_float(w[e] & 0xffff0000u); }
            float s = 0.f;
#pragma unroll
            for (int e = 0; e < 8; ++e) s += v[e] * v[e];
            const float rs = rsqrtf(wave_sum(s) * (1.0f / 512.0f) + EPS);
            u32x4 o; o.x = cvt_pk_bf16(v[0] * rs, v[1] * rs); o.y = cvt_pk_bf16(v[2] * rs, v[3] * rs); o.z = cvt_pk_bf16(v[4] * rs, v[5] * rs); o.w = cvt_pk_bf16(v[6] * rs, v[7] * rs);
            *p = o;
        }
        {
            const int hd = lane >> 3;
            const float l0 = LSE[((size_t)0 * NT + row) * 8 + hd], l1 = LSE[((size_t)1 * NT + row) * 8 + hd], l2 = LSE[((size_t)2 * NT + row) * 8 + hd];
            const float mx = fmaxf(l0, fmaxf(l1, l2));
            float w0 = fast_exp2(l0 - mx), w1 = fast_exp2(l1 - mx), w2 = fast_exp2(l2 - mx);
            const float inv = 1.0f / (w0 + w1 + w2); w0 *= inv; w1 *= inv; w2 *= inv;
            float v[8];
#pragma unroll
            for (int e = 0; e < 8; ++e) v[e] = 0.f;
#pragma unroll
            for (int n = 0; n < 3; ++n) {
                const u32x4 w = *(const u32x4*)(OD + (size_t)n * NT * 512 + (size_t)row * 512 + lane * 8); const float wn = n == 0 ? w0 : (n == 1 ? w1 : w2);
#pragma unroll
                for (int e = 0; e < 4; ++e) { v[2 * e] += wn * __uint_as_float(w[e] << 16); v[2 * e + 1] += wn * __uint_as_float(w[e] & 0xffff0000u); }
            }
            float s = 0.f;
#pragma unroll
            for (int e = 0; e < 8; ++e) s += v[e] * v[e];
            const float rs = rsqrtf(wave_sum(s) * (1.0f / 512.0f) + EPS);
            u32x4 o; o.x = cvt_pk_bf16(v[0] * rs, v[1] * rs); o.y = cvt_pk_bf16(v[2] * rs, v[3] * rs); o.z = cvt_pk_bf16(v[4] * rs, v[5] * rs); o.w = cvt_pk_bf16(v[6] * rs, v[7] * rs);
            *(u32x4*)(OMIX + (size_t)row * 1024 + 512 + lane * 8) = o;
        }
    }
    grid.sync();
    {
        pg8::Gemm g{OMIX, WOUT, NT, DM, DM}; pg8::StaticOrder S; S.init(NT, DM, G, bx);
        EpiResid E{X, X, XB, SS2, 1.0f};
        pg8::gemm_phase<EpiResid, pg8::StaticOrder, true, true>(lds, g, S, E);
    }
    grid.sync();
    {
        pg8::Gemm g{XB, W2GU, NT, 2 * FF, DM}; pg8::StaticOrder S; S.init(NT, 2 * FF, G, bx);
        EpiGateUp E{HB, SS2};
        pg8::gemm_phase<EpiGateUp, pg8::StaticOrder, true, true>(lds, g, S, E);
    }
    grid.sync();
    {
        pg8::Gemm g{HB, W2D, NT, DM, FF}; pg8::StaticOrder S; S.init(NT, DM, G, bx);
        EpiResid E{X, X, nullptr, SS3, 0.5f};
        pg8::gemm_phase<EpiResid, pg8::StaticOrder, true, true>(lds, g, S, E);
    }
    grid.sync();
    for (int row = gw; row < NT; row += NGW) {
        const float rs = rstd_parts16(SS3, row, 1.0f / 1024.0f);
        f32x4* xr = (f32x4*)(X + (size_t)row * DM) + lane; const f32x4* gr = (const f32x4*)g_fin + lane;
#pragma unroll
        for (int j = 0; j < 4; ++j) { const f32x4 v = xr[64 * j] * rs * gr[64 * j]; xr[64 * j] = v; }
    }
}

extern "C" void kernel_launch(void* const* d_in, const int* in_sizes, int n_in, void* d_out, int out_size, void* d_ws, size_t ws_size, hipStream_t stream) {
    constexpr int LDS_BYTES = 131072;
    static int grid = 0;
    if (grid == 0) {
        if (n_in != 19 || in_sizes[0] != NT * DM || out_size != NT * DM || ws_size < WS_END) {
            fprintf(stderr, "kernel_launch: unexpected problem geometry (n_in %d, in0 %d, out %d, ws %zu); nothing launched\n", n_in, n_in > 0 ? in_sizes[0] : -1, out_size, ws_size); grid = -1; return; }
        int dev = 0, cus = 0, per_cu = 0;
        hipGetDevice(&dev); hipDeviceGetAttribute(&cus, hipDeviceAttributeMultiprocessorCount, dev);
        if (hipFuncSetAttribute((const void*)mk_fwd, hipFuncAttributeMaxDynamicSharedMemorySize, LDS_BYTES) != hipSuccess) { fprintf(stderr, "kernel_launch: hipFuncSetAttribute failed\n"); grid = -1; return; }
        if (hipOccupancyMaxActiveBlocksPerMultiprocessor(&per_cu, (const void*)mk_fwd, NWAVES * 64, LDS_BYTES) != hipSuccess || per_cu < 1) { fprintf(stderr, "kernel_launch: occupancy query says %d blocks per CU\n", per_cu); per_cu = 1; }
        (void)hipGetLastError();
        grid = cus;
    }
    if (grid < 0) return;
    Args a{};
    for (int i = 0; i < 19; ++i) a.in[i] = (const float*)d_in[i];
    a.out = (float*)d_out; a.ws = (unsigned char*)d_ws;
    void* args[] = {&a};
    hipError_t e = hipLaunchCooperativeKernel((const void*)mk_fwd, dim3(grid), dim3(NWAVES * 64), args, LDS_BYTES, stream);
    if (e != hipSuccess) fprintf(stderr, "kernel_launch: cooperative launch failed: %s (grid %d)\n", hipGetErrorString(e), grid);
}
```

```cpp
#include <hip/hip_runtime.h>
#include <hip/hip_cooperative_groups.h>
#include <cmath>
#include <cstdio>
#include <cstdint>
namespace pg8 {
#define PG8_LAS __attribute__((address_space(3)))
typedef unsigned short bf16_t;
typedef short bf16x8 __attribute__((ext_vector_type(8)));
typedef float f32x4 __attribute__((ext_vector_type(4)));
typedef unsigned u32x4 __attribute__((ext_vector_type(4)));
constexpr int BM = 256, BK = 64, HALF = 128, HTB = HALF * BK * 2  , STAGE_BYTES = 8 * HTB, NXCD = 8, WGM = 8;

__host__ __device__ __forceinline__ int lds_byte(int r, int c) { const int st = (r >> 4) * 2 + (c >> 5), rr = r & 15, cc = c & 31, ob = rr * 64 + cc * 2; return st * 1024 + (ob ^ (((ob >> 9) & 1) << 5)); }
__host__ __device__ __forceinline__ void stage_rc(int b, int& R, int& C) { const int st = b / 1024, sb = b % 1024, swz = sb ^ (((sb >> 9) & 1) << 5); R = (st >> 1) * 16 + swz / 64; C = (st & 1) * 32 + (swz % 64) / 2; }
__host__ __device__ __forceinline__ int perm32(int rho) { const int n = rho >> 4, i = rho & 15; return 8 * (i >> 2) + 4 * n + (i & 3); }

struct Unit { int pm, pn; };
struct Gemm { const bf16_t* A; const bf16_t* Bt; int M, N, K; };

struct StaticOrder {
    int nM, nN, nwg, G, c;
    __host__ __device__ void init(int M, int N, int G_, int c_) { nM = M / BM; nN = N / BM; nwg = nM * nN; G = G_; c = c_; }
    __host__ __device__ bool next(int i, Unit& u) const {
        const long L = (long)i * G + c; if (L >= nwg) return false;
        int wgid = (int)L; { const int q = nwg / NXCD, r = nwg % NXCD, xcd = wgid % NXCD, off = wgid / NXCD; wgid = (xcd < r ? xcd * (q + 1) : r * (q + 1) + (xcd - r) * q) + off; }
        const int nig = WGM * nN, gid = wgid / nig, fm = gid * WGM, gsz = (nM - fm) < WGM ? (nM - fm) : WGM;
        u.pm = fm + ((wgid % nig) % gsz); u.pn = (wgid % nig) / gsz; return true;
    }
    __device__ __forceinline__ void a_ready(const Unit&) const {}
    __device__ __forceinline__ void done(const Unit&) const {}
};

__device__ __forceinline__ unsigned cvt_pk_bf16(float lo, float hi) { unsigned r; asm volatile("v_cvt_pk_bf16_f32 %0, %1, %2" : "=v"(r) : "v"(lo), "v"(hi)); return r; }

template <class Epi, class Sched, bool ALIGN_EPI = false, bool SP2 = false>
__device__ __forceinline__ void gemm_phase(PG8_LAS unsigned char* lds, const Gemm g, const Sched& S, const Epi& E) {
    int tid_ = threadIdx.x; asm volatile("" : "+v"(tid_));
    const int tid = tid_, wid = __builtin_amdgcn_readfirstlane(tid >> 6), lane = tid & 63, wr = wid >> 2, wc = wid & 3, fr = lane & 15, fq = lane >> 4;
    const int K = g.K, nt = K / BK;
    unsigned voffA[2], voffB[2];
#pragma unroll
    for (int i = 0; i < 2; ++i) { int R, C; stage_rc(tid * 16 + i * 8192, R, C); const int Rb = Epi::PERM ? ((R & ~31) + perm32(R & 31)) : R;
        voffA[i] = (unsigned)(R * K + C) * 2u; voffB[i] = (unsigned)(Rb * K + C) * 2u; }
    const size_t kstep = (size_t)(BK * 2);
    const size_t hstep = (size_t)HALF * K * 2;
    const size_t tstep = 2 * hstep;
    const unsigned ldsw = (unsigned)wid * 1024u;
    const int aoff = lds_byte(wr * 64 + fr, fq * 8), boff = lds_byte(wc * 32 + fr, fq * 8);
#define PG8_SA(b, h) (((b) * 2 + (h)) * HTB)
#define PG8_SB(b, h) ((4 + (b) * 2 + (h)) * HTB)
#define PG8_STAGE(bufoff, gbase, voff) do { _Pragma("unroll") for (int _i = 0; _i < 2; ++_i) \
        __builtin_amdgcn_global_load_lds((const unsigned*)((const char*)(gbase) + (voff)[_i]), (PG8_LAS unsigned*)(lds + (bufoff) + ldsw + _i * 8192), 16, 0, 0); } while (0)
#define PG8_LDA(dst, b, h) do { _Pragma("unroll") for (int m = 0; m < 4; ++m) _Pragma("unroll") for (int k = 0; k < 2; ++k) dst[m][k] = *(const PG8_LAS bf16x8*)(lds + PG8_SA(b, h) + aoff + m * 2048 + k * 1024); } while (0)
#define PG8_LDB(dst, b, h) do { _Pragma("unroll") for (int n = 0; n < 2; ++n) _Pragma("unroll") for (int k = 0; k < 2; ++k) dst[n][k] = *(const PG8_LAS bf16x8*)(lds + PG8_SB(b, h) + boff + n * 2048 + k * 1024); } while (0)
#define PG8_MMA(ai, bj, At, Bt) do { __builtin_amdgcn_s_setprio(1); _Pragma("unroll") for (int m = 0; m < 4; ++m) _Pragma("unroll") for (int n = 0; n < 2; ++n) _Pragma("unroll") for (int k = 0; k < 2; ++k) \
        acc[ai][bj][m][n] = __builtin_amdgcn_mfma_f32_16x16x32_bf16(Bt[n][k], At[m][k], acc[ai][bj][m][n], 0, 0, 0); __builtin_amdgcn_s_setprio(0); } while (0)
#define PG8_WAIT_V(n) asm volatile("s_waitcnt vmcnt(" #n ")" ::: "memory")
#define PG8_WAIT_L(n) asm volatile("s_waitcnt lgkmcnt(" #n ")" ::: "memory")
#define PG8_BAR __builtin_amdgcn_s_barrier()
#define PG8_SCHED __builtin_amdgcn_sched_barrier(0)
    Unit cur, nxt; int ui = 0;
    if (!S.next(0, cur)) return;
    f32x4 acc[2][2][4][2];
#pragma unroll
    for (int a = 0; a < 2; ++a)
#pragma unroll
        for (int b = 0; b < 2; ++b)
#pragma unroll
            for (int m = 0; m < 4; ++m)
#pragma unroll
                for (int n = 0; n < 2; ++n) acc[a][b][m][n] = (f32x4){0.f, 0.f, 0.f, 0.f};
    bf16x8 At[4][2], B0[2][2], B1[2][2];
    const char* cA = (const char*)g.A + (size_t)cur.pm * tstep; const char* cB = (const char*)g.Bt + (size_t)cur.pn * tstep;
    S.a_ready(cur);
    if constexpr (SP2) {
        PG8_STAGE(PG8_SB(0, 0), cB, voffB); PG8_STAGE(PG8_SB(0, 1), cB + hstep, voffB); PG8_STAGE(PG8_SA(0, 0), cA, voffA); PG8_STAGE(PG8_SA(0, 1), cA + hstep, voffA);
        if (wr == 1) PG8_BAR;
        PG8_WAIT_V(2); PG8_BAR;
        PG8_STAGE(PG8_SB(1, 0), cB + kstep, voffB); PG8_STAGE(PG8_SA(1, 0), cA + kstep, voffA); PG8_STAGE(PG8_SB(1, 1), cB + hstep + kstep, voffB);
        PG8_WAIT_V(6); PG8_BAR;
    } else {
        PG8_STAGE(PG8_SB(0, 0), cB, voffB); PG8_STAGE(PG8_SA(0, 0), cA, voffA); PG8_STAGE(PG8_SB(0, 1), cB + hstep, voffB); PG8_STAGE(PG8_SA(0, 1), cA + hstep, voffA);
        if (wr == 1) PG8_BAR;
        PG8_WAIT_V(4); PG8_BAR;
        PG8_STAGE(PG8_SB(1, 0), cB + kstep, voffB); PG8_STAGE(PG8_SA(1, 0), cA + kstep, voffA); PG8_STAGE(PG8_SB(1, 1), cB + hstep + kstep, voffB);
        PG8_WAIT_V(6); PG8_BAR;
    }
    for (;;) {
        const bool has_next = S.next(ui + 1, nxt);
        const char* nA = has_next ? (const char*)g.A + (size_t)nxt.pm * tstep : cA; const char* nB = has_next ? (const char*)g.Bt + (size_t)nxt.pn * tstep : cB;
        for (int t = 0; t < nt; t += 2) {
            const bool last = (t == nt - 2);
            const char* a1 = cA + (size_t)(t + 1) * kstep;
            const char* a2 = last ? nA : cA + (size_t)(t + 2) * kstep; const char* b2 = last ? nB : cB + (size_t)(t + 2) * kstep;
            const char* a3 = a2 + kstep; const char* b3 = b2 + kstep;
            if (last && has_next) S.a_ready(nxt);
            if constexpr (SP2) {
            PG8_LDB(B0, 0, 0); PG8_LDB(B1, 0, 1); PG8_SCHED; PG8_LDA(At, 0, 0); PG8_STAGE(PG8_SA(1, 1), a1 + hstep, voffA);
            PG8_WAIT_V(8); PG8_WAIT_L(0); PG8_BAR; PG8_MMA(0, 0, At, B0); PG8_MMA(0, 1, At, B1); PG8_BAR; PG8_SCHED;
            PG8_LDA(At, 0, 1); PG8_STAGE(PG8_SB(0, 0), b2, voffB); PG8_STAGE(PG8_SB(0, 1), b2 + hstep, voffB); PG8_STAGE(PG8_SA(0, 0), a2, voffA);
            PG8_WAIT_V(8); PG8_WAIT_L(0); PG8_BAR; PG8_MMA(1, 0, At, B0); PG8_MMA(1, 1, At, B1); PG8_BAR; PG8_SCHED;
            PG8_LDB(B0, 1, 0); PG8_LDB(B1, 1, 1); PG8_SCHED; PG8_LDA(At, 1, 0); PG8_STAGE(PG8_SA(0, 1), a2 + hstep, voffA);
            PG8_WAIT_V(8); PG8_WAIT_L(0); PG8_BAR; PG8_MMA(0, 0, At, B0); PG8_MMA(0, 1, At, B1); PG8_BAR; PG8_SCHED;
            PG8_LDA(At, 1, 1); PG8_STAGE(PG8_SB(1, 0), b3, voffB); PG8_STAGE(PG8_SB(1, 1), b3 + hstep, voffB); PG8_STAGE(PG8_SA(1, 0), a3, voffA);
            PG8_WAIT_V(8); PG8_WAIT_L(0); PG8_BAR; PG8_MMA(1, 0, At, B0); PG8_MMA(1, 1, At, B1); PG8_BAR; PG8_SCHED;
            } else {
            PG8_LDB(B0, 0, 0); PG8_SCHED; PG8_LDA(At, 0, 0); PG8_STAGE(PG8_SA(1, 1), a1 + hstep, voffA);
            PG8_WAIT_L(8); PG8_BAR; PG8_WAIT_L(0); PG8_MMA(0, 0, At, B0); PG8_BAR; PG8_SCHED;
            PG8_LDB(B1, 0, 1); PG8_STAGE(PG8_SB(0, 0), b2, voffB);
            PG8_BAR; PG8_WAIT_L(0); PG8_MMA(0, 1, At, B1); PG8_BAR;
            PG8_LDA(At, 0, 1); PG8_STAGE(PG8_SA(0, 0), a2, voffA);
            PG8_BAR; PG8_WAIT_L(0); PG8_MMA(1, 0, At, B0); PG8_BAR; PG8_SCHED;
            PG8_STAGE(PG8_SB(0, 1), b2 + hstep, voffB);
            PG8_WAIT_V(6); PG8_BAR; PG8_MMA(1, 1, At, B1); PG8_BAR;
            PG8_LDB(B0, 1, 0); PG8_SCHED; PG8_LDA(At, 1, 0); PG8_STAGE(PG8_SA(0, 1), a2 + hstep, voffA);
            PG8_WAIT_L(8); PG8_BAR; PG8_WAIT_L(0); PG8_MMA(0, 0, At, B0); PG8_BAR; PG8_SCHED;
            PG8_LDB(B1, 1, 1); PG8_STAGE(PG8_SB(1, 0), b3, voffB);
            PG8_BAR; PG8_WAIT_L(0); PG8_MMA(0, 1, At, B1); PG8_BAR;
            PG8_LDA(At, 1, 1); PG8_STAGE(PG8_SA(1, 0), a3, voffA);
            PG8_BAR; PG8_WAIT_L(0); PG8_MMA(1, 0, At, B0); PG8_BAR; PG8_SCHED;
            PG8_STAGE(PG8_SB(1, 1), b3 + hstep, voffB);
            PG8_WAIT_V(6); PG8_BAR; PG8_MMA(1, 1, At, B1); PG8_BAR;
            }
        }
        if constexpr (ALIGN_EPI) { if (wr == 0) PG8_BAR; }
        if constexpr (!Epi::AFTER_DRAIN) { E(acc, cur, wr, wc, fr, fq); S.done(cur); }
        if (!has_next) break;
#pragma unroll
        for (int a = 0; a < 2; ++a)
#pragma unroll
            for (int b = 0; b < 2; ++b)
#pragma unroll
                for (int m = 0; m < 4; ++m)
#pragma unroll
                    for (int n = 0; n < 2; ++n) acc[a][b][m][n] = (f32x4){0.f, 0.f, 0.f, 0.f};
        cur = nxt; cA = nA; cB = nB; ++ui;
        if constexpr (ALIGN_EPI) { if (wr == 1) PG8_BAR; }
    }
    PG8_WAIT_V(0);
    if constexpr (!ALIGN_EPI) { if (wr == 0) PG8_BAR; }
    PG8_BAR;
    if constexpr (Epi::AFTER_DRAIN) { E.fused(acc, cur, wr, wc, fr, fq, lds, wid, lane); S.done(cur); }
#undef PG8_SA
#undef PG8_SB
#undef PG8_STAGE
#undef PG8_LDA
#undef PG8_LDB
#undef PG8_MMA
#undef PG8_WAIT_V
#undef PG8_WAIT_L
#undef PG8_BAR
#undef PG8_SCHED
}
}

namespace cg = cooperative_groups;

#define LAS __attribute__((address_space(3)))
typedef unsigned short bf16_t;
typedef float f32x4 __attribute__((ext_vector_type(4)));
typedef float f32x16 __attribute__((ext_vector_type(16)));
typedef short bf16x8 __attribute__((ext_vector_type(8)));
typedef short s16x4 __attribute__((ext_vector_type(4)));
typedef unsigned u32x2 __attribute__((ext_vector_type(2)));
typedef unsigned u32x4 __attribute__((ext_vector_type(4)));
using pg8::Unit;
typedef float f32x2_t __attribute__((ext_vector_type(2))); typedef __bf16 bf16x2_t __attribute__((ext_vector_type(2)));
__device__ __forceinline__ unsigned cvt_pk_bf16(float lo, float hi) { const f32x2_t v = {lo, hi}; const bf16x2_t b = __builtin_convertvector(v, bf16x2_t); return __builtin_bit_cast(unsigned, b); }

constexpr int NT = 65536, SEQ = 2048, DM = 1024, FF = 2816, NWAVES = 8;
constexpr float EPS = 1e-6f, LOG2E = 1.4426950408889634f;
constexpr float QSCALE_D = 0.125f * LOG2E;
constexpr float QSCALE_M = 0.10206207261596577f * LOG2E;

constexpr size_t MiB = 1u << 20;
constexpr size_t WS_W1GU = 0, WS_W1D = 11 * MiB, WS_W2GU = 17 * MiB, WS_W2D = 28 * MiB, WS_WIN = 34 * MiB, WS_WUQ = 39 * MiB, WS_WUKV = 40 * MiB, WS_WOUT = 41 * MiB;
constexpr size_t WS_ROPE = 43 * MiB;
constexpr size_t WS_SS0 = 44 * MiB, WS_SS1 = 48 * MiB, WS_SS2 = 52 * MiB, WS_SS3 = 56 * MiB, WS_SSQ = 60 * MiB, WS_SSKV = 62 * MiB;
constexpr size_t WS_BAR = 63 * MiB;
constexpr size_t WS_XB = 64 * MiB;
constexpr size_t WS_KVM = WS_XB;
constexpr size_t WS_H = 192 * MiB;
constexpr size_t WS_OD0 = 192 * MiB, WS_OD1 = 256 * MiB, WS_OD2 = 320 * MiB, WS_OMIX = 384 * MiB, WS_LSE = 512 * MiB;
constexpr size_t WS_QD = 544 * MiB, WS_KD = 608 * MiB, WS_VD = 672 * MiB, WS_CQ = 736 * MiB, WS_CKV = 784 * MiB, WS_KR = 816 * MiB, WS_QM = 820 * MiB, WS_END = 916 * MiB;

__device__ __forceinline__ float fast_exp2(float x) { return __builtin_amdgcn_exp2f(x); }
__device__ __forceinline__ float fast_rcp(float x) { return __builtin_amdgcn_rcpf(x); }
__device__ __forceinline__ float bf2f(unsigned short b) { return __uint_as_float((unsigned)b << 16); }
__device__ __forceinline__ float sum4(f32x4 a) { return (a[0] + a[1]) + (a[2] + a[3]); }
__device__ __forceinline__ float sq4(f32x4 a) { return (a[0] * a[0] + a[1] * a[1]) + (a[2] * a[2] + a[3] * a[3]); }
__device__ __forceinline__ float rstd_parts16(const float* ss, int row, float invn) {
    const f32x4* p = (const f32x4*)(ss + (size_t)row * 16);
    const float s = (sum4(p[0]) + sum4(p[1])) + (sum4(p[2]) + sum4(p[3]));
    return rsqrtf(s * invn + EPS);
}

#define EPI_RELANE() int fr, fq; { int t_ = threadIdx.x; asm volatile("" : "+v"(t_)); fr = t_ & 15; fq = (t_ >> 4) & 3; }
struct EpiGateUp {
    static constexpr bool PERM = true, AFTER_DRAIN = false;
    bf16_t* H; const float* ss;
    __device__ __forceinline__ void operator()(const f32x4 (&acc)[2][2][4][2], const Unit& u, int wr, int wc, int fr_in, int fq_in) const {
        EPI_RELANE();
        const int row0 = u.pm * 256 + wr * 64 + fr, col = u.pn * 128 + wc * 32 + 8 * fq;
#pragma unroll
        for (int ai = 0; ai < 2; ++ai)
#pragma unroll
            for (int m = 0; m < 4; ++m) {
                const int row = row0 + ai * 128 + m * 16;
                const float rs = rstd_parts16(ss, row, 1.0f / 1024.0f);
                float o[8];
#pragma unroll
                for (int n = 0; n < 2; ++n)
#pragma unroll
                    for (int j = 0; j < 4; ++j) {
                        const float g = acc[ai][0][m][n][j] * rs, up = acc[ai][1][m][n][j] * rs;
                        o[4 * n + j] = g * fast_rcp(1.0f + fast_exp2(-g * LOG2E)) * up;
                    }
                u32x4 w; w.x = cvt_pk_bf16(o[0], o[1]); w.y = cvt_pk_bf16(o[2], o[3]); w.z = cvt_pk_bf16(o[4], o[5]); w.w = cvt_pk_bf16(o[6], o[7]);
                *(u32x4*)(H + (size_t)row * FF + col) = w;
            }
    }
};
struct EpiResid {
    static constexpr bool PERM = false, AFTER_DRAIN = false;
    const float* base; float* out; bf16_t* xb; float* ss; float alpha;
    __device__ __forceinline__ void operator()(const f32x4 (&acc)[2][2][4][2], const Unit& u, int wr, int wc, int fr_in, int fq_in) const {
        EPI_RELANE();
        const int row0 = u.pm * 256 + wr * 64 + fr, col0 = u.pn * 256 + wc * 32 + 4 * fq;
#pragma unroll
        for (int ai = 0; ai < 2; ++ai)
#pragma unroll
            for (int m = 0; m < 4; ++m) {
                const int row = row0 + ai * 128 + m * 16; float sq = 0.f;
#pragma unroll
                for (int bj = 0; bj < 2; ++bj)
#pragma unroll
                    for (int n = 0; n < 2; ++n) {
                        const size_t off = (size_t)row * DM + col0 + bj * 128 + n * 16;
                        const f32x4 b = *(const f32x4*)(base + off);
                        const f32x4 v = b + acc[ai][bj][m][n] * alpha;
                        *(f32x4*)(out + off) = v; sq += sq4(v);
                        if (xb) { u32x2 w; w.x = cvt_pk_bf16(v[0], v[1]); w.y = cvt_pk_bf16(v[2], v[3]); *(u32x2*)(xb + off) = w; }
                    }
                sq += __shfl_xor(sq, 16); sq += __shfl_xor(sq, 32);
                if (fq == 0) ss[(size_t)row * 16 + u.pn * 4 + wc] = sq;
            }
    }
};
struct EpiInProj {
    static constexpr bool PERM = false, AFTER_DRAIN = false;
    const float* ss1; bf16_t *QD, *KD, *VD, *CQ, *CKV, *KR; float *SSQ, *SSKV; const float *cosm, *sinm, *cosp, *sinp;
    __device__ __forceinline__ void operator()(const f32x4 (&acc)[2][2][4][2], const Unit& u, int wr, int wc, int fr_in, int fq_in) const {
        EPI_RELANE();
        const int row0 = u.pm * 256 + wr * 64 + fr, pn = u.pn;
#pragma unroll
        for (int ai = 0; ai < 2; ++ai)
#pragma unroll
            for (int m = 0; m < 4; ++m) {
                const int row = row0 + ai * 128 + m * 16, pos = row & (SEQ - 1);
                const float rs = rstd_parts16(ss1, row, 1.0f / 1024.0f);
                if (pn < 6) {
                    bf16_t* dst = QD + (size_t)(pn >> 1) * ((size_t)NT * 512) + (size_t)row * 512 + (pn & 1) * 256 + wc * 32 + 4 * fq;
                    const float sc = pn < 2 ? rs * QSCALE_D : rs;
                    const bool rope = (pn < 4) && ((wc & 1) == 0);
#pragma unroll
                    for (int bj = 0; bj < 2; ++bj)
#pragma unroll
                        for (int n = 0; n < 2; ++n) {
                            f32x4 v = acc[ai][bj][m][n] * sc;
                            if (n == 0 && rope) {
                                f32x4 pv; pv[0] = __shfl_xor(v[0], 32); pv[1] = __shfl_xor(v[1], 32); pv[2] = __shfl_xor(v[2], 32); pv[3] = __shfl_xor(v[3], 32);
                                const f32x4 c = *(const f32x4*)(cosp + pos * 8 + 4 * (fq & 1)), s = *(const f32x4*)(sinp + pos * 8 + 4 * (fq & 1));
                                v = (fq < 2) ? (v * c - pv * s) : (v * c + pv * s);
                            }
                            u32x2 w; w.x = cvt_pk_bf16(v[0], v[1]); w.y = cvt_pk_bf16(v[2], v[3]);
                            *(u32x2*)(dst + bj * 128 + n * 16) = w;
                        }
                } else if (pn == 6 || pn == 8) {
                    bf16_t* dst = CQ + (pn == 6 ? (size_t)row * 384 : (size_t)NT * 384 + (size_t)row * 256) + wc * 32 + 4 * fq; float sq = 0.f;
#pragma unroll
                    for (int bj = 0; bj < 2; ++bj)
#pragma unroll
                        for (int n = 0; n < 2; ++n) {
                            const f32x4 v = acc[ai][bj][m][n] * rs; sq += sq4(v);
                            u32x2 w; w.x = cvt_pk_bf16(v[0], v[1]); w.y = cvt_pk_bf16(v[2], v[3]);
                            *(u32x2*)(dst + bj * 128 + n * 16) = w;
                        }
                    sq += __shfl_xor(sq, 16); sq += __shfl_xor(sq, 32);
                    if (fq == 0) SSQ[(pn == 6 ? (size_t)row * 8 : (size_t)NT * 8 + (size_t)row * 4) + wc] = sq;
                } else {
                    bf16_t* dst = CQ + (size_t)row * 384 + 256 + wc * 32 + 4 * fq; float sq = 0.f;
#pragma unroll
                    for (int n = 0; n < 2; ++n) {
                        const f32x4 v = acc[ai][0][m][n] * rs; sq += sq4(v);
                        u32x2 w; w.x = cvt_pk_bf16(v[0], v[1]); w.y = cvt_pk_bf16(v[2], v[3]);
                        *(u32x2*)(dst + n * 16) = w;
                    }
                    sq += __shfl_xor(sq, 16); sq += __shfl_xor(sq, 32);
                    if (fq == 0) SSQ[(size_t)row * 8 + 4 + wc] = sq;
                    if (wc == 0) {
                        const f32x4 x1 = acc[ai][1][m][0] * rs, x2 = acc[ai][1][m][1] * rs;
                        const f32x4 c = *(const f32x4*)(cosm + pos * 16 + 4 * fq), s = *(const f32x4*)(sinm + pos * 16 + 4 * fq);
                        const f32x4 o1 = x1 * c - x2 * s, o2 = x2 * c + x1 * s;
                        u32x2 w1, w2; w1.x = cvt_pk_bf16(o1[0], o1[1]); w1.y = cvt_pk_bf16(o1[2], o1[3]); w2.x = cvt_pk_bf16(o2[0], o2[1]); w2.y = cvt_pk_bf16(o2[2], o2[3]);
                        *(u32x2*)(KR + (size_t)row * 32 + 4 * fq) = w1; *(u32x2*)(KR + (size_t)row * 32 + 16 + 4 * fq) = w2;
                    }
                }
            }
    }
};
struct EpiQ {
    static constexpr bool PERM = false, AFTER_DRAIN = false;
    const float* ssq; bf16_t* QM; const float *cosm, *sinm;
    __device__ __forceinline__ void operator()(const f32x4 (&acc)[2][2][4][2], const Unit& u, int wr, int wc, int fr_in, int fq_in) const {
        EPI_RELANE();
        const int row0 = u.pm * 256 + wr * 64 + fr;
#pragma unroll
        for (int ai = 0; ai < 2; ++ai)
#pragma unroll
            for (int m = 0; m < 4; ++m) {
                const int row = row0 + ai * 128 + m * 16, pos = row & (SEQ - 1);
                const f32x4* p = (const f32x4*)(ssq + (size_t)row * 8);
                const float rs = rsqrtf((sum4(p[0]) + sum4(p[1])) * (1.0f / 384.0f) + EPS) * QSCALE_M;
#pragma unroll
                for (int bj = 0; bj < 2; ++bj) {
                    const int g32 = 8 * u.pn + 4 * bj + wc;
                    bf16_t* dst = QM + (size_t)row * 768 + 32 * g32 + 4 * fq;
                    f32x4 v0 = acc[ai][bj][m][0] * rs, v1 = acc[ai][bj][m][1] * rs;
                    if (g32 % 3 == 2) {
                        const f32x4 c = *(const f32x4*)(cosm + pos * 16 + 4 * fq), s = *(const f32x4*)(sinm + pos * 16 + 4 * fq);
                        const f32x4 o1 = v0 * c - v1 * s, o2 = v1 * c + v0 * s; v0 = o1; v1 = o2;
                    }
                    u32x2 w0, w1; w0.x = cvt_pk_bf16(v0[0], v0[1]); w0.y = cvt_pk_bf16(v0[2], v0[3]); w1.x = cvt_pk_bf16(v1[0], v1[1]); w1.y = cvt_pk_bf16(v1[2], v1[3]);
                    *(u32x2*)dst = w0; *(u32x2*)(dst + 16) = w1;
                }
            }
    }
};
struct EpiKV {
    static constexpr bool PERM = true, AFTER_DRAIN = false;
    const float* sskv; bf16_t* KVM;
    __device__ __forceinline__ void operator()(const f32x4 (&acc)[2][2][4][2], const Unit& u, int wr, int wc, int fr_in, int fq_in) const {
        EPI_RELANE();
        const int row0 = u.pm * 256 + wr * 64 + fr, col = u.pn * 256 + wc * 32 + 8 * fq;
#pragma unroll
        for (int ai = 0; ai < 2; ++ai)
#pragma unroll
            for (int m = 0; m < 4; ++m) {
                const int row = row0 + ai * 128 + m * 16;
                const float rs = rsqrtf(sum4(*(const f32x4*)(sskv + (size_t)row * 4)) * (1.0f / 256.0f) + EPS);
#pragma unroll
                for (int bj = 0; bj < 2; ++bj) {
                    const f32x4 v0 = acc[ai][bj][m][0] * rs, v1 = acc[ai][bj][m][1] * rs;
                    u32x4 w; w.x = cvt_pk_bf16(v0[0], v0[1]); w.y = cvt_pk_bf16(v0[2], v0[3]); w.z = cvt_pk_bf16(v1[0], v1[1]); w.w = cvt_pk_bf16(v1[2], v1[3]);
                    *(u32x4*)(KVM + (size_t)row * 1024 + col + bj * 128) = w;
                }
            }
    }
};

constexpr int ATT_VS = 144;
constexpr int ATT_TILE = 64 * 208 + 64 * ATT_VS;
constexpr int ATT_OST = 2 * ATT_TILE, ATT_WSC = ATT_OST + NWAVES * 4096;
static_assert(ATT_WSC + NWAVES * 256 <= 131072, "attention LDS");
static_assert(WS_KD == WS_QD + (size_t)NT * 512 * 2 && WS_VD == WS_KD + (size_t)NT * 512 * 2 && WS_CKV == WS_CQ + (size_t)NT * 384 * 2 && WS_SSKV == WS_SSQ + (size_t)NT * 8 * 4, "buffers addressed relative to each other");
__device__ __forceinline__ int crow(int r, int hi) { return (r & 3) + 8 * (r >> 2) + 4 * hi; }
__device__ __forceinline__ bf16x8 pack8(const f32x16& p, int b) {
    u32x4 w; w.x = cvt_pk_bf16(p[b], p[b + 1]); w.y = cvt_pk_bf16(p[b + 2], p[b + 3]); w.z = cvt_pk_bf16(p[b + 4], p[b + 5]); w.w = cvt_pk_bf16(p[b + 6], p[b + 7]);
    return __builtin_bit_cast(bf16x8, w);
}
typedef short v4i16_t __attribute__((ext_vector_type(4)));
__device__ __forceinline__ s16x4 vtr(LAS const unsigned char* p) { return __builtin_bit_cast(s16x4, __builtin_amdgcn_ds_read_tr16_b64_v4i16((LAS v4i16_t*)p)); }

struct AttnIO {
    const bf16_t *QM, *KVM, *KR; bf16_t* OMIX;
    const bf16_t *QD, *KD, *VD; bf16_t* OD; float* LSE;
};

template <bool DIL>
__device__ __forceinline__ void attn_unit(LAS unsigned char* lds, const AttnIO& io, int unit) {
    constexpr int DK = DIL ? 64 : 96, KS = DK * 2 + 16, NKS = DK / 16;
    int tid_ = threadIdx.x; asm volatile("" : "+v"(tid_));
    const int tid = tid_, lane = tid & 63, wid = __builtin_amdgcn_readfirstlane(tid >> 6), r32 = lane & 31, hi = lane >> 5;
    int b, h, ntiles, tlo, thi, kofs = 0, L = SEQ, dil = 1, res = 0, resu = 0, br = 0, q0 = 0, pq;
    if constexpr (!DIL) {
        const int bh = unit >> 3, qb = unit & 7; b = bh >> 3; h = bh & 7; ntiles = 32; tlo = 0; thi = 32; q0 = qb * 256; pq = q0 + wid * 32 + r32;
    } else {
        const int bh = unit / 24, k = unit % 24, j = k & 7; br = k >> 3; b = bh >> 3; h = bh & 7;
        if (br == 0) { dil = 1; L = 2048; resu = 0; q0 = 256 * j; }
        else if (br == 1) { dil = 4; L = 512; resu = j >> 1; q0 = 256 * (j & 1); }
        else { dil = 16; L = 128; resu = 2 * j; q0 = 0; }
        if (br < 2) { ntiles = 6; tlo = wid >> 1; thi = tlo + 3; kofs = q0 - 64; pq = q0 + wid * 32 + r32; res = resu; }
        else { const int hw = wid >> 2; ntiles = 4; tlo = 2 * hw; thi = tlo + 2; kofs = -128 * hw; pq = (wid & 3) * 32 + r32; res = resu + hw; }
    }
    const int pq0 = pq - r32;
    const size_t kb = (size_t)b * SEQ;
    bf16x8 qf[NKS];
    {
        const bf16_t* qp = DIL ? io.QD + (kb + (size_t)pq * dil + res) * 512 + h * 64 : io.QM + (kb + pq) * 768 + h * 96;
#pragma unroll
        for (int ks = 0; ks < NKS; ++ks) qf[ks] = *(const bf16x8*)(qp + ks * 16 + hi * 8);
    }
    const int lrow = tid >> 3, lch = tid & 7, rrow = (tid >> 2) & 63, rch = tid & 3;
    u32x4 gkA, gvA, grA = (u32x4){0u, 0u, 0u, 0u}, gkB, gvB, grB = (u32x4){0u, 0u, 0u, 0u};
#define ATT_TOK(t) \
        const int s_ = 64 * (t) + lrow; size_t tok_; \
        if (br < 2) { int p_ = q0 - 64 + s_; p_ = p_ < 0 ? 0 : (p_ > L - 1 ? L - 1 : p_); tok_ = kb + (size_t)p_ * dil + resu; } \
        else { tok_ = kb + (size_t)(s_ & 127) * 16 + (size_t)(resu + (s_ >> 7)); }
#define ATT_GLOADK(t, GK, GR) do { \
        if constexpr (!DIL) { \
            GK = *(const u32x4*)(io.KVM + (kb + 64 * (t) + lrow) * 1024 + h * 128 + lch * 8); \
            GR = *(const u32x4*)(io.KR + (kb + 64 * (t) + rrow) * 32 + rch * 8); \
        } else { ATT_TOK(t) GK = *(const u32x4*)(io.KD + tok_ * 512 + h * 64 + lch * 8); } } while (0)
#define ATT_GLOADV(t, GV) do { \
        if constexpr (!DIL) { GV = *(const u32x4*)(io.KVM + (kb + 64 * (t) + lrow) * 1024 + h * 128 + 64 + lch * 8); } \
        else { ATT_TOK(t) GV = *(const u32x4*)(io.VD + tok_ * 512 + h * 64 + lch * 8); } } while (0)
#define ATT_LSTOREK(buf, GK, GR) do { \
        LAS unsigned char* Kb_ = lds + (buf) * ATT_TILE; \
        *(LAS u32x4*)(Kb_ + lrow * KS + lch * 16) = GK; \
        if constexpr (!DIL) { *(LAS u32x4*)(Kb_ + rrow * KS + 128 + rch * 16) = GR; } } while (0)
#define ATT_LSTOREV(buf, GV) do { *(LAS u32x4*)(lds + (buf) * ATT_TILE + 64 * KS + lrow * ATT_VS + lch * 16) = GV; } while (0)
#define ATT_SB() __builtin_amdgcn_sched_barrier(0)
    LAS float* wsc = (LAS float*)(lds + ATT_WSC + wid * 256);
    f32x16 o0 = {}, o1 = {}, negm = {};
    float mref = 0.f, lrun = 0.f; bool started = false;
    const int krow = (r32 & 19) | ((r32 & 4) << 1) | ((r32 & 8) >> 1);
    const int koff = krow * KS + hi * 16;
    const int i16 = lane & 15, g16 = lane >> 4;
    const int voff = 64 * KS + (8 * hi + (i16 >> 2)) * ATT_VS + (16 * (g16 & 1) + 4 * (i16 & 3)) * 2;
    ATT_GLOADK(0, gkA, grA); ATT_GLOADV(0, gvA); ATT_GLOADK(1, gkB, grB); ATT_LSTOREK(0, gkA, grA); ATT_LSTOREV(0, gvA); ATT_LSTOREK(1, gkB, grB);
    ATT_GLOADK(2, gkB, grB); ATT_GLOADV(1, gvB);
    __syncthreads();
    f32x16 c0, c1;
    if (tlo == 0) {
        c0 = negm; c1 = negm;
#pragma unroll
        for (int ks = 0; ks < NKS; ++ks) {
            const bf16x8 a0 = *(LAS const bf16x8*)(lds + koff + ks * 32), a1 = *(LAS const bf16x8*)(lds + koff + 32 * KS + ks * 32);
            c0 = __builtin_amdgcn_mfma_f32_32x32x16_bf16(a0, qf[ks], c0, 0, 0, 0); c1 = __builtin_amdgcn_mfma_f32_32x32x16_bf16(a1, qf[ks], c1, 0, 0, 0);
        }
    } else { c0 = negm; c1 = negm; }
    __syncthreads();
    for (int t2 = 0; t2 < ntiles; t2 += 2) {
      { const int t = t2;
        ATT_GLOADK(min(t + 3, ntiles - 1), gkA, grA);
        ATT_GLOADV(min(t + 2, ntiles - 1), gvA);
        const bool doP = (t >= tlo) && (t < thi), doS = (t + 1 >= tlo) && (t + 1 < thi);
        LAS const unsigned char* Kn = lds + ((t + 1) & 1) * ATT_TILE + koff;
        LAS const unsigned char* Vc = lds + (t & 1) * ATT_TILE + voff;
        f32x16 n0 = negm, n1 = negm;
        if (doP) {
            if constexpr (DIL) {
                const int P0 = 64 * t + kofs;
                const bool full = (P0 >= pq0 - 33) && (P0 + 63 <= pq0 + 64) && (P0 >= 0) && (P0 + 63 < L);
                if (!full) {
                    const int lo = max(pq - 64, 0) - P0 - 8 * hi, span = min(pq + 64, L - 1) - max(pq - 64, 0);
#pragma unroll
                    for (int r = 0; r < 16; ++r) {
                        const int i0 = 16 * (r >> 3) + (r & 7);
                        c0[r] = ((unsigned)(i0 - lo) <= (unsigned)span) ? c0[r] : -INFINITY;
                        c1[r] = ((unsigned)(i0 + 32 - lo) <= (unsigned)span) ? c1[r] : -INFINITY;
                    }
                }
            }
            float ma = fmaxf(fmaxf(c0[0], c0[1]), c1[0]), mb = fmaxf(fmaxf(c0[2], c0[3]), c1[1]);
            ma = fmaxf(fmaxf(ma, c1[2]), c1[3]);
#pragma unroll
            for (int r = 4; r < 16; r += 4) { ma = fmaxf(fmaxf(ma, c0[r]), c0[r + 1]); mb = fmaxf(fmaxf(mb, c0[r + 2]), c0[r + 3]); ma = fmaxf(fmaxf(ma, c1[r]), c1[r + 1]); mb = fmaxf(fmaxf(mb, c1[r + 2]), c1[r + 3]); }
            float rm = fmaxf(ma, mb);
            { auto rr = __builtin_amdgcn_permlane32_swap(__float_as_uint(rm), __float_as_uint(rm), false, false); rm = fmaxf(__uint_as_float(rr[0]), __uint_as_float(rr[1])); }
            const float dl = (rm > -1e30f && (!started || rm > 8.f)) ? rm : 0.f;
            started = started || (rm > -1e30f);
            const bool resc = __any(dl != 0.f);
            if (resc) {
                mref += dl;
#pragma unroll
                for (int r = 0; r < 16; ++r) { c0[r] -= dl; c1[r] -= dl; }
#pragma unroll
                for (int r = 0; r < 16; ++r) negm[r] = -mref;
                const float f = fast_exp2(-fmaxf(dl, 0.f)); lrun *= f;
                if (hi == 0) wsc[r32] = f;
                n0 = negm; n1 = negm;
            }
            float ps0 = 0.f, ps1 = 0.f;
            u32x4 pw0, pw1, pw2, pw3;
#define ATT_EXPU(u) do { c0[u] = fast_exp2(c0[u]); c1[u] = fast_exp2(c1[u]); ps0 += c0[u]; ps1 += c1[u]; } while (0)
#define ATT_PK(u) do { const unsigned x0_ = cvt_pk_bf16(c0[u - 1], c0[u]), x1_ = cvt_pk_bf16(c1[u - 1], c1[u]); \
            if ((u) < 8) { pw0[((u) >> 1) & 3] = x0_; pw2[((u) >> 1) & 3] = x1_; } else { pw1[((u) >> 1) & 3] = x0_; pw3[((u) >> 1) & 3] = x1_; } } while (0)
            if (doS) {
                bf16x8 a0 = *(LAS const bf16x8*)(Kn), a1 = *(LAS const bf16x8*)(Kn + 32 * KS);
#pragma unroll
                for (int ks = 0; ks < NKS; ++ks) {
                    bf16x8 b0 = a0, b1 = a1;
                    if (ks + 1 < NKS) { b0 = *(LAS const bf16x8*)(Kn + (ks + 1) * 32); b1 = *(LAS const bf16x8*)(Kn + 32 * KS + (ks + 1) * 32); }
                    n0 = __builtin_amdgcn_mfma_f32_32x32x16_bf16(a0, qf[ks], n0, 0, 0, 0);
                    n1 = __builtin_amdgcn_mfma_f32_32x32x16_bf16(a1, qf[ks], n1, 0, 0, 0);
                    a0 = b0; a1 = b1;
                    const int u_lo = (16 * ks) / NKS, u_hi = (16 * (ks + 1)) / NKS;
#pragma unroll
                    for (int u = u_lo; u < u_hi; ++u) { ATT_EXPU(u); if (u & 1) ATT_PK(u); }
                    ATT_SB();
                }
            } else {
#pragma unroll
                for (int u = 0; u < 16; ++u) { ATT_EXPU(u); if (u & 1) ATT_PK(u); }
            }
            lrun += ps0 + ps1;
            if (resc) {
#pragma unroll
                for (int g = 0; g < 4; ++g) {
                    const f32x4 av = *(LAS const f32x4*)(wsc + 8 * g + 4 * hi);
#pragma unroll
                    for (int e = 0; e < 4; ++e) { o0[4 * g + e] *= av[e]; o1[4 * g + e] *= av[e]; }
                }
            }
            {
                s16x4 va = vtr(Vc), vb = vtr(Vc + 4 * ATT_VS), vc = vtr(Vc + 64), vd = vtr(Vc + 64 + 4 * ATT_VS);
#pragma unroll
                for (int j = 0; j < 4; ++j) {
                    const bf16x8 pa = __builtin_bit_cast(bf16x8, j == 0 ? pw0 : (j == 1 ? pw1 : (j == 2 ? pw2 : pw3)));
                    const bf16x8 vf0 = (bf16x8){va[0], va[1], va[2], va[3], vb[0], vb[1], vb[2], vb[3]};
                    const bf16x8 vf1 = (bf16x8){vc[0], vc[1], vc[2], vc[3], vd[0], vd[1], vd[2], vd[3]};
                    if (j + 1 < 4) { LAS const unsigned char* vp = Vc + (j + 1) * 16 * ATT_VS; va = vtr(vp); vb = vtr(vp + 4 * ATT_VS); vc = vtr(vp + 64); vd = vtr(vp + 64 + 4 * ATT_VS); }
                    o0 = __builtin_amdgcn_mfma_f32_32x32x16_bf16(pa, vf0, o0, 0, 0, 0);
                    o1 = __builtin_amdgcn_mfma_f32_32x32x16_bf16(pa, vf1, o1, 0, 0, 0);
                }
            }
        } else if (doS) {
#pragma unroll
            for (int ks = 0; ks < NKS; ++ks) {
                const bf16x8 a0 = *(LAS const bf16x8*)(Kn + ks * 32), a1 = *(LAS const bf16x8*)(Kn + 32 * KS + ks * 32);
                n0 = __builtin_amdgcn_mfma_f32_32x32x16_bf16(a0, qf[ks], n0, 0, 0, 0); n1 = __builtin_amdgcn_mfma_f32_32x32x16_bf16(a1, qf[ks], n1, 0, 0, 0);
            }
        }
        c0 = n0; c1 = n1;
        ATT_LSTOREK(t & 1, gkB, grB);
        ATT_LSTOREV((t + 1) & 1, gvB);
        __syncthreads();
          }
      { const int t = t2 + 1;
        ATT_GLOADK(min(t + 3, ntiles - 1), gkB, grB);
        ATT_GLOADV(min(t + 2, ntiles - 1), gvB);
        const bool doP = (t >= tlo) && (t < thi), doS = (t + 1 >= tlo) && (t + 1 < thi);
        LAS const unsigned char* Kn = lds + ((t + 1) & 1) * ATT_TILE + koff;
        LAS const unsigned char* Vc = lds + (t & 1) * ATT_TILE + voff;
        f32x16 n0 = negm, n1 = negm;
        if (doP) {
            if constexpr (DIL) {
                const int P0 = 64 * t + kofs;
                const bool full = (P0 >= pq0 - 33) && (P0 + 63 <= pq0 + 64) && (P0 >= 0) && (P0 + 63 < L);
                if (!full) {
                    const int lo = max(pq - 64, 0) - P0 - 8 * hi, span = min(pq + 64, L - 1) - max(pq - 64, 0);
#pragma unroll
                    for (int r = 0; r < 16; ++r) {
                        const int i0 = 16 * (r >> 3) + (r & 7);
                        c0[r] = ((unsigned)(i0 - lo) <= (unsigned)span) ? c0[r] : -INFINITY;
                        c1[r] = ((unsigned)(i0 + 32 - lo) <= (unsigned)span) ? c1[r] : -INFINITY;
                    }
                }
            }
            float ma = fmaxf(fmaxf(c0[0], c0[1]), c1[0]), mb = fmaxf(fmaxf(c0[2], c0[3]), c1[1]);
            ma = fmaxf(fmaxf(ma, c1[2]), c1[3]);
#pragma unroll
            for (int r = 4; r < 16; r += 4) { ma = fmaxf(fmaxf(ma, c0[r]), c0[r + 1]); mb = fmaxf(fmaxf(mb, c0[r + 2]), c0[r + 3]); ma = fmaxf(fmaxf(ma, c1[r]), c1[r + 1]); mb = fmaxf(fmaxf(mb, c1[r + 2]), c1[r + 3]); }
            float rm = fmaxf(ma, mb);
            { auto rr = __builtin_amdgcn_permlane32_swap(__float_as_uint(rm), __float_as_uint(rm), false, false); rm = fmaxf(__uint_as_float(rr[0]), __uint_as_float(rr[1])); }
            const float dl = (rm > -1e30f && (!started || rm > 8.f)) ? rm : 0.f;
            started = started || (rm > -1e30f);
            const bool resc = __any(dl != 0.f);
            if (resc) {
                mref += dl;
#pragma unroll
                for (int r = 0; r < 16; ++r) { c0[r] -= dl; c1[r] -= dl; }
#pragma unroll
                for (int r = 0; r < 16; ++r) negm[r] = -mref;
                const float f = fast_exp2(-fmaxf(dl, 0.f)); lrun *= f;
                if (hi == 0) wsc[r32] = f;
                n0 = negm; n1 = negm;
            }
            float ps0 = 0.f, ps1 = 0.f;
            u32x4 pw0, pw1, pw2, pw3;
#define ATT_EXPU(u) do { c0[u] = fast_exp2(c0[u]); c1[u] = fast_exp2(c1[u]); ps0 += c0[u]; ps1 += c1[u]; } while (0)
#define ATT_PK(u) do { const unsigned x0_ = cvt_pk_bf16(c0[u - 1], c0[u]), x1_ = cvt_pk_bf16(c1[u - 1], c1[u]); \
            if ((u) < 8) { pw0[((u) >> 1) & 3] = x0_; pw2[((u) >> 1) & 3] = x1_; } else { pw1[((u) >> 1) & 3] = x0_; pw3[((u) >> 1) & 3] = x1_; } } while (0)
            if (doS) {
                bf16x8 a0 = *(LAS const bf16x8*)(Kn), a1 = *(LAS const bf16x8*)(Kn + 32 * KS);
#pragma unroll
                for (int ks = 0; ks < NKS; ++ks) {
                    bf16x8 b0 = a0, b1 = a1;
                    if (ks + 1 < NKS) { b0 = *(LAS const bf16x8*)(Kn + (ks + 1) * 32); b1 = *(LAS const bf16x8*)(Kn + 32 * KS + (ks + 1) * 32); }
                    n0 = __builtin_amdgcn_mfma_f32_32x32x16_bf16(a0, qf[ks], n0, 0, 0, 0);
                    n1 = __builtin_amdgcn_mfma_f32_32x32x16_bf16(a1, qf[ks], n1, 0, 0, 0);
                    a0 = b0; a1 = b1;
                    const int u_lo = (16 * ks) / NKS, u_hi = (16 * (ks + 1)) / NKS;
#pragma unroll
                    for (int u = u_lo; u < u_hi; ++u) { ATT_EXPU(u); if (u & 1) ATT_PK(u); }
                    ATT_SB();
                }
            } else {
#pragma unroll
                for (int u = 0; u < 16; ++u) { ATT_EXPU(u); if (u & 1) ATT_PK(u); }
            }
            lrun += ps0 + ps1;
            if (resc) {
#pragma unroll
                for (int g = 0; g < 4; ++g) {
                    const f32x4 av = *(LAS const f32x4*)(wsc + 8 * g + 4 * hi);
#pragma unroll
                    for (int e = 0; e < 4; ++e) { o0[4 * g + e] *= av[e]; o1[4 * g + e] *= av[e]; }
                }
            }
            {
                s16x4 va = vtr(Vc), vb = vtr(Vc + 4 * ATT_VS), vc = vtr(Vc + 64), vd = vtr(Vc + 64 + 4 * ATT_VS);
#pragma unroll
                for (int j = 0; j < 4; ++j) {
                    const bf16x8 pa = __builtin_bit_cast(bf16x8, j == 0 ? pw0 : (j == 1 ? pw1 : (j == 2 ? pw2 : pw3)));
                    const bf16x8 vf0 = (bf16x8){va[0], va[1], va[2], va[3], vb[0], vb[1], vb[2], vb[3]};
                    const bf16x8 vf1 = (bf16x8){vc[0], vc[1], vc[2], vc[3], vd[0], vd[1], vd[2], vd[3]};
                    if (j + 1 < 4) { LAS const unsigned char* vp = Vc + (j + 1) * 16 * ATT_VS; va = vtr(vp); vb = vtr(vp + 4 * ATT_VS); vc = vtr(vp + 64); vd = vtr(vp + 64 + 4 * ATT_VS); }
                    o0 = __builtin_amdgcn_mfma_f32_32x32x16_bf16(pa, vf0, o0, 0, 0, 0);
                    o1 = __builtin_amdgcn_mfma_f32_32x32x16_bf16(pa, vf1, o1, 0, 0, 0);
                }
            }
        } else if (doS) {
#pragma unroll
            for (int ks = 0; ks < NKS; ++ks) {
                const bf16x8 a0 = *(LAS const bf16x8*)(Kn + ks * 32), a1 = *(LAS const bf16x8*)(Kn + 32 * KS + ks * 32);
                n0 = __builtin_amdgcn_mfma_f32_32x32x16_bf16(a0, qf[ks], n0, 0, 0, 0); n1 = __builtin_amdgcn_mfma_f32_32x32x16_bf16(a1, qf[ks], n1, 0, 0, 0);
            }
        }
        c0 = n0; c1 = n1;
        ATT_LSTOREK(t & 1, gkA, grA);
        ATT_LSTOREV((t + 1) & 1, gvA);
        __syncthreads();
          }
    }
    float ltot;
    { auto rr = __builtin_amdgcn_permlane32_swap(__float_as_uint(lrun), __float_as_uint(lrun), false, false); ltot = __uint_as_float(rr[0]) + __uint_as_float(rr[1]); }
    if (hi == 0) wsc[r32] = fast_rcp(ltot);
    LAS bf16_t* stg = (LAS bf16_t*)(lds + ATT_OST + wid * 4096);
#pragma unroll
    for (int g = 0; g < 4; ++g) {
        const f32x4 iv = *(LAS const f32x4*)(wsc + 8 * g + 4 * hi);
#pragma unroll
        for (int e = 0; e < 4; ++e) {
            const int r = 4 * g + e, orow = crow(r, hi);
            stg[orow * 64 + r32] = (bf16_t)(cvt_pk_bf16(o0[r] * iv[e], 0.f) & 0xffffu);
            stg[orow * 64 + 32 + r32] = (bf16_t)(cvt_pk_bf16(o1[r] * iv[e], 0.f) & 0xffffu);
        }
    }
#pragma unroll
    for (int it = 0; it < 4; ++it) {
        const int row = it * 8 + (lane >> 3), ch = lane & 7;
        const u32x4 v = *(LAS const u32x4*)(stg + row * 64 + ch * 8);
        if constexpr (DIL) { const size_t tok = kb + (size_t)(pq0 + row) * dil + res; *(u32x4*)(io.OD + (size_t)br * NT * 512 + tok * 512 + h * 64 + ch * 8) = v; }
        else *(u32x4*)(io.OMIX + (kb + pq0 + row) * 1024 + h * 64 + ch * 8) = v;
    }
    if constexpr (DIL) { if (hi == 0) { const size_t tok = kb + (size_t)pq * dil + res; io.LSE[((size_t)br * NT + tok) * 8 + h] = mref + __builtin_amdgcn_logf(ltot); } }
}
#undef ATT_TOK
#undef ATT_GLOADK
#undef ATT_GLOADV
#undef ATT_LSTOREK
#undef ATT_LSTOREV
#undef ATT_SB
#undef ATT_EXPU
#undef ATT_PK

constexpr int DIL_RS = 144;
constexpr int DIL_K = 0, DIL_V = 384 * DIL_RS, DIL_OST = 2 * 384 * DIL_RS, DIL_WSC = DIL_OST + NWAVES * 4096, DIL_LDS = DIL_WSC + NWAVES * 256;
struct DilUnit { int b, h, br, dil, L, resu, q0, nrows; };
__device__ __forceinline__ DilUnit dil_decode(int unit) {
    DilUnit d; const int bh = unit / 24, k = unit % 24, j = k & 7; d.br = k >> 3; d.b = bh >> 3; d.h = bh & 7;
    if (d.br == 0) { d.dil = 1; d.L = 2048; d.resu = 0; d.q0 = 256 * j; d.nrows = 384; }
    else if (d.br == 1) { d.dil = 4; d.L = 512; d.resu = j >> 1; d.q0 = 256 * (j & 1); d.nrows = 384; }
    else { d.dil = 16; d.L = 128; d.resu = 2 * j; d.q0 = 0; d.nrows = 256; }
    return d;
}
__device__ __forceinline__ size_t dil_tok(const DilUnit& d, int s) {
    const size_t kb = (size_t)d.b * SEQ;
    if (d.br < 2) { int p = d.q0 - 64 + s; p = p < 0 ? 0 : (p > d.L - 1 ? d.L - 1 : p); return kb + (size_t)p * d.dil + d.resu; }
    return kb + (size_t)(s & 127) * 16 + (size_t)(d.resu + (s >> 7));
}
__device__ __forceinline__ void dil_phase(LAS unsigned char* lds, const AttnIO& io, int bx, int G) {
    int tid_ = threadIdx.x; asm volatile("" : "+v"(tid_));
    const int tid = tid_, lane = tid & 63, wid = __builtin_amdgcn_readfirstlane(tid >> 6), r32 = lane & 31, hi = lane >> 5;
    const int lrow = tid >> 3, lch = tid & 7;
    const int krow = (r32 & 19) | ((r32 & 4) << 1) | ((r32 & 8) >> 1);
    const int i16 = lane & 15, g16 = lane >> 4;
    const int voff = DIL_V + (8 * hi + (i16 >> 2)) * DIL_RS + (16 * (g16 & 1) + 4 * (i16 & 3)) * 2;
    LAS float* wsc = (LAS float*)(lds + DIL_WSC + wid * 256);
    LAS bf16_t* stg = (LAS bf16_t*)(lds + DIL_OST + wid * 4096);
    constexpr int NUNITS = 256 * 24;
    u32x4 gk[6], gv[6]; bf16x8 qn[4];
#define DIL_WAVE(d, TLO, NTW, KOFS, PQ, RES) \
    int TLO, NTW, KOFS, PQ, RES; \
    if ((d).br < 2) { TLO = wid >> 1; NTW = 3; KOFS = (d).q0 - 64; PQ = (d).q0 + wid * 32 + r32; RES = (d).resu; } \
    else { const int hw_ = wid >> 2; TLO = 2 * hw_; NTW = 2; KOFS = -128 * hw_; PQ = (wid & 3) * 32 + r32; RES = (d).resu + hw_; }
#define DIL_PREFETCH(unit) do { \
        const DilUnit d_ = dil_decode(unit); \
        _Pragma("unroll") for (int i = 0; i < 6; ++i) { const int row_ = lrow + 64 * i; \
            if (row_ < d_.nrows) { const size_t tok_ = dil_tok(d_, row_); gk[i] = *(const u32x4*)(io.KD + tok_ * 512 + d_.h * 64 + lch * 8); gv[i] = *(const u32x4*)(io.VD + tok_ * 512 + d_.h * 64 + lch * 8); } } \
        DIL_WAVE(d_, tlo_, ntw_, kofs_, pq_, res_) (void)tlo_; (void)ntw_; (void)kofs_; \
        const bf16_t* qp_ = io.QD + ((size_t)d_.b * SEQ + (size_t)pq_ * d_.dil + res_) * 512 + d_.h * 64; \
        _Pragma("unroll") for (int ks = 0; ks < 4; ++ks) qn[ks] = *(const bf16x8*)(qp_ + ks * 16 + hi * 8); \
    } while (0)
    int unit = bx;
    if (unit < NUNITS) DIL_PREFETCH(unit);
    for (; unit < NUNITS; unit += G) {
        const DilUnit d = dil_decode(unit);
#pragma unroll
        for (int i = 0; i < 6; ++i) { const int row = lrow + 64 * i;
            if (row < d.nrows) { *(LAS u32x4*)(lds + DIL_K + row * DIL_RS + lch * 16) = gk[i]; *(LAS u32x4*)(lds + DIL_V + row * DIL_RS + lch * 16) = gv[i]; } }
        bf16x8 qf[4];
#pragma unroll
        for (int ks = 0; ks < 4; ++ks) qf[ks] = qn[ks];
        __syncthreads();
        if (unit + G < NUNITS) DIL_PREFETCH(unit + G);
        DIL_WAVE(d, tlo, ntw, kofs, pq, res)
        const int pq0 = pq - r32;
        f32x16 o0 = {}, o1 = {};
        float mrun = -1e30f, lrun = 0.f;
        for (int tt = 0; tt < ntw; ++tt) {
            const int t = tlo + tt;
            LAS const unsigned char* Kb = lds + DIL_K + (64 * t + krow) * DIL_RS + hi * 16;
            f32x16 s0 = {}, s1 = {};
#pragma unroll
            for (int ks = 0; ks < 4; ++ks) {
                const bf16x8 a0 = *(LAS const bf16x8*)(Kb + ks * 32), a1 = *(LAS const bf16x8*)(Kb + 32 * DIL_RS + ks * 32);
                s0 = __builtin_amdgcn_mfma_f32_32x32x16_bf16(a0, qf[ks], s0, 0, 0, 0);
                s1 = __builtin_amdgcn_mfma_f32_32x32x16_bf16(a1, qf[ks], s1, 0, 0, 0);
            }
            {
                const int P0 = 64 * t + kofs;
                const bool full = (P0 >= pq0 - 33) && (P0 + 63 <= pq0 + 64) && (P0 >= 0) && (P0 + 63 < d.L);
                if (!full) {
                    const int lo = max(pq - 64, 0) - P0 - 8 * hi, span = min(pq + 64, d.L - 1) - max(pq - 64, 0);
#pragma unroll
                    for (int r = 0; r < 16; ++r) {
                        const int i0 = 16 * (r >> 3) + (r & 7);
                        s0[r] = ((unsigned)(i0 - lo) <= (unsigned)span) ? s0[r] : -INFINITY;
                        s1[r] = ((unsigned)(i0 + 32 - lo) <= (unsigned)span) ? s1[r] : -INFINITY;
                    }
                }
            }
            float ma = fmaxf(fmaxf(s0[0], s0[1]), s1[0]), mb = fmaxf(fmaxf(s0[2], s0[3]), s1[1]);
            ma = fmaxf(fmaxf(ma, s1[2]), s1[3]);
#pragma unroll
            for (int r = 4; r < 16; r += 4) { ma = fmaxf(fmaxf(ma, s0[r]), s0[r + 1]); mb = fmaxf(fmaxf(mb, s0[r + 2]), s0[r + 3]); ma = fmaxf(fmaxf(ma, s1[r]), s1[r + 1]); mb = fmaxf(fmaxf(mb, s1[r + 2]), s1[r + 3]); }
            float mx = fmaxf(ma, mb);
            { auto rr = __builtin_amdgcn_permlane32_swap(__float_as_uint(mx), __float_as_uint(mx), false, false); mx = fmaxf(__uint_as_float(rr[0]), __uint_as_float(rr[1])); }
            const float mnew = fmaxf(mrun, mx), alpha = fast_exp2(mrun - mnew);
            mrun = mnew;
            float ps0 = 0.f, ps1 = 0.f;
#pragma unroll
            for (int r = 0; r < 16; ++r) { s0[r] = fast_exp2(s0[r] - mnew); s1[r] = fast_exp2(s1[r] - mnew); ps0 += s0[r]; ps1 += s1[r]; }
            lrun = lrun * alpha + (ps0 + ps1);
            if (__any(alpha != 1.0f)) {
                if (hi == 0) wsc[r32] = alpha;
#pragma unroll
                for (int g = 0; g < 4; ++g) {
                    const f32x4 av = *(LAS const f32x4*)(wsc + 8 * g + 4 * hi);
#pragma unroll
                    for (int e = 0; e < 4; ++e) { o0[4 * g + e] *= av[e]; o1[4 * g + e] *= av[e]; }
                }
            }
            const bf16x8 pa0 = pack8(s0, 0), pa1 = pack8(s0, 8), pa2 = pack8(s1, 0), pa3 = pack8(s1, 8);
            LAS const unsigned char* Vb = lds + voff + 64 * t * DIL_RS;
#pragma unroll
            for (int j = 0; j < 4; ++j) {
                const bf16x8 pa = j == 0 ? pa0 : (j == 1 ? pa1 : (j == 2 ? pa2 : pa3));
                LAS const unsigned char* vp = Vb + j * 16 * DIL_RS;
                const s16x4 a = vtr(vp), bq = vtr(vp + 4 * DIL_RS), c = vtr(vp + 64), dd = vtr(vp + 64 + 4 * DIL_RS);
                const bf16x8 vf0 = (bf16x8){a[0], a[1], a[2], a[3], bq[0], bq[1], bq[2], bq[3]};
                const bf16x8 vf1 = (bf16x8){c[0], c[1], c[2], c[3], dd[0], dd[1], dd[2], dd[3]};
                o0 = __builtin_amdgcn_mfma_f32_32x32x16_bf16(pa, vf0, o0, 0, 0, 0);
                o1 = __builtin_amdgcn_mfma_f32_32x32x16_bf16(pa, vf1, o1, 0, 0, 0);
            }
        }
        float ltot;
        { auto rr = __builtin_amdgcn_permlane32_swap(__float_as_uint(lrun), __float_as_uint(lrun), false, false); ltot = __uint_as_float(rr[0]) + __uint_as_float(rr[1]); }
        if (hi == 0) wsc[r32] = fast_rcp(ltot);
#pragma unroll
        for (int g = 0; g < 4; ++g) {
            const f32x4 iv = *(LAS const f32x4*)(wsc + 8 * g + 4 * hi);
#pragma unroll
            for (int e = 0; e < 4; ++e) {
                const int r = 4 * g + e, orow = crow(r, hi);
                stg[orow * 64 + r32] = (bf16_t)(cvt_pk_bf16(o0[r] * iv[e], 0.f) & 0xffffu);
                stg[orow * 64 + 32 + r32] = (bf16_t)(cvt_pk_bf16(o1[r] * iv[e], 0.f) & 0xffffu);
            }
        }
        const size_t kb = (size_t)d.b * SEQ;
#pragma unroll
        for (int it = 0; it < 4; ++it) {
            const int row = it * 8 + (lane >> 3), ch = lane & 7;
            const u32x4 v = *(LAS const u32x4*)(stg + row * 64 + ch * 8);
            const size_t tok = kb + (size_t)(pq0 + row) * d.dil + res;
            *(u32x4*)(io.OD + (size_t)d.br * NT * 512 + tok * 512 + d.h * 64 + ch * 8) = v;
        }
        if (hi == 0) { const size_t tok = kb + (size_t)pq * d.dil + res; io.LSE[((size_t)d.br * NT + tok) * 8 + d.h] = mrun + __builtin_amdgcn_logf(ltot); }
        __syncthreads();
    }
#undef DIL_WAVE
#undef DIL_PREFETCH
}

__device__ __forceinline__ float wave_sum(float v) {
#pragma unroll
    for (int o = 1; o < 64; o <<= 1) v += __shfl_xor(v, o);
    return v;
}
__device__ __forceinline__ void tr_block(const float* W, int K, int N, const float* gain, bf16_t* WT, int k0, int n0, int dst_row0, LAS float* scr, int lane) {
#pragma unroll 8
    for (int i = 0; i < 32; ++i) {
        const int kk = 2 * i + (lane >> 5);
        float v = W[(size_t)(k0 + kk) * N + n0 + (lane & 31)];
        if (gain) v *= gain[k0 + kk];
        scr[kk * 33 + (lane & 31)] = v;
    }
    asm volatile("s_waitcnt lgkmcnt(0)" ::: "memory");
    const int c = lane & 7;
#pragma unroll
    for (int j = 0; j < 4; ++j) {
        const int n = (lane >> 3) + 8 * j; const LAS float* s = scr + (8 * c) * 33 + n;
        u32x4 o; o.x = cvt_pk_bf16(s[0 * 33], s[1 * 33]); o.y = cvt_pk_bf16(s[2 * 33], s[3 * 33]); o.z = cvt_pk_bf16(s[4 * 33], s[5 * 33]); o.w = cvt_pk_bf16(s[6 * 33], s[7 * 33]);
        *(u32x4*)(WT + (size_t)(dst_row0 + n) * K + k0 + 8 * c) = o;
    }
    asm volatile("s_waitcnt lgkmcnt(0)" ::: "memory");
}

#define XB_TMO      128
#define XB_XCNT(j)  (256  + 64 * (j))
#define XB_XSUB(j)  (1280 + 64 * (j))
#define XB_XGEN(j)  (2304 + 64 * (j))
#define XB_TOP      3328
#define XB_TOPGEN   3392
#define XCD_BAR_WORDS 3456
#define XB_SPIN_CAP (1u << 18)

__device__ __forceinline__ unsigned xb_ld(unsigned* p)              { return __hip_atomic_load(p, __ATOMIC_RELAXED, __HIP_MEMORY_SCOPE_AGENT); }
__device__ __forceinline__ unsigned xb_add(unsigned* p, unsigned v) { return __hip_atomic_fetch_add(p, v, __ATOMIC_RELAXED, __HIP_MEMORY_SCOPE_AGENT); }
__device__ __forceinline__ unsigned xb_xcc_id() { return (unsigned)__builtin_amdgcn_s_getreg((3 << 11) | 20) & 0xFu; }
#define XB_SPIN(cond, bar) do { unsigned _sp = 0; while (cond) { __builtin_amdgcn_s_sleep(1); \
    if ((++_sp & 255u) == 0u) { if (xb_ld(&(bar)[XB_TMO])) break; if (_sp > XB_SPIN_CAP) { atomicAdd(&(bar)[XB_TMO], 1u); break; } } } } while (0)

struct XcdBarrier {
    unsigned* bar; unsigned x;
    volatile LAS unsigned* st;
};

__device__ __forceinline__ XcdBarrier xcd_barrier_post(unsigned* bar, volatile LAS unsigned* st) {
    XcdBarrier b; b.bar = bar; b.x = xb_xcc_id(); b.st = st;
    if (threadIdx.x == 0) (void)xb_add(&bar[XB_XCNT(b.x)], 1u);
    return b;
}
__device__ __forceinline__ void xcd_barrier_complete(unsigned* bar, unsigned x, unsigned& nloc, unsigned& nx) {
    const unsigned G = gridDim.x * gridDim.y * gridDim.z;
    unsigned sum, cnt, mine, sp = 0u;
    for (;;) {
        sum = 0u; cnt = 0u; mine = 0u;
#pragma unroll
        for (unsigned j = 0; j < 16; ++j) { const unsigned c = xb_ld(&bar[XB_XCNT(j)]); sum += c; cnt += (c > 0u) ? 1u : 0u; mine = (j == x) ? c : mine; }
        if (sum == G) break;
        __builtin_amdgcn_s_sleep(1);
        if ((++sp & 255u) == 0u) { if (xb_ld(&bar[XB_TMO])) break; if (sp > XB_SPIN_CAP) { atomicAdd(&bar[XB_TMO], 1u); break; } }
    }
    nloc = mine > 0u ? mine : 1u; nx = cnt > 0u ? cnt : 1u;
}

__device__ __forceinline__ void xcd_barrier(const XcdBarrier& b) {
    asm volatile("s_waitcnt vmcnt(0)" ::: "memory");
    __syncthreads();
    if (threadIdx.x == 0) {
        unsigned* bar = b.bar;
        __builtin_amdgcn_s_waitcnt(0);
        unsigned nloc = b.st[0], nx = b.st[1];
        if (nloc == 0u) { xcd_barrier_complete(bar, b.x, nloc, nx); b.st[0] = nloc; b.st[1] = nx; }
        const unsigned old = xb_add(&bar[XB_XSUB(b.x)], 1u);
        const unsigned gen = old / nloc;
        if (old + 1u == (gen + 1u) * nloc) {
            __builtin_amdgcn_fence(__ATOMIC_RELEASE, "agent");
            asm volatile("s_waitcnt vmcnt(0)" ::: "memory");
            const unsigned og = xb_add(&bar[XB_TOP], 1u);
            const unsigned tg = og / nx;
            if (og + 1u == (tg + 1u) * nx) xb_add(&bar[XB_TOPGEN], 1u);
            else XB_SPIN(xb_ld(&bar[XB_TOPGEN]) == tg, bar);
            __builtin_amdgcn_fence(__ATOMIC_ACQUIRE, "agent");
            xb_add(&bar[XB_XGEN(b.x)], 1u);
            asm volatile("s_waitcnt vmcnt(0)" ::: "memory");
        } else {
            XB_SPIN(xb_ld(&bar[XB_XGEN(b.x)]) == gen, bar);
            __builtin_amdgcn_fence(__ATOMIC_ACQUIRE, "agent");
            asm volatile("s_waitcnt vmcnt(0)" ::: "memory");
        }
    }
    __syncthreads();
}

struct Args {
    const float* in[19]; float* out; unsigned char* ws;
};

__global__ void __launch_bounds__(NWAVES * 64) mk_fwd(Args a) {
    extern __shared__ __attribute__((aligned(16))) unsigned char lds_raw[];
    LAS unsigned char* lds = (LAS unsigned char*)lds_raw;
    cg::grid_group grid = cg::this_grid();
    const int tid = threadIdx.x, lane = tid & 63, wave = __builtin_amdgcn_readfirstlane(tid >> 6);
    const int G = gridDim.x, bx = blockIdx.x;
    const int gw = bx * NWAVES + wave, NGW = G * NWAVES;
    unsigned char* ws = a.ws;
    const float* x = a.in[0];
    const float *g_ffn1 = a.in[1], *w1g = a.in[2], *w1u = a.in[3], *w1d = a.in[4], *g_mix = a.in[5], *w_in = a.in[6], *g_q = a.in[7], *w_uq = a.in[8], *g_kv = a.in[9], *w_ukv = a.in[10],
                *g_mo = a.in[11], *g_do = a.in[12], *w_out = a.in[13], *g_ffn2 = a.in[14], *w2g = a.in[15], *w2u = a.in[16], *w2d = a.in[17], *g_fin = a.in[18];
    float* X = a.out;
    bf16_t *W1GU = (bf16_t*)(ws + WS_W1GU), *W1D = (bf16_t*)(ws + WS_W1D), *W2GU = (bf16_t*)(ws + WS_W2GU), *W2D = (bf16_t*)(ws + WS_W2D), *WIN = (bf16_t*)(ws + WS_WIN),
           *WUQ = (bf16_t*)(ws + WS_WUQ), *WUKV = (bf16_t*)(ws + WS_WUKV), *WOUT = (bf16_t*)(ws + WS_WOUT);
    float *COSM = (float*)(ws + WS_ROPE), *SINM = COSM + 2048 * 16, *COSP = SINM + 2048 * 16, *SINP = COSP + 2048 * 8;
    float *SS0 = (float*)(ws + WS_SS0), *SS1 = (float*)(ws + WS_SS1), *SS2 = (float*)(ws + WS_SS2), *SS3 = (float*)(ws + WS_SS3), *SSQ = (float*)(ws + WS_SSQ), *SSKV = (float*)(ws + WS_SSKV);
    bf16_t *XB = (bf16_t*)(ws + WS_XB), *KVM = (bf16_t*)(ws + WS_KVM), *HB = (bf16_t*)(ws + WS_H), *OD = (bf16_t*)(ws + WS_OD0), *OMIX = (bf16_t*)(ws + WS_OMIX);
    float* LSE = (float*)(ws + WS_LSE);
    bf16_t *QD = (bf16_t*)(ws + WS_QD), *KD = (bf16_t*)(ws + WS_KD), *VD = (bf16_t*)(ws + WS_VD), *CQ = (bf16_t*)(ws + WS_CQ), *CKV = (bf16_t*)(ws + WS_CKV), *KR = (bf16_t*)(ws + WS_KR), *QM = (bf16_t*)(ws + WS_QM);

    volatile LAS unsigned* xb_st = (volatile LAS unsigned*)(lds + DIL_LDS);
    if (tid < 2) xb_st[tid] = 0u;
    unsigned* xb_words = (unsigned*)(ws + WS_BAR);
    if (bx == 0) for (int i = tid; i < XCD_BAR_WORDS; i += NWAVES * 64) xb_words[i] = 0u;
    {
        LAS float* scr = (LAS float*)(lds + wave * 16384);
        constexpr int I_GU = 16 * 88, I_D = 44 * 32, I_IN = 16 * 69, I_UQ = 6 * 24, I_UKV = 4 * 32, I_OUT = 16 * 32;
        constexpr int NITEMS = 2 * (2 * I_GU + I_D) + I_IN + I_UQ + I_UKV + I_OUT;
        for (int it = gw; it < NITEMS; it += NGW) {
            int r = it;
            if (r < 2 * (2 * I_GU + I_D)) {
                const int f = r / (2 * I_GU + I_D); r -= f * (2 * I_GU + I_D);
                const float* gg = f ? g_ffn2 : g_ffn1; const float* wg = f ? w2g : w1g; const float* wu = f ? w2u : w1u; const float* wd = f ? w2d : w1d;
                bf16_t* GU = f ? W2GU : W1GU; bf16_t* DD = f ? W2D : W1D;
                if (r < 2 * I_GU) { const int s = r >= I_GU; const int q = s ? r - I_GU : r; const int kb_ = q / 88, nb = q % 88, n0 = 32 * nb;
                    tr_block(s ? wu : wg, 1024, FF, gg, GU, 64 * kb_, n0, 256 * (n0 >> 7) + 128 * s + (n0 & 127), scr, lane); }
                else { r -= 2 * I_GU; const int kb_ = r / 32, nb = r % 32; tr_block(wd, FF, 1024, nullptr, DD, 64 * kb_, 32 * nb, 32 * nb, scr, lane); }
                continue;
            }
            r -= 2 * (2 * I_GU + I_D);
            if (r < I_IN) { const int kb_ = r / 69, nb = r % 69, n0 = 32 * nb;
                int dst;
                if (n0 < 384) dst = 1536 + n0; else if (n0 < 640) dst = 2048 + (n0 - 384); else if (n0 < 672) dst = 1920 + (n0 - 640);
                else if (n0 < 1184) dst = n0 - 672; else if (n0 < 1696) dst = 512 + (n0 - 1184); else dst = 1024 + (n0 - 1696);
                tr_block(w_in, 1024, 2208, g_mix, WIN, 64 * kb_, n0, dst, scr, lane); continue; }
            r -= I_IN;
            if (r < I_UQ) { const int kb_ = r / 24, nb = r % 24; tr_block(w_uq, 384, 768, g_q, WUQ, 64 * kb_, 32 * nb, 32 * nb, scr, lane); continue; }
            r -= I_UQ;
            if (r < I_UKV) { const int kb_ = r / 32, nb = r % 32; tr_block(w_ukv, 256, 1024, g_kv, WUKV, 64 * kb_, 32 * nb, 32 * nb, scr, lane); continue; }
            r -= I_UKV;
            { const int kb_ = r / 32, nb = r % 32, k0 = 64 * kb_; tr_block(w_out, 1024, 1024, k0 < 512 ? g_mo : g_do - 512, WOUT, k0, 32 * nb, 32 * nb, scr, lane); }
        }
        for (int i = bx * 512 + tid; i < 96 * 1024 / 8; i += G * 512) *(u32x4*)(WIN + (size_t)1952 * 1024 + (size_t)i * 8) = (u32x4){0u, 0u, 0u, 0u};
        for (int i = bx * 512 + tid; i < 2048 * 24; i += G * 512) {
            int pos, fi; float invf; float *cdst, *sdst;
            if (i < 2048 * 16) { pos = i >> 4; fi = i & 15; invf = exp2f(-(float)fi * (1.0f / 16.0f) * 18.931568569324174f); cdst = COSM + i; sdst = SINM + i; }
            else { const int k = i - 2048 * 16; pos = k >> 3; fi = k & 7; invf = exp2f(-(float)fi * (1.0f / 8.0f) * 18.931568569324174f); cdst = COSP + k; sdst = SINP + k; }
            const float ang = (float)pos * invf;
            const double rev = (double)ang * 0.15915494309189535; const float fr_ = (float)(rev - floor(rev));
            *cdst = __builtin_amdgcn_cosf(fr_); *sdst = __builtin_amdgcn_sinf(fr_);
        }
        for (int row = gw; row < NT; row += NGW) {
            const f32x4* xr = (const f32x4*)(x + (size_t)row * DM) + lane; float s = 0.f;
            unsigned long long* o8 = (unsigned long long*)(XB + (size_t)row * DM) + lane;
#pragma unroll
            for (int j = 0; j < 4; ++j) { const f32x4 v = xr[64 * j]; s += sq4(v); o8[64 * j] = (unsigned long long)cvt_pk_bf16(v[0], v[1]) | ((unsigned long long)cvt_pk_bf16(v[2], v[3]) << 32); }
            s = wave_sum(s);
            if (lane < 16) SS0[(size_t)row * 16 + lane] = lane == 0 ? s : 0.f;
        }
    }
    grid.sync();
    const XcdBarrier xb = xcd_barrier_post(xb_words, xb_st);
    {
        pg8::Gemm g{XB, W1GU, NT, 2 * FF, DM}; pg8::StaticOrder S; S.init(NT, 2 * FF, G, bx);
        EpiGateUp E{HB, SS0};
        pg8::gemm_phase<EpiGateUp, pg8::StaticOrder, true, true>(lds, g, S, E);
    }
    xcd_barrier(xb);
    {
        pg8::Gemm g{HB, W1D, NT, DM, FF}; pg8::StaticOrder S; S.init(NT, DM, G, bx);
        EpiResid E{x, X, XB, SS1, 0.5f};
        pg8::gemm_phase<EpiResid, pg8::StaticOrder, true, true>(lds, g, S, E);
    }
    xcd_barrier(xb);
    {
        pg8::Gemm g{XB, WIN, NT, 2304, DM}; pg8::StaticOrder S; S.init(NT, 2304, G, bx);
        EpiInProj E{SS1, QD, KD, VD, CQ, CKV, KR, SSQ, SSKV, COSM, SINM, COSP, SINP};
        pg8::gemm_phase<EpiInProj, pg8::StaticOrder, true, true>(lds, g, S, E);
    }
    xcd_barrier(xb);
    {
        { pg8::Gemm g{CQ, WUQ, NT, 768, 384}; pg8::StaticOrder S; S.init(NT, 768, G, bx); EpiQ E{SSQ, QM, COSM, SINM};
          pg8::gemm_phase<EpiQ, pg8::StaticOrder, true, true>(lds, g, S, E); }
        { pg8::Gemm g{CKV, WUKV, NT, 1024, 256}; pg8::StaticOrder S; S.init(NT, 1024, G, bx); EpiKV E{SSKV, KVM};
          pg8::gemm_phase<EpiKV, pg8::StaticOrder, true, true>(lds, g, S, E); }
        __syncthreads();
        AttnIO io{QM, KVM, KR, OMIX, QD, KD, VD, OD, LSE};
        dil_phase(lds, io, bx, G);
    }
    xcd_barrier(xb);
    {
        AttnIO io{QM, KVM, KR, OMIX, QD, KD, VD, OD, LSE};
        for (int u = bx; u < 256 * 8; u += G) attn_unit<false>(lds, io, u);
    }
    xcd_barrier(xb);
    for (int row = gw; row < NT; row += NGW) {
        {
            u32x4* p = (u32x4*)(OMIX + (size_t)row * 1024 + lane * 8); const u32x4 w = *p; float v[8];
#pragma unroll
            for (int e = 0; e < 4; ++e) { v[2 * e] = __uint_as_float(w[e] << 16); v[2 * e + 1] = __uint_as_float(w[e] & 0xffff0000u); }
            float s = 0.f;
#pragma unroll
            for (int e = 0; e < 8; ++e) s += v[e] * v[e];
            const float rs = rsqrtf(wave_sum(s) * (1.0f / 512.0f) + EPS);
            u32x4 o; o.x = cvt_pk_bf16(v[0] * rs, v[1] * rs); o.y = cvt_pk_bf16(v[2] * rs, v[3] * rs); o.z = cvt_pk_bf16(v[4] * rs, v[5] * rs); o.w = cvt_pk_bf16(v[6] * rs, v[7] * rs);
            *p = o;
        }
        {
            const int hd = lane >> 3;
            const float l0 = LSE[((size_t)0 * NT + row) * 8 + hd], l1 = LSE[((size_t)1 * NT + row) * 8 + hd], l2 = LSE[((size_t)2 * NT + row) * 8 + hd];
            const float mx = fmaxf(l0, fmaxf(l1, l2));
            float w0 = fast_exp2(l0 - mx), w1 = fast_exp2(l1 - mx), w2 = fast_exp2(l2 - mx);
            const float inv = 1.0f / (w0 + w1 + w2); w0 *= inv; w1 *= inv; w2 *= inv;
            float v[8];
#pragma unroll
            for (int e = 0; e < 8; ++e) v[e] = 0.f;
#pragma unroll
            for (int n = 0; n < 3; ++n) {
                const u32x4 w = *(const u32x4*)(OD + (size_t)n * NT * 512 + (size_t)row * 512 + lane * 8); const float wn = n == 0 ? w0 : (n == 1 ? w1 : w2);
#pragma unroll
                for (int e = 0; e < 4; ++e) { v[2 * e] += wn * __uint_as_float(w[e] << 16); v[2 * e + 1] += wn * __uint_as_float(w[e] & 0xffff0000u); }
            }
            float s = 0.f;
#pragma unroll
            for (int e = 0; e < 8; ++e) s += v[e] * v[e];
            const float rs = rsqrtf(wave_sum(s) * (1.0f / 512.0f) + EPS);
            u32x4 o; o.x = cvt_pk_bf16(v[0] * rs, v[1] * rs); o.y = cvt_pk_bf16(v[2] * rs, v[3] * rs); o.z = cvt_pk_bf16(v[4] * rs, v[5] * rs); o.w = cvt_pk_bf16(v[6] * rs, v[7] * rs);
            *(u32x4*)(OMIX + (size_t)row * 1024 + 512 + lane * 8) = o;
        }
    }
    xcd_barrier(xb);
    {
        pg8::Gemm g{OMIX, WOUT, NT, DM, DM}; pg8::StaticOrder S; S.init(NT, DM, G, bx);
        EpiResid E{X, X, XB, SS2, 1.0f};
        pg8::gemm_phase<EpiResid, pg8::StaticOrder, true, true>(lds, g, S, E);
    }
    xcd_barrier(xb);
    {
        pg8::Gemm g{XB, W2GU, NT, 2 * FF, DM}; pg8::StaticOrder S; S.init(NT, 2 * FF, G, bx);
        EpiGateUp E{HB, SS2};
        pg8::gemm_phase<EpiGateUp, pg8::StaticOrder, true, true>(lds, g, S, E);
    }
    xcd_barrier(xb);
    {
        pg8::Gemm g{HB, W2D, NT, DM, FF}; pg8::StaticOrder S; S.init(NT, DM, G, bx);
        EpiResid E{X, X, nullptr, SS3, 0.5f};
        pg8::gemm_phase<EpiResid, pg8::StaticOrder, true, true>(lds, g, S, E);
    }
    xcd_barrier(xb);
    for (int row = gw; row < NT; row += NGW) {
        const float rs = rstd_parts16(SS3, row, 1.0f / 1024.0f);
        f32x4* xr = (f32x4*)(X + (size_t)row * DM) + lane; const f32x4* gr = (const f32x4*)g_fin + lane;
#pragma unroll
        for (int j = 0; j < 4; ++j) { const f32x4 v = xr[64 * j] * rs * gr[64 * j]; xr[64 * j] = v; }
    }
}

extern "C" void kernel_launch(void* const* d_in, const int* in_sizes, int n_in, void* d_out, int out_size, void* d_ws, size_t ws_size, hipStream_t stream) {
    constexpr int LDS_BYTES = 147456; static_assert(DIL_LDS + 64 <= LDS_BYTES, "LDS map");
    static int grid = 0;
    if (grid == 0) {
        if (n_in != 19 || in_sizes[0] != NT * DM || out_size != NT * DM || ws_size < WS_END) {
            fprintf(stderr, "kernel_launch: unexpected problem geometry (n_in %d, in0 %d, out %d, ws %zu); nothing launched\n", n_in, n_in > 0 ? in_sizes[0] : -1, out_size, ws_size); grid = -1; return; }
        int dev = 0, cus = 0, per_cu = 0;
        hipGetDevice(&dev); hipDeviceGetAttribute(&cus, hipDeviceAttributeMultiprocessorCount, dev);
        if (hipFuncSetAttribute((const void*)mk_fwd, hipFuncAttributeMaxDynamicSharedMemorySize, LDS_BYTES) != hipSuccess) { fprintf(stderr, "kernel_launch: hipFuncSetAttribute failed\n"); grid = -1; return; }
        if (hipOccupancyMaxActiveBlocksPerMultiprocessor(&per_cu, (const void*)mk_fwd, NWAVES * 64, LDS_BYTES) != hipSuccess || per_cu < 1) { fprintf(stderr, "kernel_launch: occupancy query says %d blocks per CU\n", per_cu); per_cu = 1; }
        (void)hipGetLastError();
        grid = cus;
    }
    if (grid < 0) return;
    Args a{};
    for (int i = 0; i < 19; ++i) a.in[i] = (const float*)d_in[i];
    a.out = (float*)d_out; a.ws = (unsigned char*)d_ws;
    void* args[] = {&a};
    hipError_t e = hipLaunchCooperativeKernel((const void*)mk_fwd, dim3(grid), dim3(NWAVES * 64), args, LDS_BYTES, stream);
    if (e != hipSuccess) fprintf(stderr, "kernel_launch: cooperative launch failed: %s (grid %d)\n", hipGetErrorString(e), grid);
}
```

```cpp
#include <hip/hip_runtime.h>
#include <hip/hip_cooperative_groups.h>
#include <cmath>
#include <cstdio>
#include <cstdint>
namespace pg8 {
#define PG8_LAS __attribute__((address_space(3)))
typedef unsigned short bf16_t;
typedef short bf16x8 __attribute__((ext_vector_type(8)));
typedef float f32x4 __attribute__((ext_vector_type(4)));
typedef unsigned u32x4 __attribute__((ext_vector_type(4)));
constexpr int BM = 256, BK = 64, HALF = 128, HTB = HALF * BK * 2  , STAGE_BYTES = 8 * HTB, NXCD = 8, WGM = 8;

__host__ __device__ __forceinline__ int lds_byte(int r, int c) { const int st = (r >> 4) * 2 + (c >> 5), rr = r & 15, cc = c & 31, ob = rr * 64 + cc * 2; return st * 1024 + (ob ^ (((ob >> 9) & 1) << 5)); }
__host__ __device__ __forceinline__ void stage_rc(int b, int& R, int& C) { const int st = b / 1024, sb = b % 1024, swz = sb ^ (((sb >> 9) & 1) << 5); R = (st >> 1) * 16 + swz / 64; C = (st & 1) * 32 + (swz % 64) / 2; }
__host__ __device__ __forceinline__ int perm32(int rho) { const int n = rho >> 4, i = rho & 15; return 8 * (i >> 2) + 4 * n + (i & 3); }

struct Unit { int pm, pn; };
struct Gemm { const bf16_t* A; const bf16_t* Bt; int M, N, K; };

struct StaticOrder {
    int nM, nN, nwg, G, c;
    __host__ __device__ void init(int M, int N, int G_, int c_) { nM = M / BM; nN = N / BM; nwg = nM * nN; G = G_; c = c_; }
    __host__ __device__ bool next(int i, Unit& u) const {
        const long L = (long)i * G + c; if (L >= nwg) return false;
        int wgid = (int)L; { const int q = nwg / NXCD, r = nwg % NXCD, xcd = wgid % NXCD, off = wgid / NXCD; wgid = (xcd < r ? xcd * (q + 1) : r * (q + 1) + (xcd - r) * q) + off; }
        const int nig = WGM * nN, gid = wgid / nig, fm = gid * WGM, gsz = (nM - fm) < WGM ? (nM - fm) : WGM;
        u.pm = fm + ((wgid % nig) % gsz); u.pn = (wgid % nig) / gsz; return true;
    }
    __device__ __forceinline__ void a_ready(const Unit&) const {}
    __device__ __forceinline__ void done(const Unit&) const {}
};

__device__ __forceinline__ unsigned cvt_pk_bf16(float lo, float hi) { unsigned r; asm volatile("v_cvt_pk_bf16_f32 %0, %1, %2" : "=v"(r) : "v"(lo), "v"(hi)); return r; }

template <class Epi, class Sched, bool ALIGN_EPI = false, bool SP2 = false>
__device__ __forceinline__ void gemm_phase(PG8_LAS unsigned char* lds, const Gemm g, const Sched& S, const Epi& E) {
    int tid_ = threadIdx.x; asm volatile("" : "+v"(tid_));
    const int tid = tid_, wid = __builtin_amdgcn_readfirstlane(tid >> 6), lane = tid & 63, wr = wid >> 2, wc = wid & 3, fr = lane & 15, fq = lane >> 4;
    const int K = g.K, nt = K / BK;
    unsigned voffA[2], voffB[2];
#pragma unroll
    for (int i = 0; i < 2; ++i) { int R, C; stage_rc(tid * 16 + i * 8192, R, C); const int Rb = Epi::PERM ? ((R & ~31) + perm32(R & 31)) : R;
        voffA[i] = (unsigned)(R * K + C) * 2u; voffB[i] = (unsigned)(Rb * K + C) * 2u; }
    const size_t kstep = (size_t)(BK * 2);
    const size_t hstep = (size_t)HALF * K * 2;
    const size_t tstep = 2 * hstep;
    const unsigned ldsw = (unsigned)wid * 1024u;
    const int aoff = lds_byte(wr * 64 + fr, fq * 8), boff = lds_byte(wc * 32 + fr, fq * 8);
#define PG8_SA(b, h) (((b) * 2 + (h)) * HTB)
#define PG8_SB(b, h) ((4 + (b) * 2 + (h)) * HTB)
#define PG8_STAGE(bufoff, gbase, voff) do { _Pragma("unroll") for (int _i = 0; _i < 2; ++_i) \
        __builtin_amdgcn_global_load_lds((const unsigned*)((const char*)(gbase) + (voff)[_i]), (PG8_LAS unsigned*)(lds + (bufoff) + ldsw + _i * 8192), 16, 0, 0); } while (0)
#define PG8_LDA(dst, b, h) do { _Pragma("unroll") for (int m = 0; m < 4; ++m) _Pragma("unroll") for (int k = 0; k < 2; ++k) dst[m][k] = *(const PG8_LAS bf16x8*)(lds + PG8_SA(b, h) + aoff + m * 2048 + k * 1024); } while (0)
#define PG8_LDB(dst, b, h) do { _Pragma("unroll") for (int n = 0; n < 2; ++n) _Pragma("unroll") for (int k = 0; k < 2; ++k) dst[n][k] = *(const PG8_LAS bf16x8*)(lds + PG8_SB(b, h) + boff + n * 2048 + k * 1024); } while (0)
#define PG8_MMA(ai, bj, At, Bt) do { __builtin_amdgcn_s_setprio(1); _Pragma("unroll") for (int m = 0; m < 4; ++m) _Pragma("unroll") for (int n = 0; n < 2; ++n) _Pragma("unroll") for (int k = 0; k < 2; ++k) \
        acc[ai][bj][m][n] = __builtin_amdgcn_mfma_f32_16x16x32_bf16(Bt[n][k], At[m][k], acc[ai][bj][m][n], 0, 0, 0); __builtin_amdgcn_s_setprio(0); } while (0)
#define PG8_WAIT_V(n) asm volatile("s_waitcnt vmcnt(" #n ")" ::: "memory")
#define PG8_WAIT_L(n) asm volatile("s_waitcnt lgkmcnt(" #n ")" ::: "memory")
#define PG8_BAR __builtin_amdgcn_s_barrier()
#define PG8_SCHED __builtin_amdgcn_sched_barrier(0)
    Unit cur, nxt; int ui = 0;
    if (!S.next(0, cur)) return;
    f32x4 acc[2][2][4][2];
#pragma unroll
    for (int a = 0; a < 2; ++a)
#pragma unroll
        for (int b = 0; b < 2; ++b)
#pragma unroll
            for (int m = 0; m < 4; ++m)
#pragma unroll
                for (int n = 0; n < 2; ++n) acc[a][b][m][n] = (f32x4){0.f, 0.f, 0.f, 0.f};
    bf16x8 At[4][2], B0[2][2], B1[2][2];
    const char* cA = (const char*)g.A + (size_t)cur.pm * tstep; const char* cB = (const char*)g.Bt + (size_t)cur.pn * tstep;
    S.a_ready(cur);
    if constexpr (SP2) {
        PG8_STAGE(PG8_SB(0, 0), cB, voffB); PG8_STAGE(PG8_SB(0, 1), cB + hstep, voffB); PG8_STAGE(PG8_SA(0, 0), cA, voffA); PG8_STAGE(PG8_SA(0, 1), cA + hstep, voffA);
        if (wr == 1) PG8_BAR;
        PG8_WAIT_V(2); PG8_BAR;
        PG8_STAGE(PG8_SB(1, 0), cB + kstep, voffB); PG8_STAGE(PG8_SA(1, 0), cA + kstep, voffA); PG8_STAGE(PG8_SB(1, 1), cB + hstep + kstep, voffB);
        PG8_WAIT_V(6); PG8_BAR;
    } else {
        PG8_STAGE(PG8_SB(0, 0), cB, voffB); PG8_STAGE(PG8_SA(0, 0), cA, voffA); PG8_STAGE(PG8_SB(0, 1), cB + hstep, voffB); PG8_STAGE(PG8_SA(0, 1), cA + hstep, voffA);
        if (wr == 1) PG8_BAR;
        PG8_WAIT_V(4); PG8_BAR;
        PG8_STAGE(PG8_SB(1, 0), cB + kstep, voffB); PG8_STAGE(PG8_SA(1, 0), cA + kstep, voffA); PG8_STAGE(PG8_SB(1, 1), cB + hstep + kstep, voffB);
        PG8_WAIT_V(6); PG8_BAR;
    }
    for (;;) {
        const bool has_next = S.next(ui + 1, nxt);
        const char* nA = has_next ? (const char*)g.A + (size_t)nxt.pm * tstep : cA; const char* nB = has_next ? (const char*)g.Bt + (size_t)nxt.pn * tstep : cB;
        for (int t = 0; t < nt; t += 2) {
            const bool last = (t == nt - 2);
            const char* a1 = cA + (size_t)(t + 1) * kstep;
            const char* a2 = last ? nA : cA + (size_t)(t + 2) * kstep; const char* b2 = last ? nB : cB + (size_t)(t + 2) * kstep;
            const char* a3 = a2 + kstep; const char* b3 = b2 + kstep;
            if (last && has_next) S.a_ready(nxt);
            if constexpr (SP2) {
            PG8_LDB(B0, 0, 0); PG8_LDB(B1, 0, 1); PG8_SCHED; PG8_LDA(At, 0, 0); PG8_STAGE(PG8_SA(1, 1), a1 + hstep, voffA);
            PG8_WAIT_V(8); PG8_WAIT_L(0); PG8_BAR; PG8_MMA(0, 0, At, B0); PG8_MMA(0, 1, At, B1); PG8_BAR; PG8_SCHED;
            PG8_LDA(At, 0, 1); PG8_STAGE(PG8_SB(0, 0), b2, voffB); PG8_STAGE(PG8_SB(0, 1), b2 + hstep, voffB); PG8_STAGE(PG8_SA(0, 0), a2, voffA);
            PG8_WAIT_V(8); PG8_WAIT_L(0); PG8_BAR; PG8_MMA(1, 0, At, B0); PG8_MMA(1, 1, At, B1); PG8_BAR; PG8_SCHED;
            PG8_LDB(B0, 1, 0); PG8_LDB(B1, 1, 1); PG8_SCHED; PG8_LDA(At, 1, 0); PG8_STAGE(PG8_SA(0, 1), a2 + hstep, voffA);
            PG8_WAIT_V(8); PG8_WAIT_L(0); PG8_BAR; PG8_MMA(0, 0, At, B0); PG8_MMA(0, 1, At, B1); PG8_BAR; PG8_SCHED;
            PG8_LDA(At, 1, 1); PG8_STAGE(PG8_SB(1, 0), b3, voffB); PG8_STAGE(PG8_SB(1, 1), b3 + hstep, voffB); PG8_STAGE(PG8_SA(1, 0), a3, voffA);
            PG8_WAIT_V(8); PG8_WAIT_L(0); PG8_BAR; PG8_MMA(1, 0, At, B0); PG8_MMA(1, 1, At, B1); PG8_BAR; PG8_SCHED;
            } else {
            PG8_LDB(B0, 0, 0); PG8_SCHED; PG8_LDA(At, 0, 0); PG8_STAGE(PG8_SA(1, 1), a1 + hstep, voffA);
            PG8_WAIT_L(8); PG8_BAR; PG8_WAIT_L(0); PG8_MMA(0, 0, At, B0); PG8_BAR; PG8_SCHED;
            PG8_LDB(B1, 0, 1); PG8_STAGE(PG8_SB(0, 0), b2, voffB);
            PG8_BAR; PG8_WAIT_L(0); PG8_MMA(0, 1, At, B1); PG8_BAR;
            PG8_LDA(At, 0, 1); PG8_STAGE(PG8_SA(0, 0), a2, voffA);
            PG8_BAR; PG8_WAIT_L(0); PG8_MMA(1, 0, At, B0); PG8_BAR; PG8_SCHED;
            PG8_STAGE(PG8_SB(0, 1), b2 + hstep, voffB);
            PG8_WAIT_V(6); PG8_BAR; PG8_MMA(1, 1, At, B1); PG8_BAR;
            PG8_LDB(B0, 1, 0); PG8_SCHED; PG8_LDA(At, 1, 0); PG8_STAGE(PG8_SA(0, 1), a2 + hstep, voffA);
            PG8_WAIT_L(8); PG8_BAR; PG8_WAIT_L(0); PG8_MMA(0, 0, At, B0); PG8_BAR; PG8_SCHED;
            PG8_LDB(B1, 1, 1); PG8_STAGE(PG8_SB(1, 0), b3, voffB);
            PG8_BAR; PG8_WAIT_L(0); PG8_MMA(0, 1, At, B1); PG8_BAR;
            PG8_LDA(At, 1, 1); PG8_STAGE(PG8_SA(1, 0), a3, voffA);
            PG8_BAR; PG8_WAIT_L(0); PG8_MMA(1, 0, At, B0); PG8_BAR; PG8_SCHED;
            PG8_STAGE(PG8_SB(1, 1), b3 + hstep, voffB);
            PG8_WAIT_V(6); PG8_BAR; PG8_MMA(1, 1, At, B1); PG8_BAR;
            }
        }
        if constexpr (ALIGN_EPI) { if (wr == 0) PG8_BAR; }
        if constexpr (!Epi::AFTER_DRAIN) { E(acc, cur, wr, wc, fr, fq); S.done(cur); }
        if (!has_next) break;
#pragma unroll
        for (int a = 0; a < 2; ++a)
#pragma unroll
            for (int b = 0; b < 2; ++b)
#pragma unroll
                for (int m = 0; m < 4; ++m)
#pragma unroll
                    for (int n = 0; n < 2; ++n) acc[a][b][m][n] = (f32x4){0.f, 0.f, 0.f, 0.f};
        cur = nxt; cA = nA; cB = nB; ++ui;
        if constexpr (ALIGN_EPI) { if (wr == 1) PG8_BAR; }
    }
    PG8_WAIT_V(0);
    if constexpr (!ALIGN_EPI) { if (wr == 0) PG8_BAR; }
    PG8_BAR;
    if constexpr (Epi::AFTER_DRAIN) { E.fused(acc, cur, wr, wc, fr, fq, lds, wid, lane); S.done(cur); }
#undef PG8_SA
#undef PG8_SB
#undef PG8_STAGE
#undef PG8_LDA
#undef PG8_LDB
#undef PG8_MMA
#undef PG8_WAIT_V
#undef PG8_WAIT_L
#undef PG8_BAR
#undef PG8_SCHED
}
}

namespace cg = cooperative_groups;

#define LAS __attribute__((address_space(3)))
typedef unsigned short bf16_t;
typedef float f32x4 __attribute__((ext_vector_type(4)));
typedef float f32x16 __attribute__((ext_vector_type(16)));
typedef short bf16x8 __attribute__((ext_vector_type(8)));
typedef short s16x4 __attribute__((ext_vector_type(4)));
typedef unsigned u32x2 __attribute__((ext_vector_type(2)));
typedef unsigned u32x4 __attribute__((ext_vector_type(4)));
using pg8::Unit;
typedef float f32x2_t __attribute__((ext_vector_type(2))); typedef __bf16 bf16x2_t __attribute__((ext_vector_type(2)));
__device__ __forceinline__ unsigned cvt_pk_bf16(float lo, float hi) { const f32x2_t v = {lo, hi}; const bf16x2_t b = __builtin_convertvector(v, bf16x2_t); return __builtin_bit_cast(unsigned, b); }

constexpr int NT = 65536, SEQ = 2048, DM = 1024, FF = 2816, NWAVES = 8;
constexpr float EPS = 1e-6f, LOG2E = 1.4426950408889634f;
constexpr float QSCALE_D = 0.125f * LOG2E;
constexpr float QSCALE_M = 0.10206207261596577f * LOG2E;

constexpr size_t MiB = 1u << 20;
constexpr size_t WS_W1GU = 0, WS_W1D = 11 * MiB, WS_W2GU = 17 * MiB, WS_W2D = 28 * MiB, WS_WIN = 34 * MiB, WS_WUQ = 39 * MiB, WS_WUKV = 40 * MiB, WS_WOUT = 41 * MiB;
constexpr size_t WS_ROPE = 43 * MiB;
constexpr size_t WS_SS0 = 44 * MiB, WS_SS1 = 48 * MiB, WS_SS2 = 52 * MiB, WS_SS3 = 56 * MiB, WS_SSQ = 60 * MiB, WS_SSKV = 62 * MiB;
constexpr size_t WS_BAR = 63 * MiB;
constexpr size_t WS_XB = 64 * MiB;
constexpr size_t WS_KVM = WS_XB;
constexpr size_t WS_H = 192 * MiB;
constexpr size_t WS_OD0 = 192 * MiB, WS_OD1 = 256 * MiB, WS_OD2 = 320 * MiB, WS_OMIX = 384 * MiB, WS_LSE = 512 * MiB;
constexpr size_t WS_QD = 544 * MiB, WS_KD = 608 * MiB, WS_VD = 672 * MiB, WS_CQ = 736 * MiB, WS_CKV = 784 * MiB, WS_KR = 816 * MiB, WS_QM = 820 * MiB, WS_END = 916 * MiB;

__device__ __forceinline__ float fast_exp2(float x) { return __builtin_amdgcn_exp2f(x); }
__device__ __forceinline__ float fast_rcp(float x) { return __builtin_amdgcn_rcpf(x); }
__device__ __forceinline__ float bf2f(unsigned short b) { return __uint_as_float((unsigned)b << 16); }
__device__ __forceinline__ float sum4(f32x4 a) { return (a[0] + a[1]) + (a[2] + a[3]); }
__device__ __forceinline__ float sq4(f32x4 a) { return (a[0] * a[0] + a[1] * a[1]) + (a[2] * a[2] + a[3] * a[3]); }
__device__ __forceinline__ float rstd_parts16(const float* ss, int row, float invn) {
    const f32x4* p = (const f32x4*)(ss + (size_t)row * 16);
    const float s = (sum4(p[0]) + sum4(p[1])) + (sum4(p[2]) + sum4(p[3]));
    return rsqrtf(s * invn + EPS);
}

#define EPI_RELANE() int fr, fq; { int t_ = threadIdx.x; asm volatile("" : "+v"(t_)); fr = t_ & 15; fq = (t_ >> 4) & 3; }
struct EpiGateUp {
    static constexpr bool PERM = true, AFTER_DRAIN = false;
    bf16_t* H; const float* ss;
    __device__ __forceinline__ void operator()(const f32x4 (&acc)[2][2][4][2], const Unit& u, int wr, int wc, int fr_in, int fq_in) const {
        EPI_RELANE();
        const int row0 = u.pm * 256 + wr * 64 + fr, col = u.pn * 128 + wc * 32 + 8 * fq;
#pragma unroll
        for (int ai = 0; ai < 2; ++ai)
#pragma unroll
            for (int m = 0; m < 4; ++m) {
                const int row = row0 + ai * 128 + m * 16;
                const float rs = rstd_parts16(ss, row, 1.0f / 1024.0f);
                float o[8];
#pragma unroll
                for (int n = 0; n < 2; ++n)
#pragma unroll
                    for (int j = 0; j < 4; ++j) {
                        const float g = acc[ai][0][m][n][j] * rs, up = acc[ai][1][m][n][j] * rs;
                        o[4 * n + j] = g * fast_rcp(1.0f + fast_exp2(-g * LOG2E)) * up;
                    }
                u32x4 w; w.x = cvt_pk_bf16(o[0], o[1]); w.y = cvt_pk_bf16(o[2], o[3]); w.z = cvt_pk_bf16(o[4], o[5]); w.w = cvt_pk_bf16(o[6], o[7]);
                *(u32x4*)(H + (size_t)row * FF + col) = w;
            }
    }
};
struct EpiResid {
    static constexpr bool PERM = false, AFTER_DRAIN = false;
    bf16_t* xb; float* ss; float alpha;
    __device__ __forceinline__ void operator()(const f32x4 (&acc)[2][2][4][2], const Unit& u, int wr, int wc, int fr_in, int fq_in) const {
        EPI_RELANE();
        const int row0 = u.pm * 256 + wr * 64 + fr, col0 = u.pn * 256 + wc * 32 + 4 * fq;
#pragma unroll
        for (int ai = 0; ai < 2; ++ai)
#pragma unroll
            for (int m = 0; m < 4; ++m) {
                const int row = row0 + ai * 128 + m * 16; float sq = 0.f;
#pragma unroll
                for (int bj = 0; bj < 2; ++bj)
#pragma unroll
                    for (int n = 0; n < 2; ++n) {
                        u32x2* p = (u32x2*)(xb + (size_t)row * DM + col0 + bj * 128 + n * 16);
                        const u32x2 bw = *p;
                        const f32x4 b = {__uint_as_float(bw.x << 16), __uint_as_float(bw.x & 0xffff0000u), __uint_as_float(bw.y << 16), __uint_as_float(bw.y & 0xffff0000u)};
                        const f32x4 v = b + acc[ai][bj][m][n] * alpha; sq += sq4(v);
                        u32x2 w; w.x = cvt_pk_bf16(v[0], v[1]); w.y = cvt_pk_bf16(v[2], v[3]); *p = w;
                    }
                sq += __shfl_xor(sq, 16); sq += __shfl_xor(sq, 32);
                if (fq == 0) ss[(size_t)row * 16 + u.pn * 4 + wc] = sq;
            }
    }
};
struct EpiFinal {
    static constexpr bool PERM = false, AFTER_DRAIN = false;
    const bf16_t* xb; float* X; float* ss; unsigned* cnt; const float* gfin; LAS float* tab;
    __device__ __forceinline__ void operator()(f32x4 (&acc)[2][2][4][2], const Unit& u, int wr, int wc, int fr_in, int fq_in) const {
        EPI_RELANE();
        int tid = threadIdx.x; asm volatile("" : "+v"(tid));
        const int row0 = u.pm * 256 + wr * 64 + fr, col0 = u.pn * 256 + wc * 32 + 4 * fq;
#pragma unroll
        for (int ai = 0; ai < 2; ++ai)
#pragma unroll
            for (int m = 0; m < 4; ++m) {
                const int row = row0 + ai * 128 + m * 16; float sq = 0.f;
#pragma unroll
                for (int bj = 0; bj < 2; ++bj)
#pragma unroll
                    for (int n = 0; n < 2; ++n) {
                        const u32x2 bw = *(const u32x2*)(xb + (size_t)row * DM + col0 + bj * 128 + n * 16);
                        const f32x4 b = {__uint_as_float(bw.x << 16), __uint_as_float(bw.x & 0xffff0000u), __uint_as_float(bw.y << 16), __uint_as_float(bw.y & 0xffff0000u)};
                        const f32x4 v = b + acc[ai][bj][m][n] * 0.5f; acc[ai][bj][m][n] = v; sq += sq4(v);
                    }
                sq += __shfl_xor(sq, 16); sq += __shfl_xor(sq, 32);
                if (fq == 0) ss[(size_t)row * 16 + u.pn * 4 + wc] = sq;
            }
        asm volatile("s_waitcnt vmcnt(0)" ::: "memory");
        __syncthreads();
        if (tid == 0) {
            unsigned* c = cnt + 64 * u.pm;
            __builtin_amdgcn_fence(__ATOMIC_RELEASE, "agent"); asm volatile("s_waitcnt vmcnt(0)" ::: "memory");
            __hip_atomic_fetch_add(c, 1u, __ATOMIC_RELAXED, __HIP_MEMORY_SCOPE_AGENT);
            unsigned sp = 0;
            while (__hip_atomic_load(c, __ATOMIC_RELAXED, __HIP_MEMORY_SCOPE_AGENT) < 4u) { __builtin_amdgcn_s_sleep(2); if (++sp > (1u << 22)) break; }
            __builtin_amdgcn_fence(__ATOMIC_ACQUIRE, "agent"); asm volatile("s_waitcnt vmcnt(0)" ::: "memory");
        }
        __syncthreads();
        if (tid < 256) tab[tid] = rstd_parts16(ss, u.pm * 256 + tid, 1.0f / 1024.0f);
        __syncthreads();
#pragma unroll
        for (int ai = 0; ai < 2; ++ai)
#pragma unroll
            for (int m = 0; m < 4; ++m) {
                const int r = ai * 128 + wr * 64 + m * 16 + fr; const float rs = tab[r];
#pragma unroll
                for (int bj = 0; bj < 2; ++bj)
#pragma unroll
                    for (int n = 0; n < 2; ++n) {
                        const int col = col0 + bj * 128 + n * 16;
                        const f32x4 g = *(const f32x4*)(gfin + col);
                        *(f32x4*)(X + (size_t)(u.pm * 256 + r) * DM + col) = acc[ai][bj][m][n] * rs * g;
                    }
            }
    }
};
struct EpiInProj {
    static constexpr bool PERM = false, AFTER_DRAIN = false;
    const float* ss1; bf16_t *QD, *KD, *VD, *CQ, *CKV, *KR; float *SSQ, *SSKV; const float *cosm, *sinm, *cosp, *sinp;
    __device__ __forceinline__ void operator()(const f32x4 (&acc)[2][2][4][2], const Unit& u, int wr, int wc, int fr_in, int fq_in) const {
        EPI_RELANE();
        const int row0 = u.pm * 256 + wr * 64 + fr, pn = u.pn;
#pragma unroll
        for (int ai = 0; ai < 2; ++ai)
#pragma unroll
            for (int m = 0; m < 4; ++m) {
                const int row = row0 + ai * 128 + m * 16, pos = row & (SEQ - 1);
                const float rs = rstd_parts16(ss1, row, 1.0f / 1024.0f);
                if (pn < 6) {
                    bf16_t* dst = QD + (size_t)(pn >> 1) * ((size_t)NT * 512) + (size_t)row * 512 + (pn & 1) * 256 + wc * 32 + 4 * fq;
                    const float sc = pn < 2 ? rs * QSCALE_D : rs;
                    const bool rope = (pn < 4) && ((wc & 1) == 0);
#pragma unroll
                    for (int bj = 0; bj < 2; ++bj)
#pragma unroll
                        for (int n = 0; n < 2; ++n) {
                            f32x4 v = acc[ai][bj][m][n] * sc;
                            if (n == 0 && rope) {
                                f32x4 pv; pv[0] = __shfl_xor(v[0], 32); pv[1] = __shfl_xor(v[1], 32); pv[2] = __shfl_xor(v[2], 32); pv[3] = __shfl_xor(v[3], 32);
                                const f32x4 c = *(const f32x4*)(cosp + pos * 8 + 4 * (fq & 1)), s = *(const f32x4*)(sinp + pos * 8 + 4 * (fq & 1));
                                v = (fq < 2) ? (v * c - pv * s) : (v * c + pv * s);
                            }
                            u32x2 w; w.x = cvt_pk_bf16(v[0], v[1]); w.y = cvt_pk_bf16(v[2], v[3]);
                            *(u32x2*)(dst + bj * 128 + n * 16) = w;
                        }
                } else if (pn == 6 || pn == 8) {
                    bf16_t* dst = CQ + (pn == 6 ? (size_t)row * 384 : (size_t)NT * 384 + (size_t)row * 256) + wc * 32 + 4 * fq; float sq = 0.f;
#pragma unroll
                    for (int bj = 0; bj < 2; ++bj)
#pragma unroll
                        for (int n = 0; n < 2; ++n) {
                            const f32x4 v = acc[ai][bj][m][n] * rs; sq += sq4(v);
                            u32x2 w; w.x = cvt_pk_bf16(v[0], v[1]); w.y = cvt_pk_bf16(v[2], v[3]);
                            *(u32x2*)(dst + bj * 128 + n * 16) = w;
                        }
                    sq += __shfl_xor(sq, 16); sq += __shfl_xor(sq, 32);
                    if (fq == 0) SSQ[(pn == 6 ? (size_t)row * 8 : (size_t)NT * 8 + (size_t)row * 4) + wc] = sq;
                } else {
                    bf16_t* dst = CQ + (size_t)row * 384 + 256 + wc * 32 + 4 * fq; float sq = 0.f;
#pragma unroll
                    for (int n = 0; n < 2; ++n) {
                        const f32x4 v = acc[ai][0][m][n] * rs; sq += sq4(v);
                        u32x2 w; w.x = cvt_pk_bf16(v[0], v[1]); w.y = cvt_pk_bf16(v[2], v[3]);
                        *(u32x2*)(dst + n * 16) = w;
                    }
                    sq += __shfl_xor(sq, 16); sq += __shfl_xor(sq, 32);
                    if (fq == 0) SSQ[(size_t)row * 8 + 4 + wc] = sq;
                    if (wc == 0) {
                        const f32x4 x1 = acc[ai][1][m][0] * rs, x2 = acc[ai][1][m][1] * rs;
                        const f32x4 c = *(const f32x4*)(cosm + pos * 16 + 4 * fq), s = *(const f32x4*)(sinm + pos * 16 + 4 * fq);
                        const f32x4 o1 = x1 * c - x2 * s, o2 = x2 * c + x1 * s;
                        u32x2 w1, w2; w1.x = cvt_pk_bf16(o1[0], o1[1]); w1.y = cvt_pk_bf16(o1[2], o1[3]); w2.x = cvt_pk_bf16(o2[0], o2[1]); w2.y = cvt_pk_bf16(o2[2], o2[3]);
                        *(u32x2*)(KR + (size_t)row * 32 + 4 * fq) = w1; *(u32x2*)(KR + (size_t)row * 32 + 16 + 4 * fq) = w2;
                    }
                }
            }
    }
};
struct EpiQ {
    static constexpr bool PERM = false, AFTER_DRAIN = false;
    const float* ssq; bf16_t* QM; const float *cosm, *sinm;
    __device__ __forceinline__ void operator()(const f32x4 (&acc)[2][2][4][2], const Unit& u, int wr, int wc, int fr_in, int fq_in) const {
        EPI_RELANE();
        const int row0 = u.pm * 256 + wr * 64 + fr;
#pragma unroll
        for (int ai = 0; ai < 2; ++ai)
#pragma unroll
            for (int m = 0; m < 4; ++m) {
                const int row = row0 + ai * 128 + m * 16, pos = row & (SEQ - 1);
                const f32x4* p = (const f32x4*)(ssq + (size_t)row * 8);
                const float rs = rsqrtf((sum4(p[0]) + sum4(p[1])) * (1.0f / 384.0f) + EPS) * QSCALE_M;
#pragma unroll
                for (int bj = 0; bj < 2; ++bj) {
                    const int g32 = 8 * u.pn + 4 * bj + wc;
                    bf16_t* dst = QM + (size_t)row * 768 + 32 * g32 + 4 * fq;
                    f32x4 v0 = acc[ai][bj][m][0] * rs, v1 = acc[ai][bj][m][1] * rs;
                    if (g32 % 3 == 2) {
                        const f32x4 c = *(const f32x4*)(cosm + pos * 16 + 4 * fq), s = *(const f32x4*)(sinm + pos * 16 + 4 * fq);
                        const f32x4 o1 = v0 * c - v1 * s, o2 = v1 * c + v0 * s; v0 = o1; v1 = o2;
                    }
                    u32x2 w0, w1; w0.x = cvt_pk_bf16(v0[0], v0[1]); w0.y = cvt_pk_bf16(v0[2], v0[3]); w1.x = cvt_pk_bf16(v1[0], v1[1]); w1.y = cvt_pk_bf16(v1[2], v1[3]);
                    *(u32x2*)dst = w0; *(u32x2*)(dst + 16) = w1;
                }
            }
    }
};
struct EpiKV {
    static constexpr bool PERM = true, AFTER_DRAIN = false;
    const float* sskv; bf16_t* KVM;
    __device__ __forceinline__ void operator()(const f32x4 (&acc)[2][2][4][2], const Unit& u, int wr, int wc, int fr_in, int fq_in) const {
        EPI_RELANE();
        const int row0 = u.pm * 256 + wr * 64 + fr, col = u.pn * 256 + wc * 32 + 8 * fq;
#pragma unroll
        for (int ai = 0; ai < 2; ++ai)
#pragma unroll
            for (int m = 0; m < 4; ++m) {
                const int row = row0 + ai * 128 + m * 16;
                const float rs = rsqrtf(sum4(*(const f32x4*)(sskv + (size_t)row * 4)) * (1.0f / 256.0f) + EPS);
#pragma unroll
                for (int bj = 0; bj < 2; ++bj) {
                    const f32x4 v0 = acc[ai][bj][m][0] * rs, v1 = acc[ai][bj][m][1] * rs;
                    u32x4 w; w.x = cvt_pk_bf16(v0[0], v0[1]); w.y = cvt_pk_bf16(v0[2], v0[3]); w.z = cvt_pk_bf16(v1[0], v1[1]); w.w = cvt_pk_bf16(v1[2], v1[3]);
                    *(u32x4*)(KVM + (size_t)row * 1024 + col + bj * 128) = w;
                }
            }
    }
};

constexpr int ATT_VS = 144;
constexpr int ATT_TILE = 64 * 208 + 64 * ATT_VS;
constexpr int ATT_OST = 2 * ATT_TILE, ATT_WSC = ATT_OST + NWAVES * 4096;
static_assert(ATT_WSC + NWAVES * 256 <= 131072, "attention LDS");
static_assert(WS_KD == WS_QD + (size_t)NT * 512 * 2 && WS_VD == WS_KD + (size_t)NT * 512 * 2 && WS_CKV == WS_CQ + (size_t)NT * 384 * 2 && WS_SSKV == WS_SSQ + (size_t)NT * 8 * 4, "buffers addressed relative to each other");
__device__ __forceinline__ int crow(int r, int hi) { return (r & 3) + 8 * (r >> 2) + 4 * hi; }
__device__ __forceinline__ bf16x8 pack8(const f32x16& p, int b) {
    u32x4 w; w.x = cvt_pk_bf16(p[b], p[b + 1]); w.y = cvt_pk_bf16(p[b + 2], p[b + 3]); w.z = cvt_pk_bf16(p[b + 4], p[b + 5]); w.w = cvt_pk_bf16(p[b + 6], p[b + 7]);
    return __builtin_bit_cast(bf16x8, w);
}
typedef short v4i16_t __attribute__((ext_vector_type(4)));
__device__ __forceinline__ s16x4 vtr(LAS const unsigned char* p) { return __builtin_bit_cast(s16x4, __builtin_amdgcn_ds_read_tr16_b64_v4i16((LAS v4i16_t*)p)); }

struct AttnIO {
    const bf16_t *QM, *KVM, *KR; bf16_t* OMIX;
    const bf16_t *QD, *KD, *VD; bf16_t* OD; float* LSE;
};

template <bool DIL>
__device__ __forceinline__ void attn_unit(LAS unsigned char* lds, const AttnIO& io, int unit) {
    constexpr int DK = DIL ? 64 : 96, KS = DK * 2 + 16, NKS = DK / 16;
    int tid_ = threadIdx.x; asm volatile("" : "+v"(tid_));
    const int tid = tid_, lane = tid & 63, wid = __builtin_amdgcn_readfirstlane(tid >> 6), r32 = lane & 31, hi = lane >> 5;
    int b, h, ntiles, tlo, thi, kofs = 0, L = SEQ, dil = 1, res = 0, resu = 0, br = 0, q0 = 0, pq;
    if constexpr (!DIL) {
        const int bh = unit >> 3, qb = unit & 7; b = bh >> 3; h = bh & 7; ntiles = 32; tlo = 0; thi = 32; q0 = qb * 256; pq = q0 + wid * 32 + r32;
    } else {
        const int bh = unit / 24, k = unit % 24, j = k & 7; br = k >> 3; b = bh >> 3; h = bh & 7;
        if (br == 0) { dil = 1; L = 2048; resu = 0; q0 = 256 * j; }
        else if (br == 1) { dil = 4; L = 512; resu = j >> 1; q0 = 256 * (j & 1); }
        else { dil = 16; L = 128; resu = 2 * j; q0 = 0; }
        if (br < 2) { ntiles = 6; tlo = wid >> 1; thi = tlo + 3; kofs = q0 - 64; pq = q0 + wid * 32 + r32; res = resu; }
        else { const int hw = wid >> 2; ntiles = 4; tlo = 2 * hw; thi = tlo + 2; kofs = -128 * hw; pq = (wid & 3) * 32 + r32; res = resu + hw; }
    }
    const int pq0 = pq - r32;
    const size_t kb = (size_t)b * SEQ;
    bf16x8 qf[NKS];
    {
        const bf16_t* qp = DIL ? io.QD + (kb + (size_t)pq * dil + res) * 512 + h * 64 : io.QM + (kb + pq) * 768 + h * 96;
#pragma unroll
        for (int ks = 0; ks < NKS; ++ks) qf[ks] = *(const bf16x8*)(qp + ks * 16 + hi * 8);
    }
    const int lrow = tid >> 3, lch = tid & 7, rrow = (tid >> 2) & 63, rch = tid & 3;
    u32x4 gkA, gvA, grA = (u32x4){0u, 0u, 0u, 0u}, gkB, gvB, grB = (u32x4){0u, 0u, 0u, 0u};
#define ATT_TOK(t) \
        const int s_ = 64 * (t) + lrow; size_t tok_; \
        if (br < 2) { int p_ = q0 - 64 + s_; p_ = p_ < 0 ? 0 : (p_ > L - 1 ? L - 1 : p_); tok_ = kb + (size_t)p_ * dil + resu; } \
        else { tok_ = kb + (size_t)(s_ & 127) * 16 + (size_t)(resu + (s_ >> 7)); }
#define ATT_GLOADK(t, GK, GR) do { \
        if constexpr (!DIL) { \
            GK = *(const u32x4*)(io.KVM + (kb + 64 * (t) + lrow) * 1024 + h * 128 + lch * 8); \
            GR = *(const u32x4*)(io.KR + (kb + 64 * (t) + rrow) * 32 + rch * 8); \
        } else { ATT_TOK(t) GK = *(const u32x4*)(io.KD + tok_ * 512 + h * 64 + lch * 8); } } while (0)
#define ATT_GLOADV(t, GV) do { \
        if constexpr (!DIL) { GV = *(const u32x4*)(io.KVM + (kb + 64 * (t) + lrow) * 1024 + h * 128 + 64 + lch * 8); } \
        else { ATT_TOK(t) GV = *(const u32x4*)(io.VD + tok_ * 512 + h * 64 + lch * 8); } } while (0)
#define ATT_LSTOREK(buf, GK, GR) do { \
        LAS unsigned char* Kb_ = lds + (buf) * ATT_TILE; \
        *(LAS u32x4*)(Kb_ + lrow * KS + lch * 16) = GK; \
        if constexpr (!DIL) { *(LAS u32x4*)(Kb_ + rrow * KS + 128 + rch * 16) = GR; } } while (0)
#define ATT_LSTOREV(buf, GV) do { *(LAS u32x4*)(lds + (buf) * ATT_TILE + 64 * KS + lrow * ATT_VS + lch * 16) = GV; } while (0)
#define ATT_SB() __builtin_amdgcn_sched_barrier(0)
    LAS float* wsc = (LAS float*)(lds + ATT_WSC + wid * 256);
    f32x16 o0 = {}, o1 = {}, negm = {};
    float mref = 0.f, lrun = 0.f; bool started = false;
    const int krow = (r32 & 19) | ((r32 & 4) << 1) | ((r32 & 8) >> 1);
    const int koff = krow * KS + hi * 16;
    const int i16 = lane & 15, g16 = lane >> 4;
    const int voff = 64 * KS + (8 * hi + (i16 >> 2)) * ATT_VS + (16 * (g16 & 1) + 4 * (i16 & 3)) * 2;
    ATT_GLOADK(0, gkA, grA); ATT_GLOADV(0, gvA); ATT_GLOADK(1, gkB, grB); ATT_LSTOREK(0, gkA, grA); ATT_LSTOREV(0, gvA); ATT_LSTOREK(1, gkB, grB);
    ATT_GLOADK(2, gkB, grB); ATT_GLOADV(1, gvB);
    __syncthreads();
    f32x16 c0, c1;
    if (tlo == 0) {
        c0 = negm; c1 = negm;
#pragma unroll
        for (int ks = 0; ks < NKS; ++ks) {
            const bf16x8 a0 = *(LAS const bf16x8*)(lds + koff + ks * 32), a1 = *(LAS const bf16x8*)(lds + koff + 32 * KS + ks * 32);
            c0 = __builtin_amdgcn_mfma_f32_32x32x16_bf16(a0, qf[ks], c0, 0, 0, 0); c1 = __builtin_amdgcn_mfma_f32_32x32x16_bf16(a1, qf[ks], c1, 0, 0, 0);
        }
    } else { c0 = negm; c1 = negm; }
    __syncthreads();
    for (int t2 = 0; t2 < ntiles; t2 += 2) {
      { const int t = t2;
        ATT_GLOADK(min(t + 3, ntiles - 1), gkA, grA);
        ATT_GLOADV(min(t + 2, ntiles - 1), gvA);
        const bool doP = (t >= tlo) && (t < thi), doS = (t + 1 >= tlo) && (t + 1 < thi);
        LAS const unsigned char* Kn = lds + ((t + 1) & 1) * ATT_TILE + koff;
        LAS const unsigned char* Vc = lds + (t & 1) * ATT_TILE + voff;
        f32x16 n0 = negm, n1 = negm;
        if (doP) {
            if constexpr (DIL) {
                const int P0 = 64 * t + kofs;
                const bool full = (P0 >= pq0 - 33) && (P0 + 63 <= pq0 + 64) && (P0 >= 0) && (P0 + 63 < L);
                if (!full) {
                    const int lo = max(pq - 64, 0) - P0 - 8 * hi, span = min(pq + 64, L - 1) - max(pq - 64, 0);
#pragma unroll
                    for (int r = 0; r < 16; ++r) {
                        const int i0 = 16 * (r >> 3) + (r & 7);
                        c0[r] = ((unsigned)(i0 - lo) <= (unsigned)span) ? c0[r] : -INFINITY;
                        c1[r] = ((unsigned)(i0 + 32 - lo) <= (unsigned)span) ? c1[r] : -INFINITY;
                    }
                }
            }
            float ma = fmaxf(fmaxf(c0[0], c0[1]), c1[0]), mb = fmaxf(fmaxf(c0[2], c0[3]), c1[1]);
            ma = fmaxf(fmaxf(ma, c1[2]), c1[3]);
#pragma unroll
            for (int r = 4; r < 16; r += 4) { ma = fmaxf(fmaxf(ma, c0[r]), c0[r + 1]); mb = fmaxf(fmaxf(mb, c0[r + 2]), c0[r + 3]); ma = fmaxf(fmaxf(ma, c1[r]), c1[r + 1]); mb = fmaxf(fmaxf(mb, c1[r + 2]), c1[r + 3]); }
            float rm = fmaxf(ma, mb);
            { auto rr = __builtin_amdgcn_permlane32_swap(__float_as_uint(rm), __float_as_uint(rm), false, false); rm = fmaxf(__uint_as_float(rr[0]), __uint_as_float(rr[1])); }
            const float dl = (rm > -1e30f && (!started || rm > 8.f)) ? rm : 0.f;
            started = started || (rm > -1e30f);
            const bool resc = __any(dl != 0.f);
            if (resc) {
                mref += dl;
#pragma unroll
                for (int r = 0; r < 16; ++r) { c0[r] -= dl; c1[r] -= dl; }
#pragma unroll
                for (int r = 0; r < 16; ++r) negm[r] = -mref;
                const float f = fast_exp2(-fmaxf(dl, 0.f)); lrun *= f;
                if (hi == 0) wsc[r32] = f;
                n0 = negm; n1 = negm;
            }
            float ps0 = 0.f, ps1 = 0.f;
            u32x4 pw0, pw1, pw2, pw3;
#define ATT_EXPU(u) do { c0[u] = fast_exp2(c0[u]); c1[u] = fast_exp2(c1[u]); ps0 += c0[u]; ps1 += c1[u]; } while (0)
#define ATT_PK(u) do { const unsigned x0_ = cvt_pk_bf16(c0[u - 1], c0[u]), x1_ = cvt_pk_bf16(c1[u - 1], c1[u]); \
            if ((u) < 8) { pw0[((u) >> 1) & 3] = x0_; pw2[((u) >> 1) & 3] = x1_; } else { pw1[((u) >> 1) & 3] = x0_; pw3[((u) >> 1) & 3] = x1_; } } while (0)
            if (doS) {
                bf16x8 a0 = *(LAS const bf16x8*)(Kn), a1 = *(LAS const bf16x8*)(Kn + 32 * KS);
#pragma unroll
                for (int ks = 0; ks < NKS; ++ks) {
                    bf16x8 b0 = a0, b1 = a1;
                    if (ks + 1 < NKS) { b0 = *(LAS const bf16x8*)(Kn + (ks + 1) * 32); b1 = *(LAS const bf16x8*)(Kn + 32 * KS + (ks + 1) * 32); }
                    n0 = __builtin_amdgcn_mfma_f32_32x32x16_bf16(a0, qf[ks], n0, 0, 0, 0);
                    n1 = __builtin_amdgcn_mfma_f32_32x32x16_bf16(a1, qf[ks], n1, 0, 0, 0);
                    a0 = b0; a1 = b1;
                    const int u_lo = (16 * ks) / NKS, u_hi = (16 * (ks + 1)) / NKS;
#pragma unroll
                    for (int u = u_lo; u < u_hi; ++u) { ATT_EXPU(u); if (u & 1) ATT_PK(u); }
                    ATT_SB();
                }
            } else {
#pragma unroll
                for (int u = 0; u < 16; ++u) { ATT_EXPU(u); if (u & 1) ATT_PK(u); }
            }
            lrun += ps0 + ps1;
            if (resc) {
#pragma unroll
                for (int g = 0; g < 4; ++g) {
                    const f32x4 av = *(LAS const f32x4*)(wsc + 8 * g + 4 * hi);
#pragma unroll
                    for (int e = 0; e < 4; ++e) { o0[4 * g + e] *= av[e]; o1[4 * g + e] *= av[e]; }
                }
            }
            {
                s16x4 va = vtr(Vc), vb = vtr(Vc + 4 * ATT_VS), vc = vtr(Vc + 64), vd = vtr(Vc + 64 + 4 * ATT_VS);
#pragma unroll
                for (int j = 0; j < 4; ++j) {
                    const bf16x8 pa = __builtin_bit_cast(bf16x8, j == 0 ? pw0 : (j == 1 ? pw1 : (j == 2 ? pw2 : pw3)));
                    const bf16x8 vf0 = (bf16x8){va[0], va[1], va[2], va[3], vb[0], vb[1], vb[2], vb[3]};
                    const bf16x8 vf1 = (bf16x8){vc[0], vc[1], vc[2], vc[3], vd[0], vd[1], vd[2], vd[3]};
                    if (j + 1 < 4) { LAS const unsigned char* vp = Vc + (j + 1) * 16 * ATT_VS; va = vtr(vp); vb = vtr(vp + 4 * ATT_VS); vc = vtr(vp + 64); vd = vtr(vp + 64 + 4 * ATT_VS); }
                    o0 = __builtin_amdgcn_mfma_f32_32x32x16_bf16(pa, vf0, o0, 0, 0, 0);
                    o1 = __builtin_amdgcn_mfma_f32_32x32x16_bf16(pa, vf1, o1, 0, 0, 0);
                }
            }
        } else if (doS) {
#pragma unroll
            for (int ks = 0; ks < NKS; ++ks) {
                const bf16x8 a0 = *(LAS const bf16x8*)(Kn + ks * 32), a1 = *(LAS const bf16x8*)(Kn + 32 * KS + ks * 32);
                n0 = __builtin_amdgcn_mfma_f32_32x32x16_bf16(a0, qf[ks], n0, 0, 0, 0); n1 = __builtin_amdgcn_mfma_f32_32x32x16_bf16(a1, qf[ks], n1, 0, 0, 0);
            }
        }
        c0 = n0; c1 = n1;
        ATT_LSTOREK(t & 1, gkB, grB);
        ATT_LSTOREV((t + 1) & 1, gvB);
        __syncthreads();
          }
      { const int t = t2 + 1;
        ATT_GLOADK(min(t + 3, ntiles - 1), gkB, grB);
        ATT_GLOADV(min(t + 2, ntiles - 1), gvB);
        const bool doP = (t >= tlo) && (t < thi), doS = (t + 1 >= tlo) && (t + 1 < thi);
        LAS const unsigned char* Kn = lds + ((t + 1) & 1) * ATT_TILE + koff;
        LAS const unsigned char* Vc = lds + (t & 1) * ATT_TILE + voff;
        f32x16 n0 = negm, n1 = negm;
        if (doP) {
            if constexpr (DIL) {
                const int P0 = 64 * t + kofs;
                const bool full = (P0 >= pq0 - 33) && (P0 + 63 <= pq0 + 64) && (P0 >= 0) && (P0 + 63 < L);
                if (!full) {
                    const int lo = max(pq - 64, 0) - P0 - 8 * hi, span = min(pq + 64, L - 1) - max(pq - 64, 0);
#pragma unroll
                    for (int r = 0; r < 16; ++r) {
                        const int i0 = 16 * (r >> 3) + (r & 7);
                        c0[r] = ((unsigned)(i0 - lo) <= (unsigned)span) ? c0[r] : -INFINITY;
                        c1[r] = ((unsigned)(i0 + 32 - lo) <= (unsigned)span) ? c1[r] : -INFINITY;
                    }
                }
            }
            float ma = fmaxf(fmaxf(c0[0], c0[1]), c1[0]), mb = fmaxf(fmaxf(c0[2], c0[3]), c1[1]);
            ma = fmaxf(fmaxf(ma, c1[2]), c1[3]);
#pragma unroll
            for (int r = 4; r < 16; r += 4) { ma = fmaxf(fmaxf(ma, c0[r]), c0[r + 1]); mb = fmaxf(fmaxf(mb, c0[r + 2]), c0[r + 3]); ma = fmaxf(fmaxf(ma, c1[r]), c1[r + 1]); mb = fmaxf(fmaxf(mb, c1[r + 2]), c1[r + 3]); }
            float rm = fmaxf(ma, mb);
            { auto rr = __builtin_amdgcn_permlane32_swap(__float_as_uint(rm), __float_as_uint(rm), false, false); rm = fmaxf(__uint_as_float(rr[0]), __uint_as_float(rr[1])); }
            const float dl = (rm > -1e30f && (!started || rm > 8.f)) ? rm : 0.f;
            started = started || (rm > -1e30f);
            const bool resc = __any(dl != 0.f);
            if (resc) {
                mref += dl;
#pragma unroll
                for (int r = 0; r < 16; ++r) { c0[r] -= dl; c1[r] -= dl; }
#pragma unroll
                for (int r = 0; r < 16; ++r) negm[r] = -mref;
                const float f = fast_exp2(-fmaxf(dl, 0.f)); lrun *= f;
                if (hi == 0) wsc[r32] = f;
                n0 = negm; n1 = negm;
            }
            float ps0 = 0.f, ps1 = 0.f;
            u32x4 pw0, pw1, pw2, pw3;
#define ATT_EXPU(u) do { c0[u] = fast_exp2(c0[u]); c1[u] = fast_exp2(c1[u]); ps0 += c0[u]; ps1 += c1[u]; } while (0)
#define ATT_PK(u) do { const unsigned x0_ = cvt_pk_bf16(c0[u - 1], c0[u]), x1_ = cvt_pk_bf16(c1[u - 1], c1[u]); \
            if ((u) < 8) { pw0[((u) >> 1) & 3] = x0_; pw2[((u) >> 1) & 3] = x1_; } else { pw1[((u) >> 1) & 3] = x0_; pw3[((u) >> 1) & 3] = x1_; } } while (0)
            if (doS) {
                bf16x8 a0 = *(LAS const bf16x8*)(Kn), a1 = *(LAS const bf16x8*)(Kn + 32 * KS);
#pragma unroll
                for (int ks = 0; ks < NKS; ++ks) {
                    bf16x8 b0 = a0, b1 = a1;
                    if (ks + 1 < NKS) { b0 = *(LAS const bf16x8*)(Kn + (ks + 1) * 32); b1 = *(LAS const bf16x8*)(Kn + 32 * KS + (ks + 1) * 32); }
                    n0 = __builtin_amdgcn_mfma_f32_32x32x16_bf16(a0, qf[ks], n0, 0, 0, 0);
                    n1 = __builtin_amdgcn_mfma_f32_32x32x16_bf16(a1, qf[ks], n1, 0, 0, 0);
                    a0 = b0; a1 = b1;
                    const int u_lo = (16 * ks) / NKS, u_hi = (16 * (ks + 1)) / NKS;
#pragma unroll
                    for (int u = u_lo; u < u_hi; ++u) { ATT_EXPU(u); if (u & 1) ATT_PK(u); }
                    ATT_SB();
                }
            } else {
#pragma unroll
                for (int u = 0; u < 16; ++u) { ATT_EXPU(u); if (u & 1) ATT_PK(u); }
            }
            lrun += ps0 + ps1;
            if (resc) {
#pragma unroll
                for (int g = 0; g < 4; ++g) {
                    const f32x4 av = *(LAS const f32x4*)(wsc + 8 * g + 4 * hi);
#pragma unroll
                    for (int e = 0; e < 4; ++e) { o0[4 * g + e] *= av[e]; o1[4 * g + e] *= av[e]; }
                }
            }
            {
                s16x4 va = vtr(Vc), vb = vtr(Vc + 4 * ATT_VS), vc = vtr(Vc + 64), vd = vtr(Vc + 64 + 4 * ATT_VS);
#pragma unroll
                for (int j = 0; j < 4; ++j) {
                    const bf16x8 pa = __builtin_bit_cast(bf16x8, j == 0 ? pw0 : (j == 1 ? pw1 : (j == 2 ? pw2 : pw3)));
                    const bf16x8 vf0 = (bf16x8){va[0], va[1], va[2], va[3], vb[0], vb[1], vb[2], vb[3]};
                    const bf16x8 vf1 = (bf16x8){vc[0], vc[1], vc[2], vc[3], vd[0], vd[1], vd[2], vd[3]};
                    if (j + 1 < 4) { LAS const unsigned char* vp = Vc + (j + 1) * 16 * ATT_VS; va = vtr(vp); vb = vtr(vp + 4 * ATT_VS); vc = vtr(vp + 64); vd = vtr(vp + 64 + 4 * ATT_VS); }
                    o0 = __builtin_amdgcn_mfma_f32_32x32x16_bf16(pa, vf0, o0, 0, 0, 0);
                    o1 = __builtin_amdgcn_mfma_f32_32x32x16_bf16(pa, vf1, o1, 0, 0, 0);
                }
            }
        } else if (doS) {
#pragma unroll
            for (int ks = 0; ks < NKS; ++ks) {
                const bf16x8 a0 = *(LAS const bf16x8*)(Kn + ks * 32), a1 = *(LAS const bf16x8*)(Kn + 32 * KS + ks * 32);
                n0 = __builtin_amdgcn_mfma_f32_32x32x16_bf16(a0, qf[ks], n0, 0, 0, 0); n1 = __builtin_amdgcn_mfma_f32_32x32x16_bf16(a1, qf[ks], n1, 0, 0, 0);
            }
        }
        c0 = n0; c1 = n1;
        ATT_LSTOREK(t & 1, gkA, grA);
        ATT_LSTOREV((t + 1) & 1, gvA);
        __syncthreads();
          }
    }
    float ltot;
    { auto rr = __builtin_amdgcn_permlane32_swap(__float_as_uint(lrun), __float_as_uint(lrun), false, false); ltot = __uint_as_float(rr[0]) + __uint_as_float(rr[1]); }
    if (hi == 0) wsc[r32] = fast_rcp(ltot);
    LAS bf16_t* stg = (LAS bf16_t*)(lds + ATT_OST + wid * 4096);
#pragma unroll
    for (int g = 0; g < 4; ++g) {
        const f32x4 iv = *(LAS const f32x4*)(wsc + 8 * g + 4 * hi);
#pragma unroll
        for (int e = 0; e < 4; ++e) {
            const int r = 4 * g + e, orow = crow(r, hi);
            stg[orow * 64 + r32] = (bf16_t)(cvt_pk_bf16(o0[r] * iv[e], 0.f) & 0xffffu);
            stg[orow * 64 + 32 + r32] = (bf16_t)(cvt_pk_bf16(o1[r] * iv[e], 0.f) & 0xffffu);
        }
    }
#pragma unroll
    for (int it = 0; it < 4; ++it) {
        const int row = it * 8 + (lane >> 3), ch = lane & 7;
        const u32x4 v = *(LAS const u32x4*)(stg + row * 64 + ch * 8);
        if constexpr (DIL) { const size_t tok = kb + (size_t)(pq0 + row) * dil + res; *(u32x4*)(io.OD + (size_t)br * NT * 512 + tok * 512 + h * 64 + ch * 8) = v; }
        else *(u32x4*)(io.OMIX + (kb + pq0 + row) * 1024 + h * 64 + ch * 8) = v;
    }
    if constexpr (DIL) { if (hi == 0) { const size_t tok = kb + (size_t)pq * dil + res; io.LSE[((size_t)br * NT + tok) * 8 + h] = mref + __builtin_amdgcn_logf(ltot); } }
}
#undef ATT_TOK
#undef ATT_GLOADK
#undef ATT_GLOADV
#undef ATT_LSTOREK
#undef ATT_LSTOREV
#undef ATT_SB
#undef ATT_EXPU
#undef ATT_PK

constexpr int DIL_RS = 144;
constexpr int DIL_K = 0, DIL_V = 384 * DIL_RS, DIL_OST = 2 * 384 * DIL_RS, DIL_WSC = DIL_OST + NWAVES * 4096, DIL_LDS = DIL_WSC + NWAVES * 256;
struct DilUnit { int b, h, br, dil, L, resu, q0, nrows; };
__device__ __forceinline__ DilUnit dil_decode(int unit) {
    DilUnit d; const int bh = unit / 24, k = unit % 24, j = k & 7; d.br = k >> 3; d.b = bh >> 3; d.h = bh & 7;
    if (d.br == 0) { d.dil = 1; d.L = 2048; d.resu = 0; d.q0 = 256 * j; d.nrows = 384; }
    else if (d.br == 1) { d.dil = 4; d.L = 512; d.resu = j >> 1; d.q0 = 256 * (j & 1); d.nrows = 384; }
    else { d.dil = 16; d.L = 128; d.resu = 2 * j; d.q0 = 0; d.nrows = 256; }
    return d;
}
__device__ __forceinline__ size_t dil_tok(const DilUnit& d, int s) {
    const size_t kb = (size_t)d.b * SEQ;
    if (d.br < 2) { int p = d.q0 - 64 + s; p = p < 0 ? 0 : (p > d.L - 1 ? d.L - 1 : p); return kb + (size_t)p * d.dil + d.resu; }
    return kb + (size_t)(s & 127) * 16 + (size_t)(d.resu + (s >> 7));
}
__device__ __forceinline__ void dil_phase(LAS unsigned char* lds, const AttnIO& io, int bx, int G) {
    int tid_ = threadIdx.x; asm volatile("" : "+v"(tid_));
    const int tid = tid_, lane = tid & 63, wid = __builtin_amdgcn_readfirstlane(tid >> 6), r32 = lane & 31, hi = lane >> 5;
    const int lrow = tid >> 3, lch = tid & 7;
    const int krow = (r32 & 19) | ((r32 & 4) << 1) | ((r32 & 8) >> 1);
    const int i16 = lane & 15, g16 = lane >> 4;
    const int voff = DIL_V + (8 * hi + (i16 >> 2)) * DIL_RS + (16 * (g16 & 1) + 4 * (i16 & 3)) * 2;
    LAS float* wsc = (LAS float*)(lds + DIL_WSC + wid * 256);
    LAS bf16_t* stg = (LAS bf16_t*)(lds + DIL_OST + wid * 4096);
    constexpr int NUNITS = 256 * 24;
    u32x4 gk[6], gv[6]; bf16x8 qn[4];
#define DIL_WAVE(d, TLO, NTW, KOFS, PQ, RES) \
    int TLO, NTW, KOFS, PQ, RES; \
    if ((d).br < 2) { TLO = wid >> 1; NTW = 3; KOFS = (d).q0 - 64; PQ = (d).q0 + wid * 32 + r32; RES = (d).resu; } \
    else { const int hw_ = wid >> 2; TLO = 2 * hw_; NTW = 2; KOFS = -128 * hw_; PQ = (wid & 3) * 32 + r32; RES = (d).resu + hw_; }
#define DIL_PREFETCH(unit) do { \
        const DilUnit d_ = dil_decode(unit); \
        _Pragma("unroll") for (int i = 0; i < 6; ++i) { const int row_ = lrow + 64 * i; \
            if (row_ < d_.nrows) { const size_t tok_ = dil_tok(d_, row_); gk[i] = *(const u32x4*)(io.KD + tok_ * 512 + d_.h * 64 + lch * 8); gv[i] = *(const u32x4*)(io.VD + tok_ * 512 + d_.h * 64 + lch * 8); } } \
        DIL_WAVE(d_, tlo_, ntw_, kofs_, pq_, res_) (void)tlo_; (void)ntw_; (void)kofs_; \
        const bf16_t* qp_ = io.QD + ((size_t)d_.b * SEQ + (size_t)pq_ * d_.dil + res_) * 512 + d_.h * 64; \
        _Pragma("unroll") for (int ks = 0; ks < 4; ++ks) qn[ks] = *(const bf16x8*)(qp_ + ks * 16 + hi * 8); \
    } while (0)
    int unit = bx;
    if (unit < NUNITS) DIL_PREFETCH(unit);
    for (; unit < NUNITS; unit += G) {
        const DilUnit d = dil_decode(unit);
#pragma unroll
        for (int i = 0; i < 6; ++i) { const int row = lrow + 64 * i;
            if (row < d.nrows) { *(LAS u32x4*)(lds + DIL_K + row * DIL_RS + lch * 16) = gk[i]; *(LAS u32x4*)(lds + DIL_V + row * DIL_RS + lch * 16) = gv[i]; } }
        bf16x8 qf[4];
#pragma unroll
        for (int ks = 0; ks < 4; ++ks) qf[ks] = qn[ks];
        __syncthreads();
        if (unit + G < NUNITS) DIL_PREFETCH(unit + G);
        DIL_WAVE(d, tlo, ntw, kofs, pq, res)
        const int pq0 = pq - r32;
        f32x16 o0 = {}, o1 = {};
        float mrun = -1e30f, lrun = 0.f;
        for (int tt = 0; tt < ntw; ++tt) {
            const int t = tlo + tt;
            LAS const unsigned char* Kb = lds + DIL_K + (64 * t + krow) * DIL_RS + hi * 16;
            f32x16 s0 = {}, s1 = {};
#pragma unroll
            for (int ks = 0; ks < 4; ++ks) {
                const bf16x8 a0 = *(LAS const bf16x8*)(Kb + ks * 32), a1 = *(LAS const bf16x8*)(Kb + 32 * DIL_RS + ks * 32);
                s0 = __builtin_amdgcn_mfma_f32_32x32x16_bf16(a0, qf[ks], s0, 0, 0, 0);
                s1 = __builtin_amdgcn_mfma_f32_32x32x16_bf16(a1, qf[ks], s1, 0, 0, 0);
            }
            {
                const int P0 = 64 * t + kofs;
                const bool full = (P0 >= pq0 - 33) && (P0 + 63 <= pq0 + 64) && (P0 >= 0) && (P0 + 63 < d.L);
                if (!full) {
                    const int lo = max(pq - 64, 0) - P0 - 8 * hi, span = min(pq + 64, d.L - 1) - max(pq - 64, 0);
#pragma unroll
                    for (int r = 0; r < 16; ++r) {
                        const int i0 = 16 * (r >> 3) + (r & 7);
                        s0[r] = ((unsigned)(i0 - lo) <= (unsigned)span) ? s0[r] : -INFINITY;
                        s1[r] = ((unsigned)(i0 + 32 - lo) <= (unsigned)span) ? s1[r] : -INFINITY;
                    }
                }
            }
            float ma = fmaxf(fmaxf(s0[0], s0[1]), s1[0]), mb = fmaxf(fmaxf(s0[2], s0[3]), s1[1]);
            ma = fmaxf(fmaxf(ma, s1[2]), s1[3]);
#pragma unroll
            for (int r = 4; r < 16; r += 4) { ma = fmaxf(fmaxf(ma, s0[r]), s0[r + 1]); mb = fmaxf(fmaxf(mb, s0[r + 2]), s0[r + 3]); ma = fmaxf(fmaxf(ma, s1[r]), s1[r + 1]); mb = fmaxf(fmaxf(mb, s1[r + 2]), s1[r + 3]); }
            float mx = fmaxf(ma, mb);
            { auto rr = __builtin_amdgcn_permlane32_swap(__float_as_uint(mx), __float_as_uint(mx), false, false); mx = fmaxf(__uint_as_float(rr[0]), __uint_as_float(rr[1])); }
            const float mnew = fmaxf(mrun, mx), alpha = fast_exp2(mrun - mnew);
            mrun = mnew;
            float ps0 = 0.f, ps1 = 0.f;
#pragma unroll
            for (int r = 0; r < 16; ++r) { s0[r] = fast_exp2(s0[r] - mnew); s1[r] = fast_exp2(s1[r] - mnew); ps0 += s0[r]; ps1 += s1[r]; }
            lrun = lrun * alpha + (ps0 + ps1);
            if (__any(alpha != 1.0f)) {
                if (hi == 0) wsc[r32] = alpha;
#pragma unroll
                for (int g = 0; g < 4; ++g) {
                    const f32x4 av = *(LAS const f32x4*)(wsc + 8 * g + 4 * hi);
#pragma unroll
                    for (int e = 0; e < 4; ++e) { o0[4 * g + e] *= av[e]; o1[4 * g + e] *= av[e]; }
                }
            }
            const bf16x8 pa0 = pack8(s0, 0), pa1 = pack8(s0, 8), pa2 = pack8(s1, 0), pa3 = pack8(s1, 8);
            LAS const unsigned char* Vb = lds + voff + 64 * t * DIL_RS;
#pragma unroll
            for (int j = 0; j < 4; ++j) {
                const bf16x8 pa = j == 0 ? pa0 : (j == 1 ? pa1 : (j == 2 ? pa2 : pa3));
                LAS const unsigned char* vp = Vb + j * 16 * DIL_RS;
                const s16x4 a = vtr(vp), bq = vtr(vp + 4 * DIL_RS), c = vtr(vp + 64), dd = vtr(vp + 64 + 4 * DIL_RS);
                const bf16x8 vf0 = (bf16x8){a[0], a[1], a[2], a[3], bq[0], bq[1], bq[2], bq[3]};
                const bf16x8 vf1 = (bf16x8){c[0], c[1], c[2], c[3], dd[0], dd[1], dd[2], dd[3]};
                o0 = __builtin_amdgcn_mfma_f32_32x32x16_bf16(pa, vf0, o0, 0, 0, 0);
                o1 = __builtin_amdgcn_mfma_f32_32x32x16_bf16(pa, vf1, o1, 0, 0, 0);
            }
        }
        float ltot;
        { auto rr = __builtin_amdgcn_permlane32_swap(__float_as_uint(lrun), __float_as_uint(lrun), false, false); ltot = __uint_as_float(rr[0]) + __uint_as_float(rr[1]); }
        if (hi == 0) wsc[r32] = fast_rcp(ltot);
#pragma unroll
        for (int g = 0; g < 4; ++g) {
            const f32x4 iv = *(LAS const f32x4*)(wsc + 8 * g + 4 * hi);
#pragma unroll
            for (int e = 0; e < 4; ++e) {
                const int r = 4 * g + e, orow = crow(r, hi);
                stg[orow * 64 + r32] = (bf16_t)(cvt_pk_bf16(o0[r] * iv[e], 0.f) & 0xffffu);
                stg[orow * 64 + 32 + r32] = (bf16_t)(cvt_pk_bf16(o1[r] * iv[e], 0.f) & 0xffffu);
            }
        }
        const size_t kb = (size_t)d.b * SEQ;
#pragma unroll
        for (int it = 0; it < 4; ++it) {
            const int row = it * 8 + (lane >> 3), ch = lane & 7;
            const u32x4 v = *(LAS const u32x4*)(stg + row * 64 + ch * 8);
            const size_t tok = kb + (size_t)(pq0 + row) * d.dil + res;
            *(u32x4*)(io.OD + (size_t)d.br * NT * 512 + tok * 512 + d.h * 64 + ch * 8) = v;
        }
        if (hi == 0) { const size_t tok = kb + (size_t)pq * d.dil + res; io.LSE[((size_t)d.br * NT + tok) * 8 + d.h] = mrun + __builtin_amdgcn_logf(ltot); }
        __syncthreads();
    }
#undef DIL_WAVE
#undef DIL_PREFETCH
}

__device__ __forceinline__ float wave_sum(float v) {
#pragma unroll
    for (int o = 1; o < 64; o <<= 1) v += __shfl_xor(v, o);
    return v;
}
__device__ __forceinline__ void tr_block(const float* W, int K, int N, const float* gain, bf16_t* WT, int k0, int n0, int dst_row0, LAS float* scr, int lane) {
#pragma unroll 8
    for (int i = 0; i < 32; ++i) {
        const int kk = 2 * i + (lane >> 5);
        float v = W[(size_t)(k0 + kk) * N + n0 + (lane & 31)];
        if (gain) v *= gain[k0 + kk];
        scr[kk * 33 + (lane & 31)] = v;
    }
    asm volatile("s_waitcnt lgkmcnt(0)" ::: "memory");
    const int c = lane & 7;
#pragma unroll
    for (int j = 0; j < 4; ++j) {
        const int n = (lane >> 3) + 8 * j; const LAS float* s = scr + (8 * c) * 33 + n;
        u32x4 o; o.x = cvt_pk_bf16(s[0 * 33], s[1 * 33]); o.y = cvt_pk_bf16(s[2 * 33], s[3 * 33]); o.z = cvt_pk_bf16(s[4 * 33], s[5 * 33]); o.w = cvt_pk_bf16(s[6 * 33], s[7 * 33]);
        *(u32x4*)(WT + (size_t)(dst_row0 + n) * K + k0 + 8 * c) = o;
    }
    asm volatile("s_waitcnt lgkmcnt(0)" ::: "memory");
}

#define XB_TMO      128
#define XB_XCNT(j)  (256  + 64 * (j))
#define XB_XSUB(j)  (1280 + 64 * (j))
#define XB_XGEN(j)  (2304 + 64 * (j))
#define XB_TOP      3328
#define XB_TOPGEN   3392
#define XCD_BAR_WORDS 3456
#define XB_SPIN_CAP (1u << 18)

__device__ __forceinline__ unsigned xb_ld(unsigned* p)              { return __hip_atomic_load(p, __ATOMIC_RELAXED, __HIP_MEMORY_SCOPE_AGENT); }
__device__ __forceinline__ unsigned xb_add(unsigned* p, unsigned v) { return __hip_atomic_fetch_add(p, v, __ATOMIC_RELAXED, __HIP_MEMORY_SCOPE_AGENT); }
__device__ __forceinline__ unsigned xb_xcc_id() { return (unsigned)__builtin_amdgcn_s_getreg((3 << 11) | 20) & 0xFu; }
#define XB_SPIN(cond, bar) do { unsigned _sp = 0; while (cond) { __builtin_amdgcn_s_sleep(1); \
    if ((++_sp & 255u) == 0u) { if (xb_ld(&(bar)[XB_TMO])) break; if (_sp > XB_SPIN_CAP) { atomicAdd(&(bar)[XB_TMO], 1u); break; } } } } while (0)

struct XcdBarrier {
    unsigned* bar; unsigned x;
    volatile LAS unsigned* st;
};

__device__ __forceinline__ XcdBarrier xcd_barrier_post(unsigned* bar, volatile LAS unsigned* st) {
    XcdBarrier b; b.bar = bar; b.x = xb_xcc_id(); b.st = st;
    if (threadIdx.x == 0) (void)xb_add(&bar[XB_XCNT(b.x)], 1u);
    return b;
}
__device__ __forceinline__ void xcd_barrier_complete(unsigned* bar, unsigned x, unsigned& nloc, unsigned& nx) {
    const unsigned G = gridDim.x * gridDim.y * gridDim.z;
    unsigned sum, cnt, mine, sp = 0u;
    for (;;) {
        sum = 0u; cnt = 0u; mine = 0u;
#pragma unroll
        for (unsigned j = 0; j < 16; ++j) { const unsigned c = xb_ld(&bar[XB_XCNT(j)]); sum += c; cnt += (c > 0u) ? 1u : 0u; mine = (j == x) ? c : mine; }
        if (sum == G) break;
        __builtin_amdgcn_s_sleep(1);
        if ((++sp & 255u) == 0u) { if (xb_ld(&bar[XB_TMO])) break; if (sp > XB_SPIN_CAP) { atomicAdd(&bar[XB_TMO], 1u); break; } }
    }
    nloc = mine > 0u ? mine : 1u; nx = cnt > 0u ? cnt : 1u;
}

__device__ __forceinline__ void xcd_barrier(const XcdBarrier& b) {
    asm volatile("s_waitcnt vmcnt(0)" ::: "memory");
    __syncthreads();
    if (threadIdx.x == 0) {
        unsigned* bar = b.bar;
        __builtin_amdgcn_s_waitcnt(0);
        unsigned nloc = b.st[0], nx = b.st[1];
        if (nloc == 0u) { xcd_barrier_complete(bar, b.x, nloc, nx); b.st[0] = nloc; b.st[1] = nx; }
        const unsigned old = xb_add(&bar[XB_XSUB(b.x)], 1u);
        const unsigned gen = old / nloc;
        if (old + 1u == (gen + 1u) * nloc) {
            __builtin_amdgcn_fence(__ATOMIC_RELEASE, "agent");
            asm volatile("s_waitcnt vmcnt(0)" ::: "memory");
            const unsigned og = xb_add(&bar[XB_TOP], 1u);
            const unsigned tg = og / nx;
            if (og + 1u == (tg + 1u) * nx) xb_add(&bar[XB_TOPGEN], 1u);
            else XB_SPIN(xb_ld(&bar[XB_TOPGEN]) == tg, bar);
            __builtin_amdgcn_fence(__ATOMIC_ACQUIRE, "agent");
            xb_add(&bar[XB_XGEN(b.x)], 1u);
            asm volatile("s_waitcnt vmcnt(0)" ::: "memory");
        } else {
            XB_SPIN(xb_ld(&bar[XB_XGEN(b.x)]) == gen, bar);
            __builtin_amdgcn_fence(__ATOMIC_ACQUIRE, "agent");
            asm volatile("s_waitcnt vmcnt(0)" ::: "memory");
        }
    }
    __syncthreads();
}

struct Args {
    const float* in[19]; float* out; unsigned char* ws;
};

__global__ void __launch_bounds__(NWAVES * 64) mk_fwd(Args a) {
    extern __shared__ __attribute__((aligned(16))) unsigned char lds_raw[];
    LAS unsigned char* lds = (LAS unsigned char*)lds_raw;
    cg::grid_group grid = cg::this_grid();
    const int tid = threadIdx.x, lane = tid & 63, wave = __builtin_amdgcn_readfirstlane(tid >> 6);
    const int G = gridDim.x, bx = blockIdx.x;
    const int gw = bx * NWAVES + wave, NGW = G * NWAVES;
    unsigned char* ws = a.ws;
    const float* x = a.in[0];
    const float *g_ffn1 = a.in[1], *w1g = a.in[2], *w1u = a.in[3], *w1d = a.in[4], *g_mix = a.in[5], *w_in = a.in[6], *g_q = a.in[7], *w_uq = a.in[8], *g_kv = a.in[9], *w_ukv = a.in[10],
                *g_mo = a.in[11], *g_do = a.in[12], *w_out = a.in[13], *g_ffn2 = a.in[14], *w2g = a.in[15], *w2u = a.in[16], *w2d = a.in[17], *g_fin = a.in[18];
    float* X = a.out;
    bf16_t *W1GU = (bf16_t*)(ws + WS_W1GU), *W1D = (bf16_t*)(ws + WS_W1D), *W2GU = (bf16_t*)(ws + WS_W2GU), *W2D = (bf16_t*)(ws + WS_W2D), *WIN = (bf16_t*)(ws + WS_WIN),
           *WUQ = (bf16_t*)(ws + WS_WUQ), *WUKV = (bf16_t*)(ws + WS_WUKV), *WOUT = (bf16_t*)(ws + WS_WOUT);
    float *COSM = (float*)(ws + WS_ROPE), *SINM = COSM + 2048 * 16, *COSP = SINM + 2048 * 16, *SINP = COSP + 2048 * 8;
    float *SS0 = (float*)(ws + WS_SS0), *SS1 = (float*)(ws + WS_SS1), *SS2 = (float*)(ws + WS_SS2), *SS3 = (float*)(ws + WS_SS3), *SSQ = (float*)(ws + WS_SSQ), *SSKV = (float*)(ws + WS_SSKV);
    bf16_t *XB = (bf16_t*)(ws + WS_XB), *KVM = (bf16_t*)a.out, *HB = (bf16_t*)(ws + WS_H), *OD = (bf16_t*)(ws + WS_OD0), *OMIX = (bf16_t*)(ws + WS_OMIX);
    float* LSE = (float*)(ws + WS_LSE);
    bf16_t *QD = (bf16_t*)(ws + WS_QD), *KD = (bf16_t*)(ws + WS_KD), *VD = (bf16_t*)(ws + WS_VD), *CQ = (bf16_t*)(ws + WS_CQ), *CKV = (bf16_t*)(ws + WS_CKV), *KR = (bf16_t*)(ws + WS_KR), *QM = (bf16_t*)(ws + WS_QM);

    volatile LAS unsigned* xb_st = (volatile LAS unsigned*)(lds + DIL_LDS);
    if (tid < 2) xb_st[tid] = 0u;
    unsigned* xb_words = (unsigned*)(ws + WS_BAR);
    unsigned* pan_cnt = xb_words + 4096;
    if (bx == 0) for (int i = tid; i < 4096 + 256 * 64; i += NWAVES * 64) xb_words[i] = 0u;
    {
        LAS float* scr = (LAS float*)(lds + wave * 16384);
        constexpr int I_GU = 16 * 88, I_D = 44 * 32, I_IN = 16 * 69, I_UQ = 6 * 24, I_UKV = 4 * 32, I_OUT = 16 * 32;
        constexpr int NITEMS = 2 * (2 * I_GU + I_D) + I_IN + I_UQ + I_UKV + I_OUT;
        for (int it = gw; it < NITEMS; it += NGW) {
            int r = it;
            if (r < 2 * (2 * I_GU + I_D)) {
                const int f = r / (2 * I_GU + I_D); r -= f * (2 * I_GU + I_D);
                const float* gg = f ? g_ffn2 : g_ffn1; const float* wg = f ? w2g : w1g; const float* wu = f ? w2u : w1u; const float* wd = f ? w2d : w1d;
                bf16_t* GU = f ? W2GU : W1GU; bf16_t* DD = f ? W2D : W1D;
                if (r < 2 * I_GU) { const int s = r >= I_GU; const int q = s ? r - I_GU : r; const int kb_ = q / 88, nb = q % 88, n0 = 32 * nb;
                    tr_block(s ? wu : wg, 1024, FF, gg, GU, 64 * kb_, n0, 256 * (n0 >> 7) + 128 * s + (n0 & 127), scr, lane); }
                else { r -= 2 * I_GU; const int kb_ = r / 32, nb = r % 32; tr_block(wd, FF, 1024, nullptr, DD, 64 * kb_, 32 * nb, 32 * nb, scr, lane); }
                continue;
            }
            r -= 2 * (2 * I_GU + I_D);
            if (r < I_IN) { const int kb_ = r / 69, nb = r % 69, n0 = 32 * nb;
                int dst;
                if (n0 < 384) dst = 1536 + n0; else if (n0 < 640) dst = 2048 + (n0 - 384); else if (n0 < 672) dst = 1920 + (n0 - 640);
                else if (n0 < 1184) dst = n0 - 672; else if (n0 < 1696) dst = 512 + (n0 - 1184); else dst = 1024 + (n0 - 1696);
                tr_block(w_in, 1024, 2208, g_mix, WIN, 64 * kb_, n0, dst, scr, lane); continue; }
            r -= I_IN;
            if (r < I_UQ) { const int kb_ = r / 24, nb = r % 24; tr_block(w_uq, 384, 768, g_q, WUQ, 64 * kb_, 32 * nb, 32 * nb, scr, lane); continue; }
            r -= I_UQ;
            if (r < I_UKV) { const int kb_ = r / 32, nb = r % 32; tr_block(w_ukv, 256, 1024, g_kv, WUKV, 64 * kb_, 32 * nb, 32 * nb, scr, lane); continue; }
            r -= I_UKV;
            { const int kb_ = r / 32, nb = r % 32, k0 = 64 * kb_; tr_block(w_out, 1024, 1024, k0 < 512 ? g_mo : g_do - 512, WOUT, k0, 32 * nb, 32 * nb, scr, lane); }
        }
        for (int i = bx * 512 + tid; i < 96 * 1024 / 8; i += G * 512) *(u32x4*)(WIN + (size_t)1952 * 1024 + (size_t)i * 8) = (u32x4){0u, 0u, 0u, 0u};
        for (int i = bx * 512 + tid; i < 2048 * 24; i += G * 512) {
            int pos, fi; float invf; float *cdst, *sdst;
            if (i < 2048 * 16) { pos = i >> 4; fi = i & 15; invf = exp2f(-(float)fi * (1.0f / 16.0f) * 18.931568569324174f); cdst = COSM + i; sdst = SINM + i; }
            else { const int k = i - 2048 * 16; pos = k >> 3; fi = k & 7; invf = exp2f(-(float)fi * (1.0f / 8.0f) * 18.931568569324174f); cdst = COSP + k; sdst = SINP + k; }
            const float ang = (float)pos * invf;
            const double rev = (double)ang * 0.15915494309189535; const float fr_ = (float)(rev - floor(rev));
            *cdst = __builtin_amdgcn_cosf(fr_); *sdst = __builtin_amdgcn_sinf(fr_);
        }
        for (int row0 = gw * 4; row0 < NT; row0 += NGW * 4) {
            f32x4 v[4][4];
#pragma unroll
            for (int q = 0; q < 4; ++q) { const f32x4* xr = (const f32x4*)(x + (size_t)(row0 + q) * DM) + lane;
#pragma unroll
                for (int j = 0; j < 4; ++j) v[q][j] = xr[64 * j]; }
#pragma unroll
            for (int q = 0; q < 4; ++q) {
                float sacc = 0.f; unsigned long long* o8 = (unsigned long long*)(XB + (size_t)(row0 + q) * DM) + lane;
#pragma unroll
                for (int j = 0; j < 4; ++j) { sacc += sq4(v[q][j]); o8[64 * j] = (unsigned long long)cvt_pk_bf16(v[q][j][0], v[q][j][1]) | ((unsigned long long)cvt_pk_bf16(v[q][j][2], v[q][j][3]) << 32); }
                sacc = wave_sum(sacc);
                if (lane < 16) SS0[(size_t)(row0 + q) * 16 + lane] = lane == 0 ? sacc : 0.f;
            }
        }
    }
    grid.sync();
    const XcdBarrier xb = xcd_barrier_post(xb_words, xb_st);
    {
        pg8::Gemm g{XB, W1GU, NT, 2 * FF, DM}; pg8::StaticOrder S; S.init(NT, 2 * FF, G, bx);
        EpiGateUp E{HB, SS0};
        pg8::gemm_phase<EpiGateUp, pg8::StaticOrder, true, true>(lds, g, S, E);
    }
    xcd_barrier(xb);
    {
        pg8::Gemm g{HB, W1D, NT, DM, FF}; pg8::StaticOrder S; S.init(NT, DM, G, bx);
        EpiResid E{XB, SS1, 0.5f};
        pg8::gemm_phase<EpiResid, pg8::StaticOrder, true, true>(lds, g, S, E);
    }
    xcd_barrier(xb);
    {
        pg8::Gemm g{XB, WIN, NT, 2304, DM}; pg8::StaticOrder S; S.init(NT, 2304, G, bx);
        EpiInProj E{SS1, QD, KD, VD, CQ, CKV, KR, SSQ, SSKV, COSM, SINM, COSP, SINP};
        pg8::gemm_phase<EpiInProj, pg8::StaticOrder, true, true>(lds, g, S, E);
    }
    xcd_barrier(xb);
    {
        { pg8::Gemm g{CQ, WUQ, NT, 768, 384}; pg8::StaticOrder S; S.init(NT, 768, G, bx); EpiQ E{SSQ, QM, COSM, SINM};
          pg8::gemm_phase<EpiQ, pg8::StaticOrder, true, true>(lds, g, S, E); }
        { pg8::Gemm g{CKV, WUKV, NT, 1024, 256}; pg8::StaticOrder S; S.init(NT, 1024, G, bx); EpiKV E{SSKV, KVM};
          pg8::gemm_phase<EpiKV, pg8::StaticOrder, true, true>(lds, g, S, E); }
        __syncthreads();
        AttnIO io{QM, KVM, KR, OMIX, QD, KD, VD, OD, LSE};
        dil_phase(lds, io, bx, G);
    }
    xcd_barrier(xb);
    {
        AttnIO io{QM, KVM, KR, OMIX, QD, KD, VD, OD, LSE};
        for (int u = bx; u < 256 * 8; u += G) attn_unit<false>(lds, io, u);
    }
    xcd_barrier(xb);
    for (int row = gw; row < NT; row += NGW) {
        {
            u32x4* p = (u32x4*)(OMIX + (size_t)row * 1024 + lane * 8); const u32x4 w = *p; float v[8];
#pragma unroll
            for (int e = 0; e < 4; ++e) { v[2 * e] = __uint_as_float(w[e] << 16); v[2 * e + 1] = __uint_as_float(w[e] & 0xffff0000u); }
            float s = 0.f;
#pragma unroll
            for (int e = 0; e < 8; ++e) s += v[e] * v[e];
            const float rs = rsqrtf(wave_sum(s) * (1.0f / 512.0f) + EPS);
            u32x4 o; o.x = cvt_pk_bf16(v[0] * rs, v[1] * rs); o.y = cvt_pk_bf16(v[2] * rs, v[3] * rs); o.z = cvt_pk_bf16(v[4] * rs, v[5] * rs); o.w = cvt_pk_bf16(v[6] * rs, v[7] * rs);
            *p = o;
        }
        {
            const int hd = lane >> 3;
            const float l0 = LSE[((size_t)0 * NT + row) * 8 + hd], l1 = LSE[((size_t)1 * NT + row) * 8 + hd], l2 = LSE[((size_t)2 * NT + row) * 8 + hd];
            const float mx = fmaxf(l0, fmaxf(l1, l2));
            float w0 = fast_exp2(l0 - mx), w1 = fast_exp2(l1 - mx), w2 = fast_exp2(l2 - mx);
            const float inv = 1.0f / (w0 + w1 + w2); w0 *= inv; w1 *= inv; w2 *= inv;
            float v[8];
#pragma unroll
            for (int e = 0; e < 8; ++e) v[e] = 0.f;
#pragma unroll
            for (int n = 0; n < 3; ++n) {
                const u32x4 w = *(const u32x4*)(OD + (size_t)n * NT * 512 + (size_t)row * 512 + lane * 8); const float wn = n == 0 ? w0 : (n == 1 ? w1 : w2);
#pragma unroll
                for (int e = 0; e < 4; ++e) { v[2 * e] += wn * __uint_as_float(w[e] << 16); v[2 * e + 1] += wn * __uint_as_float(w[e] & 0xffff0000u); }
            }
            float s = 0.f;
#pragma unroll
            for (int e = 0; e < 8; ++e) s += v[e] * v[e];
            const float rs = rsqrtf(wave_sum(s) * (1.0f / 512.0f) + EPS);
            u32x4 o; o.x = cvt_pk_bf16(v[0] * rs, v[1] * rs); o.y = cvt_pk_bf16(v[2] * rs, v[3] * rs); o.z = cvt_pk_bf16(v[4] * rs, v[5] * rs); o.w = cvt_pk_bf16(v[6] * rs, v[7] * rs);
            *(u32x4*)(OMIX + (size_t)row * 1024 + 512 + lane * 8) = o;
        }
    }
    xcd_barrier(xb);
    {
        pg8::Gemm g{OMIX, WOUT, NT, DM, DM}; pg8::StaticOrder S; S.init(NT, DM, G, bx);
        EpiResid E{XB, SS2, 1.0f};
        pg8::gemm_phase<EpiResid, pg8::StaticOrder, true, true>(lds, g, S, E);
    }
    xcd_barrier(xb);
    {
        pg8::Gemm g{XB, W2GU, NT, 2 * FF, DM}; pg8::StaticOrder S; S.init(NT, 2 * FF, G, bx);
        EpiGateUp E{HB, SS2};
        pg8::gemm_phase<EpiGateUp, pg8::StaticOrder, true, true>(lds, g, S, E);
    }
    xcd_barrier(xb);
    {
        pg8::Gemm g{HB, W2D, NT, DM, FF}; pg8::StaticOrder S; S.init(NT, DM, G, bx);
        EpiFinal E{XB, X, SS3, pan_cnt, g_fin, (LAS float*)(lds + 131072)};
        pg8::gemm_phase<EpiFinal, pg8::StaticOrder, true, true>(lds, g, S, E);
    }
}

extern "C" void kernel_launch(void* const* d_in, const int* in_sizes, int n_in, void* d_out, int out_size, void* d_ws, size_t ws_size, hipStream_t stream) {
    constexpr int LDS_BYTES = 147456; static_assert(DIL_LDS + 64 <= LDS_BYTES, "LDS map");
    static int grid = 0;
    if (grid == 0) {
        if (n_in != 19 || in_sizes[0] != NT * DM || out_size != NT * DM || ws_size < WS_END) {
            fprintf(stderr, "kernel_launch: unexpected problem geometry (n_in %d, in0 %d, out %d, ws %zu); nothing launched\n", n_in, n_in > 0 ? in_sizes[0] : -1, out_size, ws_size); grid = -1; return; }
        int dev = 0, cus = 0, per_cu = 0;
        hipGetDevice(&dev); hipDeviceGetAttribute(&cus, hipDeviceAttributeMultiprocessorCount, dev);
        if (hipFuncSetAttribute((const void*)mk_fwd, hipFuncAttributeMaxDynamicSharedMemorySize, LDS_BYTES) != hipSuccess) { fprintf(stderr, "kernel_launch: hipFuncSetAttribute failed\n"); grid = -1; return; }
        if (hipOccupancyMaxActiveBlocksPerMultiprocessor(&per_cu, (const void*)mk_fwd, NWAVES * 64, LDS_BYTES) != hipSuccess || per_cu < 1) { fprintf(stderr, "kernel_launch: occupancy query says %d blocks per CU\n", per_cu); per_cu = 1; }
        (void)hipGetLastError();
        grid = cus;
    }
    if (grid < 0) return;
    Args a{};
    for (int i = 0; i < 19; ++i) a.in[i] = (const float*)d_in[i];
    a.out = (float*)d_out; a.ws = (unsigned char*)d_ws;
    void* args[] = {&a};
    hipError_t e = hipLaunchCooperativeKernel((const void*)mk_fwd, dim3(grid), dim3(NWAVES * 64), args, LDS_BYTES, stream);
    if (e != hipSuccess) fprintf(stderr, "kernel_launch: cooperative launch failed: %s (grid %d)\n", hipGetErrorString(e), grid);
}
```

```cpp
#include <hip/hip_runtime.h>
#include <hip/hip_cooperative_groups.h>
#include <cmath>
#include <cstdio>
#include <cstdint>
namespace pg8 {
#define PG8_LAS __attribute__((address_space(3)))
typedef unsigned short bf16_t;
typedef short bf16x8 __attribute__((ext_vector_type(8)));
typedef float f32x4 __attribute__((ext_vector_type(4)));
typedef unsigned u32x4 __attribute__((ext_vector_type(4)));
constexpr int BM = 256, BK = 64, HALF = 128, HTB = HALF * BK * 2  , STAGE_BYTES = 8 * HTB, NXCD = 8, WGM = 8;

__host__ __device__ __forceinline__ int lds_byte(int r, int c) { const int st = (r >> 4) * 2 + (c >> 5), rr = r & 15, cc = c & 31, ob = rr * 64 + cc * 2; return st * 1024 + (ob ^ (((ob >> 9) & 1) << 5)); }
__host__ __device__ __forceinline__ void stage_rc(int b, int& R, int& C) { const int st = b / 1024, sb = b % 1024, swz = sb ^ (((sb >> 9) & 1) << 5); R = (st >> 1) * 16 + swz / 64; C = (st & 1) * 32 + (swz % 64) / 2; }
__host__ __device__ __forceinline__ int perm32(int rho) { const int n = rho >> 4, i = rho & 15; return 8 * (i >> 2) + 4 * n + (i & 3); }

struct Unit { int pm, pn; };
struct Gemm { const bf16_t* A; const bf16_t* Bt; int M, N, K; };

struct StaticOrder {
    int nM, nN, nwg, G, c;
    __host__ __device__ void init(int M, int N, int G_, int c_) { nM = M / BM; nN = N / BM; nwg = nM * nN; G = G_; c = c_; }
    __host__ __device__ bool next(int i, Unit& u) const {
        const long L = (long)i * G + c; if (L >= nwg) return false;
        int wgid = (int)L; { const int q = nwg / NXCD, r = nwg % NXCD, xcd = wgid % NXCD, off = wgid / NXCD; wgid = (xcd < r ? xcd * (q + 1) : r * (q + 1) + (xcd - r) * q) + off; }
        const int nig = WGM * nN, gid = wgid / nig, fm = gid * WGM, gsz = (nM - fm) < WGM ? (nM - fm) : WGM;
        u.pm = fm + ((wgid % nig) % gsz); u.pn = (wgid % nig) / gsz; return true;
    }
    __device__ __forceinline__ void a_ready(const Unit&) const {}
    __device__ __forceinline__ void done(const Unit&) const {}
};

__device__ __forceinline__ unsigned cvt_pk_bf16(float lo, float hi) { unsigned r; asm volatile("v_cvt_pk_bf16_f32 %0, %1, %2" : "=v"(r) : "v"(lo), "v"(hi)); return r; }

template <class Epi, class Sched, bool ALIGN_EPI = false, bool SP2 = false>
__device__ __forceinline__ void gemm_phase(PG8_LAS unsigned char* lds, const Gemm g, const Sched& S, const Epi& E) {
    int tid_ = threadIdx.x; asm volatile("" : "+v"(tid_));
    const int tid = tid_, wid = __builtin_amdgcn_readfirstlane(tid >> 6), lane = tid & 63, wr = wid >> 2, wc = wid & 3, fr = lane & 15, fq = lane >> 4;
    const int K = g.K, nt = K / BK;
    unsigned voffA[2], voffB[2];
#pragma unroll
    for (int i = 0; i < 2; ++i) { int R, C; stage_rc(tid * 16 + i * 8192, R, C); const int Rb = Epi::PERM ? ((R & ~31) + perm32(R & 31)) : R;
        voffA[i] = (unsigned)(R * K + C) * 2u; voffB[i] = (unsigned)(Rb * K + C) * 2u; }
    const size_t kstep = (size_t)(BK * 2);
    const size_t hstep = (size_t)HALF * K * 2;
    const size_t tstep = 2 * hstep;
    const unsigned ldsw = (unsigned)wid * 1024u;
    const int aoff = lds_byte(wr * 64 + fr, fq * 8), boff = lds_byte(wc * 32 + fr, fq * 8);
#define PG8_SA(b, h) (((b) * 2 + (h)) * HTB)
#define PG8_SB(b, h) ((4 + (b) * 2 + (h)) * HTB)
#define PG8_STAGE(bufoff, gbase, voff) do { _Pragma("unroll") for (int _i = 0; _i < 2; ++_i) \
        __builtin_amdgcn_global_load_lds((const unsigned*)((const char*)(gbase) + (voff)[_i]), (PG8_LAS unsigned*)(lds + (bufoff) + ldsw + _i * 8192), 16, 0, 0); } while (0)
#define PG8_LDA(dst, b, h) do { _Pragma("unroll") for (int m = 0; m < 4; ++m) _Pragma("unroll") for (int k = 0; k < 2; ++k) dst[m][k] = *(const PG8_LAS bf16x8*)(lds + PG8_SA(b, h) + aoff + m * 2048 + k * 1024); } while (0)
#define PG8_LDB(dst, b, h) do { _Pragma("unroll") for (int n = 0; n < 2; ++n) _Pragma("unroll") for (int k = 0; k < 2; ++k) dst[n][k] = *(const PG8_LAS bf16x8*)(lds + PG8_SB(b, h) + boff + n * 2048 + k * 1024); } while (0)
#define PG8_MMA(ai, bj, At, Bt) do { __builtin_amdgcn_s_setprio(1); _Pragma("unroll") for (int m = 0; m < 4; ++m) _Pragma("unroll") for (int n = 0; n < 2; ++n) _Pragma("unroll") for (int k = 0; k < 2; ++k) \
        acc[ai][bj][m][n] = __builtin_amdgcn_mfma_f32_16x16x32_bf16(Bt[n][k], At[m][k], acc[ai][bj][m][n], 0, 0, 0); __builtin_amdgcn_s_setprio(0); } while (0)
#define PG8_WAIT_V(n) asm volatile("s_waitcnt vmcnt(" #n ")" ::: "memory")
#define PG8_WAIT_L(n) asm volatile("s_waitcnt lgkmcnt(" #n ")" ::: "memory")
#define PG8_BAR __builtin_amdgcn_s_barrier()
#define PG8_SCHED __builtin_amdgcn_sched_barrier(0)
    Unit cur, nxt; int ui = 0;
    if (!S.next(0, cur)) return;
    f32x4 acc[2][2][4][2];
#pragma unroll
    for (int a = 0; a < 2; ++a)
#pragma unroll
        for (int b = 0; b < 2; ++b)
#pragma unroll
            for (int m = 0; m < 4; ++m)
#pragma unroll
                for (int n = 0; n < 2; ++n) acc[a][b][m][n] = (f32x4){0.f, 0.f, 0.f, 0.f};
    bf16x8 At[4][2], B0[2][2], B1[2][2];
    const char* cA = (const char*)g.A + (size_t)cur.pm * tstep; const char* cB = (const char*)g.Bt + (size_t)cur.pn * tstep;
    S.a_ready(cur);
    if constexpr (SP2) {
        PG8_STAGE(PG8_SB(0, 0), cB, voffB); PG8_STAGE(PG8_SB(0, 1), cB + hstep, voffB); PG8_STAGE(PG8_SA(0, 0), cA, voffA); PG8_STAGE(PG8_SA(0, 1), cA + hstep, voffA);
        if (wr == 1) PG8_BAR;
        PG8_WAIT_V(2); PG8_BAR;
        PG8_STAGE(PG8_SB(1, 0), cB + kstep, voffB); PG8_STAGE(PG8_SA(1, 0), cA + kstep, voffA); PG8_STAGE(PG8_SB(1, 1), cB + hstep + kstep, voffB);
        PG8_WAIT_V(6); PG8_BAR;
    } else {
        PG8_STAGE(PG8_SB(0, 0), cB, voffB); PG8_STAGE(PG8_SA(0, 0), cA, voffA); PG8_STAGE(PG8_SB(0, 1), cB + hstep, voffB); PG8_STAGE(PG8_SA(0, 1), cA + hstep, voffA);
        if (wr == 1) PG8_BAR;
        PG8_WAIT_V(4); PG8_BAR;
        PG8_STAGE(PG8_SB(1, 0), cB + kstep, voffB); PG8_STAGE(PG8_SA(1, 0), cA + kstep, voffA); PG8_STAGE(PG8_SB(1, 1), cB + hstep + kstep, voffB);
        PG8_WAIT_V(6); PG8_BAR;
    }
    for (;;) {
        const bool has_next = S.next(ui + 1, nxt);
        const char* nA = has_next ? (const char*)g.A + (size_t)nxt.pm * tstep : cA; const char* nB = has_next ? (const char*)g.Bt + (size_t)nxt.pn * tstep : cB;
        for (int t = 0; t < nt; t += 2) {
            const bool last = (t == nt - 2);
            const char* a1 = cA + (size_t)(t + 1) * kstep;
            const char* a2 = last ? nA : cA + (size_t)(t + 2) * kstep; const char* b2 = last ? nB : cB + (size_t)(t + 2) * kstep;
            const char* a3 = a2 + kstep; const char* b3 = b2 + kstep;
            if (last && has_next) S.a_ready(nxt);
            if constexpr (SP2) {
            PG8_LDB(B0, 0, 0); PG8_LDB(B1, 0, 1); PG8_SCHED; PG8_LDA(At, 0, 0); PG8_STAGE(PG8_SA(1, 1), a1 + hstep, voffA);
            PG8_WAIT_V(8); PG8_WAIT_L(0); PG8_BAR; PG8_MMA(0, 0, At, B0); PG8_MMA(0, 1, At, B1); PG8_BAR; PG8_SCHED;
            PG8_LDA(At, 0, 1); PG8_STAGE(PG8_SB(0, 0), b2, voffB); PG8_STAGE(PG8_SB(0, 1), b2 + hstep, voffB); PG8_STAGE(PG8_SA(0, 0), a2, voffA);
            PG8_WAIT_V(8); PG8_WAIT_L(0); PG8_BAR; PG8_MMA(1, 0, At, B0); PG8_MMA(1, 1, At, B1); PG8_BAR; PG8_SCHED;
            PG8_LDB(B0, 1, 0); PG8_LDB(B1, 1, 1); PG8_SCHED; PG8_LDA(At, 1, 0); PG8_STAGE(PG8_SA(0, 1), a2 + hstep, voffA);
            PG8_WAIT_V(8); PG8_WAIT_L(0); PG8_BAR; PG8_MMA(0, 0, At, B0); PG8_MMA(0, 1, At, B1); PG8_BAR; PG8_SCHED;
            PG8_LDA(At, 1, 1); PG8_STAGE(PG8_SB(1, 0), b3, voffB); PG8_STAGE(PG8_SB(1, 1), b3 + hstep, voffB); PG8_STAGE(PG8_SA(1, 0), a3, voffA);
            PG8_WAIT_V(8); PG8_WAIT_L(0); PG8_BAR; PG8_MMA(1, 0, At, B0); PG8_MMA(1, 1, At, B1); PG8_BAR; PG8_SCHED;
            } else {
            PG8_LDB(B0, 0, 0); PG8_SCHED; PG8_LDA(At, 0, 0); PG8_STAGE(PG8_SA(1, 1), a1 + hstep, voffA);
            PG8_WAIT_L(8); PG8_BAR; PG8_WAIT_L(0); PG8_MMA(0, 0, At, B0); PG8_BAR; PG8_SCHED;
            PG8_LDB(B1, 0, 1); PG8_STAGE(PG8_SB(0, 0), b2, voffB);
            PG8_BAR; PG8_WAIT_L(0); PG8_MMA(0, 1, At, B1); PG8_BAR;
            PG8_LDA(At, 0, 1); PG8_STAGE(PG8_SA(0, 0), a2, voffA);
            PG8_BAR; PG8_WAIT_L(0); PG8_MMA(1, 0, At, B0); PG8_BAR; PG8_SCHED;
            PG8_STAGE(PG8_SB(0, 1), b2 + hstep, voffB);
            PG8_WAIT_V(6); PG8_BAR; PG8_MMA(1, 1, At, B1); PG8_BAR;
            PG8_LDB(B0, 1, 0); PG8_SCHED; PG8_LDA(At, 1, 0); PG8_STAGE(PG8_SA(0, 1), a2 + hstep, voffA);
            PG8_WAIT_L(8); PG8_BAR; PG8_WAIT_L(0); PG8_MMA(0, 0, At, B0); PG8_BAR; PG8_SCHED;
            PG8_LDB(B1, 1, 1); PG8_STAGE(PG8_SB(1, 0), b3, voffB);
            PG8_BAR; PG8_WAIT_L(0); PG8_MMA(0, 1, At, B1); PG8_BAR;
            PG8_LDA(At, 1, 1); PG8_STAGE(PG8_SA(1, 0), a3, voffA);
            PG8_BAR; PG8_WAIT_L(0); PG8_MMA(1, 0, At, B0); PG8_BAR; PG8_SCHED;
            PG8_STAGE(PG8_SB(1, 1), b3 + hstep, voffB);
            PG8_WAIT_V(6); PG8_BAR; PG8_MMA(1, 1, At, B1); PG8_BAR;
            }
        }
        if constexpr (ALIGN_EPI) { if (wr == 0) PG8_BAR; }
        if constexpr (!Epi::AFTER_DRAIN) { E(acc, cur, wr, wc, fr, fq); S.done(cur); }
        if (!has_next) break;
#pragma unroll
        for (int a = 0; a < 2; ++a)
#pragma unroll
            for (int b = 0; b < 2; ++b)
#pragma unroll
                for (int m = 0; m < 4; ++m)
#pragma unroll
                    for (int n = 0; n < 2; ++n) acc[a][b][m][n] = (f32x4){0.f, 0.f, 0.f, 0.f};
        cur = nxt; cA = nA; cB = nB; ++ui;
        if constexpr (ALIGN_EPI) { if (wr == 1) PG8_BAR; }
    }
    PG8_WAIT_V(0);
    if constexpr (!ALIGN_EPI) { if (wr == 0) PG8_BAR; }
    PG8_BAR;
    if constexpr (Epi::AFTER_DRAIN) { E.fused(acc, cur, wr, wc, fr, fq, lds, wid, lane); S.done(cur); }
#undef PG8_SA
#undef PG8_SB
#undef PG8_STAGE
#undef PG8_LDA
#undef PG8_LDB
#undef PG8_MMA
#undef PG8_WAIT_V
#undef PG8_WAIT_L
#undef PG8_BAR
#undef PG8_SCHED
}
}

namespace cg = cooperative_groups;

#define LAS __attribute__((address_space(3)))
typedef unsigned short bf16_t;
typedef float f32x4 __attribute__((ext_vector_type(4)));
typedef float f32x16 __attribute__((ext_vector_type(16)));
typedef short bf16x8 __attribute__((ext_vector_type(8)));
typedef short s16x4 __attribute__((ext_vector_type(4)));
typedef unsigned u32x2 __attribute__((ext_vector_type(2)));
typedef unsigned u32x4 __attribute__((ext_vector_type(4)));
using pg8::Unit;
typedef float f32x2_t __attribute__((ext_vector_type(2))); typedef __bf16 bf16x2_t __attribute__((ext_vector_type(2)));
__device__ __forceinline__ unsigned cvt_pk_bf16(float lo, float hi) { const f32x2_t v = {lo, hi}; const bf16x2_t b = __builtin_convertvector(v, bf16x2_t); return __builtin_bit_cast(unsigned, b); }

constexpr int NT = 65536, SEQ = 2048, DM = 1024, FF = 2816, NWAVES = 8;
constexpr float EPS = 1e-6f, LOG2E = 1.4426950408889634f;
constexpr float QSCALE_D = 0.125f * LOG2E;
constexpr float QSCALE_M = 0.10206207261596577f * LOG2E;

constexpr size_t MiB = 1u << 20;
constexpr size_t WS_W1GU = 0, WS_W1D = 11 * MiB, WS_W2GU = 17 * MiB, WS_W2D = 28 * MiB, WS_WIN = 34 * MiB, WS_WUQ = 39 * MiB, WS_WUKV = 40 * MiB, WS_WOUT = 41 * MiB;
constexpr size_t WS_ROPE = 43 * MiB;
constexpr size_t WS_SS0 = 44 * MiB, WS_SS1 = 48 * MiB, WS_SS2 = 52 * MiB, WS_SS3 = 56 * MiB, WS_SSQ = 60 * MiB, WS_SSKV = 62 * MiB;
constexpr size_t WS_BAR = 63 * MiB;
constexpr size_t WS_XB = 64 * MiB;
constexpr size_t WS_KVM = WS_XB;
constexpr size_t WS_H = 192 * MiB;
constexpr size_t WS_OD0 = 192 * MiB, WS_OD1 = 256 * MiB, WS_OD2 = 320 * MiB, WS_OMIX = 384 * MiB, WS_LSE = 512 * MiB;
constexpr size_t WS_QD = 544 * MiB, WS_KD = 608 * MiB, WS_VD = 672 * MiB, WS_CQ = 736 * MiB, WS_CKV = 784 * MiB, WS_KR = 816 * MiB, WS_QM = 820 * MiB, WS_END = 916 * MiB;

__device__ __forceinline__ float fast_exp2(float x) { return __builtin_amdgcn_exp2f(x); }
__device__ __forceinline__ float fast_rcp(float x) { return __builtin_amdgcn_rcpf(x); }
__device__ __forceinline__ float bf2f(unsigned short b) { return __uint_as_float((unsigned)b << 16); }
__device__ __forceinline__ float sum4(f32x4 a) { return (a[0] + a[1]) + (a[2] + a[3]); }
__device__ __forceinline__ float sq4(f32x4 a) { return (a[0] * a[0] + a[1] * a[1]) + (a[2] * a[2] + a[3] * a[3]); }
__device__ __forceinline__ float rstd_parts16(const float* ss, int row, float invn) {
    const f32x4* p = (const f32x4*)(ss + (size_t)row * 16);
    const float s = (sum4(p[0]) + sum4(p[1])) + (sum4(p[2]) + sum4(p[3]));
    return rsqrtf(s * invn + EPS);
}

#define EPI_RELANE() int fr, fq; { int t_ = threadIdx.x; asm volatile("" : "+v"(t_)); fr = t_ & 15; fq = (t_ >> 4) & 3; }
struct EpiGateUp {
    static constexpr bool PERM = true, AFTER_DRAIN = false;
    bf16_t* H; const float* ss; LAS float* tab;
    __device__ __forceinline__ void operator()(const f32x4 (&acc)[2][2][4][2], const Unit& u, int wr, int wc, int fr_in, int fq_in) const {
        EPI_RELANE();
        int tid = threadIdx.x; asm volatile("" : "+v"(tid));
        if (tid < 256) tab[tid] = rstd_parts16(ss, u.pm * 256 + tid, 1.0f / 1024.0f);
        __syncthreads();
        const int r0 = wr * 64 + fr, col = u.pn * 128 + wc * 32 + 8 * fq;
#pragma unroll
        for (int ai = 0; ai < 2; ++ai)
#pragma unroll
            for (int m = 0; m < 4; ++m) {
                const int r = r0 + ai * 128 + m * 16;
                const float rs = tab[r], nrs = -rs * LOG2E;
                float o[8];
#pragma unroll
                for (int n = 0; n < 2; ++n)
#pragma unroll
                    for (int j = 0; j < 4; ++j) {
                        const float ga = acc[ai][0][m][n][j];
                        o[4 * n + j] = (ga * rs) * fast_rcp(1.0f + fast_exp2(ga * nrs)) * (acc[ai][1][m][n][j] * rs);
                    }
                u32x4 w; w.x = cvt_pk_bf16(o[0], o[1]); w.y = cvt_pk_bf16(o[2], o[3]); w.z = cvt_pk_bf16(o[4], o[5]); w.w = cvt_pk_bf16(o[6], o[7]);
                *(u32x4*)(H + (size_t)(u.pm * 256 + r) * FF + col) = w;
            }
    }
};
struct EpiResid {
    static constexpr bool PERM = false, AFTER_DRAIN = false;
    bf16_t* xb; float* ss; float alpha;
    __device__ __forceinline__ void operator()(const f32x4 (&acc)[2][2][4][2], const Unit& u, int wr, int wc, int fr_in, int fq_in) const {
        EPI_RELANE();
        const int row0 = u.pm * 256 + wr * 64 + fr, col0 = u.pn * 256 + wc * 32 + 4 * fq;
        u32x2 bws[2][4][2][2];
#pragma unroll
        for (int ai = 0; ai < 2; ++ai)
#pragma unroll
            for (int m = 0; m < 4; ++m)
#pragma unroll
                for (int bj = 0; bj < 2; ++bj)
#pragma unroll
                    for (int n = 0; n < 2; ++n) bws[ai][m][bj][n] = *(const u32x2*)(xb + (size_t)(row0 + ai * 128 + m * 16) * DM + col0 + bj * 128 + n * 16);
#pragma unroll
        for (int ai = 0; ai < 2; ++ai)
#pragma unroll
            for (int m = 0; m < 4; ++m) {
                const int row = row0 + ai * 128 + m * 16; float sq = 0.f;
#pragma unroll
                for (int bj = 0; bj < 2; ++bj)
#pragma unroll
                    for (int n = 0; n < 2; ++n) {
                        u32x2* p = (u32x2*)(xb + (size_t)row * DM + col0 + bj * 128 + n * 16);
                        const u32x2 bw = bws[ai][m][bj][n];
                        const f32x4 b = {__uint_as_float(bw.x << 16), __uint_as_float(bw.x & 0xffff0000u), __uint_as_float(bw.y << 16), __uint_as_float(bw.y & 0xffff0000u)};
                        const f32x4 v = b + acc[ai][bj][m][n] * alpha; sq += sq4(v);
                        u32x2 w; w.x = cvt_pk_bf16(v[0], v[1]); w.y = cvt_pk_bf16(v[2], v[3]); *p = w;
                    }
                sq += __shfl_xor(sq, 16); sq += __shfl_xor(sq, 32);
                if (fq == 0) ss[(size_t)row * 16 + u.pn * 4 + wc] = sq;
            }
    }
};
struct EpiFinal {
    static constexpr bool PERM = false, AFTER_DRAIN = false;
    const bf16_t* xb; float* X; float* ss; unsigned* cnt; const float* gfin; LAS float* tab;
    __device__ __forceinline__ void operator()(f32x4 (&acc)[2][2][4][2], const Unit& u, int wr, int wc, int fr_in, int fq_in) const {
        EPI_RELANE();
        int tid = threadIdx.x; asm volatile("" : "+v"(tid));
        const int row0 = u.pm * 256 + wr * 64 + fr, col0 = u.pn * 256 + wc * 32 + 4 * fq;
        u32x2 bws[2][4][2][2];
#pragma unroll
        for (int ai = 0; ai < 2; ++ai)
#pragma unroll
            for (int m = 0; m < 4; ++m)
#pragma unroll
                for (int bj = 0; bj < 2; ++bj)
#pragma unroll
                    for (int n = 0; n < 2; ++n) bws[ai][m][bj][n] = *(const u32x2*)(xb + (size_t)(row0 + ai * 128 + m * 16) * DM + col0 + bj * 128 + n * 16);
#pragma unroll
        for (int ai = 0; ai < 2; ++ai)
#pragma unroll
            for (int m = 0; m < 4; ++m) {
                const int row = row0 + ai * 128 + m * 16; float sq = 0.f;
#pragma unroll
                for (int bj = 0; bj < 2; ++bj)
#pragma unroll
                    for (int n = 0; n < 2; ++n) {
                        const u32x2 bw = bws[ai][m][bj][n];
                        const f32x4 b = {__uint_as_float(bw.x << 16), __uint_as_float(bw.x & 0xffff0000u), __uint_as_float(bw.y << 16), __uint_as_float(bw.y & 0xffff0000u)};
                        const f32x4 v = b + acc[ai][bj][m][n] * 0.5f; acc[ai][bj][m][n] = v; sq += sq4(v);
                    }
                sq += __shfl_xor(sq, 16); sq += __shfl_xor(sq, 32);
                if (fq == 0) ss[(size_t)row * 16 + u.pn * 4 + wc] = sq;
            }
        asm volatile("s_waitcnt vmcnt(0)" ::: "memory");
        __syncthreads();
        if (tid == 0) {
            unsigned* c = cnt + 64 * u.pm;
            __builtin_amdgcn_fence(__ATOMIC_RELEASE, "agent"); asm volatile("s_waitcnt vmcnt(0)" ::: "memory");
            __hip_atomic_fetch_add(c, 1u, __ATOMIC_RELAXED, __HIP_MEMORY_SCOPE_AGENT);
            unsigned sp = 0;
            while (__hip_atomic_load(c, __ATOMIC_RELAXED, __HIP_MEMORY_SCOPE_AGENT) < 4u) { __builtin_amdgcn_s_sleep(2); if (++sp > (1u << 22)) break; }
            __builtin_amdgcn_fence(__ATOMIC_ACQUIRE, "agent"); asm volatile("s_waitcnt vmcnt(0)" ::: "memory");
        }
        __syncthreads();
        if (tid < 256) tab[tid] = rstd_parts16(ss, u.pm * 256 + tid, 1.0f / 1024.0f);
        __syncthreads();
#pragma unroll
        for (int ai = 0; ai < 2; ++ai)
#pragma unroll
            for (int m = 0; m < 4; ++m) {
                const int r = ai * 128 + wr * 64 + m * 16 + fr; const float rs = tab[r];
#pragma unroll
                for (int bj = 0; bj < 2; ++bj)
#pragma unroll
                    for (int n = 0; n < 2; ++n) {
                        const int col = col0 + bj * 128 + n * 16;
                        const f32x4 g = *(const f32x4*)(gfin + col);
                        *(f32x4*)(X + (size_t)(u.pm * 256 + r) * DM + col) = acc[ai][bj][m][n] * rs * g;
                    }
            }
    }
};
struct EpiInProj {
    static constexpr bool PERM = false, AFTER_DRAIN = false;
    const float* ss1; bf16_t *QD, *KD, *VD, *CQ, *CKV, *KR; float *SSQ, *SSKV; const float *cosm, *sinm, *cosp, *sinp; LAS float* tab;
    __device__ __forceinline__ void operator()(const f32x4 (&acc)[2][2][4][2], const Unit& u, int wr, int wc, int fr_in, int fq_in) const {
        EPI_RELANE();
        { int tid = threadIdx.x; asm volatile("" : "+v"(tid)); if (tid < 256) tab[tid] = rstd_parts16(ss1, u.pm * 256 + tid, 1.0f / 1024.0f); }
        const int row0 = u.pm * 256 + wr * 64 + fr, pn = u.pn;
        const bool ropeP = (pn < 4) && ((wc & 1) == 0), ropeM = (pn == 7) && (wc == 0);
        f32x4 cs[2][4], sn[2][4];
        if (ropeP || ropeM) {
#pragma unroll
            for (int ai = 0; ai < 2; ++ai)
#pragma unroll
                for (int m = 0; m < 4; ++m) { const int pos = (row0 + ai * 128 + m * 16) & (SEQ - 1);
                    const float* cp = ropeP ? cosp + pos * 8 + 4 * (fq & 1) : cosm + pos * 16 + 4 * fq; const float* sp = ropeP ? sinp + pos * 8 + 4 * (fq & 1) : sinm + pos * 16 + 4 * fq;
                    cs[ai][m] = *(const f32x4*)cp; sn[ai][m] = *(const f32x4*)sp; }
        }
        __syncthreads();
#pragma unroll
        for (int ai = 0; ai < 2; ++ai)
#pragma unroll
            for (int m = 0; m < 4; ++m) {
                const int row = row0 + ai * 128 + m * 16, pos = row & (SEQ - 1);
                const float rs = tab[ai * 128 + wr * 64 + m * 16 + fr];
                if (pn < 6) {
                    bf16_t* dst = QD + (size_t)(pn >> 1) * ((size_t)NT * 512) + (size_t)row * 512 + (pn & 1) * 256 + wc * 32 + 4 * fq;
                    const float sc = pn < 2 ? rs * QSCALE_D : rs;
                    const bool rope = (pn < 4) && ((wc & 1) == 0);
#pragma unroll
                    for (int bj = 0; bj < 2; ++bj)
#pragma unroll
                        for (int n = 0; n < 2; ++n) {
                            f32x4 v = acc[ai][bj][m][n] * sc;
                            if (n == 0 && rope) {
                                f32x4 pv; pv[0] = __shfl_xor(v[0], 32); pv[1] = __shfl_xor(v[1], 32); pv[2] = __shfl_xor(v[2], 32); pv[3] = __shfl_xor(v[3], 32);
                                const f32x4 c = cs[ai][m], s = sn[ai][m];
                                v = (fq < 2) ? (v * c - pv * s) : (v * c + pv * s);
                            }
                            u32x2 w; w.x = cvt_pk_bf16(v[0], v[1]); w.y = cvt_pk_bf16(v[2], v[3]);
                            *(u32x2*)(dst + bj * 128 + n * 16) = w;
                        }
                } else if (pn == 6 || pn == 8) {
                    bf16_t* dst = CQ + (pn == 6 ? (size_t)row * 384 : (size_t)NT * 384 + (size_t)row * 256) + wc * 32 + 4 * fq; float sq = 0.f;
#pragma unroll
                    for (int bj = 0; bj < 2; ++bj)
#pragma unroll
                        for (int n = 0; n < 2; ++n) {
                            const f32x4 v = acc[ai][bj][m][n] * rs; sq += sq4(v);
                            u32x2 w; w.x = cvt_pk_bf16(v[0], v[1]); w.y = cvt_pk_bf16(v[2], v[3]);
                            *(u32x2*)(dst + bj * 128 + n * 16) = w;
                        }
                    sq += __shfl_xor(sq, 16); sq += __shfl_xor(sq, 32);
                    if (fq == 0) SSQ[(pn == 6 ? (size_t)row * 8 : (size_t)NT * 8 + (size_t)row * 4) + wc] = sq;
                } else {
                    bf16_t* dst = CQ + (size_t)row * 384 + 256 + wc * 32 + 4 * fq; float sq = 0.f;
#pragma unroll
                    for (int n = 0; n < 2; ++n) {
                        const f32x4 v = acc[ai][0][m][n] * rs; sq += sq4(v);
                        u32x2 w; w.x = cvt_pk_bf16(v[0], v[1]); w.y = cvt_pk_bf16(v[2], v[3]);
                        *(u32x2*)(dst + n * 16) = w;
                    }
                    sq += __shfl_xor(sq, 16); sq += __shfl_xor(sq, 32);
                    if (fq == 0) SSQ[(size_t)row * 8 + 4 + wc] = sq;
                    if (wc == 0) {
                        const f32x4 x1 = acc[ai][1][m][0] * rs, x2 = acc[ai][1][m][1] * rs;
                        const f32x4 c = cs[ai][m], s = sn[ai][m];
                        const f32x4 o1 = x1 * c - x2 * s, o2 = x2 * c + x1 * s;
                        u32x2 w1, w2; w1.x = cvt_pk_bf16(o1[0], o1[1]); w1.y = cvt_pk_bf16(o1[2], o1[3]); w2.x = cvt_pk_bf16(o2[0], o2[1]); w2.y = cvt_pk_bf16(o2[2], o2[3]);
                        *(u32x2*)(KR + (size_t)row * 32 + 4 * fq) = w1; *(u32x2*)(KR + (size_t)row * 32 + 16 + 4 * fq) = w2;
                    }
                }
            }
    }
};
struct EpiQ {
    static constexpr bool PERM = false, AFTER_DRAIN = false;
    const float* ssq; bf16_t* QM; const float *cosm, *sinm; LAS float* tab;
    __device__ __forceinline__ void operator()(const f32x4 (&acc)[2][2][4][2], const Unit& u, int wr, int wc, int fr_in, int fq_in) const {
        EPI_RELANE();
        const int row0 = u.pm * 256 + wr * 64 + fr;
        { int tid = threadIdx.x; asm volatile("" : "+v"(tid));
          if (tid < 256) { const f32x4* p = (const f32x4*)(ssq + (size_t)(u.pm * 256 + tid) * 8); tab[tid] = rsqrtf((sum4(p[0]) + sum4(p[1])) * (1.0f / 384.0f) + EPS) * QSCALE_M; } }
        __syncthreads();
#pragma unroll
        for (int ai = 0; ai < 2; ++ai) {
#pragma unroll
            for (int m = 0; m < 4; ++m) {
                const int row = row0 + ai * 128 + m * 16;
                const float rs = tab[ai * 128 + wr * 64 + m * 16 + fr];
#pragma unroll
                for (int bj = 0; bj < 2; ++bj) {
                    const int g32 = 8 * u.pn + 4 * bj + wc;
                    bf16_t* dst = QM + (size_t)row * 768 + 32 * g32 + 4 * fq;
                    f32x4 v0 = acc[ai][bj][m][0] * rs, v1 = acc[ai][bj][m][1] * rs;
                    if (g32 % 3 == 2) {
                        const int pos = row & (SEQ - 1);
                        const f32x4 c = *(const f32x4*)(cosm + pos * 16 + 4 * fq), s = *(const f32x4*)(sinm + pos * 16 + 4 * fq);
                        const f32x4 o1 = v0 * c - v1 * s, o2 = v1 * c + v0 * s; v0 = o1; v1 = o2;
                    }
                    u32x2 w0, w1; w0.x = cvt_pk_bf16(v0[0], v0[1]); w0.y = cvt_pk_bf16(v0[2], v0[3]); w1.x = cvt_pk_bf16(v1[0], v1[1]); w1.y = cvt_pk_bf16(v1[2], v1[3]);
                    *(u32x2*)dst = w0; *(u32x2*)(dst + 16) = w1;
                }
            }
        }
    }
};
struct EpiKV {
    static constexpr bool PERM = true, AFTER_DRAIN = false;
    const float* sskv; bf16_t* KVM; LAS float* tab;
    __device__ __forceinline__ void operator()(const f32x4 (&acc)[2][2][4][2], const Unit& u, int wr, int wc, int fr_in, int fq_in) const {
        EPI_RELANE();
        { int tid = threadIdx.x; asm volatile("" : "+v"(tid)); if (tid < 256) tab[tid] = rsqrtf(sum4(*(const f32x4*)(sskv + (size_t)(u.pm * 256 + tid) * 4)) * (1.0f / 256.0f) + EPS); }
        __syncthreads();
        const int row0 = u.pm * 256 + wr * 64 + fr, col = u.pn * 256 + wc * 32 + 8 * fq;
#pragma unroll
        for (int ai = 0; ai < 2; ++ai)
#pragma unroll
            for (int m = 0; m < 4; ++m) {
                const int row = row0 + ai * 128 + m * 16;
                const float rs = tab[ai * 128 + wr * 64 + m * 16 + fr];
#pragma unroll
                for (int bj = 0; bj < 2; ++bj) {
                    const f32x4 v0 = acc[ai][bj][m][0] * rs, v1 = acc[ai][bj][m][1] * rs;
                    u32x4 w; w.x = cvt_pk_bf16(v0[0], v0[1]); w.y = cvt_pk_bf16(v0[2], v0[3]); w.z = cvt_pk_bf16(v1[0], v1[1]); w.w = cvt_pk_bf16(v1[2], v1[3]);
                    *(u32x4*)(KVM + (size_t)row * 1024 + col + bj * 128) = w;
                }
            }
    }
};

constexpr int ATT_VS = 192;
constexpr int ATT_TILE = 64 * 208 + 64 * ATT_VS;
constexpr int ATT_OST = 2 * ATT_TILE, ATT_WSC = ATT_OST + NWAVES * 4096;
static_assert(ATT_WSC + NWAVES * 256 <= 131072, "attention LDS");
static_assert(WS_KD == WS_QD + (size_t)NT * 512 * 2 && WS_VD == WS_KD + (size_t)NT * 512 * 2 && WS_CKV == WS_CQ + (size_t)NT * 384 * 2 && WS_SSKV == WS_SSQ + (size_t)NT * 8 * 4, "buffers addressed relative to each other");
__device__ __forceinline__ int crow(int r, int hi) { return (r & 3) + 8 * (r >> 2) + 4 * hi; }
__device__ __forceinline__ bf16x8 pack8(const f32x16& p, int b) {
    u32x4 w; w.x = cvt_pk_bf16(p[b], p[b + 1]); w.y = cvt_pk_bf16(p[b + 2], p[b + 3]); w.z = cvt_pk_bf16(p[b + 4], p[b + 5]); w.w = cvt_pk_bf16(p[b + 6], p[b + 7]);
    return __builtin_bit_cast(bf16x8, w);
}
typedef short v4i16_t __attribute__((ext_vector_type(4)));
__device__ __forceinline__ s16x4 vtr(LAS const unsigned char* p) { return __builtin_bit_cast(s16x4, __builtin_amdgcn_ds_read_tr16_b64_v4i16((LAS v4i16_t*)p)); }

struct AttnIO {
    const bf16_t *QM, *KVM, *KR; bf16_t* OMIX;
    const bf16_t *QD, *KD, *VD; bf16_t* OD; float* LSE;
};

template <bool DIL>
__device__ __forceinline__ void attn_unit(LAS unsigned char* lds, const AttnIO& io, int unit) {
    constexpr int DK = DIL ? 64 : 96, KS = DK * 2 + 16, NKS = DK / 16;
    int tid_ = threadIdx.x; asm volatile("" : "+v"(tid_));
    const int tid = tid_, lane = tid & 63, wid = __builtin_amdgcn_readfirstlane(tid >> 6), r32 = lane & 31, hi = lane >> 5;
    int b, h, ntiles, tlo, thi, kofs = 0, L = SEQ, dil = 1, res = 0, resu = 0, br = 0, q0 = 0, pq;
    if constexpr (!DIL) {
        const int bh = unit >> 3, qb = unit & 7; b = bh >> 3; h = bh & 7; ntiles = 32; tlo = 0; thi = 32; q0 = qb * 256; pq = q0 + wid * 32 + r32;
    } else {
        const int bh = unit / 24, k = unit % 24, j = k & 7; br = k >> 3; b = bh >> 3; h = bh & 7;
        if (br == 0) { dil = 1; L = 2048; resu = 0; q0 = 256 * j; }
        else if (br == 1) { dil = 4; L = 512; resu = j >> 1; q0 = 256 * (j & 1); }
        else { dil = 16; L = 128; resu = 2 * j; q0 = 0; }
        if (br < 2) { ntiles = 6; tlo = wid >> 1; thi = tlo + 3; kofs = q0 - 64; pq = q0 + wid * 32 + r32; res = resu; }
        else { const int hw = wid >> 2; ntiles = 4; tlo = 2 * hw; thi = tlo + 2; kofs = -128 * hw; pq = (wid & 3) * 32 + r32; res = resu + hw; }
    }
    const int pq0 = pq - r32;
    const size_t kb = (size_t)b * SEQ;
    bf16x8 qf[NKS];
    {
        const bf16_t* qp = DIL ? io.QD + (kb + (size_t)pq * dil + res) * 512 + h * 64 : io.QM + (kb + pq) * 768 + h * 96;
#pragma unroll
        for (int ks = 0; ks < NKS; ++ks) qf[ks] = *(const bf16x8*)(qp + ks * 16 + hi * 8);
    }
    const int lrow = tid >> 3, lch = tid & 7, rrow = (tid >> 2) & 63, rch = tid & 3;
    u32x4 gkA, gvA, grA = (u32x4){0u, 0u, 0u, 0u}, gkB, gvB, grB = (u32x4){0u, 0u, 0u, 0u};
#define ATT_TOK(t) \
        const int s_ = 64 * (t) + lrow; size_t tok_; \
        if (br < 2) { int p_ = q0 - 64 + s_; p_ = p_ < 0 ? 0 : (p_ > L - 1 ? L - 1 : p_); tok_ = kb + (size_t)p_ * dil + resu; } \
        else { tok_ = kb + (size_t)(s_ & 127) * 16 + (size_t)(resu + (s_ >> 7)); }
#define ATT_GLOADK(t, GK, GR) do { \
        if constexpr (!DIL) { \
            GK = *(const u32x4*)(io.KVM + (kb + 64 * (t) + lrow) * 1024 + h * 128 + lch * 8); \
            GR = *(const u32x4*)(io.KR + (kb + 64 * (t) + rrow) * 32 + rch * 8); \
        } else { ATT_TOK(t) GK = *(const u32x4*)(io.KD + tok_ * 512 + h * 64 + lch * 8); } } while (0)
#define ATT_GLOADV(t, GV) do { \
        if constexpr (!DIL) { GV = *(const u32x4*)(io.KVM + (kb + 64 * (t) + lrow) * 1024 + h * 128 + 64 + lch * 8); } \
        else { ATT_TOK(t) GV = *(const u32x4*)(io.VD + tok_ * 512 + h * 64 + lch * 8); } } while (0)
#define ATT_LSTOREK(buf, GK, GR) do { \
        LAS unsigned char* Kb_ = lds + (buf) * ATT_TILE; \
        *(LAS u32x4*)(Kb_ + lrow * KS + lch * 16) = GK; \
        if constexpr (!DIL) { *(LAS u32x4*)(Kb_ + rrow * KS + 128 + rch * 16) = GR; } } while (0)
#define ATT_LSTOREV(buf, GV) do { *(LAS u32x4*)(lds + (buf) * ATT_TILE + 64 * KS + lrow * ATT_VS + lch * 16) = GV; } while (0)
#define ATT_SB() do {} while (0)
    LAS float* wsc = (LAS float*)(lds + ATT_WSC + wid * 256);
    f32x16 o0 = {}, o1 = {}, negm = {};
    float mref = 0.f, lrun = 0.f; bool started = false;
    const int krow = (r32 & 19) | ((r32 & 4) << 1) | ((r32 & 8) >> 1);
    const int koff = krow * KS + hi * 16;
    const int i16 = lane & 15, g16 = lane >> 4;
    const int voff = 64 * KS + (8 * hi + (i16 >> 2)) * ATT_VS + (16 * (g16 & 1) + 4 * (i16 & 3)) * 2;
    ATT_GLOADK(0, gkA, grA); ATT_GLOADV(0, gvA); ATT_GLOADK(1, gkB, grB); ATT_LSTOREK(0, gkA, grA); ATT_LSTOREV(0, gvA); ATT_LSTOREK(1, gkB, grB);
    ATT_GLOADK(2, gkB, grB); ATT_GLOADV(1, gvB);
    __syncthreads();
    f32x16 c0, c1;
    if (tlo == 0) {
        c0 = negm; c1 = negm;
#pragma unroll
        for (int ks = 0; ks < NKS; ++ks) {
            const bf16x8 a0 = *(LAS const bf16x8*)(lds + koff + ks * 32), a1 = *(LAS const bf16x8*)(lds + koff + 32 * KS + ks * 32);
            c0 = __builtin_amdgcn_mfma_f32_32x32x16_bf16(a0, qf[ks], c0, 0, 0, 0); c1 = __builtin_amdgcn_mfma_f32_32x32x16_bf16(a1, qf[ks], c1, 0, 0, 0);
        }
    } else { c0 = negm; c1 = negm; }
    __syncthreads();
    for (int t2 = 0; t2 < ntiles; t2 += 2) {
      { const int t = t2;
        ATT_GLOADK(min(t + 3, ntiles - 1), gkA, grA);
        ATT_GLOADV(min(t + 2, ntiles - 1), gvA);
        const bool doP = (t >= tlo) && (t < thi), doS = (t + 1 >= tlo) && (t + 1 < thi);
        LAS const unsigned char* Kn = lds + ((t + 1) & 1) * ATT_TILE + koff;
        LAS const unsigned char* Vc = lds + (t & 1) * ATT_TILE + voff;
        f32x16 n0 = negm, n1 = negm;
        if (doP) {
            if constexpr (DIL) {
                const int P0 = 64 * t + kofs;
                const bool full = (P0 >= pq0 - 33) && (P0 + 63 <= pq0 + 64) && (P0 >= 0) && (P0 + 63 < L);
                if (!full) {
                    const int lo = max(pq - 64, 0) - P0 - 8 * hi, span = min(pq + 64, L - 1) - max(pq - 64, 0);
#pragma unroll
                    for (int r = 0; r < 16; ++r) {
                        const int i0 = 16 * (r >> 3) + (r & 7);
                        c0[r] = ((unsigned)(i0 - lo) <= (unsigned)span) ? c0[r] : -INFINITY;
                        c1[r] = ((unsigned)(i0 + 32 - lo) <= (unsigned)span) ? c1[r] : -INFINITY;
                    }
                }
            }
            float ma = fmaxf(fmaxf(c0[0], c0[1]), c1[0]), mb = fmaxf(fmaxf(c0[2], c0[3]), c1[1]);
            ma = fmaxf(fmaxf(ma, c1[2]), c1[3]);
#pragma unroll
            for (int r = 4; r < 16; r += 4) { ma = fmaxf(fmaxf(ma, c0[r]), c0[r + 1]); mb = fmaxf(fmaxf(mb, c0[r + 2]), c0[r + 3]); ma = fmaxf(fmaxf(ma, c1[r]), c1[r + 1]); mb = fmaxf(fmaxf(mb, c1[r + 2]), c1[r + 3]); }
            float rm = fmaxf(ma, mb);
            { auto rr = __builtin_amdgcn_permlane32_swap(__float_as_uint(rm), __float_as_uint(rm), false, false); rm = fmaxf(__uint_as_float(rr[0]), __uint_as_float(rr[1])); }
            const float dl = (rm > -1e30f && (!started || rm > 8.f)) ? rm : 0.f;
            started = started || (rm > -1e30f);
            const bool resc = __any(dl != 0.f);
            if (resc) {
                mref += dl;
#pragma unroll
                for (int r = 0; r < 16; ++r) { c0[r] -= dl; c1[r] -= dl; }
#pragma unroll
                for (int r = 0; r < 16; ++r) negm[r] = -mref;
                const float f = fast_exp2(-fmaxf(dl, 0.f)); lrun *= f;
                if (hi == 0) wsc[r32] = f;
                n0 = negm; n1 = negm;
            }
            float ps0 = 0.f, ps1 = 0.f;
            u32x4 pw0, pw1, pw2, pw3;
#define ATT_EXPU(u) do { c0[u] = fast_exp2(c0[u]); c1[u] = fast_exp2(c1[u]); ps0 += c0[u]; ps1 += c1[u]; } while (0)
#define ATT_PK(u) do { const unsigned x0_ = cvt_pk_bf16(c0[u - 1], c0[u]), x1_ = cvt_pk_bf16(c1[u - 1], c1[u]); \
            if ((u) < 8) { pw0[((u) >> 1) & 3] = x0_; pw2[((u) >> 1) & 3] = x1_; } else { pw1[((u) >> 1) & 3] = x0_; pw3[((u) >> 1) & 3] = x1_; } } while (0)
            if (doS) {
                bf16x8 a0 = *(LAS const bf16x8*)(Kn), a1 = *(LAS const bf16x8*)(Kn + 32 * KS);
#pragma unroll
                for (int ks = 0; ks < NKS; ++ks) {
                    bf16x8 b0 = a0, b1 = a1;
                    if (ks + 1 < NKS) { b0 = *(LAS const bf16x8*)(Kn + (ks + 1) * 32); b1 = *(LAS const bf16x8*)(Kn + 32 * KS + (ks + 1) * 32); }
                    n0 = __builtin_amdgcn_mfma_f32_32x32x16_bf16(a0, qf[ks], n0, 0, 0, 0);
                    n1 = __builtin_amdgcn_mfma_f32_32x32x16_bf16(a1, qf[ks], n1, 0, 0, 0);
                    a0 = b0; a1 = b1;
                    const int u_lo = (16 * ks) / NKS, u_hi = (16 * (ks + 1)) / NKS;
#pragma unroll
                    for (int u = u_lo; u < u_hi; ++u) { ATT_EXPU(u); if (u & 1) ATT_PK(u); }
                    ATT_SB();
                }
            } else {
#pragma unroll
                for (int u = 0; u < 16; ++u) { ATT_EXPU(u); if (u & 1) ATT_PK(u); }
            }
            lrun += ps0 + ps1;
            if (resc) {
#pragma unroll
                for (int g = 0; g < 4; ++g) {
                    const f32x4 av = *(LAS const f32x4*)(wsc + 8 * g + 4 * hi);
#pragma unroll
                    for (int e = 0; e < 4; ++e) { o0[4 * g + e] *= av[e]; o1[4 * g + e] *= av[e]; }
                }
            }
            {
                s16x4 va = vtr(Vc), vb = vtr(Vc + 4 * ATT_VS), vc = vtr(Vc + 64), vd = vtr(Vc + 64 + 4 * ATT_VS);
#pragma unroll
                for (int j = 0; j < 4; ++j) {
                    const bf16x8 pa = __builtin_bit_cast(bf16x8, j == 0 ? pw0 : (j == 1 ? pw1 : (j == 2 ? pw2 : pw3)));
                    const bf16x8 vf0 = (bf16x8){va[0], va[1], va[2], va[3], vb[0], vb[1], vb[2], vb[3]};
                    const bf16x8 vf1 = (bf16x8){vc[0], vc[1], vc[2], vc[3], vd[0], vd[1], vd[2], vd[3]};
                    if (j + 1 < 4) { LAS const unsigned char* vp = Vc + (j + 1) * 16 * ATT_VS; va = vtr(vp); vb = vtr(vp + 4 * ATT_VS); vc = vtr(vp + 64); vd = vtr(vp + 64 + 4 * ATT_VS); }
                    o0 = __builtin_amdgcn_mfma_f32_32x32x16_bf16(pa, vf0, o0, 0, 0, 0);
                    o1 = __builtin_amdgcn_mfma_f32_32x32x16_bf16(pa, vf1, o1, 0, 0, 0);
                }
            }
        } else if (doS) {
#pragma unroll
            for (int ks = 0; ks < NKS; ++ks) {
                const bf16x8 a0 = *(LAS const bf16x8*)(Kn + ks * 32), a1 = *(LAS const bf16x8*)(Kn + 32 * KS + ks * 32);
                n0 = __builtin_amdgcn_mfma_f32_32x32x16_bf16(a0, qf[ks], n0, 0, 0, 0); n1 = __builtin_amdgcn_mfma_f32_32x32x16_bf16(a1, qf[ks], n1, 0, 0, 0);
            }
        }
        c0 = n0; c1 = n1;
        ATT_LSTOREK(t & 1, gkB, grB);
        ATT_LSTOREV((t + 1) & 1, gvB);
        __syncthreads();
          }
      { const int t = t2 + 1;
        ATT_GLOADK(min(t + 3, ntiles - 1), gkB, grB);
        ATT_GLOADV(min(t + 2, ntiles - 1), gvB);
        const bool doP = (t >= tlo) && (t < thi), doS = (t + 1 >= tlo) && (t + 1 < thi);
        LAS const unsigned char* Kn = lds + ((t + 1) & 1) * ATT_TILE + koff;
        LAS const unsigned char* Vc = lds + (t & 1) * ATT_TILE + voff;
        f32x16 n0 = negm, n1 = negm;
        if (doP) {
            if constexpr (DIL) {
                const int P0 = 64 * t + kofs;
                const bool full = (P0 >= pq0 - 33) && (P0 + 63 <= pq0 + 64) && (P0 >= 0) && (P0 + 63 < L);
                if (!full) {
                    const int lo = max(pq - 64, 0) - P0 - 8 * hi, span = min(pq + 64, L - 1) - max(pq - 64, 0);
#pragma unroll
                    for (int r = 0; r < 16; ++r) {
                        const int i0 = 16 * (r >> 3) + (r & 7);
                        c0[r] = ((unsigned)(i0 - lo) <= (unsigned)span) ? c0[r] : -INFINITY;
                        c1[r] = ((unsigned)(i0 + 32 - lo) <= (unsigned)span) ? c1[r] : -INFINITY;
                    }
                }
            }
            float ma = fmaxf(fmaxf(c0[0], c0[1]), c1[0]), mb = fmaxf(fmaxf(c0[2], c0[3]), c1[1]);
            ma = fmaxf(fmaxf(ma, c1[2]), c1[3]);
#pragma unroll
            for (int r = 4; r < 16; r += 4) { ma = fmaxf(fmaxf(ma, c0[r]), c0[r + 1]); mb = fmaxf(fmaxf(mb, c0[r + 2]), c0[r + 3]); ma = fmaxf(fmaxf(ma, c1[r]), c1[r + 1]); mb = fmaxf(fmaxf(mb, c1[r + 2]), c1[r + 3]); }
            float rm = fmaxf(ma, mb);
            { auto rr = __builtin_amdgcn_permlane32_swap(__float_as_uint(rm), __float_as_uint(rm), false, false); rm = fmaxf(__uint_as_float(rr[0]), __uint_as_float(rr[1])); }
            const float dl = (rm > -1e30f && (!started || rm > 8.f)) ? rm : 0.f;
            started = started || (rm > -1e30f);
            const bool resc = __any(dl != 0.f);
            if (resc) {
                mref += dl;
#pragma unroll
                for (int r = 0; r < 16; ++r) { c0[r] -= dl; c1[r] -= dl; }
#pragma unroll
                for (int r = 0; r < 16; ++r) negm[r] = -mref;
                const float f = fast_exp2(-fmaxf(dl, 0.f)); lrun *= f;
                if (hi == 0) wsc[r32] = f;
                n0 = negm; n1 = negm;
            }
            float ps0 = 0.f, ps1 = 0.f;
            u32x4 pw0, pw1, pw2, pw3;
#define ATT_EXPU(u) do { c0[u] = fast_exp2(c0[u]); c1[u] = fast_exp2(c1[u]); ps0 += c0[u]; ps1 += c1[u]; } while (0)
#define ATT_PK(u) do { const unsigned x0_ = cvt_pk_bf16(c0[u - 1], c0[u]), x1_ = cvt_pk_bf16(c1[u - 1], c1[u]); \
            if ((u) < 8) { pw0[((u) >> 1) & 3] = x0_; pw2[((u) >> 1) & 3] = x1_; } else { pw1[((u) >> 1) & 3] = x0_; pw3[((u) >> 1) & 3] = x1_; } } while (0)
            if (doS) {
                bf16x8 a0 = *(LAS const bf16x8*)(Kn), a1 = *(LAS const bf16x8*)(Kn + 32 * KS);
#pragma unroll
                for (int ks = 0; ks < NKS; ++ks) {
                    bf16x8 b0 = a0, b1 = a1;
                    if (ks + 1 < NKS) { b0 = *(LAS const bf16x8*)(Kn + (ks + 1) * 32); b1 = *(LAS const bf16x8*)(Kn + 32 * KS + (ks + 1) * 32); }
                    n0 = __builtin_amdgcn_mfma_f32_32x32x16_bf16(a0, qf[ks], n0, 0, 0, 0);
                    n1 = __builtin_amdgcn_mfma_f32_32x32x16_bf16(a1, qf[ks], n1, 0, 0, 0);
                    a0 = b0; a1 = b1;
                    const int u_lo = (16 * ks) / NKS, u_hi = (16 * (ks + 1)) / NKS;
#pragma unroll
                    for (int u = u_lo; u < u_hi; ++u) { ATT_EXPU(u); if (u & 1) ATT_PK(u); }
                    ATT_SB();
                }
            } else {
#pragma unroll
                for (int u = 0; u < 16; ++u) { ATT_EXPU(u); if (u & 1) ATT_PK(u); }
            }
            lrun += ps0 + ps1;
            if (resc) {
#pragma unroll
                for (int g = 0; g < 4; ++g) {
                    const f32x4 av = *(LAS const f32x4*)(wsc + 8 * g + 4 * hi);
#pragma unroll
                    for (int e = 0; e < 4; ++e) { o0[4 * g + e] *= av[e]; o1[4 * g + e] *= av[e]; }
                }
            }
            {
                s16x4 va = vtr(Vc), vb = vtr(Vc + 4 * ATT_VS), vc = vtr(Vc + 64), vd = vtr(Vc + 64 + 4 * ATT_VS);
#pragma unroll
                for (int j = 0; j < 4; ++j) {
                    const bf16x8 pa = __builtin_bit_cast(bf16x8, j == 0 ? pw0 : (j == 1 ? pw1 : (j == 2 ? pw2 : pw3)));
                    const bf16x8 vf0 = (bf16x8){va[0], va[1], va[2], va[3], vb[0], vb[1], vb[2], vb[3]};
                    const bf16x8 vf1 = (bf16x8){vc[0], vc[1], vc[2], vc[3], vd[0], vd[1], vd[2], vd[3]};
                    if (j + 1 < 4) { LAS const unsigned char* vp = Vc + (j + 1) * 16 * ATT_VS; va = vtr(vp); vb = vtr(vp + 4 * ATT_VS); vc = vtr(vp + 64); vd = vtr(vp + 64 + 4 * ATT_VS); }
                    o0 = __builtin_amdgcn_mfma_f32_32x32x16_bf16(pa, vf0, o0, 0, 0, 0);
                    o1 = __builtin_amdgcn_mfma_f32_32x32x16_bf16(pa, vf1, o1, 0, 0, 0);
                }
            }
        } else if (doS) {
#pragma unroll
            for (int ks = 0; ks < NKS; ++ks) {
                const bf16x8 a0 = *(LAS const bf16x8*)(Kn + ks * 32), a1 = *(LAS const bf16x8*)(Kn + 32 * KS + ks * 32);
                n0 = __builtin_amdgcn_mfma_f32_32x32x16_bf16(a0, qf[ks], n0, 0, 0, 0); n1 = __builtin_amdgcn_mfma_f32_32x32x16_bf16(a1, qf[ks], n1, 0, 0, 0);
            }
        }
        c0 = n0; c1 = n1;
        ATT_LSTOREK(t & 1, gkA, grA);
        ATT_LSTOREV((t + 1) & 1, gvA);
        __syncthreads();
          }
    }
    float ltot;
    { auto rr = __builtin_amdgcn_permlane32_swap(__float_as_uint(lrun), __float_as_uint(lrun), false, false); ltot = __uint_as_float(rr[0]) + __uint_as_float(rr[1]); }
    if (hi == 0) wsc[r32] = fast_rcp(ltot);
    LAS bf16_t* stg = (LAS bf16_t*)(lds + ATT_OST + wid * 4096);
#pragma unroll
    for (int g = 0; g < 4; ++g) {
        const f32x4 iv = *(LAS const f32x4*)(wsc + 8 * g + 4 * hi);
#pragma unroll
        for (int e = 0; e < 4; ++e) {
            const int r = 4 * g + e, orow = crow(r, hi);
            stg[orow * 64 + r32] = (bf16_t)(cvt_pk_bf16(o0[r] * iv[e], 0.f) & 0xffffu);
            stg[orow * 64 + 32 + r32] = (bf16_t)(cvt_pk_bf16(o1[r] * iv[e], 0.f) & 0xffffu);
        }
    }
#pragma unroll
    for (int it = 0; it < 4; ++it) {
        const int row = it * 8 + (lane >> 3), ch = lane & 7;
        const u32x4 v = *(LAS const u32x4*)(stg + row * 64 + ch * 8);
        if constexpr (DIL) { const size_t tok = kb + (size_t)(pq0 + row) * dil + res; *(u32x4*)(io.OD + (size_t)br * NT * 512 + tok * 512 + h * 64 + ch * 8) = v; }
        else *(u32x4*)(io.OMIX + (kb + pq0 + row) * 1024 + h * 64 + ch * 8) = v;
    }
    if constexpr (DIL) { if (hi == 0) { const size_t tok = kb + (size_t)pq * dil + res; io.LSE[((size_t)br * NT + tok) * 8 + h] = mref + __builtin_amdgcn_logf(ltot); } }
}
#undef ATT_TOK
#undef ATT_GLOADK
#undef ATT_GLOADV
#undef ATT_LSTOREK
#undef ATT_LSTOREV
#undef ATT_SB
#undef ATT_EXPU
#undef ATT_PK

constexpr int DIL_RS = 144;
constexpr int DIL_K = 0, DIL_V = 384 * DIL_RS, DIL_OST = 2 * 384 * DIL_RS, DIL_WSC = DIL_OST + NWAVES * 4096, DIL_LDS = DIL_WSC + NWAVES * 256;
struct DilUnit { int b, h, br, dil, L, resu, q0, nrows; };
__device__ __forceinline__ DilUnit dil_decode(int unit) {
    DilUnit d; const int bh = unit / 24, k = unit % 24, j = k & 7; d.br = k >> 3; d.b = bh >> 3; d.h = bh & 7;
    if (d.br == 0) { d.dil = 1; d.L = 2048; d.resu = 0; d.q0 = 256 * j; d.nrows = 384; }
    else if (d.br == 1) { d.dil = 4; d.L = 512; d.resu = j >> 1; d.q0 = 256 * (j & 1); d.nrows = 384; }
    else { d.dil = 16; d.L = 128; d.resu = 2 * j; d.q0 = 0; d.nrows = 256; }
    return d;
}
__device__ __forceinline__ size_t dil_tok(const DilUnit& d, int s) {
    const size_t kb = (size_t)d.b * SEQ;
    if (d.br < 2) { int p = d.q0 - 64 + s; p = p < 0 ? 0 : (p > d.L - 1 ? d.L - 1 : p); return kb + (size_t)p * d.dil + d.resu; }
    return kb + (size_t)(s & 127) * 16 + (size_t)(d.resu + (s >> 7));
}
__device__ __forceinline__ void dil_phase(LAS unsigned char* lds, const AttnIO& io, int bx, int G) {
    int tid_ = threadIdx.x; asm volatile("" : "+v"(tid_));
    const int tid = tid_, lane = tid & 63, wid = __builtin_amdgcn_readfirstlane(tid >> 6), r32 = lane & 31, hi = lane >> 5;
    const int lrow = tid >> 3, lch = tid & 7;
    const int krow = (r32 & 19) | ((r32 & 4) << 1) | ((r32 & 8) >> 1);
    const int i16 = lane & 15, g16 = lane >> 4;
    const int voff = DIL_V + (8 * hi + (i16 >> 2)) * DIL_RS + (16 * (g16 & 1) + 4 * (i16 & 3)) * 2;
    LAS float* wsc = (LAS float*)(lds + DIL_WSC + wid * 256);
    LAS bf16_t* stg = (LAS bf16_t*)(lds + DIL_OST + wid * 4096);
    constexpr int NUNITS = 256 * 24;
    u32x4 gk[6], gv[6]; bf16x8 qn[4];
#define DIL_WAVE(d, TLO, NTW, KOFS, PQ, RES) \
    int TLO, NTW, KOFS, PQ, RES; \
    if ((d).br < 2) { TLO = wid >> 1; NTW = 3; KOFS = (d).q0 - 64; PQ = (d).q0 + wid * 32 + r32; RES = (d).resu; } \
    else { const int hw_ = wid >> 2; TLO = 2 * hw_; NTW = 2; KOFS = -128 * hw_; PQ = (wid & 3) * 32 + r32; RES = (d).resu + hw_; }
#define DIL_PREFETCH(unit) do { \
        const DilUnit d_ = dil_decode(unit); \
        _Pragma("unroll") for (int i = 0; i < 6; ++i) { const int row_ = lrow + 64 * i; \
            if (row_ < d_.nrows) { const size_t tok_ = dil_tok(d_, row_); gk[i] = *(const u32x4*)(io.KD + tok_ * 512 + d_.h * 64 + lch * 8); gv[i] = *(const u32x4*)(io.VD + tok_ * 512 + d_.h * 64 + lch * 8); } } \
        DIL_WAVE(d_, tlo_, ntw_, kofs_, pq_, res_) (void)tlo_; (void)ntw_; (void)kofs_; \
        const bf16_t* qp_ = io.QD + ((size_t)d_.b * SEQ + (size_t)pq_ * d_.dil + res_) * 512 + d_.h * 64; \
        _Pragma("unroll") for (int ks = 0; ks < 4; ++ks) qn[ks] = *(const bf16x8*)(qp_ + ks * 16 + hi * 8); \
    } while (0)
    int unit = bx;
    if (unit < NUNITS) DIL_PREFETCH(unit);
    for (; unit < NUNITS; unit += G) {
        const DilUnit d = dil_decode(unit);
#pragma unroll
        for (int i = 0; i < 6; ++i) { const int row = lrow + 64 * i;
            if (row < d.nrows) { *(LAS u32x4*)(lds + DIL_K + row * DIL_RS + lch * 16) = gk[i]; *(LAS u32x4*)(lds + DIL_V + row * DIL_RS + lch * 16) = gv[i]; } }
        bf16x8 qf[4];
#pragma unroll
        for (int ks = 0; ks < 4; ++ks) qf[ks] = qn[ks];
        __syncthreads();
        if (unit + G < NUNITS) DIL_PREFETCH(unit + G);
        DIL_WAVE(d, tlo, ntw, kofs, pq, res)
        const int pq0 = pq - r32;
        f32x16 o0 = {}, o1 = {};
        float mrun = -1e30f, lrun = 0.f;
        for (int tt = 0; tt < ntw; ++tt) {
            const int t = tlo + tt;
            LAS const unsigned char* Kb = lds + DIL_K + (64 * t + krow) * DIL_RS + hi * 16;
            f32x16 s0 = {}, s1 = {};
#pragma unroll
            for (int ks = 0; ks < 4; ++ks) {
                const bf16x8 a0 = *(LAS const bf16x8*)(Kb + ks * 32), a1 = *(LAS const bf16x8*)(Kb + 32 * DIL_RS + ks * 32);
                s0 = __builtin_amdgcn_mfma_f32_32x32x16_bf16(a0, qf[ks], s0, 0, 0, 0);
                s1 = __builtin_amdgcn_mfma_f32_32x32x16_bf16(a1, qf[ks], s1, 0, 0, 0);
            }
            {
                const int P0 = 64 * t + kofs;
                const bool full = (P0 >= pq0 - 33) && (P0 + 63 <= pq0 + 64) && (P0 >= 0) && (P0 + 63 < d.L);
                if (!full) {
                    const int lo = max(pq - 64, 0) - P0 - 8 * hi, span = min(pq + 64, d.L - 1) - max(pq - 64, 0);
#pragma unroll
                    for (int r = 0; r < 16; ++r) {
                        const int i0 = 16 * (r >> 3) + (r & 7);
                        s0[r] = ((unsigned)(i0 - lo) <= (unsigned)span) ? s0[r] : -INFINITY;
                        s1[r] = ((unsigned)(i0 + 32 - lo) <= (unsigned)span) ? s1[r] : -INFINITY;
                    }
                }
            }
            float ma = fmaxf(fmaxf(s0[0], s0[1]), s1[0]), mb = fmaxf(fmaxf(s0[2], s0[3]), s1[1]);
            ma = fmaxf(fmaxf(ma, s1[2]), s1[3]);
#pragma unroll
            for (int r = 4; r < 16; r += 4) { ma = fmaxf(fmaxf(ma, s0[r]), s0[r + 1]); mb = fmaxf(fmaxf(mb, s0[r + 2]), s0[r + 3]); ma = fmaxf(fmaxf(ma, s1[r]), s1[r + 1]); mb = fmaxf(fmaxf(mb, s1[r + 2]), s1[r + 3]); }
            float mx = fmaxf(ma, mb);
            { auto rr = __builtin_amdgcn_permlane32_swap(__float_as_uint(mx), __float_as_uint(mx), false, false); mx = fmaxf(__uint_as_float(rr[0]), __uint_as_float(rr[1])); }
            const float mnew = fmaxf(mrun, mx), alpha = fast_exp2(mrun - mnew);
            mrun = mnew;
            float ps0 = 0.f, ps1 = 0.f;
#pragma unroll
            for (int r = 0; r < 16; ++r) { s0[r] = fast_exp2(s0[r] - mnew); s1[r] = fast_exp2(s1[r] - mnew); ps0 += s0[r]; ps1 += s1[r]; }
            lrun = lrun * alpha + (ps0 + ps1);
            if (__any(alpha != 1.0f)) {
                if (hi == 0) wsc[r32] = alpha;
#pragma unroll
                for (int g = 0; g < 4; ++g) {
                    const f32x4 av = *(LAS const f32x4*)(wsc + 8 * g + 4 * hi);
#pragma unroll
                    for (int e = 0; e < 4; ++e) { o0[4 * g + e] *= av[e]; o1[4 * g + e] *= av[e]; }
                }
            }
            const bf16x8 pa0 = pack8(s0, 0), pa1 = pack8(s0, 8), pa2 = pack8(s1, 0), pa3 = pack8(s1, 8);
            LAS const unsigned char* Vb = lds + voff + 64 * t * DIL_RS;
#pragma unroll
            for (int j = 0; j < 4; ++j) {
                const bf16x8 pa = j == 0 ? pa0 : (j == 1 ? pa1 : (j == 2 ? pa2 : pa3));
                LAS const unsigned char* vp = Vb + j * 16 * DIL_RS;
                const s16x4 a = vtr(vp), bq = vtr(vp + 4 * DIL_RS), c = vtr(vp + 64), dd = vtr(vp + 64 + 4 * DIL_RS);
                const bf16x8 vf0 = (bf16x8){a[0], a[1], a[2], a[3], bq[0], bq[1], bq[2], bq[3]};
                const bf16x8 vf1 = (bf16x8){c[0], c[1], c[2], c[3], dd[0], dd[1], dd[2], dd[3]};
                o0 = __builtin_amdgcn_mfma_f32_32x32x16_bf16(pa, vf0, o0, 0, 0, 0);
                o1 = __builtin_amdgcn_mfma_f32_32x32x16_bf16(pa, vf1, o1, 0, 0, 0);
            }
        }
        float ltot;
        { auto rr = __builtin_amdgcn_permlane32_swap(__float_as_uint(lrun), __float_as_uint(lrun), false, false); ltot = __uint_as_float(rr[0]) + __uint_as_float(rr[1]); }
        if (hi == 0) wsc[r32] = fast_rcp(ltot);
#pragma unroll
        for (int g = 0; g < 4; ++g) {
            const f32x4 iv = *(LAS const f32x4*)(wsc + 8 * g + 4 * hi);
#pragma unroll
            for (int e = 0; e < 4; ++e) {
                const int r = 4 * g + e, orow = crow(r, hi);
                stg[orow * 64 + r32] = (bf16_t)(cvt_pk_bf16(o0[r] * iv[e], 0.f) & 0xffffu);
                stg[orow * 64 + 32 + r32] = (bf16_t)(cvt_pk_bf16(o1[r] * iv[e], 0.f) & 0xffffu);
            }
        }
        const size_t kb = (size_t)d.b * SEQ;
#pragma unroll
        for (int it = 0; it < 4; ++it) {
            const int row = it * 8 + (lane >> 3), ch = lane & 7;
            const u32x4 v = *(LAS const u32x4*)(stg + row * 64 + ch * 8);
            const size_t tok = kb + (size_t)(pq0 + row) * d.dil + res;
            *(u32x4*)(io.OD + (size_t)d.br * NT * 512 + tok * 512 + d.h * 64 + ch * 8) = v;
        }
        if (hi == 0) { const size_t tok = kb + (size_t)pq * d.dil + res; io.LSE[((size_t)d.br * NT + tok) * 8 + d.h] = mrun + __builtin_amdgcn_logf(ltot); }
        __syncthreads();
    }
#undef DIL_WAVE
#undef DIL_PREFETCH
}

__device__ __forceinline__ float wave_sum(float v) {
#pragma unroll
    for (int o = 1; o < 64; o <<= 1) v += __shfl_xor(v, o);
    return v;
}
__device__ __forceinline__ void tr_block(const float* W, int K, int N, const float* gain, bf16_t* WT, int k0, int n0, int dst_row0, LAS float* scr, int lane) {
#pragma unroll 8
    for (int i = 0; i < 32; ++i) {
        const int kk = 2 * i + (lane >> 5);
        float v = W[(size_t)(k0 + kk) * N + n0 + (lane & 31)];
        if (gain) v *= gain[k0 + kk];
        scr[kk * 33 + (lane & 31)] = v;
    }
    asm volatile("s_waitcnt lgkmcnt(0)" ::: "memory");
    const int c = lane & 7;
#pragma unroll
    for (int j = 0; j < 4; ++j) {
        const int n = (lane >> 3) + 8 * j; const LAS float* s = scr + (8 * c) * 33 + n;
        u32x4 o; o.x = cvt_pk_bf16(s[0 * 33], s[1 * 33]); o.y = cvt_pk_bf16(s[2 * 33], s[3 * 33]); o.z = cvt_pk_bf16(s[4 * 33], s[5 * 33]); o.w = cvt_pk_bf16(s[6 * 33], s[7 * 33]);
        *(u32x4*)(WT + (size_t)(dst_row0 + n) * K + k0 + 8 * c) = o;
    }
    asm volatile("s_waitcnt lgkmcnt(0)" ::: "memory");
}

#define XB_TMO      128
#define XB_XCNT(j)  (256  + 64 * (j))
#define XB_XSUB(j)  (1280 + 64 * (j))
#define XB_XGEN(j)  (2304 + 64 * (j))
#define XB_TOP      3328
#define XB_TOPGEN   3392
#define XCD_BAR_WORDS 3456
#define XB_SPIN_CAP (1u << 18)

__device__ __forceinline__ unsigned xb_ld(unsigned* p)              { return __hip_atomic_load(p, __ATOMIC_RELAXED, __HIP_MEMORY_SCOPE_AGENT); }
__device__ __forceinline__ unsigned xb_add(unsigned* p, unsigned v) { return __hip_atomic_fetch_add(p, v, __ATOMIC_RELAXED, __HIP_MEMORY_SCOPE_AGENT); }
__device__ __forceinline__ unsigned xb_xcc_id() { return (unsigned)__builtin_amdgcn_s_getreg((3 << 11) | 20) & 0xFu; }
#define XB_SPIN(cond, bar) do { unsigned _sp = 0; while (cond) { __builtin_amdgcn_s_sleep(1); \
    if ((++_sp & 255u) == 0u) { if (xb_ld(&(bar)[XB_TMO])) break; if (_sp > XB_SPIN_CAP) { atomicAdd(&(bar)[XB_TMO], 1u); break; } } } } while (0)

struct XcdBarrier {
    unsigned* bar; unsigned x;
    volatile LAS unsigned* st;
};

__device__ __forceinline__ XcdBarrier xcd_barrier_post(unsigned* bar, volatile LAS unsigned* st) {
    XcdBarrier b; b.bar = bar; b.x = xb_xcc_id(); b.st = st;
    if (threadIdx.x == 0) (void)xb_add(&bar[XB_XCNT(b.x)], 1u);
    return b;
}
__device__ __forceinline__ void xcd_barrier_complete(unsigned* bar, unsigned x, unsigned& nloc, unsigned& nx) {
    const unsigned G = gridDim.x * gridDim.y * gridDim.z;
    unsigned sum, cnt, mine, sp = 0u;
    for (;;) {
        sum = 0u; cnt = 0u; mine = 0u;
#pragma unroll
        for (unsigned j = 0; j < 16; ++j) { const unsigned c = xb_ld(&bar[XB_XCNT(j)]); sum += c; cnt += (c > 0u) ? 1u : 0u; mine = (j == x) ? c : mine; }
        if (sum == G) break;
        __builtin_amdgcn_s_sleep(1);
        if ((++sp & 255u) == 0u) { if (xb_ld(&bar[XB_TMO])) break; if (sp > XB_SPIN_CAP) { atomicAdd(&bar[XB_TMO], 1u); break; } }
    }
    nloc = mine > 0u ? mine : 1u; nx = cnt > 0u ? cnt : 1u;
}

__device__ __forceinline__ void xcd_barrier(const XcdBarrier& b) {
    asm volatile("s_waitcnt vmcnt(0)" ::: "memory");
    __syncthreads();
    if (threadIdx.x == 0) {
        unsigned* bar = b.bar;
        __builtin_amdgcn_s_waitcnt(0);
        unsigned nloc = b.st[0], nx = b.st[1];
        if (nloc == 0u) { xcd_barrier_complete(bar, b.x, nloc, nx); b.st[0] = nloc; b.st[1] = nx; }
        const unsigned old = xb_add(&bar[XB_XSUB(b.x)], 1u);
        const unsigned gen = old / nloc;
        if (old + 1u == (gen + 1u) * nloc) {
            __builtin_amdgcn_fence(__ATOMIC_RELEASE, "agent");
            asm volatile("s_waitcnt vmcnt(0)" ::: "memory");
            const unsigned og = xb_add(&bar[XB_TOP], 1u);
            const unsigned tg = og / nx;
            if (og + 1u == (tg + 1u) * nx) xb_add(&bar[XB_TOPGEN], 1u);
            else XB_SPIN(xb_ld(&bar[XB_TOPGEN]) == tg, bar);
            __builtin_amdgcn_fence(__ATOMIC_ACQUIRE, "agent");
            xb_add(&bar[XB_XGEN(b.x)], 1u);
            asm volatile("s_waitcnt vmcnt(0)" ::: "memory");
        } else {
            XB_SPIN(xb_ld(&bar[XB_XGEN(b.x)]) == gen, bar);
            __builtin_amdgcn_fence(__ATOMIC_ACQUIRE, "agent");
            asm volatile("s_waitcnt vmcnt(0)" ::: "memory");
        }
    }
    __syncthreads();
}

struct Args {
    const float* in[19]; float* out; unsigned char* ws;
};

__global__ void __launch_bounds__(NWAVES * 64) mk_fwd(Args a) {
    extern __shared__ __attribute__((aligned(16))) unsigned char lds_raw[];
    LAS unsigned char* lds = (LAS unsigned char*)lds_raw;
    cg::grid_group grid = cg::this_grid();
    const int tid = threadIdx.x, lane = tid & 63, wave = __builtin_amdgcn_readfirstlane(tid >> 6);
    const int G = gridDim.x, bx = blockIdx.x;
    const int gw = bx * NWAVES + wave, NGW = G * NWAVES;
    unsigned char* ws = a.ws;
    const float* x = a.in[0];
    const float *g_ffn1 = a.in[1], *w1g = a.in[2], *w1u = a.in[3], *w1d = a.in[4], *g_mix = a.in[5], *w_in = a.in[6], *g_q = a.in[7], *w_uq = a.in[8], *g_kv = a.in[9], *w_ukv = a.in[10],
                *g_mo = a.in[11], *g_do = a.in[12], *w_out = a.in[13], *g_ffn2 = a.in[14], *w2g = a.in[15], *w2u = a.in[16], *w2d = a.in[17], *g_fin = a.in[18];
    float* X = a.out;
    bf16_t *W1GU = (bf16_t*)(ws + WS_W1GU), *W1D = (bf16_t*)(ws + WS_W1D), *W2GU = (bf16_t*)(ws + WS_W2GU), *W2D = (bf16_t*)(ws + WS_W2D), *WIN = (bf16_t*)(ws + WS_WIN),
           *WUQ = (bf16_t*)(ws + WS_WUQ), *WUKV = (bf16_t*)(ws + WS_WUKV), *WOUT = (bf16_t*)(ws + WS_WOUT);
    float *COSM = (float*)(ws + WS_ROPE), *SINM = COSM + 2048 * 16, *COSP = SINM + 2048 * 16, *SINP = COSP + 2048 * 8;
    float *SS0 = (float*)(ws + WS_SS0), *SS1 = (float*)(ws + WS_SS1), *SS2 = (float*)(ws + WS_SS2), *SS3 = (float*)(ws + WS_SS3), *SSQ = (float*)(ws + WS_SSQ), *SSKV = (float*)(ws + WS_SSKV);
    bf16_t *XB = (bf16_t*)(ws + WS_XB), *KVM = (bf16_t*)a.out, *HB = (bf16_t*)(ws + WS_H), *OD = (bf16_t*)(ws + WS_OD0), *OMIX = (bf16_t*)(ws + WS_OMIX);
    float* LSE = (float*)(ws + WS_LSE);
    bf16_t *QD = (bf16_t*)(ws + WS_QD), *KD = (bf16_t*)(ws + WS_KD), *VD = (bf16_t*)(ws + WS_VD), *CQ = (bf16_t*)(ws + WS_CQ), *CKV = (bf16_t*)(ws + WS_CKV), *KR = (bf16_t*)(ws + WS_KR), *QM = (bf16_t*)(ws + WS_QM);

    volatile LAS unsigned* xb_st = (volatile LAS unsigned*)(lds + DIL_LDS);
    if (tid < 2) xb_st[tid] = 0u;
    unsigned* xb_words = (unsigned*)(ws + WS_BAR);
    unsigned* pan_cnt = xb_words + 4096;
    if (bx == 0) for (int i = tid; i < 4096 + 256 * 64; i += NWAVES * 64) xb_words[i] = 0u;
    {
        LAS float* scr = (LAS float*)(lds + wave * 16384);
        constexpr int I_GU = 16 * 88, I_D = 44 * 32, I_IN = 16 * 69, I_UQ = 6 * 24, I_UKV = 4 * 32, I_OUT = 16 * 32;
        constexpr int NITEMS = 2 * (2 * I_GU + I_D) + I_IN + I_UQ + I_UKV + I_OUT;
        for (int it = gw; it < NITEMS; it += NGW) {
            int r = it;
            if (r < 2 * (2 * I_GU + I_D)) {
                const int f = r / (2 * I_GU + I_D); r -= f * (2 * I_GU + I_D);
                const float* gg = f ? g_ffn2 : g_ffn1; const float* wg = f ? w2g : w1g; const float* wu = f ? w2u : w1u; const float* wd = f ? w2d : w1d;
                bf16_t* GU = f ? W2GU : W1GU; bf16_t* DD = f ? W2D : W1D;
                if (r < 2 * I_GU) { const int s = r >= I_GU; const int q = s ? r - I_GU : r; const int kb_ = q / 88, nb = q % 88, n0 = 32 * nb;
                    tr_block(s ? wu : wg, 1024, FF, gg, GU, 64 * kb_, n0, 256 * (n0 >> 7) + 128 * s + (n0 & 127), scr, lane); }
                else { r -= 2 * I_GU; const int kb_ = r / 32, nb = r % 32; tr_block(wd, FF, 1024, nullptr, DD, 64 * kb_, 32 * nb, 32 * nb, scr, lane); }
                continue;
            }
            r -= 2 * (2 * I_GU + I_D);
            if (r < I_IN) { const int kb_ = r / 69, nb = r % 69, n0 = 32 * nb;
                int dst;
                if (n0 < 384) dst = 1536 + n0; else if (n0 < 640) dst = 2048 + (n0 - 384); else if (n0 < 672) dst = 1920 + (n0 - 640);
                else if (n0 < 1184) dst = n0 - 672; else if (n0 < 1696) dst = 512 + (n0 - 1184); else dst = 1024 + (n0 - 1696);
                tr_block(w_in, 1024, 2208, g_mix, WIN, 64 * kb_, n0, dst, scr, lane); continue; }
            r -= I_IN;
            if (r < I_UQ) { const int kb_ = r / 24, nb = r % 24; tr_block(w_uq, 384, 768, g_q, WUQ, 64 * kb_, 32 * nb, 32 * nb, scr, lane); continue; }
            r -= I_UQ;
            if (r < I_UKV) { const int kb_ = r / 32, nb = r % 32; tr_block(w_ukv, 256, 1024, g_kv, WUKV, 64 * kb_, 32 * nb, 32 * nb, scr, lane); continue; }
            r -= I_UKV;
            { const int kb_ = r / 32, nb = r % 32, k0 = 64 * kb_; tr_block(w_out, 1024, 1024, k0 < 512 ? g_mo : g_do - 512, WOUT, k0, 32 * nb, 32 * nb, scr, lane); }
        }
        for (int i = bx * 512 + tid; i < 96 * 1024 / 8; i += G * 512) *(u32x4*)(WIN + (size_t)1952 * 1024 + (size_t)i * 8) = (u32x4){0u, 0u, 0u, 0u};
        for (int i = bx * 512 + tid; i < 2048 * 24; i += G * 512) {
            int pos, fi; float invf; float *cdst, *sdst;
            if (i < 2048 * 16) { pos = i >> 4; fi = i & 15; invf = exp2f(-(float)fi * (1.0f / 16.0f) * 18.931568569324174f); cdst = COSM + i; sdst = SINM + i; }
            else { const int k = i - 2048 * 16; pos = k >> 3; fi = k & 7; invf = exp2f(-(float)fi * (1.0f / 8.0f) * 18.931568569324174f); cdst = COSP + k; sdst = SINP + k; }
            const float ang = (float)pos * invf;
            const double rev = (double)ang * 0.15915494309189535; const float fr_ = (float)(rev - floor(rev));
            *cdst = __builtin_amdgcn_cosf(fr_); *sdst = __builtin_amdgcn_sinf(fr_);
        }
        for (int row0 = gw * 4; row0 < NT; row0 += NGW * 4) {
            f32x4 v[4][4];
#pragma unroll
            for (int q = 0; q < 4; ++q) { const f32x4* xr = (const f32x4*)(x + (size_t)(row0 + q) * DM) + lane;
#pragma unroll
                for (int j = 0; j < 4; ++j) v[q][j] = xr[64 * j]; }
#pragma unroll
            for (int q = 0; q < 4; ++q) {
                float sacc = 0.f; unsigned long long* o8 = (unsigned long long*)(XB + (size_t)(row0 + q) * DM) + lane;
#pragma unroll
                for (int j = 0; j < 4; ++j) { sacc += sq4(v[q][j]); o8[64 * j] = (unsigned long long)cvt_pk_bf16(v[q][j][0], v[q][j][1]) | ((unsigned long long)cvt_pk_bf16(v[q][j][2], v[q][j][3]) << 32); }
                sacc = wave_sum(sacc);
                if (lane < 16) SS0[(size_t)(row0 + q) * 16 + lane] = lane == 0 ? sacc : 0.f;
            }
        }
    }
    grid.sync();
    const XcdBarrier xb = xcd_barrier_post(xb_words, xb_st);
    {
        pg8::Gemm g{XB, W1GU, NT, 2 * FF, DM}; pg8::StaticOrder S; S.init(NT, 2 * FF, G, bx);
        EpiGateUp E{HB, SS0, (LAS float*)(lds + 131072)};
        pg8::gemm_phase<EpiGateUp, pg8::StaticOrder, true, true>(lds, g, S, E);
    }
    xcd_barrier(xb);
    {
        pg8::Gemm g{HB, W1D, NT, DM, FF}; pg8::StaticOrder S; S.init(NT, DM, G, bx);
        EpiResid E{XB, SS1, 0.5f};
        pg8::gemm_phase<EpiResid, pg8::StaticOrder, true, true>(lds, g, S, E);
    }
    xcd_barrier(xb);
    {
        pg8::Gemm g{XB, WIN, NT, 2304, DM}; pg8::StaticOrder S; S.init(NT, 2304, G, bx);
        EpiInProj E{SS1, QD, KD, VD, CQ, CKV, KR, SSQ, SSKV, COSM, SINM, COSP, SINP, (LAS float*)(lds + 131072)};
        pg8::gemm_phase<EpiInProj, pg8::StaticOrder, true, true>(lds, g, S, E);
    }
    xcd_barrier(xb);
    {
        { pg8::Gemm g{CQ, WUQ, NT, 768, 384}; pg8::StaticOrder S; S.init(NT, 768, G, bx); EpiQ E{SSQ, QM, COSM, SINM, (LAS float*)(lds + 131072)};
          pg8::gemm_phase<EpiQ, pg8::StaticOrder, true, true>(lds, g, S, E); }
        { pg8::Gemm g{CKV, WUKV, NT, 1024, 256}; pg8::StaticOrder S; S.init(NT, 1024, G, bx); EpiKV E{SSKV, KVM, (LAS float*)(lds + 131072)};
          pg8::gemm_phase<EpiKV, pg8::StaticOrder, true, true>(lds, g, S, E); }
        __syncthreads();
        AttnIO io{QM, KVM, KR, OMIX, QD, KD, VD, OD, LSE};
        dil_phase(lds, io, bx, G);
    }
    xcd_barrier(xb);
    {
        AttnIO io{QM, KVM, KR, OMIX, QD, KD, VD, OD, LSE};
        for (int u = bx; u < 256 * 8; u += G) attn_unit<false>(lds, io, u);
    }
    xcd_barrier(xb);
    for (int row = gw; row < NT; row += NGW) {
        {
            u32x4* p = (u32x4*)(OMIX + (size_t)row * 1024 + lane * 8); const u32x4 w = *p; float v[8];
#pragma unroll
            for (int e = 0; e < 4; ++e) { v[2 * e] = __uint_as_float(w[e] << 16); v[2 * e + 1] = __uint_as_float(w[e] & 0xffff0000u); }
            float s = 0.f;
#pragma unroll
            for (int e = 0; e < 8; ++e) s += v[e] * v[e];
            const float rs = rsqrtf(wave_sum(s) * (1.0f / 512.0f) + EPS);
            u32x4 o; o.x = cvt_pk_bf16(v[0] * rs, v[1] * rs); o.y = cvt_pk_bf16(v[2] * rs, v[3] * rs); o.z = cvt_pk_bf16(v[4] * rs, v[5] * rs); o.w = cvt_pk_bf16(v[6] * rs, v[7] * rs);
            *p = o;
        }
        {
            const int hd = lane >> 3;
            const float l0 = LSE[((size_t)0 * NT + row) * 8 + hd], l1 = LSE[((size_t)1 * NT + row) * 8 + hd], l2 = LSE[((size_t)2 * NT + row) * 8 + hd];
            const float mx = fmaxf(l0, fmaxf(l1, l2));
            float w0 = fast_exp2(l0 - mx), w1 = fast_exp2(l1 - mx), w2 = fast_exp2(l2 - mx);
            const float inv = 1.0f / (w0 + w1 + w2); w0 *= inv; w1 *= inv; w2 *= inv;
            float v[8];
#pragma unroll
            for (int e = 0; e < 8; ++e) v[e] = 0.f;
#pragma unroll
            for (int n = 0; n < 3; ++n) {
                const u32x4 w = *(const u32x4*)(OD + (size_t)n * NT * 512 + (size_t)row * 512 + lane * 8); const float wn = n == 0 ? w0 : (n == 1 ? w1 : w2);
#pragma unroll
                for (int e = 0; e < 4; ++e) { v[2 * e] += wn * __uint_as_float(w[e] << 16); v[2 * e + 1] += wn * __uint_as_float(w[e] & 0xffff0000u); }
            }
            float s = 0.f;
#pragma unroll
            for (int e = 0; e < 8; ++e) s += v[e] * v[e];
            const float rs = rsqrtf(wave_sum(s) * (1.0f / 512.0f) + EPS);
            u32x4 o; o.x = cvt_pk_bf16(v[0] * rs, v[1] * rs); o.y = cvt_pk_bf16(v[2] * rs, v[3] * rs); o.z = cvt_pk_bf16(v[4] * rs, v[5] * rs); o.w = cvt_pk_bf16(v[6] * rs, v[7] * rs);
            *(u32x4*)(OMIX + (size_t)row * 1024 + 512 + lane * 8) = o;
        }
    }
    xcd_barrier(xb);
    {
        pg8::Gemm g{OMIX, WOUT, NT, DM, DM}; pg8::StaticOrder S; S.init(NT, DM, G, bx);
        EpiResid E{XB, SS2, 1.0f};
        pg8::gemm_phase<EpiResid, pg8::StaticOrder, true, true>(lds, g, S, E);
    }
    xcd_barrier(xb);
    {
        pg8::Gemm g{XB, W2GU, NT, 2 * FF, DM}; pg8::StaticOrder S; S.init(NT, 2 * FF, G, bx);
        EpiGateUp E{HB, SS2, (LAS float*)(lds + 131072)};
        pg8::gemm_phase<EpiGateUp, pg8::StaticOrder, true, true>(lds, g, S, E);
    }
    xcd_barrier(xb);
    {
        pg8::Gemm g{HB, W2D, NT, DM, FF}; pg8::StaticOrder S; S.init(NT, DM, G, bx);
        EpiFinal E{XB, X, SS3, pan_cnt, g_fin, (LAS float*)(lds + 131072)};
        pg8::gemm_phase<EpiFinal, pg8::StaticOrder, true, true>(lds, g, S, E);
    }
}

extern "C" void kernel_launch(void* const* d_in, const int* in_sizes, int n_in, void* d_out, int out_size, void* d_ws, size_t ws_size, hipStream_t stream) {
    constexpr int LDS_BYTES = 147456; static_assert(DIL_LDS + 64 <= LDS_BYTES, "LDS map");
    static int grid = 0;
    if (grid == 0) {
        if (n_in != 19 || in_sizes[0] != NT * DM || out_size != NT * DM || ws_size < WS_END) {
            fprintf(stderr, "kernel_launch: unexpected problem geometry (n_in %d, in0 %d, out %d, ws %zu); nothing launched\n", n_in, n_in > 0 ? in_sizes[0] : -1, out_size, ws_size); grid = -1; return; }
        int dev = 0, cus = 0, per_cu = 0;
        hipGetDevice(&dev); hipDeviceGetAttribute(&cus, hipDeviceAttributeMultiprocessorCount, dev);
        if (hipFuncSetAttribute((const void*)mk_fwd, hipFuncAttributeMaxDynamicSharedMemorySize, LDS_BYTES) != hipSuccess) { fprintf(stderr, "kernel_launch: hipFuncSetAttribute failed\n"); grid = -1; return; }
        if (hipOccupancyMaxActiveBlocksPerMultiprocessor(&per_cu, (const void*)mk_fwd, NWAVES * 64, LDS_BYTES) != hipSuccess || per_cu < 1) { fprintf(stderr, "kernel_launch: occupancy query says %d blocks per CU\n", per_cu); per_cu = 1; }
        (void)hipGetLastError();
        grid = cus;
    }
    if (grid < 0) return;
    Args a{};
    for (int i = 0; i < 19; ++i) a.in[i] = (const float*)d_in[i];
    a.out = (float*)d_out; a.ws = (unsigned char*)d_ws;
    void* args[] = {&a};
    hipError_t e = hipLaunchCooperativeKernel((const void*)mk_fwd, dim3(grid), dim3(NWAVES * 64), args, LDS_BYTES, stream);
    if (e != hipSuccess) fprintf(stderr, "kernel_launch: cooperative launch failed: %s (grid %d)\n", hipGetErrorString(e), grid);
}
```

```cpp
#include <hip/hip_runtime.h>
#include <hip/hip_cooperative_groups.h>
#include <cmath>
#include <cstdio>
#include <cstdint>
namespace pg8 {
#define PG8_LAS __attribute__((address_space(3)))
typedef unsigned short bf16_t;
typedef short bf16x8 __attribute__((ext_vector_type(8)));
typedef float f32x4 __attribute__((ext_vector_type(4)));
typedef unsigned u32x4 __attribute__((ext_vector_type(4)));
constexpr int BM = 256, BK = 64, HALF = 128, HTB = HALF * BK * 2  , STAGE_BYTES = 8 * HTB, NXCD = 8, WGM = 8;

__host__ __device__ __forceinline__ int lds_byte(int r, int c) { const int st = (r >> 4) * 2 + (c >> 5), rr = r & 15, cc = c & 31, ob = rr * 64 + cc * 2; return st * 1024 + (ob ^ (((ob >> 9) & 1) << 5)); }
__host__ __device__ __forceinline__ void stage_rc(int b, int& R, int& C) { const int st = b / 1024, sb = b % 1024, swz = sb ^ (((sb >> 9) & 1) << 5); R = (st >> 1) * 16 + swz / 64; C = (st & 1) * 32 + (swz % 64) / 2; }
__host__ __device__ __forceinline__ int perm32(int rho) { const int n = rho >> 4, i = rho & 15; return 8 * (i >> 2) + 4 * n + (i & 3); }

struct Unit { int pm, pn; };
struct Gemm { const bf16_t* A; const bf16_t* Bt; int M, N, K; };

struct StaticOrder {
    int nM, nN, nwg, G, c;
    __host__ __device__ void init(int M, int N, int G_, int c_) { nM = M / BM; nN = N / BM; nwg = nM * nN; G = G_; c = c_; }
    __host__ __device__ bool next(int i, Unit& u) const {
        const long L = (long)i * G + c; if (L >= nwg) return false;
        int wgid = (int)L; { const int q = nwg / NXCD, r = nwg % NXCD, xcd = wgid % NXCD, off = wgid / NXCD; wgid = (xcd < r ? xcd * (q + 1) : r * (q + 1) + (xcd - r) * q) + off; }
        const int nig = WGM * nN, gid = wgid / nig, fm = gid * WGM, gsz = (nM - fm) < WGM ? (nM - fm) : WGM;
        u.pm = fm + ((wgid % nig) % gsz); u.pn = (wgid % nig) / gsz; return true;
    }
    __device__ __forceinline__ void a_ready(const Unit&) const {}
    __device__ __forceinline__ void done(const Unit&) const {}
};

__device__ __forceinline__ unsigned cvt_pk_bf16(float lo, float hi) { unsigned r; asm volatile("v_cvt_pk_bf16_f32 %0, %1, %2" : "=v"(r) : "v"(lo), "v"(hi)); return r; }

template <class Epi, class Sched, bool ALIGN_EPI = false, bool SP2 = false>
__device__ __forceinline__ void gemm_phase(PG8_LAS unsigned char* lds, const Gemm g, const Sched& S, const Epi& E) {
    int tid_ = threadIdx.x; asm volatile("" : "+v"(tid_));
    const int tid = tid_, wid = __builtin_amdgcn_readfirstlane(tid >> 6), lane = tid & 63, wr = wid >> 2, wc = wid & 3, fr = lane & 15, fq = lane >> 4;
    const int K = g.K, nt = K / BK;
    unsigned voffA[2], voffB[2];
#pragma unroll
    for (int i = 0; i < 2; ++i) { int R, C; stage_rc(tid * 16 + i * 8192, R, C); const int Rb = Epi::PERM ? ((R & ~31) + perm32(R & 31)) : R;
        voffA[i] = (unsigned)(R * K + C) * 2u; voffB[i] = (unsigned)(Rb * K + C) * 2u; }
    const size_t kstep = (size_t)(BK * 2);
    const size_t hstep = (size_t)HALF * K * 2;
    const size_t tstep = 2 * hstep;
    const unsigned ldsw = (unsigned)wid * 1024u;
    const int aoff = lds_byte(wr * 64 + fr, fq * 8), boff = lds_byte(wc * 32 + fr, fq * 8);
#define PG8_SA(b, h) (((b) * 2 + (h)) * HTB)
#define PG8_SB(b, h) ((4 + (b) * 2 + (h)) * HTB)
#define PG8_STAGE(bufoff, gbase, voff) do { _Pragma("unroll") for (int _i = 0; _i < 2; ++_i) \
        __builtin_amdgcn_global_load_lds((const unsigned*)((const char*)(gbase) + (voff)[_i]), (PG8_LAS unsigned*)(lds + (bufoff) + ldsw + _i * 8192), 16, 0, 0); } while (0)
#define PG8_LDA(dst, b, h) do { _Pragma("unroll") for (int m = 0; m < 4; ++m) _Pragma("unroll") for (int k = 0; k < 2; ++k) dst[m][k] = *(const PG8_LAS bf16x8*)(lds + PG8_SA(b, h) + aoff + m * 2048 + k * 1024); } while (0)
#define PG8_LDB(dst, b, h) do { _Pragma("unroll") for (int n = 0; n < 2; ++n) _Pragma("unroll") for (int k = 0; k < 2; ++k) dst[n][k] = *(const PG8_LAS bf16x8*)(lds + PG8_SB(b, h) + boff + n * 2048 + k * 1024); } while (0)
#define PG8_MMA(ai, bj, At, Bt) do { __builtin_amdgcn_s_setprio(1); _Pragma("unroll") for (int m = 0; m < 4; ++m) _Pragma("unroll") for (int n = 0; n < 2; ++n) _Pragma("unroll") for (int k = 0; k < 2; ++k) \
        acc[ai][bj][m][n] = __builtin_amdgcn_mfma_f32_16x16x32_bf16(Bt[n][k], At[m][k], acc[ai][bj][m][n], 0, 0, 0); __builtin_amdgcn_s_setprio(0); } while (0)
#define PG8_WAIT_V(n) asm volatile("s_waitcnt vmcnt(" #n ")" ::: "memory")
#define PG8_WAIT_L(n) asm volatile("s_waitcnt lgkmcnt(" #n ")" ::: "memory")
#define PG8_BAR __builtin_amdgcn_s_barrier()
#define PG8_SCHED __builtin_amdgcn_sched_barrier(0)
    Unit cur, nxt; int ui = 0;
    if (!S.next(0, cur)) return;
    f32x4 acc[2][2][4][2];
#pragma unroll
    for (int a = 0; a < 2; ++a)
#pragma unroll
        for (int b = 0; b < 2; ++b)
#pragma unroll
            for (int m = 0; m < 4; ++m)
#pragma unroll
                for (int n = 0; n < 2; ++n) acc[a][b][m][n] = (f32x4){0.f, 0.f, 0.f, 0.f};
    bf16x8 At[4][2], B0[2][2], B1[2][2];
    const char* cA = (const char*)g.A + (size_t)cur.pm * tstep; const char* cB = (const char*)g.Bt + (size_t)cur.pn * tstep;
    S.a_ready(cur);
    if constexpr (SP2) {
        PG8_STAGE(PG8_SB(0, 0), cB, voffB); PG8_STAGE(PG8_SB(0, 1), cB + hstep, voffB); PG8_STAGE(PG8_SA(0, 0), cA, voffA); PG8_STAGE(PG8_SA(0, 1), cA + hstep, voffA);
        if (wr == 1) PG8_BAR;
        PG8_WAIT_V(2); PG8_BAR;
        PG8_STAGE(PG8_SB(1, 0), cB + kstep, voffB); PG8_STAGE(PG8_SA(1, 0), cA + kstep, voffA); PG8_STAGE(PG8_SB(1, 1), cB + hstep + kstep, voffB);
        PG8_WAIT_V(6); PG8_BAR;
    } else {
        PG8_STAGE(PG8_SB(0, 0), cB, voffB); PG8_STAGE(PG8_SA(0, 0), cA, voffA); PG8_STAGE(PG8_SB(0, 1), cB + hstep, voffB); PG8_STAGE(PG8_SA(0, 1), cA + hstep, voffA);
        if (wr == 1) PG8_BAR;
        PG8_WAIT_V(4); PG8_BAR;
        PG8_STAGE(PG8_SB(1, 0), cB + kstep, voffB); PG8_STAGE(PG8_SA(1, 0), cA + kstep, voffA); PG8_STAGE(PG8_SB(1, 1), cB + hstep + kstep, voffB);
        PG8_WAIT_V(6); PG8_BAR;
    }
    for (;;) {
        const bool has_next = S.next(ui + 1, nxt);
        const char* nA = has_next ? (const char*)g.A + (size_t)nxt.pm * tstep : cA; const char* nB = has_next ? (const char*)g.Bt + (size_t)nxt.pn * tstep : cB;
        for (int t = 0; t < nt; t += 2) {
            const bool last = (t == nt - 2);
            const char* a1 = cA + (size_t)(t + 1) * kstep;
            const char* a2 = last ? nA : cA + (size_t)(t + 2) * kstep; const char* b2 = last ? nB : cB + (size_t)(t + 2) * kstep;
            const char* a3 = a2 + kstep; const char* b3 = b2 + kstep;
            if (last && has_next) S.a_ready(nxt);
            if constexpr (SP2) {
            PG8_LDB(B0, 0, 0); PG8_LDB(B1, 0, 1); PG8_SCHED; PG8_LDA(At, 0, 0); PG8_STAGE(PG8_SA(1, 1), a1 + hstep, voffA);
            PG8_WAIT_V(8); PG8_WAIT_L(0); PG8_BAR; PG8_MMA(0, 0, At, B0); PG8_MMA(0, 1, At, B1); PG8_BAR; PG8_SCHED;
            PG8_LDA(At, 0, 1); PG8_STAGE(PG8_SB(0, 0), b2, voffB); PG8_STAGE(PG8_SB(0, 1), b2 + hstep, voffB); PG8_STAGE(PG8_SA(0, 0), a2, voffA);
            PG8_WAIT_V(8); PG8_WAIT_L(0); PG8_BAR; PG8_MMA(1, 0, At, B0); PG8_MMA(1, 1, At, B1); PG8_BAR; PG8_SCHED;
            PG8_LDB(B0, 1, 0); PG8_LDB(B1, 1, 1); PG8_SCHED; PG8_LDA(At, 1, 0); PG8_STAGE(PG8_SA(0, 1), a2 + hstep, voffA);
            PG8_WAIT_V(8); PG8_WAIT_L(0); PG8_BAR; PG8_MMA(0, 0, At, B0); PG8_MMA(0, 1, At, B1); PG8_BAR; PG8_SCHED;
            PG8_LDA(At, 1, 1); PG8_STAGE(PG8_SB(1, 0), b3, voffB); PG8_STAGE(PG8_SB(1, 1), b3 + hstep, voffB); PG8_STAGE(PG8_SA(1, 0), a3, voffA);
            PG8_WAIT_V(8); PG8_WAIT_L(0); PG8_BAR; PG8_MMA(1, 0, At, B0); PG8_MMA(1, 1, At, B1); PG8_BAR; PG8_SCHED;
            } else {
            PG8_LDB(B0, 0, 0); PG8_SCHED; PG8_LDA(At, 0, 0); PG8_STAGE(PG8_SA(1, 1), a1 + hstep, voffA);
            PG8_WAIT_L(8); PG8_BAR; PG8_WAIT_L(0); PG8_MMA(0, 0, At, B0); PG8_BAR; PG8_SCHED;
            PG8_LDB(B1, 0, 1); PG8_STAGE(PG8_SB(0, 0), b2, voffB);
            PG8_BAR; PG8_WAIT_L(0); PG8_MMA(0, 1, At, B1); PG8_BAR;
            PG8_LDA(At, 0, 1); PG8_STAGE(PG8_SA(0, 0), a2, voffA);
            PG8_BAR; PG8_WAIT_L(0); PG8_MMA(1, 0, At, B0); PG8_BAR; PG8_SCHED;
            PG8_STAGE(PG8_SB(0, 1), b2 + hstep, voffB);
            PG8_WAIT_V(6); PG8_BAR; PG8_MMA(1, 1, At, B1); PG8_BAR;
            PG8_LDB(B0, 1, 0); PG8_SCHED; PG8_LDA(At, 1, 0); PG8_STAGE(PG8_SA(0, 1), a2 + hstep, voffA);
            PG8_WAIT_L(8); PG8_BAR; PG8_WAIT_L(0); PG8_MMA(0, 0, At, B0); PG8_BAR; PG8_SCHED;
            PG8_LDB(B1, 1, 1); PG8_STAGE(PG8_SB(1, 0), b3, voffB);
            PG8_BAR; PG8_WAIT_L(0); PG8_MMA(0, 1, At, B1); PG8_BAR;
            PG8_LDA(At, 1, 1); PG8_STAGE(PG8_SA(1, 0), a3, voffA);
            PG8_BAR; PG8_WAIT_L(0); PG8_MMA(1, 0, At, B0); PG8_BAR; PG8_SCHED;
            PG8_STAGE(PG8_SB(1, 1), b3 + hstep, voffB);
            PG8_WAIT_V(6); PG8_BAR; PG8_MMA(1, 1, At, B1); PG8_BAR;
            }
        }
        if constexpr (ALIGN_EPI) { if (wr == 0) PG8_BAR; }
        if constexpr (!Epi::AFTER_DRAIN) { E(acc, cur, wr, wc, fr, fq); S.done(cur); }
        if (!has_next) break;
#pragma unroll
        for (int a = 0; a < 2; ++a)
#pragma unroll
            for (int b = 0; b < 2; ++b)
#pragma unroll
                for (int m = 0; m < 4; ++m)
#pragma unroll
                    for (int n = 0; n < 2; ++n) acc[a][b][m][n] = (f32x4){0.f, 0.f, 0.f, 0.f};
        cur = nxt; cA = nA; cB = nB; ++ui;
        if constexpr (ALIGN_EPI) { if (wr == 1) PG8_BAR; }
    }
    PG8_WAIT_V(0);
    if constexpr (!ALIGN_EPI) { if (wr == 0) PG8_BAR; }
    PG8_BAR;
    if constexpr (Epi::AFTER_DRAIN) { E.fused(acc, cur, wr, wc, fr, fq, lds, wid, lane); S.done(cur); }
#undef PG8_SA
#undef PG8_SB
#undef PG8_STAGE
#undef PG8_LDA
#undef PG8_LDB
#undef PG8_MMA
#undef PG8_WAIT_V
#undef PG8_WAIT_L
#undef PG8_BAR
#undef PG8_SCHED
}
}

namespace cg = cooperative_groups;

#define LAS __attribute__((address_space(3)))
typedef unsigned short bf16_t;
typedef float f32x4 __attribute__((ext_vector_type(4)));
typedef float f32x16 __attribute__((ext_vector_type(16)));
typedef short bf16x8 __attribute__((ext_vector_type(8)));
typedef short s16x4 __attribute__((ext_vector_type(4)));
typedef unsigned u32x2 __attribute__((ext_vector_type(2)));
typedef unsigned u32x4 __attribute__((ext_vector_type(4)));
using pg8::Unit;
typedef float f32x2_t __attribute__((ext_vector_type(2))); typedef __bf16 bf16x2_t __attribute__((ext_vector_type(2)));
__device__ __forceinline__ unsigned cvt_pk_bf16(float lo, float hi) { const f32x2_t v = {lo, hi}; const bf16x2_t b = __builtin_convertvector(v, bf16x2_t); return __builtin_bit_cast(unsigned, b); }

constexpr int NT = 65536, SEQ = 2048, DM = 1024, FF = 2816, NWAVES = 8;
constexpr float EPS = 1e-6f, LOG2E = 1.4426950408889634f;
constexpr float QSCALE_D = 0.125f * LOG2E;
constexpr float QSCALE_M = 0.10206207261596577f * LOG2E;

constexpr size_t MiB = 1u << 20;
constexpr size_t WS_W1GU = 0, WS_W1D = 11 * MiB, WS_W2GU = 17 * MiB, WS_W2D = 28 * MiB, WS_WIN = 34 * MiB, WS_WUQ = 39 * MiB, WS_WUKV = 40 * MiB, WS_WOUT = 41 * MiB;
constexpr size_t WS_ROPE = 43 * MiB;
constexpr size_t WS_SS0 = 44 * MiB, WS_SS1 = 48 * MiB, WS_SS2 = 52 * MiB, WS_SS3 = 56 * MiB, WS_SSQ = 60 * MiB, WS_SSKV = 62 * MiB;
constexpr size_t WS_BAR = 63 * MiB;
constexpr size_t WS_XB = 64 * MiB;
constexpr size_t WS_KVM = WS_XB;
constexpr size_t WS_H = 192 * MiB;
constexpr size_t WS_OD0 = 192 * MiB, WS_OD1 = 256 * MiB, WS_OD2 = 320 * MiB, WS_OMIX = 384 * MiB, WS_LSE = 512 * MiB;
constexpr size_t WS_QD = 544 * MiB, WS_KD = 608 * MiB, WS_VD = 672 * MiB, WS_CQ = 736 * MiB, WS_CKV = 784 * MiB, WS_KR = 816 * MiB, WS_QM = 820 * MiB, WS_END = 916 * MiB;

__device__ __forceinline__ float fast_exp2(float x) { return __builtin_amdgcn_exp2f(x); }
__device__ __forceinline__ float fast_rcp(float x) { return __builtin_amdgcn_rcpf(x); }
__device__ __forceinline__ float bf2f(unsigned short b) { return __uint_as_float((unsigned)b << 16); }
__device__ __forceinline__ float sum4(f32x4 a) { return (a[0] + a[1]) + (a[2] + a[3]); }
__device__ __forceinline__ float sq4(f32x4 a) { return (a[0] * a[0] + a[1] * a[1]) + (a[2] * a[2] + a[3] * a[3]); }
__device__ __forceinline__ float rstd_parts16(const float* ss, int row, float invn) {
    const f32x4* p = (const f32x4*)(ss + (size_t)row * 16);
    const float s = (sum4(p[0]) + sum4(p[1])) + (sum4(p[2]) + sum4(p[3]));
    return rsqrtf(s * invn + EPS);
}

#define EPI_RELANE() int fr, fq; { int t_ = threadIdx.x; asm volatile("" : "+v"(t_)); fr = t_ & 15; fq = (t_ >> 4) & 3; }
struct EpiGateUp {
    static constexpr bool PERM = true, AFTER_DRAIN = false;
    bf16_t* H; const float* ss; LAS float* tab;
    __device__ __forceinline__ void operator()(const f32x4 (&acc)[2][2][4][2], const Unit& u, int wr, int wc, int fr_in, int fq_in) const {
        EPI_RELANE();
        int tid = threadIdx.x; asm volatile("" : "+v"(tid));
        if (tid < 256) tab[tid] = rstd_parts16(ss, u.pm * 256 + tid, 1.0f / 1024.0f);
        __syncthreads();
        const int r0 = wr * 64 + fr, col = u.pn * 128 + wc * 32 + 8 * fq;
#pragma unroll
        for (int ai = 0; ai < 2; ++ai)
#pragma unroll
            for (int m = 0; m < 4; ++m) {
                const int r = r0 + ai * 128 + m * 16;
                const float rs = tab[r], nrs = -rs * LOG2E;
                float o[8];
#pragma unroll
                for (int n = 0; n < 2; ++n)
#pragma unroll
                    for (int j = 0; j < 4; ++j) {
                        const float ga = acc[ai][0][m][n][j];
                        o[4 * n + j] = (ga * rs) * fast_rcp(1.0f + fast_exp2(ga * nrs)) * (acc[ai][1][m][n][j] * rs);
                    }
                u32x4 w; w.x = cvt_pk_bf16(o[0], o[1]); w.y = cvt_pk_bf16(o[2], o[3]); w.z = cvt_pk_bf16(o[4], o[5]); w.w = cvt_pk_bf16(o[6], o[7]);
                *(u32x4*)(H + (size_t)(u.pm * 256 + r) * FF + col) = w;
            }
    }
};
struct EpiResid {
    static constexpr bool PERM = false, AFTER_DRAIN = false;
    bf16_t* xb; float* ss; float alpha;
    __device__ __forceinline__ void operator()(const f32x4 (&acc)[2][2][4][2], const Unit& u, int wr, int wc, int fr_in, int fq_in) const {
        EPI_RELANE();
        const int row0 = u.pm * 256 + wr * 64 + fr, col0 = u.pn * 256 + wc * 32 + 4 * fq;
        u32x2 bws[2][4][2][2];
#pragma unroll
        for (int ai = 0; ai < 2; ++ai)
#pragma unroll
            for (int m = 0; m < 4; ++m)
#pragma unroll
                for (int bj = 0; bj < 2; ++bj)
#pragma unroll
                    for (int n = 0; n < 2; ++n) bws[ai][m][bj][n] = *(const u32x2*)(xb + (size_t)(row0 + ai * 128 + m * 16) * DM + col0 + bj * 128 + n * 16);
#pragma unroll
        for (int ai = 0; ai < 2; ++ai)
#pragma unroll
            for (int m = 0; m < 4; ++m) {
                const int row = row0 + ai * 128 + m * 16; float sq = 0.f;
#pragma unroll
                for (int bj = 0; bj < 2; ++bj)
#pragma unroll
                    for (int n = 0; n < 2; ++n) {
                        u32x2* p = (u32x2*)(xb + (size_t)row * DM + col0 + bj * 128 + n * 16);
                        const u32x2 bw = bws[ai][m][bj][n];
                        const f32x4 b = {__uint_as_float(bw.x << 16), __uint_as_float(bw.x & 0xffff0000u), __uint_as_float(bw.y << 16), __uint_as_float(bw.y & 0xffff0000u)};
                        const f32x4 v = b + acc[ai][bj][m][n] * alpha; sq += sq4(v);
                        u32x2 w; w.x = cvt_pk_bf16(v[0], v[1]); w.y = cvt_pk_bf16(v[2], v[3]); *p = w;
                    }
                sq += __shfl_xor(sq, 16); sq += __shfl_xor(sq, 32);
                if (fq == 0) ss[(size_t)row * 16 + u.pn * 4 + wc] = sq;
            }
    }
};
struct EpiFinal {
    static constexpr bool PERM = false, AFTER_DRAIN = false;
    const bf16_t* xb; float* X; float* ss; unsigned* cnt; const float* gfin; LAS float* tab;
    __device__ __forceinline__ void operator()(f32x4 (&acc)[2][2][4][2], const Unit& u, int wr, int wc, int fr_in, int fq_in) const {
        EPI_RELANE();
        int tid = threadIdx.x; asm volatile("" : "+v"(tid));
        const int row0 = u.pm * 256 + wr * 64 + fr, col0 = u.pn * 256 + wc * 32 + 4 * fq;
        u32x2 bws[2][4][2][2];
#pragma unroll
        for (int ai = 0; ai < 2; ++ai)
#pragma unroll
            for (int m = 0; m < 4; ++m)
#pragma unroll
                for (int bj = 0; bj < 2; ++bj)
#pragma unroll
                    for (int n = 0; n < 2; ++n) bws[ai][m][bj][n] = *(const u32x2*)(xb + (size_t)(row0 + ai * 128 + m * 16) * DM + col0 + bj * 128 + n * 16);
#pragma unroll
        for (int ai = 0; ai < 2; ++ai)
#pragma unroll
            for (int m = 0; m < 4; ++m) {
                const int row = row0 + ai * 128 + m * 16; float sq = 0.f;
#pragma unroll
                for (int bj = 0; bj < 2; ++bj)
#pragma unroll
                    for (int n = 0; n < 2; ++n) {
                        const u32x2 bw = bws[ai][m][bj][n];
                        const f32x4 b = {__uint_as_float(bw.x << 16), __uint_as_float(bw.x & 0xffff0000u), __uint_as_float(bw.y << 16), __uint_as_float(bw.y & 0xffff0000u)};
                        const f32x4 v = b + acc[ai][bj][m][n] * 0.5f; acc[ai][bj][m][n] = v; sq += sq4(v);
                    }
                sq += __shfl_xor(sq, 16); sq += __shfl_xor(sq, 32);
                if (fq == 0) ss[(size_t)row * 16 + u.pn * 4 + wc] = sq;
            }
        asm volatile("s_waitcnt vmcnt(0)" ::: "memory");
        __syncthreads();
        if (tid == 0) {
            unsigned* c = cnt + 64 * u.pm;
            __builtin_amdgcn_fence(__ATOMIC_RELEASE, "agent"); asm volatile("s_waitcnt vmcnt(0)" ::: "memory");
            __hip_atomic_fetch_add(c, 1u, __ATOMIC_RELAXED, __HIP_MEMORY_SCOPE_AGENT);
            unsigned sp = 0;
            while (__hip_atomic_load(c, __ATOMIC_RELAXED, __HIP_MEMORY_SCOPE_AGENT) < 4u) { __builtin_amdgcn_s_sleep(2); if (++sp > (1u << 22)) break; }
            __builtin_amdgcn_fence(__ATOMIC_ACQUIRE, "agent"); asm volatile("s_waitcnt vmcnt(0)" ::: "memory");
        }
        __syncthreads();
        if (tid < 256) tab[tid] = rstd_parts16(ss, u.pm * 256 + tid, 1.0f / 1024.0f);
        __syncthreads();
#pragma unroll
        for (int ai = 0; ai < 2; ++ai)
#pragma unroll
            for (int m = 0; m < 4; ++m) {
                const int r = ai * 128 + wr * 64 + m * 16 + fr; const float rs = tab[r];
#pragma unroll
                for (int bj = 0; bj < 2; ++bj)
#pragma unroll
                    for (int n = 0; n < 2; ++n) {
                        const int col = col0 + bj * 128 + n * 16;
                        const f32x4 g = *(const f32x4*)(gfin + col);
                        *(f32x4*)(X + (size_t)(u.pm * 256 + r) * DM + col) = acc[ai][bj][m][n] * rs * g;
                    }
            }
    }
};
struct EpiInProj {
    static constexpr bool PERM = false, AFTER_DRAIN = false;
    const float* ss1; bf16_t *QD, *KD, *VD, *CQ, *CKV, *KR; float *SSQ, *SSKV; const float *cosm, *sinm, *cosp, *sinp; LAS float* tab;
    __device__ __forceinline__ void operator()(const f32x4 (&acc)[2][2][4][2], const Unit& u, int wr, int wc, int fr_in, int fq_in) const {
        EPI_RELANE();
        { int tid = threadIdx.x; asm volatile("" : "+v"(tid)); if (tid < 256) tab[tid] = rstd_parts16(ss1, u.pm * 256 + tid, 1.0f / 1024.0f); }
        const int row0 = u.pm * 256 + wr * 64 + fr, pn = u.pn;
        const bool ropeP = (pn < 4) && ((wc & 1) == 0), ropeM = (pn == 7) && (wc == 0);
        f32x4 cs[2][4], sn[2][4];
        if (ropeP || ropeM) {
#pragma unroll
            for (int ai = 0; ai < 2; ++ai)
#pragma unroll
                for (int m = 0; m < 4; ++m) { const int pos = (row0 + ai * 128 + m * 16) & (SEQ - 1);
                    const float* cp = ropeP ? cosp + pos * 8 + 4 * (fq & 1) : cosm + pos * 16 + 4 * fq; const float* sp = ropeP ? sinp + pos * 8 + 4 * (fq & 1) : sinm + pos * 16 + 4 * fq;
                    cs[ai][m] = *(const f32x4*)cp; sn[ai][m] = *(const f32x4*)sp; }
        }
        __syncthreads();
#pragma unroll
        for (int ai = 0; ai < 2; ++ai)
#pragma unroll
            for (int m = 0; m < 4; ++m) {
                const int row = row0 + ai * 128 + m * 16, pos = row & (SEQ - 1);
                const float rs = tab[ai * 128 + wr * 64 + m * 16 + fr];
                if (pn < 6) {
                    bf16_t* dst = QD + (size_t)(pn >> 1) * ((size_t)NT * 512) + (size_t)row * 512 + (pn & 1) * 256 + wc * 32 + 4 * fq;
                    const float sc = pn < 2 ? rs * QSCALE_D : rs;
                    const bool rope = (pn < 4) && ((wc & 1) == 0);
#pragma unroll
                    for (int bj = 0; bj < 2; ++bj)
#pragma unroll
                        for (int n = 0; n < 2; ++n) {
                            f32x4 v = acc[ai][bj][m][n] * sc;
                            if (n == 0 && rope) {
                                f32x4 pv; pv[0] = __shfl_xor(v[0], 32); pv[1] = __shfl_xor(v[1], 32); pv[2] = __shfl_xor(v[2], 32); pv[3] = __shfl_xor(v[3], 32);
                                const f32x4 c = cs[ai][m], s = sn[ai][m];
                                v = (fq < 2) ? (v * c - pv * s) : (v * c + pv * s);
                            }
                            u32x2 w; w.x = cvt_pk_bf16(v[0], v[1]); w.y = cvt_pk_bf16(v[2], v[3]);
                            *(u32x2*)(dst + bj * 128 + n * 16) = w;
                        }
                } else if (pn == 6 || pn == 8) {
                    bf16_t* dst = CQ + (pn == 6 ? (size_t)row * 384 : (size_t)NT * 384 + (size_t)row * 256) + wc * 32 + 4 * fq; float sq = 0.f;
#pragma unroll
                    for (int bj = 0; bj < 2; ++bj)
#pragma unroll
                        for (int n = 0; n < 2; ++n) {
                            const f32x4 v = acc[ai][bj][m][n] * rs; sq += sq4(v);
                            u32x2 w; w.x = cvt_pk_bf16(v[0], v[1]); w.y = cvt_pk_bf16(v[2], v[3]);
                            *(u32x2*)(dst + bj * 128 + n * 16) = w;
                        }
                    sq += __shfl_xor(sq, 16); sq += __shfl_xor(sq, 32);
                    if (fq == 0) SSQ[(pn == 6 ? (size_t)row * 8 : (size_t)NT * 8 + (size_t)row * 4) + wc] = sq;
                } else {
                    bf16_t* dst = CQ + (size_t)row * 384 + 256 + wc * 32 + 4 * fq; float sq = 0.f;
#pragma unroll
                    for (int n = 0; n < 2; ++n) {
                        const f32x4 v = acc[ai][0][m][n] * rs; sq += sq4(v);
                        u32x2 w; w.x = cvt_pk_bf16(v[0], v[1]); w.y = cvt_pk_bf16(v[2], v[3]);
                        *(u32x2*)(dst + n * 16) = w;
                    }
                    sq += __shfl_xor(sq, 16); sq += __shfl_xor(sq, 32);
                    if (fq == 0) SSQ[(size_t)row * 8 + 4 + wc] = sq;
                    if (wc == 0) {
                        const f32x4 x1 = acc[ai][1][m][0] * rs, x2 = acc[ai][1][m][1] * rs;
                        const f32x4 c = cs[ai][m], s = sn[ai][m];
                        const f32x4 o1 = x1 * c - x2 * s, o2 = x2 * c + x1 * s;
                        u32x2 w1, w2; w1.x = cvt_pk_bf16(o1[0], o1[1]); w1.y = cvt_pk_bf16(o1[2], o1[3]); w2.x = cvt_pk_bf16(o2[0], o2[1]); w2.y = cvt_pk_bf16(o2[2], o2[3]);
                        *(u32x2*)(KR + (size_t)row * 32 + 4 * fq) = w1; *(u32x2*)(KR + (size_t)row * 32 + 16 + 4 * fq) = w2;
                    }
                }
            }
    }
};
struct EpiQ {
    static constexpr bool PERM = false, AFTER_DRAIN = false;
    const float* ssq; bf16_t* QM; const float *cosm, *sinm; LAS float* tab;
    __device__ __forceinline__ void operator()(const f32x4 (&acc)[2][2][4][2], const Unit& u, int wr, int wc, int fr_in, int fq_in) const {
        EPI_RELANE();
        const int row0 = u.pm * 256 + wr * 64 + fr;
        { int tid = threadIdx.x; asm volatile("" : "+v"(tid));
          if (tid < 256) { const f32x4* p = (const f32x4*)(ssq + (size_t)(u.pm * 256 + tid) * 8); tab[tid] = rsqrtf((sum4(p[0]) + sum4(p[1])) * (1.0f / 384.0f) + EPS) * QSCALE_M; } }
        __syncthreads();
#pragma unroll
        for (int ai = 0; ai < 2; ++ai) {
#pragma unroll
            for (int m = 0; m < 4; ++m) {
                const int row = row0 + ai * 128 + m * 16;
                const float rs = tab[ai * 128 + wr * 64 + m * 16 + fr];
#pragma unroll
                for (int bj = 0; bj < 2; ++bj) {
                    const int g32 = 8 * u.pn + 4 * bj + wc;
                    bf16_t* dst = QM + (size_t)row * 768 + 32 * g32 + 4 * fq;
                    f32x4 v0 = acc[ai][bj][m][0] * rs, v1 = acc[ai][bj][m][1] * rs;
                    if (g32 % 3 == 2) {
                        const int pos = row & (SEQ - 1);
                        const f32x4 c = *(const f32x4*)(cosm + pos * 16 + 4 * fq), s = *(const f32x4*)(sinm + pos * 16 + 4 * fq);
                        const f32x4 o1 = v0 * c - v1 * s, o2 = v1 * c + v0 * s; v0 = o1; v1 = o2;
                    }
                    u32x2 w0, w1; w0.x = cvt_pk_bf16(v0[0], v0[1]); w0.y = cvt_pk_bf16(v0[2], v0[3]); w1.x = cvt_pk_bf16(v1[0], v1[1]); w1.y = cvt_pk_bf16(v1[2], v1[3]);
                    *(u32x2*)dst = w0; *(u32x2*)(dst + 16) = w1;
                }
            }
        }
    }
};
struct EpiKV {
    static constexpr bool PERM = true, AFTER_DRAIN = false;
    const float* sskv; bf16_t* KVM; LAS float* tab;
    __device__ __forceinline__ void operator()(const f32x4 (&acc)[2][2][4][2], const Unit& u, int wr, int wc, int fr_in, int fq_in) const {
        EPI_RELANE();
        { int tid = threadIdx.x; asm volatile("" : "+v"(tid)); if (tid < 256) tab[tid] = rsqrtf(sum4(*(const f32x4*)(sskv + (size_t)(u.pm * 256 + tid) * 4)) * (1.0f / 256.0f) + EPS); }
        __syncthreads();
        const int row0 = u.pm * 256 + wr * 64 + fr, col = u.pn * 256 + wc * 32 + 8 * fq;
#pragma unroll
        for (int ai = 0; ai < 2; ++ai)
#pragma unroll
            for (int m = 0; m < 4; ++m) {
                const int row = row0 + ai * 128 + m * 16;
                const float rs = tab[ai * 128 + wr * 64 + m * 16 + fr];
#pragma unroll
                for (int bj = 0; bj < 2; ++bj) {
                    const f32x4 v0 = acc[ai][bj][m][0] * rs, v1 = acc[ai][bj][m][1] * rs;
                    u32x4 w; w.x = cvt_pk_bf16(v0[0], v0[1]); w.y = cvt_pk_bf16(v0[2], v0[3]); w.z = cvt_pk_bf16(v1[0], v1[1]); w.w = cvt_pk_bf16(v1[2], v1[3]);
                    *(u32x4*)(KVM + (size_t)row * 1024 + col + bj * 128) = w;
                }
            }
    }
};

constexpr int ATT_VS = 192;
constexpr int ATT_TILE = 64 * 208 + 64 * ATT_VS;
constexpr int ATT_OST = 2 * ATT_TILE, ATT_WSC = ATT_OST + NWAVES * 4096;
static_assert(ATT_WSC + NWAVES * 256 <= 131072, "attention LDS");
static_assert(WS_KD == WS_QD + (size_t)NT * 512 * 2 && WS_VD == WS_KD + (size_t)NT * 512 * 2 && WS_CKV == WS_CQ + (size_t)NT * 384 * 2 && WS_SSKV == WS_SSQ + (size_t)NT * 8 * 4, "buffers addressed relative to each other");
__device__ __forceinline__ int crow(int r, int hi) { return (r & 3) + 8 * (r >> 2) + 4 * hi; }
__device__ __forceinline__ bf16x8 pack8(const f32x16& p, int b) {
    u32x4 w; w.x = cvt_pk_bf16(p[b], p[b + 1]); w.y = cvt_pk_bf16(p[b + 2], p[b + 3]); w.z = cvt_pk_bf16(p[b + 4], p[b + 5]); w.w = cvt_pk_bf16(p[b + 6], p[b + 7]);
    return __builtin_bit_cast(bf16x8, w);
}
typedef short v4i16_t __attribute__((ext_vector_type(4)));
__device__ __forceinline__ s16x4 vtr(LAS const unsigned char* p) { return __builtin_bit_cast(s16x4, __builtin_amdgcn_ds_read_tr16_b64_v4i16((LAS v4i16_t*)p)); }

struct AttnIO {
    const bf16_t *QM, *KVM, *KR; bf16_t* OMIX;
    const bf16_t *QD, *KD, *VD; bf16_t* OD; float* LSE;
};

template <bool DIL>
__device__ __forceinline__ void attn_unit(LAS unsigned char* lds, const AttnIO& io, int unit) {
    constexpr int DK = DIL ? 64 : 96, KS = DK * 2 + 16, NKS = DK / 16;
    int tid_ = threadIdx.x; asm volatile("" : "+v"(tid_));
    const int tid = tid_, lane = tid & 63, wid = __builtin_amdgcn_readfirstlane(tid >> 6), r32 = lane & 31, hi = lane >> 5;
    int b, h, ntiles, tlo, thi, kofs = 0, L = SEQ, dil = 1, res = 0, resu = 0, br = 0, q0 = 0, pq;
    if constexpr (!DIL) {
        const int bh = unit >> 3, qb = unit & 7; b = bh >> 3; h = bh & 7; ntiles = 32; tlo = 0; thi = 32; q0 = qb * 256; pq = q0 + wid * 32 + r32;
    } else {
        const int bh = unit / 24, k = unit % 24, j = k & 7; br = k >> 3; b = bh >> 3; h = bh & 7;
        if (br == 0) { dil = 1; L = 2048; resu = 0; q0 = 256 * j; }
        else if (br == 1) { dil = 4; L = 512; resu = j >> 1; q0 = 256 * (j & 1); }
        else { dil = 16; L = 128; resu = 2 * j; q0 = 0; }
        if (br < 2) { ntiles = 6; tlo = wid >> 1; thi = tlo + 3; kofs = q0 - 64; pq = q0 + wid * 32 + r32; res = resu; }
        else { const int hw = wid >> 2; ntiles = 4; tlo = 2 * hw; thi = tlo + 2; kofs = -128 * hw; pq = (wid & 3) * 32 + r32; res = resu + hw; }
    }
    const int pq0 = pq - r32;
    const size_t kb = (size_t)b * SEQ;
    bf16x8 qf[NKS];
    {
        const bf16_t* qp = DIL ? io.QD + (kb + (size_t)pq * dil + res) * 512 + h * 64 : io.QM + (kb + pq) * 768 + h * 96;
#pragma unroll
        for (int ks = 0; ks < NKS; ++ks) qf[ks] = *(const bf16x8*)(qp + ks * 16 + hi * 8);
    }
    const int lrow = tid >> 3, lch = tid & 7, rrow = (tid >> 2) & 63, rch = tid & 3;
    u32x4 gkA, gvA, grA = (u32x4){0u, 0u, 0u, 0u}, gkB, gvB, grB = (u32x4){0u, 0u, 0u, 0u};
#define ATT_TOK(t) \
        const int s_ = 64 * (t) + lrow; size_t tok_; \
        if (br < 2) { int p_ = q0 - 64 + s_; p_ = p_ < 0 ? 0 : (p_ > L - 1 ? L - 1 : p_); tok_ = kb + (size_t)p_ * dil + resu; } \
        else { tok_ = kb + (size_t)(s_ & 127) * 16 + (size_t)(resu + (s_ >> 7)); }
#define ATT_GLOADK(t, GK, GR) do { \
        if constexpr (!DIL) { \
            GK = *(const u32x4*)(io.KVM + (kb + 64 * (t) + lrow) * 1024 + h * 128 + lch * 8); \
            GR = *(const u32x4*)(io.KR + (kb + 64 * (t) + rrow) * 32 + rch * 8); \
        } else { ATT_TOK(t) GK = *(const u32x4*)(io.KD + tok_ * 512 + h * 64 + lch * 8); } } while (0)
#define ATT_GLOADV(t, GV) do { \
        if constexpr (!DIL) { GV = *(const u32x4*)(io.KVM + (kb + 64 * (t) + lrow) * 1024 + h * 128 + 64 + lch * 8); } \
        else { ATT_TOK(t) GV = *(const u32x4*)(io.VD + tok_ * 512 + h * 64 + lch * 8); } } while (0)
#define ATT_LSTOREK(buf, GK, GR) do { \
        LAS unsigned char* Kb_ = lds + (buf) * ATT_TILE; \
        *(LAS u32x4*)(Kb_ + lrow * KS + lch * 16) = GK; \
        if constexpr (!DIL) { *(LAS u32x4*)(Kb_ + rrow * KS + 128 + rch * 16) = GR; } } while (0)
#define ATT_LSTOREV(buf, GV) do { *(LAS u32x4*)(lds + (buf) * ATT_TILE + 64 * KS + lrow * ATT_VS + lch * 16) = GV; } while (0)
#define ATT_SB() do {} while (0)
    LAS float* wsc = (LAS float*)(lds + ATT_WSC + wid * 256);
    f32x16 o0 = {}, o1 = {}, negm = {};
    float mref = 0.f, lrun = 0.f; bool started = false;
    const int krow = (r32 & 19) | ((r32 & 4) << 1) | ((r32 & 8) >> 1);
    const int koff = krow * KS + hi * 16;
    const int i16 = lane & 15, g16 = lane >> 4;
    const int voff = 64 * KS + (8 * hi + (i16 >> 2)) * ATT_VS + (16 * (g16 & 1) + 4 * (i16 & 3)) * 2;
    ATT_GLOADK(0, gkA, grA); ATT_GLOADV(0, gvA); ATT_GLOADK(1, gkB, grB); ATT_LSTOREK(0, gkA, grA); ATT_LSTOREV(0, gvA); ATT_LSTOREK(1, gkB, grB);
    ATT_GLOADK(2, gkB, grB); ATT_GLOADV(1, gvB);
    __syncthreads();
    f32x16 c0, c1;
    if (tlo == 0) {
        c0 = negm; c1 = negm;
#pragma unroll
        for (int ks = 0; ks < NKS; ++ks) {
            const bf16x8 a0 = *(LAS const bf16x8*)(lds + koff + ks * 32), a1 = *(LAS const bf16x8*)(lds + koff + 32 * KS + ks * 32);
            c0 = __builtin_amdgcn_mfma_f32_32x32x16_bf16(a0, qf[ks], c0, 0, 0, 0); c1 = __builtin_amdgcn_mfma_f32_32x32x16_bf16(a1, qf[ks], c1, 0, 0, 0);
        }
    } else { c0 = negm; c1 = negm; }
    __syncthreads();
    for (int t2 = 0; t2 < ntiles; t2 += 2) {
      { const int t = t2;
        ATT_GLOADK(min(t + 3, ntiles - 1), gkA, grA);
        ATT_GLOADV(min(t + 2, ntiles - 1), gvA);
        const bool doP = (t >= tlo) && (t < thi), doS = (t + 1 >= tlo) && (t + 1 < thi);
        LAS const unsigned char* Kn = lds + ((t + 1) & 1) * ATT_TILE + koff;
        LAS const unsigned char* Vc = lds + (t & 1) * ATT_TILE + voff;
        f32x16 n0 = negm, n1 = negm;
        if (doP) {
            if constexpr (DIL) {
                const int P0 = 64 * t + kofs;
                const bool full = (P0 >= pq0 - 33) && (P0 + 63 <= pq0 + 64) && (P0 >= 0) && (P0 + 63 < L);
                if (!full) {
                    const int lo = max(pq - 64, 0) - P0 - 8 * hi, span = min(pq + 64, L - 1) - max(pq - 64, 0);
#pragma unroll
                    for (int r = 0; r < 16; ++r) {
                        const int i0 = 16 * (r >> 3) + (r & 7);
                        c0[r] = ((unsigned)(i0 - lo) <= (unsigned)span) ? c0[r] : -INFINITY;
                        c1[r] = ((unsigned)(i0 + 32 - lo) <= (unsigned)span) ? c1[r] : -INFINITY;
                    }
                }
            }
            float ma = fmaxf(fmaxf(c0[0], c0[1]), c1[0]), mb = fmaxf(fmaxf(c0[2], c0[3]), c1[1]);
            ma = fmaxf(fmaxf(ma, c1[2]), c1[3]);
#pragma unroll
            for (int r = 4; r < 16; r += 4) { ma = fmaxf(fmaxf(ma, c0[r]), c0[r + 1]); mb = fmaxf(fmaxf(mb, c0[r + 2]), c0[r + 3]); ma = fmaxf(fmaxf(ma, c1[r]), c1[r + 1]); mb = fmaxf(fmaxf(mb, c1[r + 2]), c1[r + 3]); }
            float rm = fmaxf(ma, mb);
            { auto rr = __builtin_amdgcn_permlane32_swap(__float_as_uint(rm), __float_as_uint(rm), false, false); rm = fmaxf(__uint_as_float(rr[0]), __uint_as_float(rr[1])); }
            const float dl = (rm > -1e30f && (!started || rm > 8.f)) ? rm : 0.f;
            started = started || (rm > -1e30f);
            const bool resc = __any(dl != 0.f);
            if (resc) {
                mref += dl;
#pragma unroll
                for (int r = 0; r < 16; ++r) { c0[r] -= dl; c1[r] -= dl; }
#pragma unroll
                for (int r = 0; r < 16; ++r) negm[r] = -mref;
                const float f = fast_exp2(-fmaxf(dl, 0.f)); lrun *= f;
                if (hi == 0) wsc[r32] = f;
                n0 = negm; n1 = negm;
            }
            float ps0 = 0.f, ps1 = 0.f;
            u32x4 pw0, pw1, pw2, pw3;
#define ATT_EXPU(u) do { c0[u] = fast_exp2(c0[u]); c1[u] = fast_exp2(c1[u]); ps0 += c0[u]; ps1 += c1[u]; } while (0)
#define ATT_PK(u) do { const unsigned x0_ = cvt_pk_bf16(c0[u - 1], c0[u]), x1_ = cvt_pk_bf16(c1[u - 1], c1[u]); \
            if ((u) < 8) { pw0[((u) >> 1) & 3] = x0_; pw2[((u) >> 1) & 3] = x1_; } else { pw1[((u) >> 1) & 3] = x0_; pw3[((u) >> 1) & 3] = x1_; } } while (0)
            if (doS) {
                bf16x8 a0 = *(LAS const bf16x8*)(Kn), a1 = *(LAS const bf16x8*)(Kn + 32 * KS);
#pragma unroll
                for (int ks = 0; ks < NKS; ++ks) {
                    bf16x8 b0 = a0, b1 = a1;
                    if (ks + 1 < NKS) { b0 = *(LAS const bf16x8*)(Kn + (ks + 1) * 32); b1 = *(LAS const bf16x8*)(Kn + 32 * KS + (ks + 1) * 32); }
                    n0 = __builtin_amdgcn_mfma_f32_32x32x16_bf16(a0, qf[ks], n0, 0, 0, 0);
                    n1 = __builtin_amdgcn_mfma_f32_32x32x16_bf16(a1, qf[ks], n1, 0, 0, 0);
                    a0 = b0; a1 = b1;
                    const int u_lo = (16 * ks) / NKS, u_hi = (16 * (ks + 1)) / NKS;
#pragma unroll
                    for (int u = u_lo; u < u_hi; ++u) { ATT_EXPU(u); if (u & 1) ATT_PK(u); }
                    ATT_SB();
                }
            } else {
#pragma unroll
                for (int u = 0; u < 16; ++u) { ATT_EXPU(u); if (u & 1) ATT_PK(u); }
            }
            lrun += ps0 + ps1;
            if (resc) {
#pragma unroll
                for (int g = 0; g < 4; ++g) {
                    const f32x4 av = *(LAS const f32x4*)(wsc + 8 * g + 4 * hi);
#pragma unroll
                    for (int e = 0; e < 4; ++e) { o0[4 * g + e] *= av[e]; o1[4 * g + e] *= av[e]; }
                }
            }
            {
                s16x4 va = vtr(Vc), vb = vtr(Vc + 4 * ATT_VS), vc = vtr(Vc + 64), vd = vtr(Vc + 64 + 4 * ATT_VS);
#pragma unroll
                for (int j = 0; j < 4; ++j) {
                    const bf16x8 pa = __builtin_bit_cast(bf16x8, j == 0 ? pw0 : (j == 1 ? pw1 : (j == 2 ? pw2 : pw3)));
                    const bf16x8 vf0 = (bf16x8){va[0], va[1], va[2], va[3], vb[0], vb[1], vb[2], vb[3]};
                    const bf16x8 vf1 = (bf16x8){vc[0], vc[1], vc[2], vc[3], vd[0], vd[1], vd[2], vd[3]};
                    if (j + 1 < 4) { LAS const unsigned char* vp = Vc + (j + 1) * 16 * ATT_VS; va = vtr(vp); vb = vtr(vp + 4 * ATT_VS); vc = vtr(vp + 64); vd = vtr(vp + 64 + 4 * ATT_VS); }
                    o0 = __builtin_amdgcn_mfma_f32_32x32x16_bf16(pa, vf0, o0, 0, 0, 0);
                    o1 = __builtin_amdgcn_mfma_f32_32x32x16_bf16(pa, vf1, o1, 0, 0, 0);
                }
            }
        } else if (doS) {
#pragma unroll
            for (int ks = 0; ks < NKS; ++ks) {
                const bf16x8 a0 = *(LAS const bf16x8*)(Kn + ks * 32), a1 = *(LAS const bf16x8*)(Kn + 32 * KS + ks * 32);
                n0 = __builtin_amdgcn_mfma_f32_32x32x16_bf16(a0, qf[ks], n0, 0, 0, 0); n1 = __builtin_amdgcn_mfma_f32_32x32x16_bf16(a1, qf[ks], n1, 0, 0, 0);
            }
        }
        c0 = n0; c1 = n1;
        ATT_LSTOREK(t & 1, gkB, grB);
        ATT_LSTOREV((t + 1) & 1, gvB);
        __syncthreads();
          }
      { const int t = t2 + 1;
        ATT_GLOADK(min(t + 3, ntiles - 1), gkB, grB);
        ATT_GLOADV(min(t + 2, ntiles - 1), gvB);
        const bool doP = (t >= tlo) && (t < thi), doS = (t + 1 >= tlo) && (t + 1 < thi);
        LAS const unsigned char* Kn = lds + ((t + 1) & 1) * ATT_TILE + koff;
        LAS const unsigned char* Vc = lds + (t & 1) * ATT_TILE + voff;
        f32x16 n0 = negm, n1 = negm;
        if (doP) {
            if constexpr (DIL) {
                const int P0 = 64 * t + kofs;
                const bool full = (P0 >= pq0 - 33) && (P0 + 63 <= pq0 + 64) && (P0 >= 0) && (P0 + 63 < L);
                if (!full) {
                    const int lo = max(pq - 64, 0) - P0 - 8 * hi, span = min(pq + 64, L - 1) - max(pq - 64, 0);
#pragma unroll
                    for (int r = 0; r < 16; ++r) {
                        const int i0 = 16 * (r >> 3) + (r & 7);
                        c0[r] = ((unsigned)(i0 - lo) <= (unsigned)span) ? c0[r] : -INFINITY;
                        c1[r] = ((unsigned)(i0 + 32 - lo) <= (unsigned)span) ? c1[r] : -INFINITY;
                    }
                }
            }
            float ma = fmaxf(fmaxf(c0[0], c0[1]), c1[0]), mb = fmaxf(fmaxf(c0[2], c0[3]), c1[1]);
            ma = fmaxf(fmaxf(ma, c1[2]), c1[3]);
#pragma unroll
            for (int r = 4; r < 16; r += 4) { ma = fmaxf(fmaxf(ma, c0[r]), c0[r + 1]); mb = fmaxf(fmaxf(mb, c0[r + 2]), c0[r + 3]); ma = fmaxf(fmaxf(ma, c1[r]), c1[r + 1]); mb = fmaxf(fmaxf(mb, c1[r + 2]), c1[r + 3]); }
            float rm = fmaxf(ma, mb);
            { auto rr = __builtin_amdgcn_permlane32_swap(__float_as_uint(rm), __float_as_uint(rm), false, false); rm = fmaxf(__uint_as_float(rr[0]), __uint_as_float(rr[1])); }
            const float dl = (rm > -1e30f && (!started || rm > 8.f)) ? rm : 0.f;
            started = started || (rm > -1e30f);
            const bool resc = __any(dl != 0.f);
            if (resc) {
                mref += dl;
#pragma unroll
                for (int r = 0; r < 16; ++r) { c0[r] -= dl; c1[r] -= dl; }
#pragma unroll
                for (int r = 0; r < 16; ++r) negm[r] = -mref;
                const float f = fast_exp2(-fmaxf(dl, 0.f)); lrun *= f;
                if (hi == 0) wsc[r32] = f;
                n0 = negm; n1 = negm;
            }
            float ps0 = 0.f, ps1 = 0.f;
            u32x4 pw0, pw1, pw2, pw3;
#define ATT_EXPU(u) do { c0[u] = fast_exp2(c0[u]); c1[u] = fast_exp2(c1[u]); ps0 += c0[u]; ps1 += c1[u]; } while (0)
#define ATT_PK(u) do { const unsigned x0_ = cvt_pk_bf16(c0[u - 1], c0[u]), x1_ = cvt_pk_bf16(c1[u - 1], c1[u]); \
            if ((u) < 8) { pw0[((u) >> 1) & 3] = x0_; pw2[((u) >> 1) & 3] = x1_; } else { pw1[((u) >> 1) & 3] = x0_; pw3[((u) >> 1) & 3] = x1_; } } while (0)
            if (doS) {
                bf16x8 a0 = *(LAS const bf16x8*)(Kn), a1 = *(LAS const bf16x8*)(Kn + 32 * KS);
#pragma unroll
                for (int ks = 0; ks < NKS; ++ks) {
                    bf16x8 b0 = a0, b1 = a1;
                    if (ks + 1 < NKS) { b0 = *(LAS const bf16x8*)(Kn + (ks + 1) * 32); b1 = *(LAS const bf16x8*)(Kn + 32 * KS + (ks + 1) * 32); }
                    n0 = __builtin_amdgcn_mfma_f32_32x32x16_bf16(a0, qf[ks], n0, 0, 0, 0);
                    n1 = __builtin_amdgcn_mfma_f32_32x32x16_bf16(a1, qf[ks], n1, 0, 0, 0);
                    a0 = b0; a1 = b1;
                    const int u_lo = (16 * ks) / NKS, u_hi = (16 * (ks + 1)) / NKS;
#pragma unroll
                    for (int u = u_lo; u < u_hi; ++u) { ATT_EXPU(u); if (u & 1) ATT_PK(u); }
                    ATT_SB();
                }
            } else {
#pragma unroll
                for (int u = 0; u < 16; ++u) { ATT_EXPU(u); if (u & 1) ATT_PK(u); }
            }
            lrun += ps0 + ps1;
            if (resc) {
#pragma unroll
                for (int g = 0; g < 4; ++g) {
                    const f32x4 av = *(LAS const f32x4*)(wsc + 8 * g + 4 * hi);
#pragma unroll
                    for (int e = 0; e < 4; ++e) { o0[4 * g + e] *= av[e]; o1[4 * g + e] *= av[e]; }
                }
            }
            {
                s16x4 va = vtr(Vc), vb = vtr(Vc + 4 * ATT_VS), vc = vtr(Vc + 64), vd = vtr(Vc + 64 + 4 * ATT_VS);
#pragma unroll
                for (int j = 0; j < 4; ++j) {
                    const bf16x8 pa = __builtin_bit_cast(bf16x8, j == 0 ? pw0 : (j == 1 ? pw1 : (j == 2 ? pw2 : pw3)));
                    const bf16x8 vf0 = (bf16x8){va[0], va[1], va[2], va[3], vb[0], vb[1], vb[2], vb[3]};
                    const bf16x8 vf1 = (bf16x8){vc[0], vc[1], vc[2], vc[3], vd[0], vd[1], vd[2], vd[3]};
                    if (j + 1 < 4) { LAS const unsigned char* vp = Vc + (j + 1) * 16 * ATT_VS; va = vtr(vp); vb = vtr(vp + 4 * ATT_VS); vc = vtr(vp + 64); vd = vtr(vp + 64 + 4 * ATT_VS); }
                    o0 = __builtin_amdgcn_mfma_f32_32x32x16_bf16(pa, vf0, o0, 0, 0, 0);
                    o1 = __builtin_amdgcn_mfma_f32_32x32x16_bf16(pa, vf1, o1, 0, 0, 0);
                }
            }
        } else if (doS) {
#pragma unroll
            for (int ks = 0; ks < NKS; ++ks) {
                const bf16x8 a0 = *(LAS const bf16x8*)(Kn + ks * 32), a1 = *(LAS const bf16x8*)(Kn + 32 * KS + ks * 32);
                n0 = __builtin_amdgcn_mfma_f32_32x32x16_bf16(a0, qf[ks], n0, 0, 0, 0); n1 = __builtin_amdgcn_mfma_f32_32x32x16_bf16(a1, qf[ks], n1, 0, 0, 0);
            }
        }
        c0 = n0; c1 = n1;
        ATT_LSTOREK(t & 1, gkA, grA);
        ATT_LSTOREV((t + 1) & 1, gvA);
        __syncthreads();
          }
    }
    float ltot;
    { auto rr = __builtin_amdgcn_permlane32_swap(__float_as_uint(lrun), __float_as_uint(lrun), false, false); ltot = __uint_as_float(rr[0]) + __uint_as_float(rr[1]); }
    if (hi == 0) wsc[r32] = fast_rcp(ltot);
    LAS bf16_t* stg = (LAS bf16_t*)(lds + ATT_OST + wid * 4096);
#pragma unroll
    for (int g = 0; g < 4; ++g) {
        const f32x4 iv = *(LAS const f32x4*)(wsc + 8 * g + 4 * hi);
#pragma unroll
        for (int e = 0; e < 4; ++e) {
            const int r = 4 * g + e, orow = crow(r, hi);
            stg[orow * 64 + r32] = (bf16_t)(cvt_pk_bf16(o0[r] * iv[e], 0.f) & 0xffffu);
            stg[orow * 64 + 32 + r32] = (bf16_t)(cvt_pk_bf16(o1[r] * iv[e], 0.f) & 0xffffu);
        }
    }
#pragma unroll
    for (int it = 0; it < 4; ++it) {
        const int row = it * 8 + (lane >> 3), ch = lane & 7;
        const u32x4 v = *(LAS const u32x4*)(stg + row * 64 + ch * 8);
        if constexpr (DIL) { const size_t tok = kb + (size_t)(pq0 + row) * dil + res; *(u32x4*)(io.OD + (size_t)br * NT * 512 + tok * 512 + h * 64 + ch * 8) = v; }
        else *(u32x4*)(io.OMIX + (kb + pq0 + row) * 1024 + h * 64 + ch * 8) = v;
    }
    if constexpr (DIL) { if (hi == 0) { const size_t tok = kb + (size_t)pq * dil + res; io.LSE[((size_t)br * NT + tok) * 8 + h] = mref + __builtin_amdgcn_logf(ltot); } }
}
#undef ATT_TOK
#undef ATT_GLOADK
#undef ATT_GLOADV
#undef ATT_LSTOREK
#undef ATT_LSTOREV
#undef ATT_SB
#undef ATT_EXPU
#undef ATT_PK

constexpr int DIL_RS = 144;
constexpr int DIL_K = 0, DIL_V = 384 * DIL_RS, DIL_OST = 2 * 384 * DIL_RS, DIL_WSC = DIL_OST + NWAVES * 4096, DIL_LDS = DIL_WSC + NWAVES * 256;
struct DilUnit { int b, h, br, dil, L, resu, q0, nrows; };
__device__ __forceinline__ DilUnit dil_decode(int unit) {
    DilUnit d; const int bh = unit / 24, k = unit % 24, j = k & 7; d.br = k >> 3; d.b = bh >> 3; d.h = bh & 7;
    if (d.br == 0) { d.dil = 1; d.L = 2048; d.resu = 0; d.q0 = 256 * j; d.nrows = 384; }
    else if (d.br == 1) { d.dil = 4; d.L = 512; d.resu = j >> 1; d.q0 = 256 * (j & 1); d.nrows = 384; }
    else { d.dil = 16; d.L = 128; d.resu = 2 * j; d.q0 = 0; d.nrows = 256; }
    return d;
}
__device__ __forceinline__ size_t dil_tok(const DilUnit& d, int s) {
    const size_t kb = (size_t)d.b * SEQ;
    if (d.br < 2) { int p = d.q0 - 64 + s; p = p < 0 ? 0 : (p > d.L - 1 ? d.L - 1 : p); return kb + (size_t)p * d.dil + d.resu; }
    return kb + (size_t)(s & 127) * 16 + (size_t)(d.resu + (s >> 7));
}
__device__ __forceinline__ void dil_phase(LAS unsigned char* lds, const AttnIO& io, int bx, int G) {
    int tid_ = threadIdx.x; asm volatile("" : "+v"(tid_));
    const int tid = tid_, lane = tid & 63, wid = __builtin_amdgcn_readfirstlane(tid >> 6), r32 = lane & 31, hi = lane >> 5;
    const int lrow = tid >> 3, lch = tid & 7;
    const int krow = (r32 & 19) | ((r32 & 4) << 1) | ((r32 & 8) >> 1);
    const int i16 = lane & 15, g16 = lane >> 4;
    const int voff = DIL_V + (8 * hi + (i16 >> 2)) * DIL_RS + (16 * (g16 & 1) + 4 * (i16 & 3)) * 2;
    LAS float* wsc = (LAS float*)(lds + DIL_WSC + wid * 256);
    LAS bf16_t* stg = (LAS bf16_t*)(lds + DIL_OST + wid * 4096);
    constexpr int NUNITS = 256 * 24;
    u32x4 gk[6], gv[6]; bf16x8 qn[4];
#define DIL_WAVE(d, TLO, NTW, KOFS, PQ, RES) \
    int TLO, NTW, KOFS, PQ, RES; \
    if ((d).br < 2) { TLO = wid >> 1; NTW = 3; KOFS = (d).q0 - 64; PQ = (d).q0 + wid * 32 + r32; RES = (d).resu; } \
    else { const int hw_ = wid >> 2; TLO = 2 * hw_; NTW = 2; KOFS = -128 * hw_; PQ = (wid & 3) * 32 + r32; RES = (d).resu + hw_; }
#define DIL_PREFETCH(unit) do { \
        const DilUnit d_ = dil_decode(unit); \
        _Pragma("unroll") for (int i = 0; i < 6; ++i) { const int row_ = lrow + 64 * i; \
            if (row_ < d_.nrows) { const size_t tok_ = dil_tok(d_, row_); gk[i] = *(const u32x4*)(io.KD + tok_ * 512 + d_.h * 64 + lch * 8); gv[i] = *(const u32x4*)(io.VD + tok_ * 512 + d_.h * 64 + lch * 8); } } \
        DIL_WAVE(d_, tlo_, ntw_, kofs_, pq_, res_) (void)tlo_; (void)ntw_; (void)kofs_; \
        const bf16_t* qp_ = io.QD + ((size_t)d_.b * SEQ + (size_t)pq_ * d_.dil + res_) * 512 + d_.h * 64; \
        _Pragma("unroll") for (int ks = 0; ks < 4; ++ks) qn[ks] = *(const bf16x8*)(qp_ + ks * 16 + hi * 8); \
    } while (0)
    int unit = bx;
    if (unit < NUNITS) DIL_PREFETCH(unit);
    for (; unit < NUNITS; unit += G) {
        const DilUnit d = dil_decode(unit);
#pragma unroll
        for (int i = 0; i < 6; ++i) { const int row = lrow + 64 * i;
            if (row < d.nrows) { *(LAS u32x4*)(lds + DIL_K + row * DIL_RS + lch * 16) = gk[i]; *(LAS u32x4*)(lds + DIL_V + row * DIL_RS + lch * 16) = gv[i]; } }
        bf16x8 qf[4];
#pragma unroll
        for (int ks = 0; ks < 4; ++ks) qf[ks] = qn[ks];
        __syncthreads();
        if (unit + G < NUNITS) DIL_PREFETCH(unit + G);
        DIL_WAVE(d, tlo, ntw, kofs, pq, res)
        (void)tlo; (void)ntw; (void)kofs;
        const int pq0 = pq - r32;
        const int srow0 = (d.br < 2) ? (pq0 - d.q0) : (128 * (wid >> 2) + pq0 - 64);
        f32x16 sc[5];
#pragma unroll
        for (int i = 0; i < 5; ++i) {
            const int P0 = pq0 - 64 + 32 * i;
            if (P0 >= 0 && P0 < d.L) {
                LAS const unsigned char* Kb = lds + DIL_K + (srow0 + 32 * i + krow) * DIL_RS + hi * 16;
                f32x16 acc = {};
#pragma unroll
                for (int ks = 0; ks < 4; ++ks) acc = __builtin_amdgcn_mfma_f32_32x32x16_bf16(*(LAS const bf16x8*)(Kb + ks * 32), qf[ks], acc, 0, 0, 0);
                if (i == 0 || i == 4) {
                    const int dd = r32 - 8 * hi;
#pragma unroll
                    for (int r = 0; r < 16; ++r) { const int cr = 16 * (r >> 3) + (r & 7); const bool ok = (i == 0) ? (cr >= dd) : (cr <= dd); acc[r] = ok ? acc[r] : -INFINITY; }
                }
                sc[i] = acc;
            } else {
#pragma unroll
                for (int r = 0; r < 16; ++r) sc[i][r] = -INFINITY;
            }
        }
        float mx = sc[2][0];
#pragma unroll
        for (int i = 0; i < 5; ++i)
#pragma unroll
            for (int r = 0; r < 16; r += 2) mx = fmaxf(fmaxf(mx, sc[i][r]), sc[i][r + 1]);
        { auto rr = __builtin_amdgcn_permlane32_swap(__float_as_uint(mx), __float_as_uint(mx), false, false); mx = fmaxf(__uint_as_float(rr[0]), __uint_as_float(rr[1])); }
        const float mrun = mx;
        float lrun = 0.f;
        f32x16 o0 = {}, o1 = {};
#pragma unroll
        for (int i = 0; i < 5; ++i) {
            const int P0 = pq0 - 64 + 32 * i;
            if (P0 >= 0 && P0 < d.L) {
                float ps = 0.f;
#pragma unroll
                for (int r = 0; r < 16; ++r) { sc[i][r] = fast_exp2(sc[i][r] - mrun); ps += sc[i][r]; }
                lrun += ps;
                const bf16x8 pa0 = pack8(sc[i], 0), pa1 = pack8(sc[i], 8);
                LAS const unsigned char* Vb = lds + voff + (srow0 + 32 * i) * DIL_RS;
#pragma unroll
                for (int j = 0; j < 2; ++j) {
                    LAS const unsigned char* vp = Vb + j * 16 * DIL_RS;
                    const s16x4 a = vtr(vp), bq = vtr(vp + 4 * DIL_RS), c = vtr(vp + 64), dq = vtr(vp + 64 + 4 * DIL_RS);
                    const bf16x8 vf0 = (bf16x8){a[0], a[1], a[2], a[3], bq[0], bq[1], bq[2], bq[3]};
                    const bf16x8 vf1 = (bf16x8){c[0], c[1], c[2], c[3], dq[0], dq[1], dq[2], dq[3]};
                    o0 = __builtin_amdgcn_mfma_f32_32x32x16_bf16(j == 0 ? pa0 : pa1, vf0, o0, 0, 0, 0);
                    o1 = __builtin_amdgcn_mfma_f32_32x32x16_bf16(j == 0 ? pa0 : pa1, vf1, o1, 0, 0, 0);
                }
            }
        }
        float ltot;
        { auto rr = __builtin_amdgcn_permlane32_swap(__float_as_uint(lrun), __float_as_uint(lrun), false, false); ltot = __uint_as_float(rr[0]) + __uint_as_float(rr[1]); }
        if (hi == 0) wsc[r32] = fast_rcp(ltot);
#pragma unroll
        for (int g = 0; g < 4; ++g) {
            const f32x4 iv = *(LAS const f32x4*)(wsc + 8 * g + 4 * hi);
#pragma unroll
            for (int e = 0; e < 4; ++e) {
                const int r = 4 * g + e, orow = crow(r, hi);
                stg[orow * 64 + r32] = (bf16_t)(cvt_pk_bf16(o0[r] * iv[e], 0.f) & 0xffffu);
                stg[orow * 64 + 32 + r32] = (bf16_t)(cvt_pk_bf16(o1[r] * iv[e], 0.f) & 0xffffu);
            }
        }
        const size_t kb = (size_t)d.b * SEQ;
#pragma unroll
        for (int it = 0; it < 4; ++it) {
            const int row = it * 8 + (lane >> 3), ch = lane & 7;
            const u32x4 v = *(LAS const u32x4*)(stg + row * 64 + ch * 8);
            const size_t tok = kb + (size_t)(pq0 + row) * d.dil + res;
            *(u32x4*)(io.OD + (size_t)d.br * NT * 512 + tok * 512 + d.h * 64 + ch * 8) = v;
        }
        if (hi == 0) { const size_t tok = kb + (size_t)pq * d.dil + res; io.LSE[((size_t)d.br * NT + tok) * 8 + d.h] = mrun + __builtin_amdgcn_logf(ltot); }
        __syncthreads();
    }
#undef DIL_WAVE
#undef DIL_PREFETCH
}

__device__ __forceinline__ float wave_sum(float v) {
#pragma unroll
    for (int o = 1; o < 64; o <<= 1) v += __shfl_xor(v, o);
    return v;
}
__device__ __forceinline__ void tr_block(const float* W, int K, int N, const float* gain, bf16_t* WT, int k0, int n0, int dst_row0, LAS float* scr, int lane) {
#pragma unroll 8
    for (int i = 0; i < 32; ++i) {
        const int kk = 2 * i + (lane >> 5);
        float v = W[(size_t)(k0 + kk) * N + n0 + (lane & 31)];
        if (gain) v *= gain[k0 + kk];
        scr[kk * 33 + (lane & 31)] = v;
    }
    asm volatile("s_waitcnt lgkmcnt(0)" ::: "memory");
    const int c = lane & 7;
#pragma unroll
    for (int j = 0; j < 4; ++j) {
        const int n = (lane >> 3) + 8 * j; const LAS float* s = scr + (8 * c) * 33 + n;
        u32x4 o; o.x = cvt_pk_bf16(s[0 * 33], s[1 * 33]); o.y = cvt_pk_bf16(s[2 * 33], s[3 * 33]); o.z = cvt_pk_bf16(s[4 * 33], s[5 * 33]); o.w = cvt_pk_bf16(s[6 * 33], s[7 * 33]);
        *(u32x4*)(WT + (size_t)(dst_row0 + n) * K + k0 + 8 * c) = o;
    }
    asm volatile("s_waitcnt lgkmcnt(0)" ::: "memory");
}

__device__ __forceinline__ void tr_block64(const float* W, int K, int N, const float* gain, bf16_t* WT, int k0, int n0, int dst_row0, LAS float* scr, int lane) {
    const int kk = lane >> 4, n4 = lane & 15;
    f32x4 v[16];
#pragma unroll
    for (int i = 0; i < 16; ++i) v[i] = *(const f32x4*)(W + (size_t)(k0 + 4 * i + kk) * N + n0 + 4 * n4);
#pragma unroll
    for (int i = 0; i < 16; ++i) {
        const float g = gain ? gain[k0 + 4 * i + kk] : 1.0f;
        LAS float* d = scr + (4 * i + kk) * 65 + 4 * n4;
        d[0] = v[i][0] * g; d[1] = v[i][1] * g; d[2] = v[i][2] * g; d[3] = v[i][3] * g;
    }
    asm volatile("s_waitcnt lgkmcnt(0)" ::: "memory");
    const int c = lane & 7;
#pragma unroll
    for (int it = 0; it < 8; ++it) {
        const int n = it * 8 + (lane >> 3); const LAS float* s = scr + (8 * c) * 65 + n;
        u32x4 o; o.x = cvt_pk_bf16(s[0 * 65], s[1 * 65]); o.y = cvt_pk_bf16(s[2 * 65], s[3 * 65]); o.z = cvt_pk_bf16(s[4 * 65], s[5 * 65]); o.w = cvt_pk_bf16(s[6 * 65], s[7 * 65]);
        *(u32x4*)(WT + (size_t)(dst_row0 + n) * K + k0 + 8 * c) = o;
    }
    asm volatile("s_waitcnt lgkmcnt(0)" ::: "memory");
}

#define XB_TMO      128
#define XB_XCNT(j)  (256  + 64 * (j))
#define XB_XSUB(j)  (1280 + 64 * (j))
#define XB_XGEN(j)  (2304 + 64 * (j))
#define XB_TOP      3328
#define XB_TOPGEN   3392
#define XCD_BAR_WORDS 3456
#define XB_SPIN_CAP (1u << 18)

__device__ __forceinline__ unsigned xb_ld(unsigned* p)              { return __hip_atomic_load(p, __ATOMIC_RELAXED, __HIP_MEMORY_SCOPE_AGENT); }
__device__ __forceinline__ unsigned xb_add(unsigned* p, unsigned v) { return __hip_atomic_fetch_add(p, v, __ATOMIC_RELAXED, __HIP_MEMORY_SCOPE_AGENT); }
__device__ __forceinline__ unsigned xb_xcc_id() { return (unsigned)__builtin_amdgcn_s_getreg((3 << 11) | 20) & 0xFu; }
#define XB_SPIN(cond, bar) do { unsigned _sp = 0; while (cond) { __builtin_amdgcn_s_sleep(1); \
    if ((++_sp & 255u) == 0u) { if (xb_ld(&(bar)[XB_TMO])) break; if (_sp > XB_SPIN_CAP) { atomicAdd(&(bar)[XB_TMO], 1u); break; } } } } while (0)

struct XcdBarrier {
    unsigned* bar; unsigned x;
    volatile LAS unsigned* st;
};

__device__ __forceinline__ XcdBarrier xcd_barrier_post(unsigned* bar, volatile LAS unsigned* st) {
    XcdBarrier b; b.bar = bar; b.x = xb_xcc_id(); b.st = st;
    if (threadIdx.x == 0) (void)xb_add(&bar[XB_XCNT(b.x)], 1u);
    return b;
}
__device__ __forceinline__ void xcd_barrier_complete(unsigned* bar, unsigned x, unsigned& nloc, unsigned& nx) {
    const unsigned G = gridDim.x * gridDim.y * gridDim.z;
    unsigned sum, cnt, mine, sp = 0u;
    for (;;) {
        sum = 0u; cnt = 0u; mine = 0u;
#pragma unroll
        for (unsigned j = 0; j < 16; ++j) { const unsigned c = xb_ld(&bar[XB_XCNT(j)]); sum += c; cnt += (c > 0u) ? 1u : 0u; mine = (j == x) ? c : mine; }
        if (sum == G) break;
        __builtin_amdgcn_s_sleep(1);
        if ((++sp & 255u) == 0u) { if (xb_ld(&bar[XB_TMO])) break; if (sp > XB_SPIN_CAP) { atomicAdd(&bar[XB_TMO], 1u); break; } }
    }
    nloc = mine > 0u ? mine : 1u; nx = cnt > 0u ? cnt : 1u;
}

__device__ __forceinline__ void xcd_barrier(const XcdBarrier& b) {
    asm volatile("s_waitcnt vmcnt(0)" ::: "memory");
    __syncthreads();
    if (threadIdx.x == 0) {
        unsigned* bar = b.bar;
        __builtin_amdgcn_s_waitcnt(0);
        unsigned nloc = b.st[0], nx = b.st[1];
        if (nloc == 0u) { xcd_barrier_complete(bar, b.x, nloc, nx); b.st[0] = nloc; b.st[1] = nx; }
        const unsigned old = xb_add(&bar[XB_XSUB(b.x)], 1u);
        const unsigned gen = old / nloc;
        if (old + 1u == (gen + 1u) * nloc) {
            __builtin_amdgcn_fence(__ATOMIC_RELEASE, "agent");
            asm volatile("s_waitcnt vmcnt(0)" ::: "memory");
            const unsigned og = xb_add(&bar[XB_TOP], 1u);
            const unsigned tg = og / nx;
            if (og + 1u == (tg + 1u) * nx) xb_add(&bar[XB_TOPGEN], 1u);
            else XB_SPIN(xb_ld(&bar[XB_TOPGEN]) == tg, bar);
            __builtin_amdgcn_fence(__ATOMIC_ACQUIRE, "agent");
            xb_add(&bar[XB_XGEN(b.x)], 1u);
            asm volatile("s_waitcnt vmcnt(0)" ::: "memory");
        } else {
            XB_SPIN(xb_ld(&bar[XB_XGEN(b.x)]) == gen, bar);
            __builtin_amdgcn_fence(__ATOMIC_ACQUIRE, "agent");
            asm volatile("s_waitcnt vmcnt(0)" ::: "memory");
        }
    }
    __syncthreads();
}

struct Args {
    const float* in[19]; float* out; unsigned char* ws;
};

__global__ void __launch_bounds__(NWAVES * 64) mk_fwd(Args a) {
    extern __shared__ __attribute__((aligned(16))) unsigned char lds_raw[];
    LAS unsigned char* lds = (LAS unsigned char*)lds_raw;
    cg::grid_group grid = cg::this_grid();
    const int tid = threadIdx.x, lane = tid & 63, wave = __builtin_amdgcn_readfirstlane(tid >> 6);
    const int G = gridDim.x, bx = blockIdx.x;
    const int gw = bx * NWAVES + wave, NGW = G * NWAVES;
    unsigned char* ws = a.ws;
    const float* x = a.in[0];
    const float *g_ffn1 = a.in[1], *w1g = a.in[2], *w1u = a.in[3], *w1d = a.in[4], *g_mix = a.in[5], *w_in = a.in[6], *g_q = a.in[7], *w_uq = a.in[8], *g_kv = a.in[9], *w_ukv = a.in[10],
                *g_mo = a.in[11], *g_do = a.in[12], *w_out = a.in[13], *g_ffn2 = a.in[14], *w2g = a.in[15], *w2u = a.in[16], *w2d = a.in[17], *g_fin = a.in[18];
    float* X = a.out;
    bf16_t *W1GU = (bf16_t*)(ws + WS_W1GU), *W1D = (bf16_t*)(ws + WS_W1D), *W2GU = (bf16_t*)(ws + WS_W2GU), *W2D = (bf16_t*)(ws + WS_W2D), *WIN = (bf16_t*)(ws + WS_WIN),
           *WUQ = (bf16_t*)(ws + WS_WUQ), *WUKV = (bf16_t*)(ws + WS_WUKV), *WOUT = (bf16_t*)(ws + WS_WOUT);
    float *COSM = (float*)(ws + WS_ROPE), *SINM = COSM + 2048 * 16, *COSP = SINM + 2048 * 16, *SINP = COSP + 2048 * 8;
    float *SS0 = (float*)(ws + WS_SS0), *SS1 = (float*)(ws + WS_SS1), *SS2 = (float*)(ws + WS_SS2), *SS3 = (float*)(ws + WS_SS3), *SSQ = (float*)(ws + WS_SSQ), *SSKV = (float*)(ws + WS_SSKV);
    bf16_t *XB = (bf16_t*)(ws + WS_XB), *KVM = (bf16_t*)a.out, *HB = (bf16_t*)(ws + WS_H), *OD = (bf16_t*)(ws + WS_OD0), *OMIX = (bf16_t*)(ws + WS_OMIX);
    float* LSE = (float*)(ws + WS_LSE);
    bf16_t *QD = (bf16_t*)(ws + WS_QD), *KD = (bf16_t*)(ws + WS_KD), *VD = (bf16_t*)(ws + WS_VD), *CQ = (bf16_t*)(ws + WS_CQ), *CKV = (bf16_t*)(ws + WS_CKV), *KR = (bf16_t*)(ws + WS_KR), *QM = (bf16_t*)(ws + WS_QM);

    volatile LAS unsigned* xb_st = (volatile LAS unsigned*)(lds + DIL_LDS);
    if (tid < 2) xb_st[tid] = 0u;
    unsigned* xb_words = (unsigned*)(ws + WS_BAR);
    unsigned* pan_cnt = xb_words + 4096;
    if (bx == 0) for (int i = tid; i < 4096 + 256 * 64; i += NWAVES * 64) xb_words[i] = 0u;
    {
        LAS float* scr = (LAS float*)(lds + wave * 16640);
        constexpr int J_GU = 16 * 44, J_D = 44 * 16, J_FFN = 2 * J_GU + J_D, J_UQ = 6 * 12, J_UKV = 4 * 16, J_OUT = 16 * 16, I_IN = 16 * 69;
        constexpr int NITEMS = 2 * J_FFN + J_UQ + J_UKV + J_OUT + I_IN;
        for (int it = gw; it < NITEMS; it += NGW) {
            int r = it;
            if (r < 2 * J_FFN) {
                const int f = r / J_FFN; r -= f * J_FFN;
                const float* gg = f ? g_ffn2 : g_ffn1; const float* wg = f ? w2g : w1g; const float* wu = f ? w2u : w1u; const float* wd = f ? w2d : w1d;
                bf16_t* GU = f ? W2GU : W1GU; bf16_t* DD = f ? W2D : W1D;
                if (r < 2 * J_GU) { const int s = r >= J_GU; const int q = s ? r - J_GU : r; const int kb_ = q / 44, nb = q % 44, n0 = 64 * nb;
                    tr_block64(s ? wu : wg, 1024, FF, gg, GU, 64 * kb_, n0, 256 * (n0 >> 7) + 128 * s + (n0 & 127), scr, lane); }
                else { r -= 2 * J_GU; const int kb_ = r / 16, nb = r % 16; tr_block64(wd, FF, 1024, nullptr, DD, 64 * kb_, 64 * nb, 64 * nb, scr, lane); }
                continue;
            }
            r -= 2 * J_FFN;
            if (r < J_UQ) { const int kb_ = r / 12, nb = r % 12; tr_block64(w_uq, 384, 768, g_q, WUQ, 64 * kb_, 64 * nb, 64 * nb, scr, lane); continue; }
            r -= J_UQ;
            if (r < J_UKV) { const int kb_ = r / 16, nb = r % 16; tr_block64(w_ukv, 256, 1024, g_kv, WUKV, 64 * kb_, 64 * nb, 64 * nb, scr, lane); continue; }
            r -= J_UKV;
            if (r < J_OUT) { const int kb_ = r / 16, nb = r % 16, k0 = 64 * kb_; tr_block64(w_out, 1024, 1024, k0 < 512 ? g_mo : g_do - 512, WOUT, k0, 64 * nb, 64 * nb, scr, lane); continue; }
            r -= J_OUT;
            { const int kb_ = r / 69, nb = r % 69, n0 = 32 * nb;
                int dst;
                if (n0 < 384) dst = 1536 + n0; else if (n0 < 640) dst = 2048 + (n0 - 384); else if (n0 < 672) dst = 1920 + (n0 - 640);
                else if (n0 < 1184) dst = n0 - 672; else if (n0 < 1696) dst = 512 + (n0 - 1184); else dst = 1024 + (n0 - 1696);
                tr_block(w_in, 1024, 2208, g_mix, WIN, 64 * kb_, n0, dst, scr, lane); }
        }
        for (int i = bx * 512 + tid; i < 96 * 1024 / 8; i += G * 512) *(u32x4*)(WIN + (size_t)1952 * 1024 + (size_t)i * 8) = (u32x4){0u, 0u, 0u, 0u};
        for (int i = bx * 512 + tid; i < 2048 * 24; i += G * 512) {
            int pos, fi; float invf; float *cdst, *sdst;
            if (i < 2048 * 16) { pos = i >> 4; fi = i & 15; invf = exp2f(-(float)fi * (1.0f / 16.0f) * 18.931568569324174f); cdst = COSM + i; sdst = SINM + i; }
            else { const int k = i - 2048 * 16; pos = k >> 3; fi = k & 7; invf = exp2f(-(float)fi * (1.0f / 8.0f) * 18.931568569324174f); cdst = COSP + k; sdst = SINP + k; }
            const float ang = (float)pos * invf;
            const double rev = (double)ang * 0.15915494309189535; const float fr_ = (float)(rev - floor(rev));
            *cdst = __builtin_amdgcn_cosf(fr_); *sdst = __builtin_amdgcn_sinf(fr_);
        }
        for (int row0 = gw * 4; row0 < NT; row0 += NGW * 4) {
            f32x4 v[4][4];
#pragma unroll
            for (int q = 0; q < 4; ++q) { const f32x4* xr = (const f32x4*)(x + (size_t)(row0 + q) * DM) + lane;
#pragma unroll
                for (int j = 0; j < 4; ++j) v[q][j] = xr[64 * j]; }
#pragma unroll
            for (int q = 0; q < 4; ++q) {
                float sacc = 0.f; unsigned long long* o8 = (unsigned long long*)(XB + (size_t)(row0 + q) * DM) + lane;
#pragma unroll
                for (int j = 0; j < 4; ++j) { sacc += sq4(v[q][j]); o8[64 * j] = (unsigned long long)cvt_pk_bf16(v[q][j][0], v[q][j][1]) | ((unsigned long long)cvt_pk_bf16(v[q][j][2], v[q][j][3]) << 32); }
                sacc = wave_sum(sacc);
                if (lane < 16) SS0[(size_t)(row0 + q) * 16 + lane] = lane == 0 ? sacc : 0.f;
            }
        }
    }
    grid.sync();
    const XcdBarrier xb = xcd_barrier_post(xb_words, xb_st);
    {
        pg8::Gemm g{XB, W1GU, NT, 2 * FF, DM}; pg8::StaticOrder S; S.init(NT, 2 * FF, G, bx);
        EpiGateUp E{HB, SS0, (LAS float*)(lds + 131072)};
        pg8::gemm_phase<EpiGateUp, pg8::StaticOrder, true, true>(lds, g, S, E);
    }
    xcd_barrier(xb);
    {
        pg8::Gemm g{HB, W1D, NT, DM, FF}; pg8::StaticOrder S; S.init(NT, DM, G, bx);
        EpiResid E{XB, SS1, 0.5f};
        pg8::gemm_phase<EpiResid, pg8::StaticOrder, true, true>(lds, g, S, E);
    }
    xcd_barrier(xb);
    {
        pg8::Gemm g{XB, WIN, NT, 2304, DM}; pg8::StaticOrder S; S.init(NT, 2304, G, bx);
        EpiInProj E{SS1, QD, KD, VD, CQ, CKV, KR, SSQ, SSKV, COSM, SINM, COSP, SINP, (LAS float*)(lds + 131072)};
        pg8::gemm_phase<EpiInProj, pg8::StaticOrder, true, true>(lds, g, S, E);
    }
    xcd_barrier(xb);
    {
        { pg8::Gemm g{CQ, WUQ, NT, 768, 384}; pg8::StaticOrder S; S.init(NT, 768, G, bx); EpiQ E{SSQ, QM, COSM, SINM, (LAS float*)(lds + 131072)};
          pg8::gemm_phase<EpiQ, pg8::StaticOrder, true, true>(lds, g, S, E); }
        { pg8::Gemm g{CKV, WUKV, NT, 1024, 256}; pg8::StaticOrder S; S.init(NT, 1024, G, bx); EpiKV E{SSKV, KVM, (LAS float*)(lds + 131072)};
          pg8::gemm_phase<EpiKV, pg8::StaticOrder, true, true>(lds, g, S, E); }
        __syncthreads();
        AttnIO io{QM, KVM, KR, OMIX, QD, KD, VD, OD, LSE};
        dil_phase(lds, io, bx, G);
    }
    xcd_barrier(xb);
    {
        AttnIO io{QM, KVM, KR, OMIX, QD, KD, VD, OD, LSE};
        for (int u = bx; u < 256 * 8; u += G) attn_unit<false>(lds, io, u);
    }
    xcd_barrier(xb);
    for (int rowb = gw * 4; rowb < NT; rowb += NGW * 4) {
        u32x4 wm[4], wd[4][3]; float ls[4][3];
        const int hd = lane >> 3;
#pragma unroll
        for (int q = 0; q < 4; ++q) {
            const int row = rowb + q;
            wm[q] = *(const u32x4*)(OMIX + (size_t)row * 1024 + lane * 8);
#pragma unroll
            for (int n = 0; n < 3; ++n) { ls[q][n] = LSE[((size_t)n * NT + row) * 8 + hd]; wd[q][n] = *(const u32x4*)(OD + (size_t)n * NT * 512 + (size_t)row * 512 + lane * 8); }
        }
#pragma unroll
        for (int q = 0; q < 4; ++q) {
            const int row = rowb + q;
            {
                float v[8];
#pragma unroll
                for (int e = 0; e < 4; ++e) { v[2 * e] = __uint_as_float(wm[q][e] << 16); v[2 * e + 1] = __uint_as_float(wm[q][e] & 0xffff0000u); }
                float s = 0.f;
#pragma unroll
                for (int e = 0; e < 8; ++e) s += v[e] * v[e];
                const float rs = rsqrtf(wave_sum(s) * (1.0f / 512.0f) + EPS);
                u32x4 o; o.x = cvt_pk_bf16(v[0] * rs, v[1] * rs); o.y = cvt_pk_bf16(v[2] * rs, v[3] * rs); o.z = cvt_pk_bf16(v[4] * rs, v[5] * rs); o.w = cvt_pk_bf16(v[6] * rs, v[7] * rs);
                *(u32x4*)(OMIX + (size_t)row * 1024 + lane * 8) = o;
            }
            {
                const float l0 = ls[q][0], l1 = ls[q][1], l2 = ls[q][2];
                const float mx = fmaxf(l0, fmaxf(l1, l2));
                float w0 = fast_exp2(l0 - mx), w1 = fast_exp2(l1 - mx), w2 = fast_exp2(l2 - mx);
                const float inv = 1.0f / (w0 + w1 + w2); w0 *= inv; w1 *= inv; w2 *= inv;
                float v[8];
#pragma unroll
                for (int e = 0; e < 8; ++e) v[e] = 0.f;
#pragma unroll
                for (int n = 0; n < 3; ++n) {
                    const u32x4 w = wd[q][n]; const float wn = n == 0 ? w0 : (n == 1 ? w1 : w2);
#pragma unroll
                    for (int e = 0; e < 4; ++e) { v[2 * e] += wn * __uint_as_float(w[e] << 16); v[2 * e + 1] += wn * __uint_as_float(w[e] & 0xffff0000u); }
                }
                float s = 0.f;
#pragma unroll
                for (int e = 0; e < 8; ++e) s += v[e] * v[e];
                const float rs = rsqrtf(wave_sum(s) * (1.0f / 512.0f) + EPS);
                u32x4 o; o.x = cvt_pk_bf16(v[0] * rs, v[1] * rs); o.y = cvt_pk_bf16(v[2] * rs, v[3] * rs); o.z = cvt_pk_bf16(v[4] * rs, v[5] * rs); o.w = cvt_pk_bf16(v[6] * rs, v[7] * rs);
                *(u32x4*)(OMIX + (size_t)row * 1024 + 512 + lane * 8) = o;
            }
        }
    }
    xcd_barrier(xb);
    {
        pg8::Gemm g{OMIX, WOUT, NT, DM, DM}; pg8::StaticOrder S; S.init(NT, DM, G, bx);
        EpiResid E{XB, SS2, 1.0f};
        pg8::gemm_phase<EpiResid, pg8::StaticOrder, true, true>(lds, g, S, E);
    }
    xcd_barrier(xb);
    {
        pg8::Gemm g{XB, W2GU, NT, 2 * FF, DM}; pg8::StaticOrder S; S.init(NT, 2 * FF, G, bx);
        EpiGateUp E{HB, SS2, (LAS float*)(lds + 131072)};
        pg8::gemm_phase<EpiGateUp, pg8::StaticOrder, true, true>(lds, g, S, E);
    }
    xcd_barrier(xb);
    {
        pg8::Gemm g{HB, W2D, NT, DM, FF}; pg8::StaticOrder S; S.init(NT, DM, G, bx);
        EpiFinal E{XB, X, SS3, pan_cnt, g_fin, (LAS float*)(lds + 131072)};
        pg8::gemm_phase<EpiFinal, pg8::StaticOrder, true, true>(lds, g, S, E);
    }
}

extern "C" void kernel_launch(void* const* d_in, const int* in_sizes, int n_in, void* d_out, int out_size, void* d_ws, size_t ws_size, hipStream_t stream) {
    constexpr int LDS_BYTES = 147456; static_assert(DIL_LDS + 64 <= LDS_BYTES, "LDS map");
    static int grid = 0;
    if (grid == 0) {
        if (n_in != 19 || in_sizes[0] != NT * DM || out_size != NT * DM || ws_size < WS_END) {
            fprintf(stderr, "kernel_launch: unexpected problem geometry (n_in %d, in0 %d, out %d, ws %zu); nothing launched\n", n_in, n_in > 0 ? in_sizes[0] : -1, out_size, ws_size); grid = -1; return; }
        int dev = 0, cus = 0, per_cu = 0;
        hipGetDevice(&dev); hipDeviceGetAttribute(&cus, hipDeviceAttributeMultiprocessorCount, dev);
        if (hipFuncSetAttribute((const void*)mk_fwd, hipFuncAttributeMaxDynamicSharedMemorySize, LDS_BYTES) != hipSuccess) { fprintf(stderr, "kernel_launch: hipFuncSetAttribute failed\n"); grid = -1; return; }
        if (hipOccupancyMaxActiveBlocksPerMultiprocessor(&per_cu, (const void*)mk_fwd, NWAVES * 64, LDS_BYTES) != hipSuccess || per_cu < 1) { fprintf(stderr, "kernel_launch: occupancy query says %d blocks per CU\n", per_cu); per_cu = 1; }
        (void)hipGetLastError();
        grid = cus;
    }
    if (grid < 0) return;
    Args a{};
    for (int i = 0; i < 19; ++i) a.in[i] = (const float*)d_in[i];
    a.out = (float*)d_out; a.ws = (unsigned char*)d_ws;
    void* args[] = {&a};
    hipError_t e = hipLaunchCooperativeKernel((const void*)mk_fwd, dim3(grid), dim3(NWAVES * 64), args, LDS_BYTES, stream);
    if (e != hipSuccess) fprintf(stderr, "kernel_launch: cooperative launch failed: %s (grid %d)\n", hipGetErrorString(e), grid);
}
```

```cpp
#include <hip/hip_runtime.h>
#include <hip/hip_cooperative_groups.h>
#include <cmath>
#include <cstdio>
#include <cstdint>
namespace pg8 {
#define PG8_LAS __attribute__((address_space(3)))
typedef unsigned short bf16_t;
typedef short bf16x8 __attribute__((ext_vector_type(8)));
typedef float f32x4 __attribute__((ext_vector_type(4)));
typedef unsigned u32x4 __attribute__((ext_vector_type(4)));
constexpr int BM = 256, BK = 64, HALF = 128, HTB = HALF * BK * 2  , STAGE_BYTES = 8 * HTB, NXCD = 8, WGM = 8;

__host__ __device__ __forceinline__ int lds_byte(int r, int c) { const int st = (r >> 4) * 2 + (c >> 5), rr = r & 15, cc = c & 31, ob = rr * 64 + cc * 2; return st * 1024 + (ob ^ (((ob >> 9) & 1) << 5)); }
__host__ __device__ __forceinline__ void stage_rc(int b, int& R, int& C) { const int st = b / 1024, sb = b % 1024, swz = sb ^ (((sb >> 9) & 1) << 5); R = (st >> 1) * 16 + swz / 64; C = (st & 1) * 32 + (swz % 64) / 2; }
__host__ __device__ __forceinline__ int perm32(int rho) { const int n = rho >> 4, i = rho & 15; return 8 * (i >> 2) + 4 * n + (i & 3); }

struct Unit { int pm, pn; };
struct Gemm { const bf16_t* A; const bf16_t* Bt; int M, N, K; };

struct StaticOrder {
    int nM, nN, nwg, G, c;
    __host__ __device__ void init(int M, int N, int G_, int c_) { nM = M / BM; nN = N / BM; nwg = nM * nN; G = G_; c = c_; }
    __host__ __device__ bool next(int i, Unit& u) const {
        const long L = (long)i * G + c; if (L >= nwg) return false;
        int wgid = (int)L; { const int q = nwg / NXCD, r = nwg % NXCD, xcd = wgid % NXCD, off = wgid / NXCD; wgid = (xcd < r ? xcd * (q + 1) : r * (q + 1) + (xcd - r) * q) + off; }
        const int nig = WGM * nN, gid = wgid / nig, fm = gid * WGM, gsz = (nM - fm) < WGM ? (nM - fm) : WGM;
        u.pm = fm + ((wgid % nig) % gsz); u.pn = (wgid % nig) / gsz; return true;
    }
    __device__ __forceinline__ void a_ready(const Unit&) const {}
    __device__ __forceinline__ void done(const Unit&) const {}
};

__device__ __forceinline__ unsigned cvt_pk_bf16(float lo, float hi) { unsigned r; asm volatile("v_cvt_pk_bf16_f32 %0, %1, %2" : "=v"(r) : "v"(lo), "v"(hi)); return r; }

template <class Epi, class Sched, bool ALIGN_EPI = false, bool SP2 = false>
__device__ __forceinline__ void gemm_phase(PG8_LAS unsigned char* lds, const Gemm g, const Sched& S, const Epi& E) {
    int tid_ = threadIdx.x; asm volatile("" : "+v"(tid_));
    const int tid = tid_, wid = __builtin_amdgcn_readfirstlane(tid >> 6), lane = tid & 63, wr = wid >> 2, wc = wid & 3, fr = lane & 15, fq = lane >> 4;
    const int K = g.K, nt = K / BK;
    unsigned voffA[2], voffB[2];
#pragma unroll
    for (int i = 0; i < 2; ++i) { int R, C; stage_rc(tid * 16 + i * 8192, R, C); const int Rb = Epi::PERM ? ((R & ~31) + perm32(R & 31)) : R;
        voffA[i] = (unsigned)(R * K + C) * 2u; voffB[i] = (unsigned)(Rb * K + C) * 2u; }
    const size_t kstep = (size_t)(BK * 2);
    const size_t hstep = (size_t)HALF * K * 2;
    const size_t tstep = 2 * hstep;
    const unsigned ldsw = (unsigned)wid * 1024u;
    const int aoff = lds_byte(wr * 64 + fr, fq * 8), boff = lds_byte(wc * 32 + fr, fq * 8);
#define PG8_SA(b, h) (((b) * 2 + (h)) * HTB)
#define PG8_SB(b, h) ((4 + (b) * 2 + (h)) * HTB)
#define PG8_STAGE(bufoff, gbase, voff) do { _Pragma("unroll") for (int _i = 0; _i < 2; ++_i) \
        __builtin_amdgcn_global_load_lds((const unsigned*)((const char*)(gbase) + (voff)[_i]), (PG8_LAS unsigned*)(lds + (bufoff) + ldsw + _i * 8192), 16, 0, 0); } while (0)
#define PG8_LDA(dst, b, h) do { _Pragma("unroll") for (int m = 0; m < 4; ++m) _Pragma("unroll") for (int k = 0; k < 2; ++k) dst[m][k] = *(const PG8_LAS bf16x8*)(lds + PG8_SA(b, h) + aoff + m * 2048 + k * 1024); } while (0)
#define PG8_LDB(dst, b, h) do { _Pragma("unroll") for (int n = 0; n < 2; ++n) _Pragma("unroll") for (int k = 0; k < 2; ++k) dst[n][k] = *(const PG8_LAS bf16x8*)(lds + PG8_SB(b, h) + boff + n * 2048 + k * 1024); } while (0)
#define PG8_MMA(ai, bj, At, Bt) do { __builtin_amdgcn_s_setprio(1); _Pragma("unroll") for (int m = 0; m < 4; ++m) _Pragma("unroll") for (int n = 0; n < 2; ++n) _Pragma("unroll") for (int k = 0; k < 2; ++k) \
        acc[ai][bj][m][n] = __builtin_amdgcn_mfma_f32_16x16x32_bf16(Bt[n][k], At[m][k], acc[ai][bj][m][n], 0, 0, 0); __builtin_amdgcn_s_setprio(0); } while (0)
#define PG8_WAIT_V(n) asm volatile("s_waitcnt vmcnt(" #n ")" ::: "memory")
#define PG8_WAIT_L(n) asm volatile("s_waitcnt lgkmcnt(" #n ")" ::: "memory")
#define PG8_BAR __builtin_amdgcn_s_barrier()
#define PG8_SCHED __builtin_amdgcn_sched_barrier(0)
    Unit cur, nxt; int ui = 0;
    if (!S.next(0, cur)) return;
    f32x4 acc[2][2][4][2];
#pragma unroll
    for (int a = 0; a < 2; ++a)
#pragma unroll
        for (int b = 0; b < 2; ++b)
#pragma unroll
            for (int m = 0; m < 4; ++m)
#pragma unroll
                for (int n = 0; n < 2; ++n) acc[a][b][m][n] = (f32x4){0.f, 0.f, 0.f, 0.f};
    bf16x8 At[4][2], B0[2][2], B1[2][2];
    const char* cA = (const char*)g.A + (size_t)cur.pm * tstep; const char* cB = (const char*)g.Bt + (size_t)cur.pn * tstep;
    S.a_ready(cur);
    if constexpr (SP2) {
        PG8_STAGE(PG8_SB(0, 0), cB, voffB); PG8_STAGE(PG8_SB(0, 1), cB + hstep, voffB); PG8_STAGE(PG8_SA(0, 0), cA, voffA); PG8_STAGE(PG8_SA(0, 1), cA + hstep, voffA);
        if (wr == 1) PG8_BAR;
        PG8_WAIT_V(2); PG8_BAR;
        PG8_STAGE(PG8_SB(1, 0), cB + kstep, voffB); PG8_STAGE(PG8_SA(1, 0), cA + kstep, voffA); PG8_STAGE(PG8_SB(1, 1), cB + hstep + kstep, voffB);
        PG8_WAIT_V(6); PG8_BAR;
    } else {
        PG8_STAGE(PG8_SB(0, 0), cB, voffB); PG8_STAGE(PG8_SA(0, 0), cA, voffA); PG8_STAGE(PG8_SB(0, 1), cB + hstep, voffB); PG8_STAGE(PG8_SA(0, 1), cA + hstep, voffA);
        if (wr == 1) PG8_BAR;
        PG8_WAIT_V(4); PG8_BAR;
        PG8_STAGE(PG8_SB(1, 0), cB + kstep, voffB); PG8_STAGE(PG8_SA(1, 0), cA + kstep, voffA); PG8_STAGE(PG8_SB(1, 1), cB + hstep + kstep, voffB);
        PG8_WAIT_V(6); PG8_BAR;
    }
    for (;;) {
        const bool has_next = S.next(ui + 1, nxt);
        const char* nA = has_next ? (const char*)g.A + (size_t)nxt.pm * tstep : cA; const char* nB = has_next ? (const char*)g.Bt + (size_t)nxt.pn * tstep : cB;
        for (int t = 0; t < nt; t += 2) {
            const bool last = (t == nt - 2);
            const char* a1 = cA + (size_t)(t + 1) * kstep;
            const char* a2 = last ? nA : cA + (size_t)(t + 2) * kstep; const char* b2 = last ? nB : cB + (size_t)(t + 2) * kstep;
            const char* a3 = a2 + kstep; const char* b3 = b2 + kstep;
            if (last && has_next) S.a_ready(nxt);
            if constexpr (SP2) {
            PG8_LDB(B0, 0, 0); PG8_LDB(B1, 0, 1); PG8_SCHED; PG8_LDA(At, 0, 0); PG8_STAGE(PG8_SA(1, 1), a1 + hstep, voffA);
            PG8_WAIT_V(8); PG8_WAIT_L(0); PG8_BAR; PG8_MMA(0, 0, At, B0); PG8_MMA(0, 1, At, B1); PG8_BAR; PG8_SCHED;
            PG8_LDA(At, 0, 1); PG8_STAGE(PG8_SB(0, 0), b2, voffB); PG8_STAGE(PG8_SB(0, 1), b2 + hstep, voffB); PG8_STAGE(PG8_SA(0, 0), a2, voffA);
            PG8_WAIT_V(8); PG8_WAIT_L(0); PG8_BAR; PG8_MMA(1, 0, At, B0); PG8_MMA(1, 1, At, B1); PG8_BAR; PG8_SCHED;
            PG8_LDB(B0, 1, 0); PG8_LDB(B1, 1, 1); PG8_SCHED; PG8_LDA(At, 1, 0); PG8_STAGE(PG8_SA(0, 1), a2 + hstep, voffA);
            PG8_WAIT_V(8); PG8_WAIT_L(0); PG8_BAR; PG8_MMA(0, 0, At, B0); PG8_MMA(0, 1, At, B1); PG8_BAR; PG8_SCHED;
            PG8_LDA(At, 1, 1); PG8_STAGE(PG8_SB(1, 0), b3, voffB); PG8_STAGE(PG8_SB(1, 1), b3 + hstep, voffB); PG8_STAGE(PG8_SA(1, 0), a3, voffA);
            PG8_WAIT_V(8); PG8_WAIT_L(0); PG8_BAR; PG8_MMA(1, 0, At, B0); PG8_MMA(1, 1, At, B1); PG8_BAR; PG8_SCHED;
            } else {
            PG8_LDB(B0, 0, 0); PG8_SCHED; PG8_LDA(At, 0, 0); PG8_STAGE(PG8_SA(1, 1), a1 + hstep, voffA);
            PG8_WAIT_L(8); PG8_BAR; PG8_WAIT_L(0); PG8_MMA(0, 0, At, B0); PG8_BAR; PG8_SCHED;
            PG8_LDB(B1, 0, 1); PG8_STAGE(PG8_SB(0, 0), b2, voffB);
            PG8_BAR; PG8_WAIT_L(0); PG8_MMA(0, 1, At, B1); PG8_BAR;
            PG8_LDA(At, 0, 1); PG8_STAGE(PG8_SA(0, 0), a2, voffA);
            PG8_BAR; PG8_WAIT_L(0); PG8_MMA(1, 0, At, B0); PG8_BAR; PG8_SCHED;
            PG8_STAGE(PG8_SB(0, 1), b2 + hstep, voffB);
            PG8_WAIT_V(6); PG8_BAR; PG8_MMA(1, 1, At, B1); PG8_BAR;
            PG8_LDB(B0, 1, 0); PG8_SCHED; PG8_LDA(At, 1, 0); PG8_STAGE(PG8_SA(0, 1), a2 + hstep, voffA);
            PG8_WAIT_L(8); PG8_BAR; PG8_WAIT_L(0); PG8_MMA(0, 0, At, B0); PG8_BAR; PG8_SCHED;
            PG8_LDB(B1, 1, 1); PG8_STAGE(PG8_SB(1, 0), b3, voffB);
            PG8_BAR; PG8_WAIT_L(0); PG8_MMA(0, 1, At, B1); PG8_BAR;
            PG8_LDA(At, 1, 1); PG8_STAGE(PG8_SA(1, 0), a3, voffA);
            PG8_BAR; PG8_WAIT_L(0); PG8_MMA(1, 0, At, B0); PG8_BAR; PG8_SCHED;
            PG8_STAGE(PG8_SB(1, 1), b3 + hstep, voffB);
            PG8_WAIT_V(6); PG8_BAR; PG8_MMA(1, 1, At, B1); PG8_BAR;
            }
        }
        if constexpr (ALIGN_EPI) { if (wr == 0) PG8_BAR; }
        if constexpr (!Epi::AFTER_DRAIN) { E(acc, cur, wr, wc, fr, fq); S.done(cur); }
        if (!has_next) break;
#pragma unroll
        for (int a = 0; a < 2; ++a)
#pragma unroll
            for (int b = 0; b < 2; ++b)
#pragma unroll
                for (int m = 0; m < 4; ++m)
#pragma unroll
                    for (int n = 0; n < 2; ++n) acc[a][b][m][n] = (f32x4){0.f, 0.f, 0.f, 0.f};
        cur = nxt; cA = nA; cB = nB; ++ui;
        if constexpr (ALIGN_EPI) { if (wr == 1) PG8_BAR; }
    }
    PG8_WAIT_V(0);
    if constexpr (!ALIGN_EPI) { if (wr == 0) PG8_BAR; }
    PG8_BAR;
    if constexpr (Epi::AFTER_DRAIN) { E.fused(acc, cur, wr, wc, fr, fq, lds, wid, lane); S.done(cur); }
#undef PG8_SA
#undef PG8_SB
#undef PG8_STAGE
#undef PG8_LDA
#undef PG8_LDB
#undef PG8_MMA
#undef PG8_WAIT_V
#undef PG8_WAIT_L
#undef PG8_BAR
#undef PG8_SCHED
}
}

namespace cg = cooperative_groups;

#define LAS __attribute__((address_space(3)))
typedef unsigned short bf16_t;
typedef float f32x4 __attribute__((ext_vector_type(4)));
typedef float f32x16 __attribute__((ext_vector_type(16)));
typedef short bf16x8 __attribute__((ext_vector_type(8)));
typedef short s16x4 __attribute__((ext_vector_type(4)));
typedef unsigned u32x2 __attribute__((ext_vector_type(2)));
typedef unsigned u32x4 __attribute__((ext_vector_type(4)));
using pg8::Unit;
typedef float f32x2_t __attribute__((ext_vector_type(2))); typedef __bf16 bf16x2_t __attribute__((ext_vector_type(2)));
__device__ __forceinline__ unsigned cvt_pk_bf16(float lo, float hi) { const f32x2_t v = {lo, hi}; const bf16x2_t b = __builtin_convertvector(v, bf16x2_t); return __builtin_bit_cast(unsigned, b); }

constexpr int NT = 65536, SEQ = 2048, DM = 1024, FF = 2816, NWAVES = 8;
constexpr float EPS = 1e-6f, LOG2E = 1.4426950408889634f;
constexpr float QSCALE_D = 0.125f * LOG2E;
constexpr float QSCALE_M = 0.10206207261596577f * LOG2E;

constexpr size_t MiB = 1u << 20;
constexpr size_t WS_W1GU = 0, WS_W1D = 11 * MiB, WS_W2GU = 17 * MiB, WS_W2D = 28 * MiB, WS_WIN = 34 * MiB, WS_WUQ = 39 * MiB, WS_WUKV = 40 * MiB, WS_WOUT = 41 * MiB;
constexpr size_t WS_ROPE = 43 * MiB;
constexpr size_t WS_SS0 = 44 * MiB, WS_SS1 = 48 * MiB, WS_SS2 = 52 * MiB, WS_SS3 = 56 * MiB, WS_SSQ = 60 * MiB, WS_SSKV = 62 * MiB;
constexpr size_t WS_BAR = 63 * MiB;
constexpr size_t WS_XB = 64 * MiB;
constexpr size_t WS_KVM = WS_XB;
constexpr size_t WS_H = 192 * MiB;
constexpr size_t WS_OD0 = 192 * MiB, WS_OD1 = 256 * MiB, WS_OD2 = 320 * MiB, WS_OMIX = 384 * MiB, WS_LSE = 512 * MiB;
constexpr size_t WS_QD = 544 * MiB, WS_KD = 608 * MiB, WS_VD = 672 * MiB, WS_CQ = 736 * MiB, WS_CKV = 784 * MiB, WS_KR = 816 * MiB, WS_QM = 820 * MiB, WS_END = 916 * MiB;

__device__ __forceinline__ float fast_exp2(float x) { return __builtin_amdgcn_exp2f(x); }
__device__ __forceinline__ float fast_rcp(float x) { return __builtin_amdgcn_rcpf(x); }
__device__ __forceinline__ float bf2f(unsigned short b) { return __uint_as_float((unsigned)b << 16); }
__device__ __forceinline__ float sum4(f32x4 a) { return (a[0] + a[1]) + (a[2] + a[3]); }
__device__ __forceinline__ float sq4(f32x4 a) { return (a[0] * a[0] + a[1] * a[1]) + (a[2] * a[2] + a[3] * a[3]); }
__device__ __forceinline__ float rstd_parts16(const float* ss, int row, float invn) {
    const f32x4* p = (const f32x4*)(ss + (size_t)row * 16);
    const float s = (sum4(p[0]) + sum4(p[1])) + (sum4(p[2]) + sum4(p[3]));
    return rsqrtf(s * invn + EPS);
}

#define EPI_RELANE() int fr, fq; { int t_ = threadIdx.x; asm volatile("" : "+v"(t_)); fr = t_ & 15; fq = (t_ >> 4) & 3; }
__device__ __forceinline__ void rstd4_fill(LAS float* tab4, const float* ss) {
    int tid = threadIdx.x; asm volatile("" : "+v"(tid));
    const int c = blockIdx.x;
#pragma unroll
    for (int k = 0; k < 2; ++k) { const int idx = tid + 512 * k, slot = idx >> 8, r = idx & 255, pm = 8 * (4 * (c & 7) + slot) + ((c >> 3) & 7); tab4[idx] = rstd_parts16(ss, pm * 256 + r, 1.0f / 1024.0f); }
    __syncthreads();
}
__device__ __forceinline__ int rstd4_slot(int pm) { return (pm >> 3) - 4 * ((int)blockIdx.x & 7); }
struct EpiGateUp {
    static constexpr bool PERM = true, AFTER_DRAIN = false;
    bf16_t* H; const float* ss; LAS float* tab;
    __device__ __forceinline__ void operator()(const f32x4 (&acc)[2][2][4][2], const Unit& u, int wr, int wc, int fr_in, int fq_in) const {
        EPI_RELANE();
        const LAS float* tb = tab + rstd4_slot(u.pm) * 256;
        const int r0 = wr * 64 + fr, col = u.pn * 128 + wc * 32 + 8 * fq;
#pragma unroll
        for (int ai = 0; ai < 2; ++ai)
#pragma unroll
            for (int m = 0; m < 4; ++m) {
                const int r = r0 + ai * 128 + m * 16;
                const float rs = tb[r], nrs = -rs * LOG2E;
                float o[8];
#pragma unroll
                for (int n = 0; n < 2; ++n)
#pragma unroll
                    for (int j = 0; j < 4; ++j) {
                        const float ga = acc[ai][0][m][n][j];
                        o[4 * n + j] = (ga * rs) * fast_rcp(1.0f + fast_exp2(ga * nrs)) * (acc[ai][1][m][n][j] * rs);
                    }
                u32x4 w; w.x = cvt_pk_bf16(o[0], o[1]); w.y = cvt_pk_bf16(o[2], o[3]); w.z = cvt_pk_bf16(o[4], o[5]); w.w = cvt_pk_bf16(o[6], o[7]);
                *(u32x4*)(H + (size_t)(u.pm * 256 + r) * FF + col) = w;
            }
    }
};
struct EpiResid {
    static constexpr bool PERM = false, AFTER_DRAIN = false;
    bf16_t* xb; float* ss; float alpha;
    __device__ __forceinline__ void operator()(const f32x4 (&acc)[2][2][4][2], const Unit& u, int wr, int wc, int fr_in, int fq_in) const {
        EPI_RELANE();
        const int row0 = u.pm * 256 + wr * 64 + fr, col0 = u.pn * 256 + wc * 32 + 4 * fq;
        u32x2 bws[2][4][2][2];
#pragma unroll
        for (int ai = 0; ai < 2; ++ai)
#pragma unroll
            for (int m = 0; m < 4; ++m)
#pragma unroll
                for (int bj = 0; bj < 2; ++bj)
#pragma unroll
                    for (int n = 0; n < 2; ++n) bws[ai][m][bj][n] = *(const u32x2*)(xb + (size_t)(row0 + ai * 128 + m * 16) * DM + col0 + bj * 128 + n * 16);
#pragma unroll
        for (int ai = 0; ai < 2; ++ai)
#pragma unroll
            for (int m = 0; m < 4; ++m) {
                const int row = row0 + ai * 128 + m * 16; float sq = 0.f;
#pragma unroll
                for (int bj = 0; bj < 2; ++bj)
#pragma unroll
                    for (int n = 0; n < 2; ++n) {
                        u32x2* p = (u32x2*)(xb + (size_t)row * DM + col0 + bj * 128 + n * 16);
                        const u32x2 bw = bws[ai][m][bj][n];
                        const f32x4 b = {__uint_as_float(bw.x << 16), __uint_as_float(bw.x & 0xffff0000u), __uint_as_float(bw.y << 16), __uint_as_float(bw.y & 0xffff0000u)};
                        const f32x4 v = b + acc[ai][bj][m][n] * alpha; sq += sq4(v);
                        u32x2 w; w.x = cvt_pk_bf16(v[0], v[1]); w.y = cvt_pk_bf16(v[2], v[3]); *p = w;
                    }
                sq += __shfl_xor(sq, 16); sq += __shfl_xor(sq, 32);
                if (fq == 0) ss[(size_t)row * 16 + u.pn * 4 + wc] = sq;
            }
    }
};
struct EpiFinal {
    static constexpr bool PERM = false, AFTER_DRAIN = false;
    const bf16_t* xb; float* X; float* ss; unsigned* cnt; const float* gfin; LAS float* tab;
    __device__ __forceinline__ void operator()(f32x4 (&acc)[2][2][4][2], const Unit& u, int wr, int wc, int fr_in, int fq_in) const {
        EPI_RELANE();
        int tid = threadIdx.x; asm volatile("" : "+v"(tid));
        const int row0 = u.pm * 256 + wr * 64 + fr, col0 = u.pn * 256 + wc * 32 + 4 * fq;
        u32x2 bws[2][4][2][2];
#pragma unroll
        for (int ai = 0; ai < 2; ++ai)
#pragma unroll
            for (int m = 0; m < 4; ++m)
#pragma unroll
                for (int bj = 0; bj < 2; ++bj)
#pragma unroll
                    for (int n = 0; n < 2; ++n) bws[ai][m][bj][n] = *(const u32x2*)(xb + (size_t)(row0 + ai * 128 + m * 16) * DM + col0 + bj * 128 + n * 16);
#pragma unroll
        for (int ai = 0; ai < 2; ++ai)
#pragma unroll
            for (int m = 0; m < 4; ++m) {
                const int row = row0 + ai * 128 + m * 16; float sq = 0.f;
#pragma unroll
                for (int bj = 0; bj < 2; ++bj)
#pragma unroll
                    for (int n = 0; n < 2; ++n) {
                        const u32x2 bw = bws[ai][m][bj][n];
                        const f32x4 b = {__uint_as_float(bw.x << 16), __uint_as_float(bw.x & 0xffff0000u), __uint_as_float(bw.y << 16), __uint_as_float(bw.y & 0xffff0000u)};
                        const f32x4 v = b + acc[ai][bj][m][n] * 0.5f; acc[ai][bj][m][n] = v; sq += sq4(v);
                    }
                sq += __shfl_xor(sq, 16); sq += __shfl_xor(sq, 32);
                if (fq == 0) ss[(size_t)row * 16 + u.pn * 4 + wc] = sq;
            }
        asm volatile("s_waitcnt vmcnt(0)" ::: "memory");
        __syncthreads();
        if (tid == 0) {
            unsigned* c = cnt + 64 * u.pm;
            __builtin_amdgcn_fence(__ATOMIC_RELEASE, "agent"); asm volatile("s_waitcnt vmcnt(0)" ::: "memory");
            __hip_atomic_fetch_add(c, 1u, __ATOMIC_RELAXED, __HIP_MEMORY_SCOPE_AGENT);
            unsigned sp = 0;
            while (__hip_atomic_load(c, __ATOMIC_RELAXED, __HIP_MEMORY_SCOPE_AGENT) < 4u) { __builtin_amdgcn_s_sleep(2); if (++sp > (1u << 22)) break; }
            __builtin_amdgcn_fence(__ATOMIC_ACQUIRE, "agent"); asm volatile("s_waitcnt vmcnt(0)" ::: "memory");
        }
        __syncthreads();
        if (tid < 256) tab[tid] = rstd_parts16(ss, u.pm * 256 + tid, 1.0f / 1024.0f);
        __syncthreads();
#pragma unroll
        for (int ai = 0; ai < 2; ++ai)
#pragma unroll
            for (int m = 0; m < 4; ++m) {
                const int r = ai * 128 + wr * 64 + m * 16 + fr; const float rs = tab[r];
#pragma unroll
                for (int bj = 0; bj < 2; ++bj)
#pragma unroll
                    for (int n = 0; n < 2; ++n) {
                        const int col = col0 + bj * 128 + n * 16;
                        const f32x4 g = *(const f32x4*)(gfin + col);
                        *(f32x4*)(X + (size_t)(u.pm * 256 + r) * DM + col) = acc[ai][bj][m][n] * rs * g;
                    }
            }
    }
};
struct EpiInProj {
    static constexpr bool PERM = false, AFTER_DRAIN = false;
    const float* ss1; bf16_t *QD, *KD, *VD, *CQ, *CKV, *KR; float *SSQ, *SSKV; const float *cosm, *sinm, *cosp, *sinp; LAS float* tab;
    __device__ __forceinline__ void operator()(const f32x4 (&acc)[2][2][4][2], const Unit& u, int wr, int wc, int fr_in, int fq_in) const {
        EPI_RELANE();
        const LAS float* tb = tab + rstd4_slot(u.pm) * 256;
        const int row0 = u.pm * 256 + wr * 64 + fr, pn = u.pn;
        const bool ropeP = (pn < 4) && ((wc & 1) == 0), ropeM = (pn == 7) && (wc == 0);
        f32x4 cs[2][4], sn[2][4];
        if (ropeP || ropeM) {
#pragma unroll
            for (int ai = 0; ai < 2; ++ai)
#pragma unroll
                for (int m = 0; m < 4; ++m) { const int pos = (row0 + ai * 128 + m * 16) & (SEQ - 1);
                    const float* cp = ropeP ? cosp + pos * 8 + 4 * (fq & 1) : cosm + pos * 16 + 4 * fq; const float* sp = ropeP ? sinp + pos * 8 + 4 * (fq & 1) : sinm + pos * 16 + 4 * fq;
                    cs[ai][m] = *(const f32x4*)cp; sn[ai][m] = *(const f32x4*)sp; }
        }
#pragma unroll
        for (int ai = 0; ai < 2; ++ai)
#pragma unroll
            for (int m = 0; m < 4; ++m) {
                const int row = row0 + ai * 128 + m * 16, pos = row & (SEQ - 1);
                const float rs = tb[ai * 128 + wr * 64 + m * 16 + fr];
                if (pn < 6) {
                    bf16_t* dst = QD + (size_t)(pn >> 1) * ((size_t)NT * 512) + (size_t)row * 512 + (pn & 1) * 256 + wc * 32 + 4 * fq;
                    const float sc = pn < 2 ? rs * QSCALE_D : rs;
                    const bool rope = (pn < 4) && ((wc & 1) == 0);
#pragma unroll
                    for (int bj = 0; bj < 2; ++bj)
#pragma unroll
                        for (int n = 0; n < 2; ++n) {
                            f32x4 v = acc[ai][bj][m][n] * sc;
                            if (n == 0 && rope) {
                                f32x4 pv; pv[0] = __shfl_xor(v[0], 32); pv[1] = __shfl_xor(v[1], 32); pv[2] = __shfl_xor(v[2], 32); pv[3] = __shfl_xor(v[3], 32);
                                const f32x4 c = cs[ai][m], s = sn[ai][m];
                                v = (fq < 2) ? (v * c - pv * s) : (v * c + pv * s);
                            }
                            u32x2 w; w.x = cvt_pk_bf16(v[0], v[1]); w.y = cvt_pk_bf16(v[2], v[3]);
                            *(u32x2*)(dst + bj * 128 + n * 16) = w;
                        }
                } else if (pn == 6 || pn == 8) {
                    bf16_t* dst = CQ + (pn == 6 ? (size_t)row * 384 : (size_t)NT * 384 + (size_t)row * 256) + wc * 32 + 4 * fq; float sq = 0.f;
#pragma unroll
                    for (int bj = 0; bj < 2; ++bj)
#pragma unroll
                        for (int n = 0; n < 2; ++n) {
                            const f32x4 v = acc[ai][bj][m][n] * rs; sq += sq4(v);
                            u32x2 w; w.x = cvt_pk_bf16(v[0], v[1]); w.y = cvt_pk_bf16(v[2], v[3]);
                            *(u32x2*)(dst + bj * 128 + n * 16) = w;
                        }
                    sq += __shfl_xor(sq, 16); sq += __shfl_xor(sq, 32);
                    if (fq == 0) SSQ[(pn == 6 ? (size_t)row * 8 : (size_t)NT * 8 + (size_t)row * 4) + wc] = sq;
                } else {
                    bf16_t* dst = CQ + (size_t)row * 384 + 256 + wc * 32 + 4 * fq; float sq = 0.f;
#pragma unroll
                    for (int n = 0; n < 2; ++n) {
                        const f32x4 v = acc[ai][0][m][n] * rs; sq += sq4(v);
                        u32x2 w; w.x = cvt_pk_bf16(v[0], v[1]); w.y = cvt_pk_bf16(v[2], v[3]);
                        *(u32x2*)(dst + n * 16) = w;
                    }
                    sq += __shfl_xor(sq, 16); sq += __shfl_xor(sq, 32);
                    if (fq == 0) SSQ[(size_t)row * 8 + 4 + wc] = sq;
                    if (wc == 0) {
                        const f32x4 x1 = acc[ai][1][m][0] * rs, x2 = acc[ai][1][m][1] * rs;
                        const f32x4 c = cs[ai][m], s = sn[ai][m];
                        const f32x4 o1 = x1 * c - x2 * s, o2 = x2 * c + x1 * s;
                        u32x2 w1, w2; w1.x = cvt_pk_bf16(o1[0], o1[1]); w1.y = cvt_pk_bf16(o1[2], o1[3]); w2.x = cvt_pk_bf16(o2[0], o2[1]); w2.y = cvt_pk_bf16(o2[2], o2[3]);
                        *(u32x2*)(KR + (size_t)row * 32 + 4 * fq) = w1; *(u32x2*)(KR + (size_t)row * 32 + 16 + 4 * fq) = w2;
                    }
                }
            }
    }
};
struct EpiQ {
    static constexpr bool PERM = false, AFTER_DRAIN = false;
    const float* ssq; bf16_t* QM; const float *cosm, *sinm; LAS float* tab;
    __device__ __forceinline__ void operator()(const f32x4 (&acc)[2][2][4][2], const Unit& u, int wr, int wc, int fr_in, int fq_in) const {
        EPI_RELANE();
        const int row0 = u.pm * 256 + wr * 64 + fr;
        { int tid = threadIdx.x; asm volatile("" : "+v"(tid));
          if (tid < 256) { const f32x4* p = (const f32x4*)(ssq + (size_t)(u.pm * 256 + tid) * 8); tab[tid] = rsqrtf((sum4(p[0]) + sum4(p[1])) * (1.0f / 384.0f) + EPS) * QSCALE_M; } }
        __syncthreads();
#pragma unroll
        for (int ai = 0; ai < 2; ++ai) {
#pragma unroll
            for (int m = 0; m < 4; ++m) {
                const int row = row0 + ai * 128 + m * 16;
                const float rs = tab[ai * 128 + wr * 64 + m * 16 + fr];
#pragma unroll
                for (int bj = 0; bj < 2; ++bj) {
                    const int g32 = 8 * u.pn + 4 * bj + wc;
                    bf16_t* dst = QM + (size_t)row * 768 + 32 * g32 + 4 * fq;
                    f32x4 v0 = acc[ai][bj][m][0] * rs, v1 = acc[ai][bj][m][1] * rs;
                    if (g32 % 3 == 2) {
                        const int pos = row & (SEQ - 1);
                        const f32x4 c = *(const f32x4*)(cosm + pos * 16 + 4 * fq), s = *(const f32x4*)(sinm + pos * 16 + 4 * fq);
                        const f32x4 o1 = v0 * c - v1 * s, o2 = v1 * c + v0 * s; v0 = o1; v1 = o2;
                    }
                    u32x2 w0, w1; w0.x = cvt_pk_bf16(v0[0], v0[1]); w0.y = cvt_pk_bf16(v0[2], v0[3]); w1.x = cvt_pk_bf16(v1[0], v1[1]); w1.y = cvt_pk_bf16(v1[2], v1[3]);
                    *(u32x2*)dst = w0; *(u32x2*)(dst + 16) = w1;
                }
            }
        }
    }
};
struct EpiKV {
    static constexpr bool PERM = true, AFTER_DRAIN = false;
    const float* sskv; bf16_t* KVM; LAS float* tab;
    __device__ __forceinline__ void operator()(const f32x4 (&acc)[2][2][4][2], const Unit& u, int wr, int wc, int fr_in, int fq_in) const {
        EPI_RELANE();
        { int tid = threadIdx.x; asm volatile("" : "+v"(tid)); if (tid < 256) tab[tid] = rsqrtf(sum4(*(const f32x4*)(sskv + (size_t)(u.pm * 256 + tid) * 4)) * (1.0f / 256.0f) + EPS); }
        __syncthreads();
        const int row0 = u.pm * 256 + wr * 64 + fr, col = u.pn * 256 + wc * 32 + 8 * fq;
#pragma unroll
        for (int ai = 0; ai < 2; ++ai)
#pragma unroll
            for (int m = 0; m < 4; ++m) {
                const int row = row0 + ai * 128 + m * 16;
                const float rs = tab[ai * 128 + wr * 64 + m * 16 + fr];
#pragma unroll
                for (int bj = 0; bj < 2; ++bj) {
                    const f32x4 v0 = acc[ai][bj][m][0] * rs, v1 = acc[ai][bj][m][1] * rs;
                    u32x4 w; w.x = cvt_pk_bf16(v0[0], v0[1]); w.y = cvt_pk_bf16(v0[2], v0[3]); w.z = cvt_pk_bf16(v1[0], v1[1]); w.w = cvt_pk_bf16(v1[2], v1[3]);
                    *(u32x4*)(KVM + (size_t)row * 1024 + col + bj * 128) = w;
                }
            }
    }
};

constexpr int ATT_VS = 192;
constexpr int ATT_TILE = 64 * 208 + 64 * ATT_VS;
constexpr int ATT_OST = 2 * ATT_TILE, ATT_WSC = ATT_OST + NWAVES * 4096;
static_assert(ATT_WSC + NWAVES * 256 <= 131072, "attention LDS");
static_assert(WS_KD == WS_QD + (size_t)NT * 512 * 2 && WS_VD == WS_KD + (size_t)NT * 512 * 2 && WS_CKV == WS_CQ + (size_t)NT * 384 * 2 && WS_SSKV == WS_SSQ + (size_t)NT * 8 * 4, "buffers addressed relative to each other");
__device__ __forceinline__ int crow(int r, int hi) { return (r & 3) + 8 * (r >> 2) + 4 * hi; }
__device__ __forceinline__ bf16x8 pack8(const f32x16& p, int b) {
    u32x4 w; w.x = cvt_pk_bf16(p[b], p[b + 1]); w.y = cvt_pk_bf16(p[b + 2], p[b + 3]); w.z = cvt_pk_bf16(p[b + 4], p[b + 5]); w.w = cvt_pk_bf16(p[b + 6], p[b + 7]);
    return __builtin_bit_cast(bf16x8, w);
}
typedef short v4i16_t __attribute__((ext_vector_type(4)));
__device__ __forceinline__ s16x4 vtr(LAS const unsigned char* p) { return __builtin_bit_cast(s16x4, __builtin_amdgcn_ds_read_tr16_b64_v4i16((LAS v4i16_t*)p)); }

struct AttnIO {
    const bf16_t *QM, *KVM, *KR; bf16_t* OMIX;
    const bf16_t *QD, *KD, *VD; bf16_t* OD; float* LSE;
};

template <bool DIL>
__device__ __forceinline__ void attn_unit(LAS unsigned char* lds, const AttnIO& io, int unit) {
    constexpr int DK = DIL ? 64 : 96, KS = DK * 2 + 16, NKS = DK / 16;
    int tid_ = threadIdx.x; asm volatile("" : "+v"(tid_));
    const int tid = tid_, lane = tid & 63, wid = __builtin_amdgcn_readfirstlane(tid >> 6), r32 = lane & 31, hi = lane >> 5;
    int b, h, ntiles, tlo, thi, kofs = 0, L = SEQ, dil = 1, res = 0, resu = 0, br = 0, q0 = 0, pq;
    if constexpr (!DIL) {
        const int bh = unit >> 3, qb = unit & 7; b = bh >> 3; h = bh & 7; ntiles = 32; tlo = 0; thi = 32; q0 = qb * 256; pq = q0 + wid * 32 + r32;
    } else {
        const int bh = unit / 24, k = unit % 24, j = k & 7; br = k >> 3; b = bh >> 3; h = bh & 7;
        if (br == 0) { dil = 1; L = 2048; resu = 0; q0 = 256 * j; }
        else if (br == 1) { dil = 4; L = 512; resu = j >> 1; q0 = 256 * (j & 1); }
        else { dil = 16; L = 128; resu = 2 * j; q0 = 0; }
        if (br < 2) { ntiles = 6; tlo = wid >> 1; thi = tlo + 3; kofs = q0 - 64; pq = q0 + wid * 32 + r32; res = resu; }
        else { const int hw = wid >> 2; ntiles = 4; tlo = 2 * hw; thi = tlo + 2; kofs = -128 * hw; pq = (wid & 3) * 32 + r32; res = resu + hw; }
    }
    const int pq0 = pq - r32;
    const size_t kb = (size_t)b * SEQ;
    bf16x8 qf[NKS];
    {
        const bf16_t* qp = DIL ? io.QD + (kb + (size_t)pq * dil + res) * 512 + h * 64 : io.QM + (kb + pq) * 768 + h * 96;
#pragma unroll
        for (int ks = 0; ks < NKS; ++ks) qf[ks] = *(const bf16x8*)(qp + ks * 16 + hi * 8);
    }
    const int lrow = tid >> 3, lch = tid & 7, rrow = (tid >> 2) & 63, rch = tid & 3;
    u32x4 gkA, gvA, grA = (u32x4){0u, 0u, 0u, 0u}, gkB, gvB, grB = (u32x4){0u, 0u, 0u, 0u};
#define ATT_TOK(t) \
        const int s_ = 64 * (t) + lrow; size_t tok_; \
        if (br < 2) { int p_ = q0 - 64 + s_; p_ = p_ < 0 ? 0 : (p_ > L - 1 ? L - 1 : p_); tok_ = kb + (size_t)p_ * dil + resu; } \
        else { tok_ = kb + (size_t)(s_ & 127) * 16 + (size_t)(resu + (s_ >> 7)); }
#define ATT_GLOADK(t, GK, GR) do { \
        if constexpr (!DIL) { \
            GK = *(const u32x4*)(io.KVM + (kb + 64 * (t) + lrow) * 1024 + h * 128 + lch * 8); \
            GR = *(const u32x4*)(io.KR + (kb + 64 * (t) + rrow) * 32 + rch * 8); \
        } else { ATT_TOK(t) GK = *(const u32x4*)(io.KD + tok_ * 512 + h * 64 + lch * 8); } } while (0)
#define ATT_GLOADV(t, GV) do { \
        if constexpr (!DIL) { GV = *(const u32x4*)(io.KVM + (kb + 64 * (t) + lrow) * 1024 + h * 128 + 64 + lch * 8); } \
        else { ATT_TOK(t) GV = *(const u32x4*)(io.VD + tok_ * 512 + h * 64 + lch * 8); } } while (0)
#define ATT_LSTOREK(buf, GK, GR) do { \
        LAS unsigned char* Kb_ = lds + (buf) * ATT_TILE; \
        *(LAS u32x4*)(Kb_ + lrow * KS + lch * 16) = GK; \
        if constexpr (!DIL) { *(LAS u32x4*)(Kb_ + rrow * KS + 128 + rch * 16) = GR; } } while (0)
#define ATT_LSTOREV(buf, GV) do { *(LAS u32x4*)(lds + (buf) * ATT_TILE + 64 * KS + lrow * ATT_VS + lch * 16) = GV; } while (0)
#define ATT_SB() do {} while (0)
    LAS float* wsc = (LAS float*)(lds + ATT_WSC + wid * 256);
    f32x16 o0 = {}, o1 = {}, negm = {};
    float mref = 0.f, lrun = 0.f; bool started = false;
    const int krow = (r32 & 19) | ((r32 & 4) << 1) | ((r32 & 8) >> 1);
    const int koff = krow * KS + hi * 16;
    const int i16 = lane & 15, g16 = lane >> 4;
    const int voff = 64 * KS + (8 * hi + (i16 >> 2)) * ATT_VS + (16 * (g16 & 1) + 4 * (i16 & 3)) * 2;
    ATT_GLOADK(0, gkA, grA); ATT_GLOADV(0, gvA); ATT_GLOADK(1, gkB, grB); ATT_LSTOREK(0, gkA, grA); ATT_LSTOREV(0, gvA); ATT_LSTOREK(1, gkB, grB);
    ATT_GLOADK(2, gkB, grB); ATT_GLOADV(1, gvB);
    __syncthreads();
    f32x16 c0, c1;
    if (tlo == 0) {
        c0 = negm; c1 = negm;
#pragma unroll
        for (int ks = 0; ks < NKS; ++ks) {
            const bf16x8 a0 = *(LAS const bf16x8*)(lds + koff + ks * 32), a1 = *(LAS const bf16x8*)(lds + koff + 32 * KS + ks * 32);
            c0 = __builtin_amdgcn_mfma_f32_32x32x16_bf16(a0, qf[ks], c0, 0, 0, 0); c1 = __builtin_amdgcn_mfma_f32_32x32x16_bf16(a1, qf[ks], c1, 0, 0, 0);
        }
    } else { c0 = negm; c1 = negm; }
    __syncthreads();
    for (int t2 = 0; t2 < ntiles; t2 += 2) {
      { const int t = t2;
        ATT_GLOADK(min(t + 3, ntiles - 1), gkA, grA);
        ATT_GLOADV(min(t + 2, ntiles - 1), gvA);
        const bool doP = (t >= tlo) && (t < thi), doS = (t + 1 >= tlo) && (t + 1 < thi);
        LAS const unsigned char* Kn = lds + ((t + 1) & 1) * ATT_TILE + koff;
        LAS const unsigned char* Vc = lds + (t & 1) * ATT_TILE + voff;
        f32x16 n0 = negm, n1 = negm;
        if (doP) {
            if constexpr (DIL) {
                const int P0 = 64 * t + kofs;
                const bool full = (P0 >= pq0 - 33) && (P0 + 63 <= pq0 + 64) && (P0 >= 0) && (P0 + 63 < L);
                if (!full) {
                    const int lo = max(pq - 64, 0) - P0 - 8 * hi, span = min(pq + 64, L - 1) - max(pq - 64, 0);
#pragma unroll
                    for (int r = 0; r < 16; ++r) {
                        const int i0 = 16 * (r >> 3) + (r & 7);
                        c0[r] = ((unsigned)(i0 - lo) <= (unsigned)span) ? c0[r] : -INFINITY;
                        c1[r] = ((unsigned)(i0 + 32 - lo) <= (unsigned)span) ? c1[r] : -INFINITY;
                    }
                }
            }
            float ma = fmaxf(fmaxf(c0[0], c0[1]), c1[0]), mb = fmaxf(fmaxf(c0[2], c0[3]), c1[1]);
            ma = fmaxf(fmaxf(ma, c1[2]), c1[3]);
#pragma unroll
            for (int r = 4; r < 16; r += 4) { ma = fmaxf(fmaxf(ma, c0[r]), c0[r + 1]); mb = fmaxf(fmaxf(mb, c0[r + 2]), c0[r + 3]); ma = fmaxf(fmaxf(ma, c1[r]), c1[r + 1]); mb = fmaxf(fmaxf(mb, c1[r + 2]), c1[r + 3]); }
            float rm = fmaxf(ma, mb);
            { auto rr = __builtin_amdgcn_permlane32_swap(__float_as_uint(rm), __float_as_uint(rm), false, false); rm = fmaxf(__uint_as_float(rr[0]), __uint_as_float(rr[1])); }
            const float dl = (rm > -1e30f && (!started || rm > 8.f)) ? rm : 0.f;
            started = started || (rm > -1e30f);
            const bool resc = __any(dl != 0.f);
            if (resc) {
                mref += dl;
#pragma unroll
                for (int r = 0; r < 16; ++r) { c0[r] -= dl; c1[r] -= dl; }
#pragma unroll
                for (int r = 0; r < 16; ++r) negm[r] = -mref;
                const float f = fast_exp2(-fmaxf(dl, 0.f)); lrun *= f;
                if (hi == 0) wsc[r32] = f;
                n0 = negm; n1 = negm;
            }
            float ps0 = 0.f, ps1 = 0.f;
            u32x4 pw0, pw1, pw2, pw3;
#define ATT_EXPU(u) do { c0[u] = fast_exp2(c0[u]); c1[u] = fast_exp2(c1[u]); ps0 += c0[u]; ps1 += c1[u]; } while (0)
#define ATT_PK(u) do { const unsigned x0_ = cvt_pk_bf16(c0[u - 1], c0[u]), x1_ = cvt_pk_bf16(c1[u - 1], c1[u]); \
            if ((u) < 8) { pw0[((u) >> 1) & 3] = x0_; pw2[((u) >> 1) & 3] = x1_; } else { pw1[((u) >> 1) & 3] = x0_; pw3[((u) >> 1) & 3] = x1_; } } while (0)
            if (doS) {
                bf16x8 a0 = *(LAS const bf16x8*)(Kn), a1 = *(LAS const bf16x8*)(Kn + 32 * KS);
#pragma unroll
                for (int ks = 0; ks < NKS; ++ks) {
                    bf16x8 b0 = a0, b1 = a1;
                    if (ks + 1 < NKS) { b0 = *(LAS const bf16x8*)(Kn + (ks + 1) * 32); b1 = *(LAS const bf16x8*)(Kn + 32 * KS + (ks + 1) * 32); }
                    n0 = __builtin_amdgcn_mfma_f32_32x32x16_bf16(a0, qf[ks], n0, 0, 0, 0);
                    n1 = __builtin_amdgcn_mfma_f32_32x32x16_bf16(a1, qf[ks], n1, 0, 0, 0);
                    a0 = b0; a1 = b1;
                    const int u_lo = (16 * ks) / NKS, u_hi = (16 * (ks + 1)) / NKS;
#pragma unroll
                    for (int u = u_lo; u < u_hi; ++u) { ATT_EXPU(u); if (u & 1) ATT_PK(u); }
                    ATT_SB();
                }
            } else {
#pragma unroll
                for (int u = 0; u < 16; ++u) { ATT_EXPU(u); if (u & 1) ATT_PK(u); }
            }
            lrun += ps0 + ps1;
            if (resc) {
#pragma unroll
                for (int g = 0; g < 4; ++g) {
                    const f32x4 av = *(LAS const f32x4*)(wsc + 8 * g + 4 * hi);
#pragma unroll
                    for (int e = 0; e < 4; ++e) { o0[4 * g + e] *= av[e]; o1[4 * g + e] *= av[e]; }
                }
            }
            {
                s16x4 va = vtr(Vc), vb = vtr(Vc + 4 * ATT_VS), vc = vtr(Vc + 64), vd = vtr(Vc + 64 + 4 * ATT_VS);
#pragma unroll
                for (int j = 0; j < 4; ++j) {
                    const bf16x8 pa = __builtin_bit_cast(bf16x8, j == 0 ? pw0 : (j == 1 ? pw1 : (j == 2 ? pw2 : pw3)));
                    const bf16x8 vf0 = (bf16x8){va[0], va[1], va[2], va[3], vb[0], vb[1], vb[2], vb[3]};
                    const bf16x8 vf1 = (bf16x8){vc[0], vc[1], vc[2], vc[3], vd[0], vd[1], vd[2], vd[3]};
                    if (j + 1 < 4) { LAS const unsigned char* vp = Vc + (j + 1) * 16 * ATT_VS; va = vtr(vp); vb = vtr(vp + 4 * ATT_VS); vc = vtr(vp + 64); vd = vtr(vp + 64 + 4 * ATT_VS); }
                    o0 = __builtin_amdgcn_mfma_f32_32x32x16_bf16(pa, vf0, o0, 0, 0, 0);
                    o1 = __builtin_amdgcn_mfma_f32_32x32x16_bf16(pa, vf1, o1, 0, 0, 0);
                }
            }
        } else if (doS) {
#pragma unroll
            for (int ks = 0; ks < NKS; ++ks) {
                const bf16x8 a0 = *(LAS const bf16x8*)(Kn + ks * 32), a1 = *(LAS const bf16x8*)(Kn + 32 * KS + ks * 32);
                n0 = __builtin_amdgcn_mfma_f32_32x32x16_bf16(a0, qf[ks], n0, 0, 0, 0); n1 = __builtin_amdgcn_mfma_f32_32x32x16_bf16(a1, qf[ks], n1, 0, 0, 0);
            }
        }
        c0 = n0; c1 = n1;
        ATT_LSTOREK(t & 1, gkB, grB);
        ATT_LSTOREV((t + 1) & 1, gvB);
        __syncthreads();
          }
      { const int t = t2 + 1;
        ATT_GLOADK(min(t + 3, ntiles - 1), gkB, grB);
        ATT_GLOADV(min(t + 2, ntiles - 1), gvB);
        const bool doP = (t >= tlo) && (t < thi), doS = (t + 1 >= tlo) && (t + 1 < thi);
        LAS const unsigned char* Kn = lds + ((t + 1) & 1) * ATT_TILE + koff;
        LAS const unsigned char* Vc = lds + (t & 1) * ATT_TILE + voff;
        f32x16 n0 = negm, n1 = negm;
        if (doP) {
            if constexpr (DIL) {
                const int P0 = 64 * t + kofs;
                const bool full = (P0 >= pq0 - 33) && (P0 + 63 <= pq0 + 64) && (P0 >= 0) && (P0 + 63 < L);
                if (!full) {
                    const int lo = max(pq - 64, 0) - P0 - 8 * hi, span = min(pq + 64, L - 1) - max(pq - 64, 0);
#pragma unroll
                    for (int r = 0; r < 16; ++r) {
                        const int i0 = 16 * (r >> 3) + (r & 7);
                        c0[r] = ((unsigned)(i0 - lo) <= (unsigned)span) ? c0[r] : -INFINITY;
                        c1[r] = ((unsigned)(i0 + 32 - lo) <= (unsigned)span) ? c1[r] : -INFINITY;
                    }
                }
            }
            float ma = fmaxf(fmaxf(c0[0], c0[1]), c1[0]), mb = fmaxf(fmaxf(c0[2], c0[3]), c1[1]);
            ma = fmaxf(fmaxf(ma, c1[2]), c1[3]);
#pragma unroll
            for (int r = 4; r < 16; r += 4) { ma = fmaxf(fmaxf(ma, c0[r]), c0[r + 1]); mb = fmaxf(fmaxf(mb, c0[r + 2]), c0[r + 3]); ma = fmaxf(fmaxf(ma, c1[r]), c1[r + 1]); mb = fmaxf(fmaxf(mb, c1[r + 2]), c1[r + 3]); }
            float rm = fmaxf(ma, mb);
            { auto rr = __builtin_amdgcn_permlane32_swap(__float_as_uint(rm), __float_as_uint(rm), false, false); rm = fmaxf(__uint_as_float(rr[0]), __uint_as_float(rr[1])); }
            const float dl = (rm > -1e30f && (!started || rm > 8.f)) ? rm : 0.f;
            started = started || (rm > -1e30f);
            const bool resc = __any(dl != 0.f);
            if (resc) {
                mref += dl;
#pragma unroll
                for (int r = 0; r < 16; ++r) { c0[r] -= dl; c1[r] -= dl; }
#pragma unroll
                for (int r = 0; r < 16; ++r) negm[r] = -mref;
                const float f = fast_exp2(-fmaxf(dl, 0.f)); lrun *= f;
                if (hi == 0) wsc[r32] = f;
                n0 = negm; n1 = negm;
            }
            float ps0 = 0.f, ps1 = 0.f;
            u32x4 pw0, pw1, pw2, pw3;
#define ATT_EXPU(u) do { c0[u] = fast_exp2(c0[u]); c1[u] = fast_exp2(c1[u]); ps0 += c0[u]; ps1 += c1[u]; } while (0)
#define ATT_PK(u) do { const unsigned x0_ = cvt_pk_bf16(c0[u - 1], c0[u]), x1_ = cvt_pk_bf16(c1[u - 1], c1[u]); \
            if ((u) < 8) { pw0[((u) >> 1) & 3] = x0_; pw2[((u) >> 1) & 3] = x1_; } else { pw1[((u) >> 1) & 3] = x0_; pw3[((u) >> 1) & 3] = x1_; } } while (0)
            if (doS) {
                bf16x8 a0 = *(LAS const bf16x8*)(Kn), a1 = *(LAS const bf16x8*)(Kn + 32 * KS);
#pragma unroll
                for (int ks = 0; ks < NKS; ++ks) {
                    bf16x8 b0 = a0, b1 = a1;
                    if (ks + 1 < NKS) { b0 = *(LAS const bf16x8*)(Kn + (ks + 1) * 32); b1 = *(LAS const bf16x8*)(Kn + 32 * KS + (ks + 1) * 32); }
                    n0 = __builtin_amdgcn_mfma_f32_32x32x16_bf16(a0, qf[ks], n0, 0, 0, 0);
                    n1 = __builtin_amdgcn_mfma_f32_32x32x16_bf16(a1, qf[ks], n1, 0, 0, 0);
                    a0 = b0; a1 = b1;
                    const int u_lo = (16 * ks) / NKS, u_hi = (16 * (ks + 1)) / NKS;
#pragma unroll
                    for (int u = u_lo; u < u_hi; ++u) { ATT_EXPU(u); if (u & 1) ATT_PK(u); }
                    ATT_SB();
                }
            } else {
#pragma unroll
                for (int u = 0; u < 16; ++u) { ATT_EXPU(u); if (u & 1) ATT_PK(u); }
            }
            lrun += ps0 + ps1;
            if (resc) {
#pragma unroll
                for (int g = 0; g < 4; ++g) {
                    const f32x4 av = *(LAS const f32x4*)(wsc + 8 * g + 4 * hi);
#pragma unroll
                    for (int e = 0; e < 4; ++e) { o0[4 * g + e] *= av[e]; o1[4 * g + e] *= av[e]; }
                }
            }
            {
                s16x4 va = vtr(Vc), vb = vtr(Vc + 4 * ATT_VS), vc = vtr(Vc + 64), vd = vtr(Vc + 64 + 4 * ATT_VS);
#pragma unroll
                for (int j = 0; j < 4; ++j) {
                    const bf16x8 pa = __builtin_bit_cast(bf16x8, j == 0 ? pw0 : (j == 1 ? pw1 : (j == 2 ? pw2 : pw3)));
                    const bf16x8 vf0 = (bf16x8){va[0], va[1], va[2], va[3], vb[0], vb[1], vb[2], vb[3]};
                    const bf16x8 vf1 = (bf16x8){vc[0], vc[1], vc[2], vc[3], vd[0], vd[1], vd[2], vd[3]};
                    if (j + 1 < 4) { LAS const unsigned char* vp = Vc + (j + 1) * 16 * ATT_VS; va = vtr(vp); vb = vtr(vp + 4 * ATT_VS); vc = vtr(vp + 64); vd = vtr(vp + 64 + 4 * ATT_VS); }
                    o0 = __builtin_amdgcn_mfma_f32_32x32x16_bf16(pa, vf0, o0, 0, 0, 0);
                    o1 = __builtin_amdgcn_mfma_f32_32x32x16_bf16(pa, vf1, o1, 0, 0, 0);
                }
            }
        } else if (doS) {
#pragma unroll
            for (int ks = 0; ks < NKS; ++ks) {
                const bf16x8 a0 = *(LAS const bf16x8*)(Kn + ks * 32), a1 = *(LAS const bf16x8*)(Kn + 32 * KS + ks * 32);
                n0 = __builtin_amdgcn_mfma_f32_32x32x16_bf16(a0, qf[ks], n0, 0, 0, 0); n1 = __builtin_amdgcn_mfma_f32_32x32x16_bf16(a1, qf[ks], n1, 0, 0, 0);
            }
        }
        c0 = n0; c1 = n1;
        ATT_LSTOREK(t & 1, gkA, grA);
        ATT_LSTOREV((t + 1) & 1, gvA);
        __syncthreads();
          }
    }
    float ltot;
    { auto rr = __builtin_amdgcn_permlane32_swap(__float_as_uint(lrun), __float_as_uint(lrun), false, false); ltot = __uint_as_float(rr[0]) + __uint_as_float(rr[1]); }
    if (hi == 0) wsc[r32] = fast_rcp(ltot);
    LAS bf16_t* stg = (LAS bf16_t*)(lds + ATT_OST + wid * 4096);
#pragma unroll
    for (int g = 0; g < 4; ++g) {
        const f32x4 iv = *(LAS const f32x4*)(wsc + 8 * g + 4 * hi);
#pragma unroll
        for (int e = 0; e < 4; ++e) {
            const int r = 4 * g + e, orow = crow(r, hi);
            stg[orow * 64 + r32] = (bf16_t)(cvt_pk_bf16(o0[r] * iv[e], 0.f) & 0xffffu);
            stg[orow * 64 + 32 + r32] = (bf16_t)(cvt_pk_bf16(o1[r] * iv[e], 0.f) & 0xffffu);
        }
    }
#pragma unroll
    for (int it = 0; it < 4; ++it) {
        const int row = it * 8 + (lane >> 3), ch = lane & 7;
        const u32x4 v = *(LAS const u32x4*)(stg + row * 64 + ch * 8);
        if constexpr (DIL) { const size_t tok = kb + (size_t)(pq0 + row) * dil + res; *(u32x4*)(io.OD + (size_t)br * NT * 512 + tok * 512 + h * 64 + ch * 8) = v; }
        else *(u32x4*)(io.OMIX + (kb + pq0 + row) * 1024 + h * 64 + ch * 8) = v;
    }
    if constexpr (DIL) { if (hi == 0) { const size_t tok = kb + (size_t)pq * dil + res; io.LSE[((size_t)br * NT + tok) * 8 + h] = mref + __builtin_amdgcn_logf(ltot); } }
}
#undef ATT_TOK
#undef ATT_GLOADK
#undef ATT_GLOADV
#undef ATT_LSTOREK
#undef ATT_LSTOREV
#undef ATT_SB
#undef ATT_EXPU
#undef ATT_PK

constexpr int DIL_RS = 144;
constexpr int DIL_K = 0, DIL_V = 384 * DIL_RS, DIL_OST = 2 * 384 * DIL_RS, DIL_WSC = DIL_OST + NWAVES * 4096, DIL_LDS = DIL_WSC + NWAVES * 256;
struct DilUnit { int b, h, br, dil, L, resu, q0, nrows; };
__device__ __forceinline__ DilUnit dil_decode(int unit) {
    DilUnit d; const int bh = unit / 24, k = unit % 24, j = k & 7; d.br = k >> 3; d.b = bh >> 3; d.h = bh & 7;
    if (d.br == 0) { d.dil = 1; d.L = 2048; d.resu = 0; d.q0 = 256 * j; d.nrows = 384; }
    else if (d.br == 1) { d.dil = 4; d.L = 512; d.resu = j >> 1; d.q0 = 256 * (j & 1); d.nrows = 384; }
    else { d.dil = 16; d.L = 128; d.resu = 2 * j; d.q0 = 0; d.nrows = 256; }
    return d;
}
__device__ __forceinline__ size_t dil_tok(const DilUnit& d, int s) {
    const size_t kb = (size_t)d.b * SEQ;
    if (d.br < 2) { int p = d.q0 - 64 + s; p = p < 0 ? 0 : (p > d.L - 1 ? d.L - 1 : p); return kb + (size_t)p * d.dil + d.resu; }
    return kb + (size_t)(s & 127) * 16 + (size_t)(d.resu + (s >> 7));
}
__device__ __forceinline__ void dil_phase(LAS unsigned char* lds, const AttnIO& io, int bx, int G) {
    int tid_ = threadIdx.x; asm volatile("" : "+v"(tid_));
    const int tid = tid_, lane = tid & 63, wid = __builtin_amdgcn_readfirstlane(tid >> 6), r32 = lane & 31, hi = lane >> 5;
    const int lrow = tid >> 3, lch = tid & 7;
    const int krow = (r32 & 19) | ((r32 & 4) << 1) | ((r32 & 8) >> 1);
    const int i16 = lane & 15, g16 = lane >> 4;
    const int voff = DIL_V + (8 * hi + (i16 >> 2)) * DIL_RS + (16 * (g16 & 1) + 4 * (i16 & 3)) * 2;
    LAS float* wsc = (LAS float*)(lds + DIL_WSC + wid * 256);
    LAS bf16_t* stg = (LAS bf16_t*)(lds + DIL_OST + wid * 4096);
    constexpr int NUNITS = 256 * 24;
    u32x4 gk[6], gv[6]; bf16x8 qn[4];
#define DIL_WAVE(d, TLO, NTW, KOFS, PQ, RES) \
    int TLO, NTW, KOFS, PQ, RES; \
    if ((d).br < 2) { TLO = wid >> 1; NTW = 3; KOFS = (d).q0 - 64; PQ = (d).q0 + wid * 32 + r32; RES = (d).resu; } \
    else { const int hw_ = wid >> 2; TLO = 2 * hw_; NTW = 2; KOFS = -128 * hw_; PQ = (wid & 3) * 32 + r32; RES = (d).resu + hw_; }
#define DIL_PREFETCH(unit) do { \
        const DilUnit d_ = dil_decode(unit); \
        _Pragma("unroll") for (int i = 0; i < 6; ++i) { const int row_ = lrow + 64 * i; \
            if (row_ < d_.nrows) { const size_t tok_ = dil_tok(d_, row_); gk[i] = *(const u32x4*)(io.KD + tok_ * 512 + d_.h * 64 + lch * 8); gv[i] = *(const u32x4*)(io.VD + tok_ * 512 + d_.h * 64 + lch * 8); } } \
        DIL_WAVE(d_, tlo_, ntw_, kofs_, pq_, res_) (void)tlo_; (void)ntw_; (void)kofs_; \
        const bf16_t* qp_ = io.QD + ((size_t)d_.b * SEQ + (size_t)pq_ * d_.dil + res_) * 512 + d_.h * 64; \
        _Pragma("unroll") for (int ks = 0; ks < 4; ++ks) qn[ks] = *(const bf16x8*)(qp_ + ks * 16 + hi * 8); \
    } while (0)
    int unit = bx;
    if (unit < NUNITS) DIL_PREFETCH(unit);
    for (; unit < NUNITS; unit += G) {
        const DilUnit d = dil_decode(unit);
#pragma unroll
        for (int i = 0; i < 6; ++i) { const int row = lrow + 64 * i;
            if (row < d.nrows) { *(LAS u32x4*)(lds + DIL_K + row * DIL_RS + lch * 16) = gk[i]; *(LAS u32x4*)(lds + DIL_V + row * DIL_RS + lch * 16) = gv[i]; } }
        bf16x8 qf[4];
#pragma unroll
        for (int ks = 0; ks < 4; ++ks) qf[ks] = qn[ks];
        __syncthreads();
        if (unit + G < NUNITS) DIL_PREFETCH(unit + G);
        DIL_WAVE(d, tlo, ntw, kofs, pq, res)
        (void)tlo; (void)ntw; (void)kofs;
        const int pq0 = pq - r32;
        const int srow0 = (d.br < 2) ? (pq0 - d.q0) : (128 * (wid >> 2) + pq0 - 64);
        f32x16 sc[5];
#pragma unroll
        for (int i = 0; i < 5; ++i) {
            const int P0 = pq0 - 64 + 32 * i;
            if (P0 >= 0 && P0 < d.L) {
                LAS const unsigned char* Kb = lds + DIL_K + (srow0 + 32 * i + krow) * DIL_RS + hi * 16;
                f32x16 acc = {};
#pragma unroll
                for (int ks = 0; ks < 4; ++ks) acc = __builtin_amdgcn_mfma_f32_32x32x16_bf16(*(LAS const bf16x8*)(Kb + ks * 32), qf[ks], acc, 0, 0, 0);
                if (i == 0 || i == 4) {
                    const int dd = r32 - 8 * hi;
#pragma unroll
                    for (int r = 0; r < 16; ++r) { const int cr = 16 * (r >> 3) + (r & 7); const bool ok = (i == 0) ? (cr >= dd) : (cr <= dd); acc[r] = ok ? acc[r] : -INFINITY; }
                }
                sc[i] = acc;
            } else {
#pragma unroll
                for (int r = 0; r < 16; ++r) sc[i][r] = -INFINITY;
            }
        }
        float mx = sc[2][0];
#pragma unroll
        for (int i = 0; i < 5; ++i)
#pragma unroll
            for (int r = 0; r < 16; r += 2) mx = fmaxf(fmaxf(mx, sc[i][r]), sc[i][r + 1]);
        { auto rr = __builtin_amdgcn_permlane32_swap(__float_as_uint(mx), __float_as_uint(mx), false, false); mx = fmaxf(__uint_as_float(rr[0]), __uint_as_float(rr[1])); }
        const float mrun = mx;
        float lrun = 0.f;
        f32x16 o0 = {}, o1 = {};
#pragma unroll
        for (int i = 0; i < 5; ++i) {
            const int P0 = pq0 - 64 + 32 * i;
            if (P0 >= 0 && P0 < d.L) {
                float ps = 0.f;
#pragma unroll
                for (int r = 0; r < 16; ++r) { sc[i][r] = fast_exp2(sc[i][r] - mrun); ps += sc[i][r]; }
                lrun += ps;
                const bf16x8 pa0 = pack8(sc[i], 0), pa1 = pack8(sc[i], 8);
                LAS const unsigned char* Vb = lds + voff + (srow0 + 32 * i) * DIL_RS;
#pragma unroll
                for (int j = 0; j < 2; ++j) {
                    LAS const unsigned char* vp = Vb + j * 16 * DIL_RS;
                    const s16x4 a = vtr(vp), bq = vtr(vp + 4 * DIL_RS), c = vtr(vp + 64), dq = vtr(vp + 64 + 4 * DIL_RS);
                    const bf16x8 vf0 = (bf16x8){a[0], a[1], a[2], a[3], bq[0], bq[1], bq[2], bq[3]};
                    const bf16x8 vf1 = (bf16x8){c[0], c[1], c[2], c[3], dq[0], dq[1], dq[2], dq[3]};
                    o0 = __builtin_amdgcn_mfma_f32_32x32x16_bf16(j == 0 ? pa0 : pa1, vf0, o0, 0, 0, 0);
                    o1 = __builtin_amdgcn_mfma_f32_32x32x16_bf16(j == 0 ? pa0 : pa1, vf1, o1, 0, 0, 0);
                }
            }
        }
        float ltot;
        { auto rr = __builtin_amdgcn_permlane32_swap(__float_as_uint(lrun), __float_as_uint(lrun), false, false); ltot = __uint_as_float(rr[0]) + __uint_as_float(rr[1]); }
        if (hi == 0) wsc[r32] = fast_rcp(ltot);
#pragma unroll
        for (int g = 0; g < 4; ++g) {
            const f32x4 iv = *(LAS const f32x4*)(wsc + 8 * g + 4 * hi);
#pragma unroll
            for (int e = 0; e < 4; ++e) {
                const int r = 4 * g + e, orow = crow(r, hi);
                stg[orow * 64 + r32] = (bf16_t)(cvt_pk_bf16(o0[r] * iv[e], 0.f) & 0xffffu);
                stg[orow * 64 + 32 + r32] = (bf16_t)(cvt_pk_bf16(o1[r] * iv[e], 0.f) & 0xffffu);
            }
        }
        const size_t kb = (size_t)d.b * SEQ;
#pragma unroll
        for (int it = 0; it < 4; ++it) {
            const int row = it * 8 + (lane >> 3), ch = lane & 7;
            const u32x4 v = *(LAS const u32x4*)(stg + row * 64 + ch * 8);
            const size_t tok = kb + (size_t)(pq0 + row) * d.dil + res;
            *(u32x4*)(io.OD + (size_t)d.br * NT * 512 + tok * 512 + d.h * 64 + ch * 8) = v;
        }
        if (hi == 0) { const size_t tok = kb + (size_t)pq * d.dil + res; io.LSE[((size_t)d.br * NT + tok) * 8 + d.h] = mrun + __builtin_amdgcn_logf(ltot); }
        __syncthreads();
    }
#undef DIL_WAVE
#undef DIL_PREFETCH
}

__device__ __forceinline__ float wave_sum(float v) {
#pragma unroll
    for (int o = 1; o < 64; o <<= 1) v += __shfl_xor(v, o);
    return v;
}
__device__ __forceinline__ void tr_block(const float* W, int K, int N, const float* gain, bf16_t* WT, int k0, int n0, int dst_row0, LAS float* scr, int lane) {
#pragma unroll 8
    for (int i = 0; i < 32; ++i) {
        const int kk = 2 * i + (lane >> 5);
        float v = W[(size_t)(k0 + kk) * N + n0 + (lane & 31)];
        if (gain) v *= gain[k0 + kk];
        scr[kk * 33 + (lane & 31)] = v;
    }
    asm volatile("s_waitcnt lgkmcnt(0)" ::: "memory");
    const int c = lane & 7;
#pragma unroll
    for (int j = 0; j < 4; ++j) {
        const int n = (lane >> 3) + 8 * j; const LAS float* s = scr + (8 * c) * 33 + n;
        u32x4 o; o.x = cvt_pk_bf16(s[0 * 33], s[1 * 33]); o.y = cvt_pk_bf16(s[2 * 33], s[3 * 33]); o.z = cvt_pk_bf16(s[4 * 33], s[5 * 33]); o.w = cvt_pk_bf16(s[6 * 33], s[7 * 33]);
        *(u32x4*)(WT + (size_t)(dst_row0 + n) * K + k0 + 8 * c) = o;
    }
    asm volatile("s_waitcnt lgkmcnt(0)" ::: "memory");
}

__device__ __forceinline__ void tr_block64(const float* W, int K, int N, const float* gain, bf16_t* WT, int k0, int n0, int dst_row0, LAS float* scr, int lane) {
    const int kk = lane >> 4, n4 = lane & 15;
    f32x4 v[16];
#pragma unroll
    for (int i = 0; i < 16; ++i) v[i] = *(const f32x4*)(W + (size_t)(k0 + 4 * i + kk) * N + n0 + 4 * n4);
#pragma unroll
    for (int i = 0; i < 16; ++i) {
        const float g = gain ? gain[k0 + 4 * i + kk] : 1.0f;
        LAS float* d = scr + (4 * i + kk) * 65 + 4 * n4;
        d[0] = v[i][0] * g; d[1] = v[i][1] * g; d[2] = v[i][2] * g; d[3] = v[i][3] * g;
    }
    asm volatile("s_waitcnt lgkmcnt(0)" ::: "memory");
    const int c = lane & 7;
#pragma unroll
    for (int it = 0; it < 8; ++it) {
        const int n = it * 8 + (lane >> 3); const LAS float* s = scr + (8 * c) * 65 + n;
        u32x4 o; o.x = cvt_pk_bf16(s[0 * 65], s[1 * 65]); o.y = cvt_pk_bf16(s[2 * 65], s[3 * 65]); o.z = cvt_pk_bf16(s[4 * 65], s[5 * 65]); o.w = cvt_pk_bf16(s[6 * 65], s[7 * 65]);
        *(u32x4*)(WT + (size_t)(dst_row0 + n) * K + k0 + 8 * c) = o;
    }
    asm volatile("s_waitcnt lgkmcnt(0)" ::: "memory");
}

#define XB_TMO      128
#define XB_XCNT(j)  (256  + 64 * (j))
#define XB_XSUB(j)  (1280 + 64 * (j))
#define XB_XGEN(j)  (2304 + 64 * (j))
#define XB_TOP      3328
#define XB_TOPGEN   3392
#define XCD_BAR_WORDS 3456
#define XB_SPIN_CAP (1u << 18)

__device__ __forceinline__ unsigned xb_ld(unsigned* p)              { return __hip_atomic_load(p, __ATOMIC_RELAXED, __HIP_MEMORY_SCOPE_AGENT); }
__device__ __forceinline__ unsigned xb_add(unsigned* p, unsigned v) { return __hip_atomic_fetch_add(p, v, __ATOMIC_RELAXED, __HIP_MEMORY_SCOPE_AGENT); }
__device__ __forceinline__ unsigned xb_xcc_id() { return (unsigned)__builtin_amdgcn_s_getreg((3 << 11) | 20) & 0xFu; }
#define XB_SPIN(cond, bar) do { unsigned _sp = 0; while (cond) { __builtin_amdgcn_s_sleep(1); \
    if ((++_sp & 255u) == 0u) { if (xb_ld(&(bar)[XB_TMO])) break; if (_sp > XB_SPIN_CAP) { atomicAdd(&(bar)[XB_TMO], 1u); break; } } } } while (0)

struct XcdBarrier {
    unsigned* bar; unsigned x;
    volatile LAS unsigned* st;
};

__device__ __forceinline__ XcdBarrier xcd_barrier_post(unsigned* bar, volatile LAS unsigned* st) {
    XcdBarrier b; b.bar = bar; b.x = xb_xcc_id(); b.st = st;
    if (threadIdx.x == 0) (void)xb_add(&bar[XB_XCNT(b.x)], 1u);
    return b;
}
__device__ __forceinline__ void xcd_barrier_complete(unsigned* bar, unsigned x, unsigned& nloc, unsigned& nx) {
    const unsigned G = gridDim.x * gridDim.y * gridDim.z;
    unsigned sum, cnt, mine, sp = 0u;
    for (;;) {
        sum = 0u; cnt = 0u; mine = 0u;
#pragma unroll
        for (unsigned j = 0; j < 16; ++j) { const unsigned c = xb_ld(&bar[XB_XCNT(j)]); sum += c; cnt += (c > 0u) ? 1u : 0u; mine = (j == x) ? c : mine; }
        if (sum == G) break;
        __builtin_amdgcn_s_sleep(1);
        if ((++sp & 255u) == 0u) { if (xb_ld(&bar[XB_TMO])) break; if (sp > XB_SPIN_CAP) { atomicAdd(&bar[XB_TMO], 1u); break; } }
    }
    nloc = mine > 0u ? mine : 1u; nx = cnt > 0u ? cnt : 1u;
}

__device__ __forceinline__ void xcd_barrier(const XcdBarrier& b) {
    asm volatile("s_waitcnt vmcnt(0)" ::: "memory");
    __syncthreads();
    if (threadIdx.x == 0) {
        unsigned* bar = b.bar;
        __builtin_amdgcn_s_waitcnt(0);
        unsigned nloc = b.st[0], nx = b.st[1];
        if (nloc == 0u) { xcd_barrier_complete(bar, b.x, nloc, nx); b.st[0] = nloc; b.st[1] = nx; }
        const unsigned old = xb_add(&bar[XB_XSUB(b.x)], 1u);
        const unsigned gen = old / nloc;
        if (old + 1u == (gen + 1u) * nloc) {
            __builtin_amdgcn_fence(__ATOMIC_RELEASE, "agent");
            asm volatile("s_waitcnt vmcnt(0)" ::: "memory");
            const unsigned og = xb_add(&bar[XB_TOP], 1u);
            const unsigned tg = og / nx;
            if (og + 1u == (tg + 1u) * nx) xb_add(&bar[XB_TOPGEN], 1u);
            else XB_SPIN(xb_ld(&bar[XB_TOPGEN]) == tg, bar);
            __builtin_amdgcn_fence(__ATOMIC_ACQUIRE, "agent");
            xb_add(&bar[XB_XGEN(b.x)], 1u);
            asm volatile("s_waitcnt vmcnt(0)" ::: "memory");
        } else {
            XB_SPIN(xb_ld(&bar[XB_XGEN(b.x)]) == gen, bar);
            __builtin_amdgcn_fence(__ATOMIC_ACQUIRE, "agent");
            asm volatile("s_waitcnt vmcnt(0)" ::: "memory");
        }
    }
    __syncthreads();
}

struct Args {
    const float* in[19]; float* out; unsigned char* ws;
};

__global__ void __launch_bounds__(NWAVES * 64) mk_fwd(Args a) {
    extern __shared__ __attribute__((aligned(16))) unsigned char lds_raw[];
    LAS unsigned char* lds = (LAS unsigned char*)lds_raw;
    cg::grid_group grid = cg::this_grid();
    const int tid = threadIdx.x, lane = tid & 63, wave = __builtin_amdgcn_readfirstlane(tid >> 6);
    const int G = gridDim.x, bx = blockIdx.x;
    const int gw = bx * NWAVES + wave, NGW = G * NWAVES;
    unsigned char* ws = a.ws;
    const float* x = a.in[0];
    const float *g_ffn1 = a.in[1], *w1g = a.in[2], *w1u = a.in[3], *w1d = a.in[4], *g_mix = a.in[5], *w_in = a.in[6], *g_q = a.in[7], *w_uq = a.in[8], *g_kv = a.in[9], *w_ukv = a.in[10],
                *g_mo = a.in[11], *g_do = a.in[12], *w_out = a.in[13], *g_ffn2 = a.in[14], *w2g = a.in[15], *w2u = a.in[16], *w2d = a.in[17], *g_fin = a.in[18];
    float* X = a.out;
    bf16_t *W1GU = (bf16_t*)(ws + WS_W1GU), *W1D = (bf16_t*)(ws + WS_W1D), *W2GU = (bf16_t*)(ws + WS_W2GU), *W2D = (bf16_t*)(ws + WS_W2D), *WIN = (bf16_t*)(ws + WS_WIN),
           *WUQ = (bf16_t*)(ws + WS_WUQ), *WUKV = (bf16_t*)(ws + WS_WUKV), *WOUT = (bf16_t*)(ws + WS_WOUT);
    float *COSM = (float*)(ws + WS_ROPE), *SINM = COSM + 2048 * 16, *COSP = SINM + 2048 * 16, *SINP = COSP + 2048 * 8;
    float *SS0 = (float*)(ws + WS_SS0), *SS1 = (float*)(ws + WS_SS1), *SS2 = (float*)(ws + WS_SS2), *SS3 = (float*)(ws + WS_SS3), *SSQ = (float*)(ws + WS_SSQ), *SSKV = (float*)(ws + WS_SSKV);
    bf16_t *XB = (bf16_t*)(ws + WS_XB), *KVM = (bf16_t*)a.out, *HB = (bf16_t*)(ws + WS_H), *OD = (bf16_t*)(ws + WS_OD0), *OMIX = (bf16_t*)(ws + WS_OMIX);
    float* LSE = (float*)(ws + WS_LSE);
    bf16_t *QD = (bf16_t*)(ws + WS_QD), *KD = (bf16_t*)(ws + WS_KD), *VD = (bf16_t*)(ws + WS_VD), *CQ = (bf16_t*)(ws + WS_CQ), *CKV = (bf16_t*)(ws + WS_CKV), *KR = (bf16_t*)(ws + WS_KR), *QM = (bf16_t*)(ws + WS_QM);

    volatile LAS unsigned* xb_st = (volatile LAS unsigned*)(lds + DIL_LDS);
    if (tid < 2) xb_st[tid] = 0u;
    unsigned* xb_words = (unsigned*)(ws + WS_BAR);
    unsigned* pan_cnt = xb_words + 4096;
    if (bx == 0) for (int i = tid; i < 4096 + 256 * 64; i += NWAVES * 64) xb_words[i] = 0u;
    {
        LAS float* scr = (LAS float*)(lds + wave * 16640);
        constexpr int J_GU = 16 * 44, J_D = 44 * 16, J_FFN = 2 * J_GU + J_D, J_UQ = 6 * 12, J_UKV = 4 * 16, J_OUT = 16 * 16, I_IN = 16 * 69;
        constexpr int NITEMS = 2 * J_FFN + J_UQ + J_UKV + J_OUT + I_IN;
        for (int it = gw; it < NITEMS; it += NGW) {
            int r = it;
            if (r < 2 * J_FFN) {
                const int f = r / J_FFN; r -= f * J_FFN;
                const float* gg = f ? g_ffn2 : g_ffn1; const float* wg = f ? w2g : w1g; const float* wu = f ? w2u : w1u; const float* wd = f ? w2d : w1d;
                bf16_t* GU = f ? W2GU : W1GU; bf16_t* DD = f ? W2D : W1D;
                if (r < 2 * J_GU) { const int s = r >= J_GU; const int q = s ? r - J_GU : r; const int kb_ = q / 44, nb = q % 44, n0 = 64 * nb;
                    tr_block64(s ? wu : wg, 1024, FF, gg, GU, 64 * kb_, n0, 256 * (n0 >> 7) + 128 * s + (n0 & 127), scr, lane); }
                else { r -= 2 * J_GU; const int kb_ = r / 16, nb = r % 16; tr_block64(wd, FF, 1024, nullptr, DD, 64 * kb_, 64 * nb, 64 * nb, scr, lane); }
                continue;
            }
            r -= 2 * J_FFN;
            if (r < J_UQ) { const int kb_ = r / 12, nb = r % 12; tr_block64(w_uq, 384, 768, g_q, WUQ, 64 * kb_, 64 * nb, 64 * nb, scr, lane); continue; }
            r -= J_UQ;
            if (r < J_UKV) { const int kb_ = r / 16, nb = r % 16; tr_block64(w_ukv, 256, 1024, g_kv, WUKV, 64 * kb_, 64 * nb, 64 * nb, scr, lane); continue; }
            r -= J_UKV;
            if (r < J_OUT) { const int kb_ = r / 16, nb = r % 16, k0 = 64 * kb_; tr_block64(w_out, 1024, 1024, k0 < 512 ? g_mo : g_do - 512, WOUT, k0, 64 * nb, 64 * nb, scr, lane); continue; }
            r -= J_OUT;
            { const int kb_ = r / 69, nb = r % 69, n0 = 32 * nb;
                int dst;
                if (n0 < 384) dst = 1536 + n0; else if (n0 < 640) dst = 2048 + (n0 - 384); else if (n0 < 672) dst = 1920 + (n0 - 640);
                else if (n0 < 1184) dst = n0 - 672; else if (n0 < 1696) dst = 512 + (n0 - 1184); else dst = 1024 + (n0 - 1696);
                tr_block(w_in, 1024, 2208, g_mix, WIN, 64 * kb_, n0, dst, scr, lane); }
        }
        for (int i = bx * 512 + tid; i < 96 * 1024 / 8; i += G * 512) *(u32x4*)(WIN + (size_t)1952 * 1024 + (size_t)i * 8) = (u32x4){0u, 0u, 0u, 0u};
        for (int i = bx * 512 + tid; i < 2048 * 24; i += G * 512) {
            int pos, fi; float invf; float *cdst, *sdst;
            if (i < 2048 * 16) { pos = i >> 4; fi = i & 15; invf = exp2f(-(float)fi * (1.0f / 16.0f) * 18.931568569324174f); cdst = COSM + i; sdst = SINM + i; }
            else { const int k = i - 2048 * 16; pos = k >> 3; fi = k & 7; invf = exp2f(-(float)fi * (1.0f / 8.0f) * 18.931568569324174f); cdst = COSP + k; sdst = SINP + k; }
            const float ang = (float)pos * invf;
            const double rev = (double)ang * 0.15915494309189535; const float fr_ = (float)(rev - floor(rev));
            *cdst = __builtin_amdgcn_cosf(fr_); *sdst = __builtin_amdgcn_sinf(fr_);
        }
        for (int row0 = gw * 4; row0 < NT; row0 += NGW * 4) {
            f32x4 v[4][4];
#pragma unroll
            for (int q = 0; q < 4; ++q) { const f32x4* xr = (const f32x4*)(x + (size_t)(row0 + q) * DM) + lane;
#pragma unroll
                for (int j = 0; j < 4; ++j) v[q][j] = xr[64 * j]; }
#pragma unroll
            for (int q = 0; q < 4; ++q) {
                float sacc = 0.f; unsigned long long* o8 = (unsigned long long*)(XB + (size_t)(row0 + q) * DM) + lane;
#pragma unroll
                for (int j = 0; j < 4; ++j) { sacc += sq4(v[q][j]); o8[64 * j] = (unsigned long long)cvt_pk_bf16(v[q][j][0], v[q][j][1]) | ((unsigned long long)cvt_pk_bf16(v[q][j][2], v[q][j][3]) << 32); }
                sacc = wave_sum(sacc);
                if (lane < 16) SS0[(size_t)(row0 + q) * 16 + lane] = lane == 0 ? sacc : 0.f;
            }
        }
    }
    grid.sync();
    const XcdBarrier xb = xcd_barrier_post(xb_words, xb_st);
    {
        pg8::Gemm g{XB, W1GU, NT, 2 * FF, DM}; pg8::StaticOrder S; S.init(NT, 2 * FF, G, bx);
        rstd4_fill((LAS float*)(lds + 131072), SS0);
        EpiGateUp E{HB, SS0, (LAS float*)(lds + 131072)};
        pg8::gemm_phase<EpiGateUp, pg8::StaticOrder, true, true>(lds, g, S, E);
    }
    xcd_barrier(xb);
    {
        pg8::Gemm g{HB, W1D, NT, DM, FF}; pg8::StaticOrder S; S.init(NT, DM, G, bx);
        EpiResid E{XB, SS1, 0.5f};
        pg8::gemm_phase<EpiResid, pg8::StaticOrder, true, true>(lds, g, S, E);
    }
    xcd_barrier(xb);
    {
        pg8::Gemm g{XB, WIN, NT, 2304, DM}; pg8::StaticOrder S; S.init(NT, 2304, G, bx);
        rstd4_fill((LAS float*)(lds + 131072), SS1);
        EpiInProj E{SS1, QD, KD, VD, CQ, CKV, KR, SSQ, SSKV, COSM, SINM, COSP, SINP, (LAS float*)(lds + 131072)};
        pg8::gemm_phase<EpiInProj, pg8::StaticOrder, true, true>(lds, g, S, E);
    }
    xcd_barrier(xb);
    {
        { pg8::Gemm g{CQ, WUQ, NT, 768, 384}; pg8::StaticOrder S; S.init(NT, 768, G, bx); EpiQ E{SSQ, QM, COSM, SINM, (LAS float*)(lds + 131072)};
          pg8::gemm_phase<EpiQ, pg8::StaticOrder, true, true>(lds, g, S, E); }
        { pg8::Gemm g{CKV, WUKV, NT, 1024, 256}; pg8::StaticOrder S; S.init(NT, 1024, G, bx); EpiKV E{SSKV, KVM, (LAS float*)(lds + 131072)};
          pg8::gemm_phase<EpiKV, pg8::StaticOrder, true, true>(lds, g, S, E); }
        __syncthreads();
        AttnIO io{QM, KVM, KR, OMIX, QD, KD, VD, OD, LSE};
        dil_phase(lds, io, bx, G);
    }
    xcd_barrier(xb);
    {
        AttnIO io{QM, KVM, KR, OMIX, QD, KD, VD, OD, LSE};
        for (int u = bx; u < 256 * 8; u += G) attn_unit<false>(lds, io, u);
    }
    xcd_barrier(xb);
    for (int rowb = gw * 4; rowb < NT; rowb += NGW * 4) {
        u32x4 wm[4], wd[4][3]; float ls[4][3];
        const int hd = lane >> 3;
#pragma unroll
        for (int q = 0; q < 4; ++q) {
            const int row = rowb + q;
            wm[q] = *(const u32x4*)(OMIX + (size_t)row * 1024 + lane * 8);
#pragma unroll
            for (int n = 0; n < 3; ++n) { ls[q][n] = LSE[((size_t)n * NT + row) * 8 + hd]; wd[q][n] = *(const u32x4*)(OD + (size_t)n * NT * 512 + (size_t)row * 512 + lane * 8); }
        }
#pragma unroll
        for (int q = 0; q < 4; ++q) {
            const int row = rowb + q;
            {
                float v[8];
#pragma unroll
                for (int e = 0; e < 4; ++e) { v[2 * e] = __uint_as_float(wm[q][e] << 16); v[2 * e + 1] = __uint_as_float(wm[q][e] & 0xffff0000u); }
                float s = 0.f;
#pragma unroll
                for (int e = 0; e < 8; ++e) s += v[e] * v[e];
                const float rs = rsqrtf(wave_sum(s) * (1.0f / 512.0f) + EPS);
                u32x4 o; o.x = cvt_pk_bf16(v[0] * rs, v[1] * rs); o.y = cvt_pk_bf16(v[2] * rs, v[3] * rs); o.z = cvt_pk_bf16(v[4] * rs, v[5] * rs); o.w = cvt_pk_bf16(v[6] * rs, v[7] * rs);
                *(u32x4*)(OMIX + (size_t)row * 1024 + lane * 8) = o;
            }
            {
                const float l0 = ls[q][0], l1 = ls[q][1], l2 = ls[q][2];
                const float mx = fmaxf(l0, fmaxf(l1, l2));
                float w0 = fast_exp2(l0 - mx), w1 = fast_exp2(l1 - mx), w2 = fast_exp2(l2 - mx);
                const float inv = 1.0f / (w0 + w1 + w2); w0 *= inv; w1 *= inv; w2 *= inv;
                float v[8];
#pragma unroll
                for (int e = 0; e < 8; ++e) v[e] = 0.f;
#pragma unroll
                for (int n = 0; n < 3; ++n) {
                    const u32x4 w = wd[q][n]; const float wn = n == 0 ? w0 : (n == 1 ? w1 : w2);
#pragma unroll
                    for (int e = 0; e < 4; ++e) { v[2 * e] += wn * __uint_as_float(w[e] << 16); v[2 * e + 1] += wn * __uint_as_float(w[e] & 0xffff0000u); }
                }
                float s = 0.f;
#pragma unroll
                for (int e = 0; e < 8; ++e) s += v[e] * v[e];
                const float rs = rsqrtf(wave_sum(s) * (1.0f / 512.0f) + EPS);
                u32x4 o; o.x = cvt_pk_bf16(v[0] * rs, v[1] * rs); o.y = cvt_pk_bf16(v[2] * rs, v[3] * rs); o.z = cvt_pk_bf16(v[4] * rs, v[5] * rs); o.w = cvt_pk_bf16(v[6] * rs, v[7] * rs);
                *(u32x4*)(OMIX + (size_t)row * 1024 + 512 + lane * 8) = o;
            }
        }
    }
    xcd_barrier(xb);
    {
        pg8::Gemm g{OMIX, WOUT, NT, DM, DM}; pg8::StaticOrder S; S.init(NT, DM, G, bx);
        EpiResid E{XB, SS2, 1.0f};
        pg8::gemm_phase<EpiResid, pg8::StaticOrder, true, true>(lds, g, S, E);
    }
    xcd_barrier(xb);
    {
        pg8::Gemm g{XB, W2GU, NT, 2 * FF, DM}; pg8::StaticOrder S; S.init(NT, 2 * FF, G, bx);
        rstd4_fill((LAS float*)(lds + 131072), SS2);
        EpiGateUp E{HB, SS2, (LAS float*)(lds + 131072)};
        pg8::gemm_phase<EpiGateUp, pg8::StaticOrder, true, true>(lds, g, S, E);
    }
    xcd_barrier(xb);
    {
        pg8::Gemm g{HB, W2D, NT, DM, FF}; pg8::StaticOrder S; S.init(NT, DM, G, bx);
        EpiFinal E{XB, X, SS3, pan_cnt, g_fin, (LAS float*)(lds + 131072)};
        pg8::gemm_phase<EpiFinal, pg8::StaticOrder, true, true>(lds, g, S, E);
    }
}

extern "C" void kernel_launch(void* const* d_in, const int* in_sizes, int n_in, void* d_out, int out_size, void* d_ws, size_t ws_size, hipStream_t stream) {
    constexpr int LDS_BYTES = 147456; static_assert(DIL_LDS + 64 <= LDS_BYTES, "LDS map");
    static int grid = 0;
    if (grid == 0) {
        if (n_in != 19 || in_sizes[0] != NT * DM || out_size != NT * DM || ws_size < WS_END) {
            fprintf(stderr, "kernel_launch: unexpected problem geometry (n_in %d, in0 %d, out %d, ws %zu); nothing launched\n", n_in, n_in > 0 ? in_sizes[0] : -1, out_size, ws_size); grid = -1; return; }
        int dev = 0, cus = 0, per_cu = 0;
        hipGetDevice(&dev); hipDeviceGetAttribute(&cus, hipDeviceAttributeMultiprocessorCount, dev);
        if (hipFuncSetAttribute((const void*)mk_fwd, hipFuncAttributeMaxDynamicSharedMemorySize, LDS_BYTES) != hipSuccess) { fprintf(stderr, "kernel_launch: hipFuncSetAttribute failed\n"); grid = -1; return; }
        if (hipOccupancyMaxActiveBlocksPerMultiprocessor(&per_cu, (const void*)mk_fwd, NWAVES * 64, LDS_BYTES) != hipSuccess || per_cu < 1) { fprintf(stderr, "kernel_launch: occupancy query says %d blocks per CU\n", per_cu); per_cu = 1; }
        (void)hipGetLastError();
        grid = cus >= 256 ? 256 : cus;
        if (cus != 256) fprintf(stderr, "kernel_launch: built for a 256-CU device, found %d CUs\n", cus);
        (void)0;
    }
    if (grid < 0) return;
    Args a{};
    for (int i = 0; i < 19; ++i) a.in[i] = (const float*)d_in[i];
    a.out = (float*)d_out; a.ws = (unsigned char*)d_ws;
    void* args[] = {&a};
    hipError_t e = hipLaunchCooperativeKernel((const void*)mk_fwd, dim3(grid), dim3(NWAVES * 64), args, LDS_BYTES, stream);
    if (e != hipSuccess) fprintf(stderr, "kernel_launch: cooperative launch failed: %s (grid %d)\n", hipGetErrorString(e), grid);
}
```

```cpp
#include <hip/hip_runtime.h>
#include <hip/hip_cooperative_groups.h>
#include <cmath>
#include <cstdio>
#include <cstdint>
namespace pg8 {
#define PG8_LAS __attribute__((address_space(3)))
typedef unsigned short bf16_t;
typedef short bf16x8 __attribute__((ext_vector_type(8)));
typedef float f32x4 __attribute__((ext_vector_type(4)));
typedef unsigned u32x4 __attribute__((ext_vector_type(4)));
constexpr int BM = 256, BK = 64, HALF = 128, HTB = HALF * BK * 2  , STAGE_BYTES = 8 * HTB, NXCD = 8, WGM = 8;

__host__ __device__ __forceinline__ int lds_byte(int r, int c) { const int st = (r >> 4) * 2 + (c >> 5), rr = r & 15, cc = c & 31, ob = rr * 64 + cc * 2; return st * 1024 + (ob ^ (((ob >> 9) & 1) << 5)); }
__host__ __device__ __forceinline__ void stage_rc(int b, int& R, int& C) { const int st = b / 1024, sb = b % 1024, swz = sb ^ (((sb >> 9) & 1) << 5); R = (st >> 1) * 16 + swz / 64; C = (st & 1) * 32 + (swz % 64) / 2; }
__host__ __device__ __forceinline__ int perm32(int rho) { const int n = rho >> 4, i = rho & 15; return 8 * (i >> 2) + 4 * n + (i & 3); }

struct Unit { int pm, pn; };
struct Gemm { const bf16_t* A; const bf16_t* Bt; int M, N, K; };

struct StaticOrder {
    int nM, nN, nwg, G, c;
    __host__ __device__ void init(int M, int N, int G_, int c_) { nM = M / BM; nN = N / BM; nwg = nM * nN; G = G_; c = c_; }
    __host__ __device__ bool next(int i, Unit& u) const {
        const long L = (long)i * G + c; if (L >= nwg) return false;
        int wgid = (int)L; { const int q = nwg / NXCD, r = nwg % NXCD, xcd = wgid % NXCD, off = wgid / NXCD; wgid = (xcd < r ? xcd * (q + 1) : r * (q + 1) + (xcd - r) * q) + off; }
        const int nig = WGM * nN, gid = wgid / nig, fm = gid * WGM, gsz = (nM - fm) < WGM ? (nM - fm) : WGM;
        u.pm = fm + ((wgid % nig) % gsz); u.pn = (wgid % nig) / gsz; return true;
    }
    __device__ __forceinline__ void a_ready(const Unit&) const {}
    __device__ __forceinline__ void done(const Unit&) const {}
};

__device__ __forceinline__ unsigned cvt_pk_bf16(float lo, float hi) { unsigned r; asm volatile("v_cvt_pk_bf16_f32 %0, %1, %2" : "=v"(r) : "v"(lo), "v"(hi)); return r; }

template <class Epi, class Sched, bool ALIGN_EPI = false, bool SP2 = false>
__device__ __forceinline__ void gemm_phase(PG8_LAS unsigned char* lds, const Gemm g, const Sched& S, const Epi& E) {
    int tid_ = threadIdx.x; asm volatile("" : "+v"(tid_));
    const int tid = tid_, wid = __builtin_amdgcn_readfirstlane(tid >> 6), lane = tid & 63, wr = wid >> 2, wc = wid & 3, fr = lane & 15, fq = lane >> 4;
    const int K = g.K, nt = K / BK;
    unsigned voffA[2], voffB[2];
#pragma unroll
    for (int i = 0; i < 2; ++i) { int R, C; stage_rc(tid * 16 + i * 8192, R, C); const int Rb = Epi::PERM ? ((R & ~31) + perm32(R & 31)) : R;
        voffA[i] = (unsigned)(R * K + C) * 2u; voffB[i] = (unsigned)(Rb * K + C) * 2u; }
    const size_t kstep = (size_t)(BK * 2);
    const size_t hstep = (size_t)HALF * K * 2;
    const size_t tstep = 2 * hstep;
    const unsigned ldsw = (unsigned)wid * 1024u;
    const int aoff = lds_byte(wr * 64 + fr, fq * 8), boff = lds_byte(wc * 32 + fr, fq * 8);
#define PG8_SA(b, h) (((b) * 2 + (h)) * HTB)
#define PG8_SB(b, h) ((4 + (b) * 2 + (h)) * HTB)
#define PG8_STAGE(bufoff, gbase, voff) do { _Pragma("unroll") for (int _i = 0; _i < 2; ++_i) \
        __builtin_amdgcn_global_load_lds((const unsigned*)((const char*)(gbase) + (voff)[_i]), (PG8_LAS unsigned*)(lds + (bufoff) + ldsw + _i * 8192), 16, 0, 0); } while (0)
#define PG8_LDA(dst, b, h) do { _Pragma("unroll") for (int m = 0; m < 4; ++m) _Pragma("unroll") for (int k = 0; k < 2; ++k) dst[m][k] = *(const PG8_LAS bf16x8*)(lds + PG8_SA(b, h) + aoff + m * 2048 + k * 1024); } while (0)
#define PG8_LDB(dst, b, h) do { _Pragma("unroll") for (int n = 0; n < 2; ++n) _Pragma("unroll") for (int k = 0; k < 2; ++k) dst[n][k] = *(const PG8_LAS bf16x8*)(lds + PG8_SB(b, h) + boff + n * 2048 + k * 1024); } while (0)
#define PG8_MMA(ai, bj, At, Bt) do { __builtin_amdgcn_s_setprio(1); _Pragma("unroll") for (int m = 0; m < 4; ++m) _Pragma("unroll") for (int n = 0; n < 2; ++n) _Pragma("unroll") for (int k = 0; k < 2; ++k) \
        acc[ai][bj][m][n] = __builtin_amdgcn_mfma_f32_16x16x32_bf16(Bt[n][k], At[m][k], acc[ai][bj][m][n], 0, 0, 0); __builtin_amdgcn_s_setprio(0); } while (0)
#define PG8_WAIT_V(n) asm volatile("s_waitcnt vmcnt(" #n ")" ::: "memory")
#define PG8_WAIT_L(n) asm volatile("s_waitcnt lgkmcnt(" #n ")" ::: "memory")
#define PG8_BAR __builtin_amdgcn_s_barrier()
#define PG8_SCHED __builtin_amdgcn_sched_barrier(0)
    Unit cur, nxt; int ui = 0;
    if (!S.next(0, cur)) return;
    f32x4 acc[2][2][4][2];
#pragma unroll
    for (int a = 0; a < 2; ++a)
#pragma unroll
        for (int b = 0; b < 2; ++b)
#pragma unroll
            for (int m = 0; m < 4; ++m)
#pragma unroll
                for (int n = 0; n < 2; ++n) acc[a][b][m][n] = (f32x4){0.f, 0.f, 0.f, 0.f};
    bf16x8 At[4][2], B0[2][2], B1[2][2];
    const char* cA = (const char*)g.A + (size_t)cur.pm * tstep; const char* cB = (const char*)g.Bt + (size_t)cur.pn * tstep;
    S.a_ready(cur);
    if constexpr (SP2) {
        PG8_STAGE(PG8_SB(0, 0), cB, voffB); PG8_STAGE(PG8_SB(0, 1), cB + hstep, voffB); PG8_STAGE(PG8_SA(0, 0), cA, voffA); PG8_STAGE(PG8_SA(0, 1), cA + hstep, voffA);
        if (wr == 1) PG8_BAR;
        PG8_WAIT_V(2); PG8_BAR;
        PG8_STAGE(PG8_SB(1, 0), cB + kstep, voffB); PG8_STAGE(PG8_SA(1, 0), cA + kstep, voffA); PG8_STAGE(PG8_SB(1, 1), cB + hstep + kstep, voffB);
        PG8_WAIT_V(6); PG8_BAR;
    } else {
        PG8_STAGE(PG8_SB(0, 0), cB, voffB); PG8_STAGE(PG8_SA(0, 0), cA, voffA); PG8_STAGE(PG8_SB(0, 1), cB + hstep, voffB); PG8_STAGE(PG8_SA(0, 1), cA + hstep, voffA);
        if (wr == 1) PG8_BAR;
        PG8_WAIT_V(4); PG8_BAR;
        PG8_STAGE(PG8_SB(1, 0), cB + kstep, voffB); PG8_STAGE(PG8_SA(1, 0), cA + kstep, voffA); PG8_STAGE(PG8_SB(1, 1), cB + hstep + kstep, voffB);
        PG8_WAIT_V(6); PG8_BAR;
    }
    for (;;) {
        const bool has_next = S.next(ui + 1, nxt);
        const char* nA = has_next ? (const char*)g.A + (size_t)nxt.pm * tstep : cA; const char* nB = has_next ? (const char*)g.Bt + (size_t)nxt.pn * tstep : cB;
        for (int t = 0; t < nt; t += 2) {
            const bool last = (t == nt - 2);
            const char* a1 = cA + (size_t)(t + 1) * kstep;
            const char* a2 = last ? nA : cA + (size_t)(t + 2) * kstep; const char* b2 = last ? nB : cB + (size_t)(t + 2) * kstep;
            const char* a3 = a2 + kstep; const char* b3 = b2 + kstep;
            if (last && has_next) S.a_ready(nxt);
            if constexpr (SP2) {
            PG8_LDB(B0, 0, 0); PG8_LDB(B1, 0, 1); PG8_SCHED; PG8_LDA(At, 0, 0); PG8_STAGE(PG8_SA(1, 1), a1 + hstep, voffA);
            PG8_WAIT_V(8); PG8_WAIT_L(0); PG8_BAR; PG8_MMA(0, 0, At, B0); PG8_MMA(0, 1, At, B1); PG8_BAR; PG8_SCHED;
            PG8_LDA(At, 0, 1); PG8_STAGE(PG8_SB(0, 0), b2, voffB); PG8_STAGE(PG8_SB(0, 1), b2 + hstep, voffB); PG8_STAGE(PG8_SA(0, 0), a2, voffA);
            PG8_WAIT_V(8); PG8_WAIT_L(0); PG8_BAR; PG8_MMA(1, 0, At, B0); PG8_MMA(1, 1, At, B1); PG8_BAR; PG8_SCHED;
            PG8_LDB(B0, 1, 0); PG8_LDB(B1, 1, 1); PG8_SCHED; PG8_LDA(At, 1, 0); PG8_STAGE(PG8_SA(0, 1), a2 + hstep, voffA);
            PG8_WAIT_V(8); PG8_WAIT_L(0); PG8_BAR; PG8_MMA(0, 0, At, B0); PG8_MMA(0, 1, At, B1); PG8_BAR; PG8_SCHED;
            PG8_LDA(At, 1, 1); PG8_STAGE(PG8_SB(1, 0), b3, voffB); PG8_STAGE(PG8_SB(1, 1), b3 + hstep, voffB); PG8_STAGE(PG8_SA(1, 0), a3, voffA);
            PG8_WAIT_V(8); PG8_WAIT_L(0); PG8_BAR; PG8_MMA(1, 0, At, B0); PG8_MMA(1, 1, At, B1); PG8_BAR; PG8_SCHED;
            } else {
            PG8_LDB(B0, 0, 0); PG8_SCHED; PG8_LDA(At, 0, 0); PG8_STAGE(PG8_SA(1, 1), a1 + hstep, voffA);
            PG8_WAIT_L(8); PG8_BAR; PG8_WAIT_L(0); PG8_MMA(0, 0, At, B0); PG8_BAR; PG8_SCHED;
            PG8_LDB(B1, 0, 1); PG8_STAGE(PG8_SB(0, 0), b2, voffB);
            PG8_BAR; PG8_WAIT_L(0); PG8_MMA(0, 1, At, B1); PG8_BAR;
            PG8_LDA(At, 0, 1); PG8_STAGE(PG8_SA(0, 0), a2, voffA);
            PG8_BAR; PG8_WAIT_L(0); PG8_MMA(1, 0, At, B0); PG8_BAR; PG8_SCHED;
            PG8_STAGE(PG8_SB(0, 1), b2 + hstep, voffB);
            PG8_WAIT_V(6); PG8_BAR; PG8_MMA(1, 1, At, B1); PG8_BAR;
            PG8_LDB(B0, 1, 0); PG8_SCHED; PG8_LDA(At, 1, 0); PG8_STAGE(PG8_SA(0, 1), a2 + hstep, voffA);
            PG8_WAIT_L(8); PG8_BAR; PG8_WAIT_L(0); PG8_MMA(0, 0, At, B0); PG8_BAR; PG8_SCHED;
            PG8_LDB(B1, 1, 1); PG8_STAGE(PG8_SB(1, 0), b3, voffB);
            PG8_BAR; PG8_WAIT_L(0); PG8_MMA(0, 1, At, B1); PG8_BAR;
            PG8_LDA(At, 1, 1); PG8_STAGE(PG8_SA(1, 0), a3, voffA);
            PG8_BAR; PG8_WAIT_L(0); PG8_MMA(1, 0, At, B0); PG8_BAR; PG8_SCHED;
            PG8_STAGE(PG8_SB(1, 1), b3 + hstep, voffB);
            PG8_WAIT_V(6); PG8_BAR; PG8_MMA(1, 1, At, B1); PG8_BAR;
            }
        }
        if constexpr (ALIGN_EPI) { if (wr == 0) PG8_BAR; }
        if constexpr (!Epi::AFTER_DRAIN) { E(acc, cur, wr, wc, fr, fq); S.done(cur); }
        if (!has_next) break;
#pragma unroll
        for (int a = 0; a < 2; ++a)
#pragma unroll
            for (int b = 0; b < 2; ++b)
#pragma unroll
                for (int m = 0; m < 4; ++m)
#pragma unroll
                    for (int n = 0; n < 2; ++n) acc[a][b][m][n] = (f32x4){0.f, 0.f, 0.f, 0.f};
        cur = nxt; cA = nA; cB = nB; ++ui;
        if constexpr (ALIGN_EPI) { if (wr == 1) PG8_BAR; }
    }
    PG8_WAIT_V(0);
    if constexpr (!ALIGN_EPI) { if (wr == 0) PG8_BAR; }
    PG8_BAR;
    if constexpr (Epi::AFTER_DRAIN) { E.fused(acc, cur, wr, wc, fr, fq, lds, wid, lane); S.done(cur); }
#undef PG8_SA
#undef PG8_SB
#undef PG8_STAGE
#undef PG8_LDA
#undef PG8_LDB
#undef PG8_MMA
#undef PG8_WAIT_V
#undef PG8_WAIT_L
#undef PG8_BAR
#undef PG8_SCHED
}
}

namespace cg = cooperative_groups;

#define LAS __attribute__((address_space(3)))
typedef unsigned short bf16_t;
typedef float f32x4 __attribute__((ext_vector_type(4)));
typedef float f32x16 __attribute__((ext_vector_type(16)));
typedef short bf16x8 __attribute__((ext_vector_type(8)));
typedef short s16x4 __attribute__((ext_vector_type(4)));
typedef unsigned u32x2 __attribute__((ext_vector_type(2)));
typedef unsigned u32x4 __attribute__((ext_vector_type(4)));
using pg8::Unit;
typedef float f32x2_t __attribute__((ext_vector_type(2))); typedef __bf16 bf16x2_t __attribute__((ext_vector_type(2)));
__device__ __forceinline__ unsigned cvt_pk_bf16(float lo, float hi) { const f32x2_t v = {lo, hi}; const bf16x2_t b = __builtin_convertvector(v, bf16x2_t); return __builtin_bit_cast(unsigned, b); }

constexpr int NT = 65536, SEQ = 2048, DM = 1024, FF = 2816, NWAVES = 8;
constexpr float EPS = 1e-6f, LOG2E = 1.4426950408889634f;
constexpr float QSCALE_D = 0.125f * LOG2E;
constexpr float QSCALE_M = 0.10206207261596577f * LOG2E;

constexpr size_t MiB = 1u << 20;
constexpr size_t WS_W1GU = 0, WS_W1D = 11 * MiB, WS_W2GU = 17 * MiB, WS_W2D = 28 * MiB, WS_WIN = 34 * MiB, WS_WUQ = 39 * MiB, WS_WUKV = 40 * MiB, WS_WOUT = 41 * MiB;
constexpr size_t WS_ROPE = 43 * MiB;
constexpr size_t WS_SS0 = 44 * MiB, WS_SS1 = 48 * MiB, WS_SS2 = 52 * MiB, WS_SS3 = 56 * MiB, WS_SSQ = 60 * MiB, WS_SSKV = 62 * MiB;
constexpr size_t WS_BAR = 63 * MiB;
constexpr size_t WS_XB = 64 * MiB;
constexpr size_t WS_KVM = WS_XB;
constexpr size_t WS_H = 192 * MiB;
constexpr size_t WS_OD0 = 192 * MiB, WS_OD1 = 256 * MiB, WS_OD2 = 320 * MiB, WS_OMIX = 384 * MiB, WS_LSE = 512 * MiB;
constexpr size_t WS_QD = 544 * MiB, WS_KD = 608 * MiB, WS_VD = 672 * MiB, WS_CQ = 736 * MiB, WS_CKV = 784 * MiB, WS_KR = 816 * MiB, WS_QM = 820 * MiB, WS_END = 916 * MiB;

__device__ __forceinline__ float fast_exp2(float x) { return __builtin_amdgcn_exp2f(x); }
__device__ __forceinline__ float fast_rcp(float x) { return __builtin_amdgcn_rcpf(x); }
__device__ __forceinline__ float bf2f(unsigned short b) { return __uint_as_float((unsigned)b << 16); }
__device__ __forceinline__ float sum4(f32x4 a) { return (a[0] + a[1]) + (a[2] + a[3]); }
__device__ __forceinline__ float sq4(f32x4 a) { return (a[0] * a[0] + a[1] * a[1]) + (a[2] * a[2] + a[3] * a[3]); }
__device__ __forceinline__ float rstd_parts16(const float* ss, int row, float invn) {
    const f32x4* p = (const f32x4*)(ss + (size_t)row * 16);
    const float s = (sum4(p[0]) + sum4(p[1])) + (sum4(p[2]) + sum4(p[3]));
    return rsqrtf(s * invn + EPS);
}

#define EPI_RELANE() int fr, fq; { int t_ = threadIdx.x; asm volatile("" : "+v"(t_)); fr = t_ & 15; fq = (t_ >> 4) & 3; }
__device__ __forceinline__ void rstd4_fill(LAS float* tab4, const float* ss) {
    int tid = threadIdx.x; asm volatile("" : "+v"(tid));
    const int c = blockIdx.x;
#pragma unroll
    for (int k = 0; k < 2; ++k) { const int idx = tid + 512 * k, slot = idx >> 8, r = idx & 255, pm = 8 * (4 * (c & 7) + slot) + ((c >> 3) & 7); tab4[idx] = rstd_parts16(ss, pm * 256 + r, 1.0f / 1024.0f); }
    __syncthreads();
}
__device__ __forceinline__ int rstd4_slot(int pm) { return (pm >> 3) - 4 * ((int)blockIdx.x & 7); }
struct EpiGateUp {
    static constexpr bool PERM = true, AFTER_DRAIN = false;
    bf16_t* H; const float* ss; LAS float* tab;
    __device__ __forceinline__ void operator()(const f32x4 (&acc)[2][2][4][2], const Unit& u, int wr, int wc, int fr_in, int fq_in) const {
        EPI_RELANE();
        const LAS float* tb = tab + rstd4_slot(u.pm) * 256;
        const int r0 = wr * 64 + fr, col = u.pn * 128 + wc * 32 + 8 * fq;
#pragma unroll
        for (int ai = 0; ai < 2; ++ai)
#pragma unroll
            for (int m = 0; m < 4; ++m) {
                const int r = r0 + ai * 128 + m * 16;
                const float rs = tb[r], nrs = -rs * LOG2E;
                float o[8];
#pragma unroll
                for (int n = 0; n < 2; ++n)
#pragma unroll
                    for (int j = 0; j < 4; ++j) {
                        const float ga = acc[ai][0][m][n][j];
                        o[4 * n + j] = (ga * rs) * fast_rcp(1.0f + fast_exp2(ga * nrs)) * (acc[ai][1][m][n][j] * rs);
                    }
                u32x4 w; w.x = cvt_pk_bf16(o[0], o[1]); w.y = cvt_pk_bf16(o[2], o[3]); w.z = cvt_pk_bf16(o[4], o[5]); w.w = cvt_pk_bf16(o[6], o[7]);
                *(u32x4*)(H + (size_t)(u.pm * 256 + r) * FF + col) = w;
            }
    }
};
struct EpiResid {
    static constexpr bool PERM = true, AFTER_DRAIN = false;
    bf16_t* xb; float* ss; float alpha;
    __device__ __forceinline__ void operator()(const f32x4 (&acc)[2][2][4][2], const Unit& u, int wr, int wc, int fr_in, int fq_in) const {
        EPI_RELANE();
        const int row0 = u.pm * 256 + wr * 64 + fr, col0 = u.pn * 256 + wc * 32 + 8 * fq;
        u32x4 bws[2][4][2];
#pragma unroll
        for (int ai = 0; ai < 2; ++ai)
#pragma unroll
            for (int m = 0; m < 4; ++m)
#pragma unroll
                for (int bj = 0; bj < 2; ++bj) bws[ai][m][bj] = *(const u32x4*)(xb + (size_t)(row0 + ai * 128 + m * 16) * DM + col0 + bj * 128);
#pragma unroll
        for (int ai = 0; ai < 2; ++ai)
#pragma unroll
            for (int m = 0; m < 4; ++m) {
                const int row = row0 + ai * 128 + m * 16; float sq = 0.f;
#pragma unroll
                for (int bj = 0; bj < 2; ++bj) {
                    const u32x4 bw = bws[ai][m][bj];
                    const f32x4 b0 = {__uint_as_float(bw.x << 16), __uint_as_float(bw.x & 0xffff0000u), __uint_as_float(bw.y << 16), __uint_as_float(bw.y & 0xffff0000u)};
                    const f32x4 b1 = {__uint_as_float(bw.z << 16), __uint_as_float(bw.z & 0xffff0000u), __uint_as_float(bw.w << 16), __uint_as_float(bw.w & 0xffff0000u)};
                    const f32x4 v0 = b0 + acc[ai][bj][m][0] * alpha, v1 = b1 + acc[ai][bj][m][1] * alpha; sq += sq4(v0) + sq4(v1);
                    u32x4 w; w.x = cvt_pk_bf16(v0[0], v0[1]); w.y = cvt_pk_bf16(v0[2], v0[3]); w.z = cvt_pk_bf16(v1[0], v1[1]); w.w = cvt_pk_bf16(v1[2], v1[3]);
                    *(u32x4*)(xb + (size_t)row * DM + col0 + bj * 128) = w;
                }
                sq += __shfl_xor(sq, 16); sq += __shfl_xor(sq, 32);
                if (fq == 0) ss[(size_t)row * 16 + u.pn * 4 + wc] = sq;
            }
    }
};
struct EpiFinal {
    static constexpr bool PERM = true, AFTER_DRAIN = false;
    const bf16_t* xb; float* X; float* ss; unsigned* cnt; const float* gfin; LAS float* tab;
    __device__ __forceinline__ void operator()(f32x4 (&acc)[2][2][4][2], const Unit& u, int wr, int wc, int fr_in, int fq_in) const {
        EPI_RELANE();
        int tid = threadIdx.x; asm volatile("" : "+v"(tid));
        const int row0 = u.pm * 256 + wr * 64 + fr, col0 = u.pn * 256 + wc * 32 + 8 * fq;
        u32x4 bws[2][4][2];
#pragma unroll
        for (int ai = 0; ai < 2; ++ai)
#pragma unroll
            for (int m = 0; m < 4; ++m)
#pragma unroll
                for (int bj = 0; bj < 2; ++bj) bws[ai][m][bj] = *(const u32x4*)(xb + (size_t)(row0 + ai * 128 + m * 16) * DM + col0 + bj * 128);
#pragma unroll
        for (int ai = 0; ai < 2; ++ai)
#pragma unroll
            for (int m = 0; m < 4; ++m) {
                const int row = row0 + ai * 128 + m * 16; float sq = 0.f;
#pragma unroll
                for (int bj = 0; bj < 2; ++bj) {
                    const u32x4 bw = bws[ai][m][bj];
                    const f32x4 b0 = {__uint_as_float(bw.x << 16), __uint_as_float(bw.x & 0xffff0000u), __uint_as_float(bw.y << 16), __uint_as_float(bw.y & 0xffff0000u)};
                    const f32x4 b1 = {__uint_as_float(bw.z << 16), __uint_as_float(bw.z & 0xffff0000u), __uint_as_float(bw.w << 16), __uint_as_float(bw.w & 0xffff0000u)};
                    const f32x4 v0 = b0 + acc[ai][bj][m][0] * 0.5f, v1 = b1 + acc[ai][bj][m][1] * 0.5f; acc[ai][bj][m][0] = v0; acc[ai][bj][m][1] = v1; sq += sq4(v0) + sq4(v1);
                }
                sq += __shfl_xor(sq, 16); sq += __shfl_xor(sq, 32);
                if (fq == 0) ss[(size_t)row * 16 + u.pn * 4 + wc] = sq;
            }
        asm volatile("s_waitcnt vmcnt(0)" ::: "memory");
        __syncthreads();
        if (tid == 0) {
            unsigned* c = cnt + 64 * u.pm;
            __builtin_amdgcn_fence(__ATOMIC_RELEASE, "agent"); asm volatile("s_waitcnt vmcnt(0)" ::: "memory");
            __hip_atomic_fetch_add(c, 1u, __ATOMIC_RELAXED, __HIP_MEMORY_SCOPE_AGENT);
            unsigned sp = 0;
            while (__hip_atomic_load(c, __ATOMIC_RELAXED, __HIP_MEMORY_SCOPE_AGENT) < 4u) { __builtin_amdgcn_s_sleep(2); if (++sp > (1u << 22)) break; }
            __builtin_amdgcn_fence(__ATOMIC_ACQUIRE, "agent"); asm volatile("s_waitcnt vmcnt(0)" ::: "memory");
        }
        __syncthreads();
        if (tid < 256) tab[tid] = rstd_parts16(ss, u.pm * 256 + tid, 1.0f / 1024.0f);
        __syncthreads();
#pragma unroll
        for (int ai = 0; ai < 2; ++ai)
#pragma unroll
            for (int m = 0; m < 4; ++m) {
                const int r = ai * 128 + wr * 64 + m * 16 + fr; const float rs = tab[r];
#pragma unroll
                for (int bj = 0; bj < 2; ++bj)
#pragma unroll
                    for (int n = 0; n < 2; ++n) {
                        const int col = col0 + bj * 128 + n * 4;
                        const f32x4 g = *(const f32x4*)(gfin + col);
                        *(f32x4*)(X + (size_t)(u.pm * 256 + r) * DM + col) = acc[ai][bj][m][n] * rs * g;
                    }
            }
    }
};
__device__ __forceinline__ void store8_pair(bf16_t* grp, int fq, u32x2 w0, u32x2 w1) {
    const bool odd = (fq & 1) != 0;
    const u32x2 snd = odd ? w0 : w1;
    u32x2 rcv; rcv.x = __shfl_xor(snd.x, 16); rcv.y = __shfl_xor(snd.y, 16);
    u32x4 o; if (odd) { o.x = rcv.x; o.y = rcv.y; o.z = w1.x; o.w = w1.y; } else { o.x = w0.x; o.y = w0.y; o.z = rcv.x; o.w = rcv.y; }
    *(u32x4*)(grp + (odd ? 16 + 4 * (fq - 1) : 4 * fq)) = o;
}
struct EpiInProj {
    static constexpr bool PERM = false, AFTER_DRAIN = false;
    const float* ss1; bf16_t *QD, *KD, *VD, *CQ, *CKV, *KR; float *SSQ, *SSKV; const float *cosm, *sinm, *cosp, *sinp; LAS float* tab;
    __device__ __forceinline__ void operator()(const f32x4 (&acc)[2][2][4][2], const Unit& u, int wr, int wc, int fr_in, int fq_in) const {
        EPI_RELANE();
        const LAS float* tb = tab + rstd4_slot(u.pm) * 256;
        const int row0 = u.pm * 256 + wr * 64 + fr, pn = u.pn;
        const bool ropeP = (pn < 4) && ((wc & 1) == 0), ropeM = (pn == 7) && (wc == 0);
        f32x4 cs[2][4], sn[2][4];
        if (ropeP || ropeM) {
#pragma unroll
            for (int ai = 0; ai < 2; ++ai)
#pragma unroll
                for (int m = 0; m < 4; ++m) { const int pos = (row0 + ai * 128 + m * 16) & (SEQ - 1);
                    const float* cp = ropeP ? cosp + pos * 8 + 4 * (fq & 1) : cosm + pos * 16 + 4 * fq; const float* sp = ropeP ? sinp + pos * 8 + 4 * (fq & 1) : sinm + pos * 16 + 4 * fq;
                    cs[ai][m] = *(const f32x4*)cp; sn[ai][m] = *(const f32x4*)sp; }
        }
#pragma unroll
        for (int ai = 0; ai < 2; ++ai)
#pragma unroll
            for (int m = 0; m < 4; ++m) {
                const int row = row0 + ai * 128 + m * 16, pos = row & (SEQ - 1);
                const float rs = tb[ai * 128 + wr * 64 + m * 16 + fr];
                if (pn < 6) {
                    bf16_t* dst = QD + (size_t)(pn >> 1) * ((size_t)NT * 512) + (size_t)row * 512 + (pn & 1) * 256 + wc * 32;
                    const float sc = pn < 2 ? rs * QSCALE_D : rs;
                    const bool rope = (pn < 4) && ((wc & 1) == 0);
#pragma unroll
                    for (int bj = 0; bj < 2; ++bj) {
                        u32x2 wp[2];
#pragma unroll
                        for (int n = 0; n < 2; ++n) {
                            f32x4 v = acc[ai][bj][m][n] * sc;
                            if (n == 0 && rope) {
                                f32x4 pv; pv[0] = __shfl_xor(v[0], 32); pv[1] = __shfl_xor(v[1], 32); pv[2] = __shfl_xor(v[2], 32); pv[3] = __shfl_xor(v[3], 32);
                                const f32x4 c = cs[ai][m], s = sn[ai][m];
                                v = (fq < 2) ? (v * c - pv * s) : (v * c + pv * s);
                            }
                            wp[n].x = cvt_pk_bf16(v[0], v[1]); wp[n].y = cvt_pk_bf16(v[2], v[3]);
                        }
                        store8_pair(dst + bj * 128, fq, wp[0], wp[1]);
                    }
                } else if (pn == 6 || pn == 8) {
                    bf16_t* dst = CQ + (pn == 6 ? (size_t)row * 384 : (size_t)NT * 384 + (size_t)row * 256) + wc * 32; float sq = 0.f;
#pragma unroll
                    for (int bj = 0; bj < 2; ++bj) {
                        u32x2 wp[2];
#pragma unroll
                        for (int n = 0; n < 2; ++n) {
                            const f32x4 v = acc[ai][bj][m][n] * rs; sq += sq4(v);
                            wp[n].x = cvt_pk_bf16(v[0], v[1]); wp[n].y = cvt_pk_bf16(v[2], v[3]);
                        }
                        store8_pair(dst + bj * 128, fq, wp[0], wp[1]);
                    }
                    sq += __shfl_xor(sq, 16); sq += __shfl_xor(sq, 32);
                    if (fq == 0) SSQ[(pn == 6 ? (size_t)row * 8 : (size_t)NT * 8 + (size_t)row * 4) + wc] = sq;
                } else {
                    bf16_t* dst = CQ + (size_t)row * 384 + 256 + wc * 32; float sq = 0.f;
                    { u32x2 wp[2];
#pragma unroll
                      for (int n = 0; n < 2; ++n) {
                          const f32x4 v = acc[ai][0][m][n] * rs; sq += sq4(v);
                          wp[n].x = cvt_pk_bf16(v[0], v[1]); wp[n].y = cvt_pk_bf16(v[2], v[3]);
                      }
                      store8_pair(dst, fq, wp[0], wp[1]); }
                    sq += __shfl_xor(sq, 16); sq += __shfl_xor(sq, 32);
                    if (fq == 0) SSQ[(size_t)row * 8 + 4 + wc] = sq;
                    if (wc == 0) {
                        const f32x4 x1 = acc[ai][1][m][0] * rs, x2 = acc[ai][1][m][1] * rs;
                        const f32x4 c = cs[ai][m], s = sn[ai][m];
                        const f32x4 o1 = x1 * c - x2 * s, o2 = x2 * c + x1 * s;
                        u32x2 w1, w2; w1.x = cvt_pk_bf16(o1[0], o1[1]); w1.y = cvt_pk_bf16(o1[2], o1[3]); w2.x = cvt_pk_bf16(o2[0], o2[1]); w2.y = cvt_pk_bf16(o2[2], o2[3]);
                        *(u32x2*)(KR + (size_t)row * 32 + 4 * fq) = w1; *(u32x2*)(KR + (size_t)row * 32 + 16 + 4 * fq) = w2;
                    }
                }
            }
    }
};
struct EpiQ {
    static constexpr bool PERM = false, AFTER_DRAIN = false;
    const float* ssq; bf16_t* QM; const float *cosm, *sinm; LAS float* tab;
    __device__ __forceinline__ void operator()(const f32x4 (&acc)[2][2][4][2], const Unit& u, int wr, int wc, int fr_in, int fq_in) const {
        EPI_RELANE();
        const int row0 = u.pm * 256 + wr * 64 + fr;
        { int tid = threadIdx.x; asm volatile("" : "+v"(tid));
          if (tid < 256) { const f32x4* p = (const f32x4*)(ssq + (size_t)(u.pm * 256 + tid) * 8); tab[tid] = rsqrtf((sum4(p[0]) + sum4(p[1])) * (1.0f / 384.0f) + EPS) * QSCALE_M; } }
        __syncthreads();
#pragma unroll
        for (int ai = 0; ai < 2; ++ai) {
#pragma unroll
            for (int m = 0; m < 4; ++m) {
                const int row = row0 + ai * 128 + m * 16;
                const float rs = tab[ai * 128 + wr * 64 + m * 16 + fr];
#pragma unroll
                for (int bj = 0; bj < 2; ++bj) {
                    const int g32 = 8 * u.pn + 4 * bj + wc;
                    bf16_t* dst = QM + (size_t)row * 768 + 32 * g32 + 4 * fq;
                    f32x4 v0 = acc[ai][bj][m][0] * rs, v1 = acc[ai][bj][m][1] * rs;
                    if (g32 % 3 == 2) {
                        const int pos = row & (SEQ - 1);
                        const f32x4 c = *(const f32x4*)(cosm + pos * 16 + 4 * fq), s = *(const f32x4*)(sinm + pos * 16 + 4 * fq);
                        const f32x4 o1 = v0 * c - v1 * s, o2 = v1 * c + v0 * s; v0 = o1; v1 = o2;
                    }
                    u32x2 w0, w1; w0.x = cvt_pk_bf16(v0[0], v0[1]); w0.y = cvt_pk_bf16(v0[2], v0[3]); w1.x = cvt_pk_bf16(v1[0], v1[1]); w1.y = cvt_pk_bf16(v1[2], v1[3]);
                    *(u32x2*)dst = w0; *(u32x2*)(dst + 16) = w1;
                }
            }
        }
    }
};
struct EpiKV {
    static constexpr bool PERM = true, AFTER_DRAIN = false;
    const float* sskv; bf16_t* KVM; LAS float* tab;
    __device__ __forceinline__ void operator()(const f32x4 (&acc)[2][2][4][2], const Unit& u, int wr, int wc, int fr_in, int fq_in) const {
        EPI_RELANE();
        { int tid = threadIdx.x; asm volatile("" : "+v"(tid)); if (tid < 256) tab[tid] = rsqrtf(sum4(*(const f32x4*)(sskv + (size_t)(u.pm * 256 + tid) * 4)) * (1.0f / 256.0f) + EPS); }
        __syncthreads();
        const int row0 = u.pm * 256 + wr * 64 + fr, col = u.pn * 256 + wc * 32 + 8 * fq;
#pragma unroll
        for (int ai = 0; ai < 2; ++ai)
#pragma unroll
            for (int m = 0; m < 4; ++m) {
                const int row = row0 + ai * 128 + m * 16;
                const float rs = tab[ai * 128 + wr * 64 + m * 16 + fr];
#pragma unroll
                for (int bj = 0; bj < 2; ++bj) {
                    const f32x4 v0 = acc[ai][bj][m][0] * rs, v1 = acc[ai][bj][m][1] * rs;
                    u32x4 w; w.x = cvt_pk_bf16(v0[0], v0[1]); w.y = cvt_pk_bf16(v0[2], v0[3]); w.z = cvt_pk_bf16(v1[0], v1[1]); w.w = cvt_pk_bf16(v1[2], v1[3]);
                    *(u32x4*)(KVM + (size_t)row * 1024 + col + bj * 128) = w;
                }
            }
    }
};

constexpr int ATT_VS = 192;
constexpr int ATT_TILE = 64 * 208 + 64 * ATT_VS;
constexpr int ATT_OST = 2 * ATT_TILE, ATT_WSC = ATT_OST + NWAVES * 4096;
static_assert(ATT_WSC + NWAVES * 256 <= 131072, "attention LDS");
static_assert(WS_KD == WS_QD + (size_t)NT * 512 * 2 && WS_VD == WS_KD + (size_t)NT * 512 * 2 && WS_CKV == WS_CQ + (size_t)NT * 384 * 2 && WS_SSKV == WS_SSQ + (size_t)NT * 8 * 4, "buffers addressed relative to each other");
__device__ __forceinline__ int crow(int r, int hi) { return (r & 3) + 8 * (r >> 2) + 4 * hi; }
__device__ __forceinline__ bf16x8 pack8(const f32x16& p, int b) {
    u32x4 w; w.x = cvt_pk_bf16(p[b], p[b + 1]); w.y = cvt_pk_bf16(p[b + 2], p[b + 3]); w.z = cvt_pk_bf16(p[b + 4], p[b + 5]); w.w = cvt_pk_bf16(p[b + 6], p[b + 7]);
    return __builtin_bit_cast(bf16x8, w);
}
typedef short v4i16_t __attribute__((ext_vector_type(4)));
__device__ __forceinline__ s16x4 vtr(LAS const unsigned char* p) { return __builtin_bit_cast(s16x4, __builtin_amdgcn_ds_read_tr16_b64_v4i16((LAS v4i16_t*)p)); }

struct AttnIO {
    const bf16_t *QM, *KVM, *KR; bf16_t* OMIX;
    const bf16_t *QD, *KD, *VD; bf16_t* OD; float* LSE;
};

template <bool DIL>
__device__ __forceinline__ void attn_unit(LAS unsigned char* lds, const AttnIO& io, int unit) {
    constexpr int DK = DIL ? 64 : 96, KS = DK * 2 + 16, NKS = DK / 16;
    int tid_ = threadIdx.x; asm volatile("" : "+v"(tid_));
    const int tid = tid_, lane = tid & 63, wid = __builtin_amdgcn_readfirstlane(tid >> 6), r32 = lane & 31, hi = lane >> 5;
    int b, h, ntiles, tlo, thi, kofs = 0, L = SEQ, dil = 1, res = 0, resu = 0, br = 0, q0 = 0, pq;
    if constexpr (!DIL) {
        const int bh = unit >> 3, qb = unit & 7; b = bh >> 3; h = bh & 7; ntiles = 32; tlo = 0; thi = 32; q0 = qb * 256; pq = q0 + wid * 32 + r32;
    } else {
        const int bh = unit / 24, k = unit % 24, j = k & 7; br = k >> 3; b = bh >> 3; h = bh & 7;
        if (br == 0) { dil = 1; L = 2048; resu = 0; q0 = 256 * j; }
        else if (br == 1) { dil = 4; L = 512; resu = j >> 1; q0 = 256 * (j & 1); }
        else { dil = 16; L = 128; resu = 2 * j; q0 = 0; }
        if (br < 2) { ntiles = 6; tlo = wid >> 1; thi = tlo + 3; kofs = q0 - 64; pq = q0 + wid * 32 + r32; res = resu; }
        else { const int hw = wid >> 2; ntiles = 4; tlo = 2 * hw; thi = tlo + 2; kofs = -128 * hw; pq = (wid & 3) * 32 + r32; res = resu + hw; }
    }
    const int pq0 = pq - r32;
    const size_t kb = (size_t)b * SEQ;
    bf16x8 qf[NKS];
    {
        const bf16_t* qp = DIL ? io.QD + (kb + (size_t)pq * dil + res) * 512 + h * 64 : io.QM + (kb + pq) * 768 + h * 96;
#pragma unroll
        for (int ks = 0; ks < NKS; ++ks) qf[ks] = *(const bf16x8*)(qp + ks * 16 + hi * 8);
    }
    const int lrow = tid >> 3, lch = tid & 7, rrow = (tid >> 2) & 63, rch = tid & 3;
    u32x4 gkA, gvA, grA = (u32x4){0u, 0u, 0u, 0u}, gkB, gvB, grB = (u32x4){0u, 0u, 0u, 0u};
#define ATT_TOK(t) \
        const int s_ = 64 * (t) + lrow; size_t tok_; \
        if (br < 2) { int p_ = q0 - 64 + s_; p_ = p_ < 0 ? 0 : (p_ > L - 1 ? L - 1 : p_); tok_ = kb + (size_t)p_ * dil + resu; } \
        else { tok_ = kb + (size_t)(s_ & 127) * 16 + (size_t)(resu + (s_ >> 7)); }
#define ATT_GLOADK(t, GK, GR) do { \
        if constexpr (!DIL) { \
            GK = *(const u32x4*)(io.KVM + (kb + 64 * (t) + lrow) * 1024 + h * 128 + lch * 8); \
            GR = *(const u32x4*)(io.KR + (kb + 64 * (t) + rrow) * 32 + rch * 8); \
        } else { ATT_TOK(t) GK = *(const u32x4*)(io.KD + tok_ * 512 + h * 64 + lch * 8); } } while (0)
#define ATT_GLOADV(t, GV) do { \
        if constexpr (!DIL) { GV = *(const u32x4*)(io.KVM + (kb + 64 * (t) + lrow) * 1024 + h * 128 + 64 + lch * 8); } \
        else { ATT_TOK(t) GV = *(const u32x4*)(io.VD + tok_ * 512 + h * 64 + lch * 8); } } while (0)
#define ATT_LSTOREK(buf, GK, GR) do { \
        LAS unsigned char* Kb_ = lds + (buf) * ATT_TILE; \
        *(LAS u32x4*)(Kb_ + lrow * KS + lch * 16) = GK; \
        if constexpr (!DIL) { *(LAS u32x4*)(Kb_ + rrow * KS + 128 + rch * 16) = GR; } } while (0)
#define ATT_LSTOREV(buf, GV) do { *(LAS u32x4*)(lds + (buf) * ATT_TILE + 64 * KS + lrow * ATT_VS + lch * 16) = GV; } while (0)
#define ATT_SB() do {} while (0)
    LAS float* wsc = (LAS float*)(lds + ATT_WSC + wid * 256);
    f32x16 o0 = {}, o1 = {}, negm = {};
    float mref = 0.f, lrun = 0.f; bool started = false;
    const int krow = (r32 & 19) | ((r32 & 4) << 1) | ((r32 & 8) >> 1);
    const int koff = krow * KS + hi * 16;
    const int i16 = lane & 15, g16 = lane >> 4;
    const int voff = 64 * KS + (8 * hi + (i16 >> 2)) * ATT_VS + (16 * (g16 & 1) + 4 * (i16 & 3)) * 2;
    ATT_GLOADK(0, gkA, grA); ATT_GLOADV(0, gvA); ATT_GLOADK(1, gkB, grB); ATT_LSTOREK(0, gkA, grA); ATT_LSTOREV(0, gvA); ATT_LSTOREK(1, gkB, grB);
    ATT_GLOADK(2, gkB, grB); ATT_GLOADV(1, gvB);
    __syncthreads();
    f32x16 c0, c1;
    if (tlo == 0) {
        c0 = negm; c1 = negm;
#pragma unroll
        for (int ks = 0; ks < NKS; ++ks) {
            const bf16x8 a0 = *(LAS const bf16x8*)(lds + koff + ks * 32), a1 = *(LAS const bf16x8*)(lds + koff + 32 * KS + ks * 32);
            c0 = __builtin_amdgcn_mfma_f32_32x32x16_bf16(a0, qf[ks], c0, 0, 0, 0); c1 = __builtin_amdgcn_mfma_f32_32x32x16_bf16(a1, qf[ks], c1, 0, 0, 0);
        }
    } else { c0 = negm; c1 = negm; }
    __syncthreads();
    for (int t2 = 0; t2 < ntiles; t2 += 2) {
      { const int t = t2;
        ATT_GLOADK(min(t + 3, ntiles - 1), gkA, grA);
        ATT_GLOADV(min(t + 2, ntiles - 1), gvA);
        const bool doP = (t >= tlo) && (t < thi), doS = (t + 1 >= tlo) && (t + 1 < thi);
        LAS const unsigned char* Kn = lds + ((t + 1) & 1) * ATT_TILE + koff;
        LAS const unsigned char* Vc = lds + (t & 1) * ATT_TILE + voff;
        f32x16 n0 = negm, n1 = negm;
        if (doP) {
            if constexpr (DIL) {
                const int P0 = 64 * t + kofs;
                const bool full = (P0 >= pq0 - 33) && (P0 + 63 <= pq0 + 64) && (P0 >= 0) && (P0 + 63 < L);
                if (!full) {
                    const int lo = max(pq - 64, 0) - P0 - 8 * hi, span = min(pq + 64, L - 1) - max(pq - 64, 0);
#pragma unroll
                    for (int r = 0; r < 16; ++r) {
                        const int i0 = 16 * (r >> 3) + (r & 7);
                        c0[r] = ((unsigned)(i0 - lo) <= (unsigned)span) ? c0[r] : -INFINITY;
                        c1[r] = ((unsigned)(i0 + 32 - lo) <= (unsigned)span) ? c1[r] : -INFINITY;
                    }
                }
            }
            float ma = fmaxf(fmaxf(c0[0], c0[1]), c1[0]), mb = fmaxf(fmaxf(c0[2], c0[3]), c1[1]);
            ma = fmaxf(fmaxf(ma, c1[2]), c1[3]);
#pragma unroll
            for (int r = 4; r < 16; r += 4) { ma = fmaxf(fmaxf(ma, c0[r]), c0[r + 1]); mb = fmaxf(fmaxf(mb, c0[r + 2]), c0[r + 3]); ma = fmaxf(fmaxf(ma, c1[r]), c1[r + 1]); mb = fmaxf(fmaxf(mb, c1[r + 2]), c1[r + 3]); }
            float rm = fmaxf(ma, mb);
            { auto rr = __builtin_amdgcn_permlane32_swap(__float_as_uint(rm), __float_as_uint(rm), false, false); rm = fmaxf(__uint_as_float(rr[0]), __uint_as_float(rr[1])); }
            const float dl = (rm > -1e30f && (!started || rm > 8.f)) ? rm : 0.f;
            started = started || (rm > -1e30f);
            const bool resc = __any(dl != 0.f);
            if (resc) {
                mref += dl;
#pragma unroll
                for (int r = 0; r < 16; ++r) { c0[r] -= dl; c1[r] -= dl; }
#pragma unroll
                for (int r = 0; r < 16; ++r) negm[r] = -mref;
                const float f = fast_exp2(-fmaxf(dl, 0.f)); lrun *= f;
                if (hi == 0) wsc[r32] = f;
                n0 = negm; n1 = negm;
            }
            float ps0 = 0.f, ps1 = 0.f;
            u32x4 pw0, pw1, pw2, pw3;
#define ATT_EXPU(u) do { c0[u] = fast_exp2(c0[u]); c1[u] = fast_exp2(c1[u]); ps0 += c0[u]; ps1 += c1[u]; } while (0)
#define ATT_PK(u) do { const unsigned x0_ = cvt_pk_bf16(c0[u - 1], c0[u]), x1_ = cvt_pk_bf16(c1[u - 1], c1[u]); \
            if ((u) < 8) { pw0[((u) >> 1) & 3] = x0_; pw2[((u) >> 1) & 3] = x1_; } else { pw1[((u) >> 1) & 3] = x0_; pw3[((u) >> 1) & 3] = x1_; } } while (0)
            if (doS) {
                bf16x8 a0 = *(LAS const bf16x8*)(Kn), a1 = *(LAS const bf16x8*)(Kn + 32 * KS);
#pragma unroll
                for (int ks = 0; ks < NKS; ++ks) {
                    bf16x8 b0 = a0, b1 = a1;
                    if (ks + 1 < NKS) { b0 = *(LAS const bf16x8*)(Kn + (ks + 1) * 32); b1 = *(LAS const bf16x8*)(Kn + 32 * KS + (ks + 1) * 32); }
                    n0 = __builtin_amdgcn_mfma_f32_32x32x16_bf16(a0, qf[ks], n0, 0, 0, 0);
                    n1 = __builtin_amdgcn_mfma_f32_32x32x16_bf16(a1, qf[ks], n1, 0, 0, 0);
                    a0 = b0; a1 = b1;
                    const int u_lo = (16 * ks) / NKS, u_hi = (16 * (ks + 1)) / NKS;
#pragma unroll
                    for (int u = u_lo; u < u_hi; ++u) { ATT_EXPU(u); if (u & 1) ATT_PK(u); }
                    ATT_SB();
                }
            } else {
#pragma unroll
                for (int u = 0; u < 16; ++u) { ATT_EXPU(u); if (u & 1) ATT_PK(u); }
            }
            lrun += ps0 + ps1;
            if (resc) {
#pragma unroll
                for (int g = 0; g < 4; ++g) {
                    const f32x4 av = *(LAS const f32x4*)(wsc + 8 * g + 4 * hi);
#pragma unroll
                    for (int e = 0; e < 4; ++e) { o0[4 * g + e] *= av[e]; o1[4 * g + e] *= av[e]; }
                }
            }
            {
                s16x4 va = vtr(Vc), vb = vtr(Vc + 4 * ATT_VS), vc = vtr(Vc + 64), vd = vtr(Vc + 64 + 4 * ATT_VS);
#pragma unroll
                for (int j = 0; j < 4; ++j) {
                    const bf16x8 pa = __builtin_bit_cast(bf16x8, j == 0 ? pw0 : (j == 1 ? pw1 : (j == 2 ? pw2 : pw3)));
                    const bf16x8 vf0 = (bf16x8){va[0], va[1], va[2], va[3], vb[0], vb[1], vb[2], vb[3]};
                    const bf16x8 vf1 = (bf16x8){vc[0], vc[1], vc[2], vc[3], vd[0], vd[1], vd[2], vd[3]};
                    if (j + 1 < 4) { LAS const unsigned char* vp = Vc + (j + 1) * 16 * ATT_VS; va = vtr(vp); vb = vtr(vp + 4 * ATT_VS); vc = vtr(vp + 64); vd = vtr(vp + 64 + 4 * ATT_VS); }
                    o0 = __builtin_amdgcn_mfma_f32_32x32x16_bf16(pa, vf0, o0, 0, 0, 0);
                    o1 = __builtin_amdgcn_mfma_f32_32x32x16_bf16(pa, vf1, o1, 0, 0, 0);
                }
            }
        } else if (doS) {
#pragma unroll
            for (int ks = 0; ks < NKS; ++ks) {
                const bf16x8 a0 = *(LAS const bf16x8*)(Kn + ks * 32), a1 = *(LAS const bf16x8*)(Kn + 32 * KS + ks * 32);
                n0 = __builtin_amdgcn_mfma_f32_32x32x16_bf16(a0, qf[ks], n0, 0, 0, 0); n1 = __builtin_amdgcn_mfma_f32_32x32x16_bf16(a1, qf[ks], n1, 0, 0, 0);
            }
        }
        c0 = n0; c1 = n1;
        ATT_LSTOREK(t & 1, gkB, grB);
        ATT_LSTOREV((t + 1) & 1, gvB);
        __syncthreads();
          }
      { const int t = t2 + 1;
        ATT_GLOADK(min(t + 3, ntiles - 1), gkB, grB);
        ATT_GLOADV(min(t + 2, ntiles - 1), gvB);
        const bool doP = (t >= tlo) && (t < thi), doS = (t + 1 >= tlo) && (t + 1 < thi);
        LAS const unsigned char* Kn = lds + ((t + 1) & 1) * ATT_TILE + koff;
        LAS const unsigned char* Vc = lds + (t & 1) * ATT_TILE + voff;
        f32x16 n0 = negm, n1 = negm;
        if (doP) {
            if constexpr (DIL) {
                const int P0 = 64 * t + kofs;
                const bool full = (P0 >= pq0 - 33) && (P0 + 63 <= pq0 + 64) && (P0 >= 0) && (P0 + 63 < L);
                if (!full) {
                    const int lo = max(pq - 64, 0) - P0 - 8 * hi, span = min(pq + 64, L - 1) - max(pq - 64, 0);
#pragma unroll
                    for (int r = 0; r < 16; ++r) {
                        const int i0 = 16 * (r >> 3) + (r & 7);
                        c0[r] = ((unsigned)(i0 - lo) <= (unsigned)span) ? c0[r] : -INFINITY;
                        c1[r] = ((unsigned)(i0 + 32 - lo) <= (unsigned)span) ? c1[r] : -INFINITY;
                    }
                }
            }
            float ma = fmaxf(fmaxf(c0[0], c0[1]), c1[0]), mb = fmaxf(fmaxf(c0[2], c0[3]), c1[1]);
            ma = fmaxf(fmaxf(ma, c1[2]), c1[3]);
#pragma unroll
            for (int r = 4; r < 16; r += 4) { ma = fmaxf(fmaxf(ma, c0[r]), c0[r + 1]); mb = fmaxf(fmaxf(mb, c0[r + 2]), c0[r + 3]); ma = fmaxf(fmaxf(ma, c1[r]), c1[r + 1]); mb = fmaxf(fmaxf(mb, c1[r + 2]), c1[r + 3]); }
            float rm = fmaxf(ma, mb);
            { auto rr = __builtin_amdgcn_permlane32_swap(__float_as_uint(rm), __float_as_uint(rm), false, false); rm = fmaxf(__uint_as_float(rr[0]), __uint_as_float(rr[1])); }
            const float dl = (rm > -1e30f && (!started || rm > 8.f)) ? rm : 0.f;
            started = started || (rm > -1e30f);
            const bool resc = __any(dl != 0.f);
            if (resc) {
                mref += dl;
#pragma unroll
                for (int r = 0; r < 16; ++r) { c0[r] -= dl; c1[r] -= dl; }
#pragma unroll
                for (int r = 0; r < 16; ++r) negm[r] = -mref;
                const float f = fast_exp2(-fmaxf(dl, 0.f)); lrun *= f;
                if (hi == 0) wsc[r32] = f;
                n0 = negm; n1 = negm;
            }
            float ps0 = 0.f, ps1 = 0.f;
            u32x4 pw0, pw1, pw2, pw3;
#define ATT_EXPU(u) do { c0[u] = fast_exp2(c0[u]); c1[u] = fast_exp2(c1[u]); ps0 += c0[u]; ps1 += c1[u]; } while (0)
#define ATT_PK(u) do { const unsigned x0_ = cvt_pk_bf16(c0[u - 1], c0[u]), x1_ = cvt_pk_bf16(c1[u - 1], c1[u]); \
            if ((u) < 8) { pw0[((u) >> 1) & 3] = x0_; pw2[((u) >> 1) & 3] = x1_; } else { pw1[((u) >> 1) & 3] = x0_; pw3[((u) >> 1) & 3] = x1_; } } while (0)
            if (doS) {
                bf16x8 a0 = *(LAS const bf16x8*)(Kn), a1 = *(LAS const bf16x8*)(Kn + 32 * KS);
#pragma unroll
                for (int ks = 0; ks < NKS; ++ks) {
                    bf16x8 b0 = a0, b1 = a1;
                    if (ks + 1 < NKS) { b0 = *(LAS const bf16x8*)(Kn + (ks + 1) * 32); b1 = *(LAS const bf16x8*)(Kn + 32 * KS + (ks + 1) * 32); }
                    n0 = __builtin_amdgcn_mfma_f32_32x32x16_bf16(a0, qf[ks], n0, 0, 0, 0);
                    n1 = __builtin_amdgcn_mfma_f32_32x32x16_bf16(a1, qf[ks], n1, 0, 0, 0);
                    a0 = b0; a1 = b1;
                    const int u_lo = (16 * ks) / NKS, u_hi = (16 * (ks + 1)) / NKS;
#pragma unroll
                    for (int u = u_lo; u < u_hi; ++u) { ATT_EXPU(u); if (u & 1) ATT_PK(u); }
                    ATT_SB();
                }
            } else {
#pragma unroll
                for (int u = 0; u < 16; ++u) { ATT_EXPU(u); if (u & 1) ATT_PK(u); }
            }
            lrun += ps0 + ps1;
            if (resc) {
#pragma unroll
                for (int g = 0; g < 4; ++g) {
                    const f32x4 av = *(LAS const f32x4*)(wsc + 8 * g + 4 * hi);
#pragma unroll
                    for (int e = 0; e < 4; ++e) { o0[4 * g + e] *= av[e]; o1[4 * g + e] *= av[e]; }
                }
            }
            {
                s16x4 va = vtr(Vc), vb = vtr(Vc + 4 * ATT_VS), vc = vtr(Vc + 64), vd = vtr(Vc + 64 + 4 * ATT_VS);
#pragma unroll
                for (int j = 0; j < 4; ++j) {
                    const bf16x8 pa = __builtin_bit_cast(bf16x8, j == 0 ? pw0 : (j == 1 ? pw1 : (j == 2 ? pw2 : pw3)));
                    const bf16x8 vf0 = (bf16x8){va[0], va[1], va[2], va[3], vb[0], vb[1], vb[2], vb[3]};
                    const bf16x8 vf1 = (bf16x8){vc[0], vc[1], vc[2], vc[3], vd[0], vd[1], vd[2], vd[3]};
                    if (j + 1 < 4) { LAS const unsigned char* vp = Vc + (j + 1) * 16 * ATT_VS; va = vtr(vp); vb = vtr(vp + 4 * ATT_VS); vc = vtr(vp + 64); vd = vtr(vp + 64 + 4 * ATT_VS); }
                    o0 = __builtin_amdgcn_mfma_f32_32x32x16_bf16(pa, vf0, o0, 0, 0, 0);
                    o1 = __builtin_amdgcn_mfma_f32_32x32x16_bf16(pa, vf1, o1, 0, 0, 0);
                }
            }
        } else if (doS) {
#pragma unroll
            for (int ks = 0; ks < NKS; ++ks) {
                const bf16x8 a0 = *(LAS const bf16x8*)(Kn + ks * 32), a1 = *(LAS const bf16x8*)(Kn + 32 * KS + ks * 32);
                n0 = __builtin_amdgcn_mfma_f32_32x32x16_bf16(a0, qf[ks], n0, 0, 0, 0); n1 = __builtin_amdgcn_mfma_f32_32x32x16_bf16(a1, qf[ks], n1, 0, 0, 0);
            }
        }
        c0 = n0; c1 = n1;
        ATT_LSTOREK(t & 1, gkA, grA);
        ATT_LSTOREV((t + 1) & 1, gvA);
        __syncthreads();
          }
    }
    float ltot;
    { auto rr = __builtin_amdgcn_permlane32_swap(__float_as_uint(lrun), __float_as_uint(lrun), false, false); ltot = __uint_as_float(rr[0]) + __uint_as_float(rr[1]); }
    if (hi == 0) wsc[r32] = fast_rcp(ltot);
    LAS bf16_t* stg = (LAS bf16_t*)(lds + ATT_OST + wid * 4096);
#pragma unroll
    for (int g = 0; g < 4; ++g) {
        const f32x4 iv = *(LAS const f32x4*)(wsc + 8 * g + 4 * hi);
#pragma unroll
        for (int e = 0; e < 4; ++e) {
            const int r = 4 * g + e, orow = crow(r, hi);
            stg[orow * 64 + r32] = (bf16_t)(cvt_pk_bf16(o0[r] * iv[e], 0.f) & 0xffffu);
            stg[orow * 64 + 32 + r32] = (bf16_t)(cvt_pk_bf16(o1[r] * iv[e], 0.f) & 0xffffu);
        }
    }
#pragma unroll
    for (int it = 0; it < 4; ++it) {
        const int row = it * 8 + (lane >> 3), ch = lane & 7;
        const u32x4 v = *(LAS const u32x4*)(stg + row * 64 + ch * 8);
        if constexpr (DIL) { const size_t tok = kb + (size_t)(pq0 + row) * dil + res; *(u32x4*)(io.OD + (size_t)br * NT * 512 + tok * 512 + h * 64 + ch * 8) = v; }
        else *(u32x4*)(io.OMIX + (kb + pq0 + row) * 1024 + h * 64 + ch * 8) = v;
    }
    if constexpr (DIL) { if (hi == 0) { const size_t tok = kb + (size_t)pq * dil + res; io.LSE[((size_t)br * NT + tok) * 8 + h] = mref + __builtin_amdgcn_logf(ltot); } }
}
#undef ATT_TOK
#undef ATT_GLOADK
#undef ATT_GLOADV
#undef ATT_LSTOREK
#undef ATT_LSTOREV
#undef ATT_SB
#undef ATT_EXPU
#undef ATT_PK

constexpr int DIL_RS = 144;
constexpr int DIL_K = 0, DIL_V = 384 * DIL_RS, DIL_OST = 2 * 384 * DIL_RS, DIL_WSC = DIL_OST + NWAVES * 4096, DIL_LDS = DIL_WSC + NWAVES * 256;
struct DilUnit { int b, h, br, dil, L, resu, q0, nrows; };
__device__ __forceinline__ DilUnit dil_decode(int unit) {
    DilUnit d; const int bh = unit / 24, k = unit % 24, j = k & 7; d.br = k >> 3; d.b = bh >> 3; d.h = bh & 7;
    if (d.br == 0) { d.dil = 1; d.L = 2048; d.resu = 0; d.q0 = 256 * j; d.nrows = 384; }
    else if (d.br == 1) { d.dil = 4; d.L = 512; d.resu = j >> 1; d.q0 = 256 * (j & 1); d.nrows = 384; }
    else { d.dil = 16; d.L = 128; d.resu = 2 * j; d.q0 = 0; d.nrows = 256; }
    return d;
}
__device__ __forceinline__ size_t dil_tok(const DilUnit& d, int s) {
    const size_t kb = (size_t)d.b * SEQ;
    if (d.br < 2) { int p = d.q0 - 64 + s; p = p < 0 ? 0 : (p > d.L - 1 ? d.L - 1 : p); return kb + (size_t)p * d.dil + d.resu; }
    return kb + (size_t)(s & 127) * 16 + (size_t)(d.resu + (s >> 7));
}
__device__ __forceinline__ void dil_phase(LAS unsigned char* lds, const AttnIO& io, int bx, int G) {
    int tid_ = threadIdx.x; asm volatile("" : "+v"(tid_));
    const int tid = tid_, lane = tid & 63, wid = __builtin_amdgcn_readfirstlane(tid >> 6), r32 = lane & 31, hi = lane >> 5;
    const int lrow = tid >> 3, lch = tid & 7;
    const int krow = (r32 & 19) | ((r32 & 4) << 1) | ((r32 & 8) >> 1);
    const int i16 = lane & 15, g16 = lane >> 4;
    const int voff = DIL_V + (8 * hi + (i16 >> 2)) * DIL_RS + (16 * (g16 & 1) + 4 * (i16 & 3)) * 2;
    LAS float* wsc = (LAS float*)(lds + DIL_WSC + wid * 256);
    LAS bf16_t* stg = (LAS bf16_t*)(lds + DIL_OST + wid * 4096);
    constexpr int NUNITS = 256 * 24;
    u32x4 gk[6], gv[6]; bf16x8 qn[4];
#define DIL_WAVE(d, TLO, NTW, KOFS, PQ, RES) \
    int TLO, NTW, KOFS, PQ, RES; \
    if ((d).br < 2) { TLO = wid >> 1; NTW = 3; KOFS = (d).q0 - 64; PQ = (d).q0 + wid * 32 + r32; RES = (d).resu; } \
    else { const int hw_ = wid >> 2; TLO = 2 * hw_; NTW = 2; KOFS = -128 * hw_; PQ = (wid & 3) * 32 + r32; RES = (d).resu + hw_; }
#define DIL_PREFETCH(unit) do { \
        const DilUnit d_ = dil_decode(unit); \
        _Pragma("unroll") for (int i = 0; i < 6; ++i) { const int row_ = lrow + 64 * i; \
            if (row_ < d_.nrows) { const size_t tok_ = dil_tok(d_, row_); gk[i] = *(const u32x4*)(io.KD + tok_ * 512 + d_.h * 64 + lch * 8); gv[i] = *(const u32x4*)(io.VD + tok_ * 512 + d_.h * 64 + lch * 8); } } \
        DIL_WAVE(d_, tlo_, ntw_, kofs_, pq_, res_) (void)tlo_; (void)ntw_; (void)kofs_; \
        const bf16_t* qp_ = io.QD + ((size_t)d_.b * SEQ + (size_t)pq_ * d_.dil + res_) * 512 + d_.h * 64; \
        _Pragma("unroll") for (int ks = 0; ks < 4; ++ks) qn[ks] = *(const bf16x8*)(qp_ + ks * 16 + hi * 8); \
    } while (0)
    int unit = bx;
    if (unit < NUNITS) DIL_PREFETCH(unit);
    for (; unit < NUNITS; unit += G) {
        const DilUnit d = dil_decode(unit);
#pragma unroll
        for (int i = 0; i < 6; ++i) { const int row = lrow + 64 * i;
            if (row < d.nrows) { *(LAS u32x4*)(lds + DIL_K + row * DIL_RS + lch * 16) = gk[i]; *(LAS u32x4*)(lds + DIL_V + row * DIL_RS + lch * 16) = gv[i]; } }
        bf16x8 qf[4];
#pragma unroll
        for (int ks = 0; ks < 4; ++ks) qf[ks] = qn[ks];
        __syncthreads();
        if (unit + G < NUNITS) DIL_PREFETCH(unit + G);
        DIL_WAVE(d, tlo, ntw, kofs, pq, res)
        (void)tlo; (void)ntw; (void)kofs;
        const int pq0 = pq - r32;
        const int srow0 = (d.br < 2) ? (pq0 - d.q0) : (128 * (wid >> 2) + pq0 - 64);
        f32x16 sc[5];
#pragma unroll
        for (int i = 0; i < 5; ++i) {
            const int P0 = pq0 - 64 + 32 * i;
            if (P0 >= 0 && P0 < d.L) {
                LAS const unsigned char* Kb = lds + DIL_K + (srow0 + 32 * i + krow) * DIL_RS + hi * 16;
                f32x16 acc = {};
#pragma unroll
                for (int ks = 0; ks < 4; ++ks) acc = __builtin_amdgcn_mfma_f32_32x32x16_bf16(*(LAS const bf16x8*)(Kb + ks * 32), qf[ks], acc, 0, 0, 0);
                if (i == 0 || i == 4) {
                    const int dd = r32 - 8 * hi;
#pragma unroll
                    for (int r = 0; r < 16; ++r) { const int cr = 16 * (r >> 3) + (r & 7); const bool ok = (i == 0) ? (cr >= dd) : (cr <= dd); acc[r] = ok ? acc[r] : -INFINITY; }
                }
                sc[i] = acc;
            } else {
#pragma unroll
                for (int r = 0; r < 16; ++r) sc[i][r] = -INFINITY;
            }
        }
        float mx = sc[2][0];
#pragma unroll
        for (int i = 0; i < 5; ++i)
#pragma unroll
            for (int r = 0; r < 16; r += 2) mx = fmaxf(fmaxf(mx, sc[i][r]), sc[i][r + 1]);
        { auto rr = __builtin_amdgcn_permlane32_swap(__float_as_uint(mx), __float_as_uint(mx), false, false); mx = fmaxf(__uint_as_float(rr[0]), __uint_as_float(rr[1])); }
        const float mrun = mx;
        float lrun = 0.f;
        f32x16 o0 = {}, o1 = {};
#pragma unroll
        for (int i = 0; i < 5; ++i) {
            const int P0 = pq0 - 64 + 32 * i;
            if (P0 >= 0 && P0 < d.L) {
                float ps = 0.f;
#pragma unroll
                for (int r = 0; r < 16; ++r) { sc[i][r] = fast_exp2(sc[i][r] - mrun); ps += sc[i][r]; }
                lrun += ps;
                const bf16x8 pa0 = pack8(sc[i], 0), pa1 = pack8(sc[i], 8);
                LAS const unsigned char* Vb = lds + voff + (srow0 + 32 * i) * DIL_RS;
#pragma unroll
                for (int j = 0; j < 2; ++j) {
                    LAS const unsigned char* vp = Vb + j * 16 * DIL_RS;
                    const s16x4 a = vtr(vp), bq = vtr(vp + 4 * DIL_RS), c = vtr(vp + 64), dq = vtr(vp + 64 + 4 * DIL_RS);
                    const bf16x8 vf0 = (bf16x8){a[0], a[1], a[2], a[3], bq[0], bq[1], bq[2], bq[3]};
                    const bf16x8 vf1 = (bf16x8){c[0], c[1], c[2], c[3], dq[0], dq[1], dq[2], dq[3]};
                    o0 = __builtin_amdgcn_mfma_f32_32x32x16_bf16(j == 0 ? pa0 : pa1, vf0, o0, 0, 0, 0);
                    o1 = __builtin_amdgcn_mfma_f32_32x32x16_bf16(j == 0 ? pa0 : pa1, vf1, o1, 0, 0, 0);
                }
            }
        }
        float ltot;
        { auto rr = __builtin_amdgcn_permlane32_swap(__float_as_uint(lrun), __float_as_uint(lrun), false, false); ltot = __uint_as_float(rr[0]) + __uint_as_float(rr[1]); }
        if (hi == 0) wsc[r32] = fast_rcp(ltot);
#pragma unroll
        for (int g = 0; g < 4; ++g) {
            const f32x4 iv = *(LAS const f32x4*)(wsc + 8 * g + 4 * hi);
#pragma unroll
            for (int e = 0; e < 4; ++e) {
                const int r = 4 * g + e, orow = crow(r, hi);
                stg[orow * 64 + r32] = (bf16_t)(cvt_pk_bf16(o0[r] * iv[e], 0.f) & 0xffffu);
                stg[orow * 64 + 32 + r32] = (bf16_t)(cvt_pk_bf16(o1[r] * iv[e], 0.f) & 0xffffu);
            }
        }
        const size_t kb = (size_t)d.b * SEQ;
#pragma unroll
        for (int it = 0; it < 4; ++it) {
            const int row = it * 8 + (lane >> 3), ch = lane & 7;
            const u32x4 v = *(LAS const u32x4*)(stg + row * 64 + ch * 8);
            const size_t tok = kb + (size_t)(pq0 + row) * d.dil + res;
            *(u32x4*)(io.OD + (size_t)d.br * NT * 512 + tok * 512 + d.h * 64 + ch * 8) = v;
        }
        if (hi == 0) { const size_t tok = kb + (size_t)pq * d.dil + res; io.LSE[((size_t)d.br * NT + tok) * 8 + d.h] = mrun + __builtin_amdgcn_logf(ltot); }
        __syncthreads();
    }
#undef DIL_WAVE
#undef DIL_PREFETCH
}

__device__ __forceinline__ float wave_sum(float v) {
#pragma unroll
    for (int o = 1; o < 64; o <<= 1) v += __shfl_xor(v, o);
    return v;
}
__device__ __forceinline__ void tr_block(const float* W, int K, int N, const float* gain, bf16_t* WT, int k0, int n0, int dst_row0, LAS float* scr, int lane) {
#pragma unroll 8
    for (int i = 0; i < 32; ++i) {
        const int kk = 2 * i + (lane >> 5);
        float v = W[(size_t)(k0 + kk) * N + n0 + (lane & 31)];
        if (gain) v *= gain[k0 + kk];
        scr[kk * 33 + (lane & 31)] = v;
    }
    asm volatile("s_waitcnt lgkmcnt(0)" ::: "memory");
    const int c = lane & 7;
#pragma unroll
    for (int j = 0; j < 4; ++j) {
        const int n = (lane >> 3) + 8 * j; const LAS float* s = scr + (8 * c) * 33 + n;
        u32x4 o; o.x = cvt_pk_bf16(s[0 * 33], s[1 * 33]); o.y = cvt_pk_bf16(s[2 * 33], s[3 * 33]); o.z = cvt_pk_bf16(s[4 * 33], s[5 * 33]); o.w = cvt_pk_bf16(s[6 * 33], s[7 * 33]);
        *(u32x4*)(WT + (size_t)(dst_row0 + n) * K + k0 + 8 * c) = o;
    }
    asm volatile("s_waitcnt lgkmcnt(0)" ::: "memory");
}

__device__ __forceinline__ void tr_block64(const float* W, int K, int N, const float* gain, bf16_t* WT, int k0, int n0, int dst_row0, LAS float* scr, int lane) {
    const int kk = lane >> 4, n4 = lane & 15;
    f32x4 v[16];
#pragma unroll
    for (int i = 0; i < 16; ++i) v[i] = *(const f32x4*)(W + (size_t)(k0 + 4 * i + kk) * N + n0 + 4 * n4);
#pragma unroll
    for (int i = 0; i < 16; ++i) {
        const float g = gain ? gain[k0 + 4 * i + kk] : 1.0f;
        LAS float* d = scr + (4 * i + kk) * 65 + 4 * n4;
        d[0] = v[i][0] * g; d[1] = v[i][1] * g; d[2] = v[i][2] * g; d[3] = v[i][3] * g;
    }
    asm volatile("s_waitcnt lgkmcnt(0)" ::: "memory");
    const int c = lane & 7;
#pragma unroll
    for (int it = 0; it < 8; ++it) {
        const int n = it * 8 + (lane >> 3); const LAS float* s = scr + (8 * c) * 65 + n;
        u32x4 o; o.x = cvt_pk_bf16(s[0 * 65], s[1 * 65]); o.y = cvt_pk_bf16(s[2 * 65], s[3 * 65]); o.z = cvt_pk_bf16(s[4 * 65], s[5 * 65]); o.w = cvt_pk_bf16(s[6 * 65], s[7 * 65]);
        *(u32x4*)(WT + (size_t)(dst_row0 + n) * K + k0 + 8 * c) = o;
    }
    asm volatile("s_waitcnt lgkmcnt(0)" ::: "memory");
}

#define XB_TMO      128
#define XB_XCNT(j)  (256  + 64 * (j))
#define XB_XSUB(j)  (1280 + 64 * (j))
#define XB_XGEN(j)  (2304 + 64 * (j))
#define XB_TOP      3328
#define XB_TOPGEN   3392
#define XCD_BAR_WORDS 3456
#define XB_SPIN_CAP (1u << 18)

__device__ __forceinline__ unsigned xb_ld(unsigned* p)              { return __hip_atomic_load(p, __ATOMIC_RELAXED, __HIP_MEMORY_SCOPE_AGENT); }
__device__ __forceinline__ unsigned xb_add(unsigned* p, unsigned v) { return __hip_atomic_fetch_add(p, v, __ATOMIC_RELAXED, __HIP_MEMORY_SCOPE_AGENT); }
__device__ __forceinline__ unsigned xb_xcc_id() { return (unsigned)__builtin_amdgcn_s_getreg((3 << 11) | 20) & 0xFu; }
#define XB_SPIN(cond, bar) do { unsigned _sp = 0; while (cond) { __builtin_amdgcn_s_sleep(1); \
    if ((++_sp & 255u) == 0u) { if (xb_ld(&(bar)[XB_TMO])) break; if (_sp > XB_SPIN_CAP) { atomicAdd(&(bar)[XB_TMO], 1u); break; } } } } while (0)

struct XcdBarrier {
    unsigned* bar; unsigned x;
    volatile LAS unsigned* st;
};

__device__ __forceinline__ XcdBarrier xcd_barrier_post(unsigned* bar, volatile LAS unsigned* st) {
    XcdBarrier b; b.bar = bar; b.x = xb_xcc_id(); b.st = st;
    if (threadIdx.x == 0) (void)xb_add(&bar[XB_XCNT(b.x)], 1u);
    return b;
}
__device__ __forceinline__ void xcd_barrier_complete(unsigned* bar, unsigned x, unsigned& nloc, unsigned& nx) {
    const unsigned G = gridDim.x * gridDim.y * gridDim.z;
    unsigned sum, cnt, mine, sp = 0u;
    for (;;) {
        sum = 0u; cnt = 0u; mine = 0u;
#pragma unroll
        for (unsigned j = 0; j < 16; ++j) { const unsigned c = xb_ld(&bar[XB_XCNT(j)]); sum += c; cnt += (c > 0u) ? 1u : 0u; mine = (j == x) ? c : mine; }
        if (sum == G) break;
        __builtin_amdgcn_s_sleep(1);
        if ((++sp & 255u) == 0u) { if (xb_ld(&bar[XB_TMO])) break; if (sp > XB_SPIN_CAP) { atomicAdd(&bar[XB_TMO], 1u); break; } }
    }
    nloc = mine > 0u ? mine : 1u; nx = cnt > 0u ? cnt : 1u;
}

__device__ __forceinline__ void xcd_barrier(const XcdBarrier& b) {
    asm volatile("s_waitcnt vmcnt(0)" ::: "memory");
    __syncthreads();
    if (threadIdx.x == 0) {
        unsigned* bar = b.bar;
        __builtin_amdgcn_s_waitcnt(0);
        unsigned nloc = b.st[0], nx = b.st[1];
        if (nloc == 0u) { xcd_barrier_complete(bar, b.x, nloc, nx); b.st[0] = nloc; b.st[1] = nx; }
        const unsigned old = xb_add(&bar[XB_XSUB(b.x)], 1u);
        const unsigned gen = old / nloc;
        if (old + 1u == (gen + 1u) * nloc) {
            __builtin_amdgcn_fence(__ATOMIC_RELEASE, "agent");
            asm volatile("s_waitcnt vmcnt(0)" ::: "memory");
            const unsigned og = xb_add(&bar[XB_TOP], 1u);
            const unsigned tg = og / nx;
            if (og + 1u == (tg + 1u) * nx) xb_add(&bar[XB_TOPGEN], 1u);
            else XB_SPIN(xb_ld(&bar[XB_TOPGEN]) == tg, bar);
            __builtin_amdgcn_fence(__ATOMIC_ACQUIRE, "agent");
            xb_add(&bar[XB_XGEN(b.x)], 1u);
            asm volatile("s_waitcnt vmcnt(0)" ::: "memory");
        } else {
            XB_SPIN(xb_ld(&bar[XB_XGEN(b.x)]) == gen, bar);
            __builtin_amdgcn_fence(__ATOMIC_ACQUIRE, "agent");
            asm volatile("s_waitcnt vmcnt(0)" ::: "memory");
        }
    }
    __syncthreads();
}

struct Args {
    const float* in[19]; float* out; unsigned char* ws;
};

__global__ void __launch_bounds__(NWAVES * 64) mk_fwd(Args a) {
    extern __shared__ __attribute__((aligned(16))) unsigned char lds_raw[];
    LAS unsigned char* lds = (LAS unsigned char*)lds_raw;
    cg::grid_group grid = cg::this_grid();
    const int tid = threadIdx.x, lane = tid & 63, wave = __builtin_amdgcn_readfirstlane(tid >> 6);
    const int G = gridDim.x, bx = blockIdx.x;
    const int gw = bx * NWAVES + wave, NGW = G * NWAVES;
    unsigned char* ws = a.ws;
    const float* x = a.in[0];
    const float *g_ffn1 = a.in[1], *w1g = a.in[2], *w1u = a.in[3], *w1d = a.in[4], *g_mix = a.in[5], *w_in = a.in[6], *g_q = a.in[7], *w_uq = a.in[8], *g_kv = a.in[9], *w_ukv = a.in[10],
                *g_mo = a.in[11], *g_do = a.in[12], *w_out = a.in[13], *g_ffn2 = a.in[14], *w2g = a.in[15], *w2u = a.in[16], *w2d = a.in[17], *g_fin = a.in[18];
    float* X = a.out;
    bf16_t *W1GU = (bf16_t*)(ws + WS_W1GU), *W1D = (bf16_t*)(ws + WS_W1D), *W2GU = (bf16_t*)(ws + WS_W2GU), *W2D = (bf16_t*)(ws + WS_W2D), *WIN = (bf16_t*)(ws + WS_WIN),
           *WUQ = (bf16_t*)(ws + WS_WUQ), *WUKV = (bf16_t*)(ws + WS_WUKV), *WOUT = (bf16_t*)(ws + WS_WOUT);
    float *COSM = (float*)(ws + WS_ROPE), *SINM = COSM + 2048 * 16, *COSP = SINM + 2048 * 16, *SINP = COSP + 2048 * 8;
    float *SS0 = (float*)(ws + WS_SS0), *SS1 = (float*)(ws + WS_SS1), *SS2 = (float*)(ws + WS_SS2), *SS3 = (float*)(ws + WS_SS3), *SSQ = (float*)(ws + WS_SSQ), *SSKV = (float*)(ws + WS_SSKV);
    bf16_t *XB = (bf16_t*)(ws + WS_XB), *KVM = (bf16_t*)a.out, *HB = (bf16_t*)(ws + WS_H), *OD = (bf16_t*)(ws + WS_OD0), *OMIX = (bf16_t*)(ws + WS_OMIX);
    float* LSE = (float*)(ws + WS_LSE);
    bf16_t *QD = (bf16_t*)(ws + WS_QD), *KD = (bf16_t*)(ws + WS_KD), *VD = (bf16_t*)(ws + WS_VD), *CQ = (bf16_t*)(ws + WS_CQ), *CKV = (bf16_t*)(ws + WS_CKV), *KR = (bf16_t*)(ws + WS_KR), *QM = (bf16_t*)(ws + WS_QM);

    volatile LAS unsigned* xb_st = (volatile LAS unsigned*)(lds + DIL_LDS);
    if (tid < 2) xb_st[tid] = 0u;
    unsigned* xb_words = (unsigned*)(ws + WS_BAR);
    unsigned* pan_cnt = xb_words + 4096;
    if (bx == 0) for (int i = tid; i < 4096 + 256 * 64; i += NWAVES * 64) xb_words[i] = 0u;
    {
        LAS float* scr = (LAS float*)(lds + wave * 16640);
        constexpr int J_GU = 16 * 44, J_D = 44 * 16, J_FFN = 2 * J_GU + J_D, J_UQ = 6 * 12, J_UKV = 4 * 16, J_OUT = 16 * 16, I_IN = 16 * 69;
        constexpr int NITEMS = 2 * J_FFN + J_UQ + J_UKV + J_OUT + I_IN;
        for (int it = gw; it < NITEMS; it += NGW) {
            int r = it;
            if (r < 2 * J_FFN) {
                const int f = r / J_FFN; r -= f * J_FFN;
                const float* gg = f ? g_ffn2 : g_ffn1; const float* wg = f ? w2g : w1g; const float* wu = f ? w2u : w1u; const float* wd = f ? w2d : w1d;
                bf16_t* GU = f ? W2GU : W1GU; bf16_t* DD = f ? W2D : W1D;
                if (r < 2 * J_GU) { const int s = r >= J_GU; const int q = s ? r - J_GU : r; const int kb_ = q / 44, nb = q % 44, n0 = 64 * nb;
                    tr_block64(s ? wu : wg, 1024, FF, gg, GU, 64 * kb_, n0, 256 * (n0 >> 7) + 128 * s + (n0 & 127), scr, lane); }
                else { r -= 2 * J_GU; const int kb_ = r / 16, nb = r % 16; tr_block64(wd, FF, 1024, nullptr, DD, 64 * kb_, 64 * nb, 64 * nb, scr, lane); }
                continue;
            }
            r -= 2 * J_FFN;
            if (r < J_UQ) { const int kb_ = r / 12, nb = r % 12; tr_block64(w_uq, 384, 768, g_q, WUQ, 64 * kb_, 64 * nb, 64 * nb, scr, lane); continue; }
            r -= J_UQ;
            if (r < J_UKV) { const int kb_ = r / 16, nb = r % 16; tr_block64(w_ukv, 256, 1024, g_kv, WUKV, 64 * kb_, 64 * nb, 64 * nb, scr, lane); continue; }
            r -= J_UKV;
            if (r < J_OUT) { const int kb_ = r / 16, nb = r % 16, k0 = 64 * kb_; tr_block64(w_out, 1024, 1024, k0 < 512 ? g_mo : g_do - 512, WOUT, k0, 64 * nb, 64 * nb, scr, lane); continue; }
            r -= J_OUT;
            { const int kb_ = r / 69, nb = r % 69, n0 = 32 * nb;
                int dst;
                if (n0 < 384) dst = 1536 + n0; else if (n0 < 640) dst = 2048 + (n0 - 384); else if (n0 < 672) dst = 1920 + (n0 - 640);
                else if (n0 < 1184) dst = n0 - 672; else if (n0 < 1696) dst = 512 + (n0 - 1184); else dst = 1024 + (n0 - 1696);
                tr_block(w_in, 1024, 2208, g_mix, WIN, 64 * kb_, n0, dst, scr, lane); }
        }
        for (int i = bx * 512 + tid; i < 96 * 1024 / 8; i += G * 512) *(u32x4*)(WIN + (size_t)1952 * 1024 + (size_t)i * 8) = (u32x4){0u, 0u, 0u, 0u};
        for (int i = bx * 512 + tid; i < 2048 * 24; i += G * 512) {
            int pos, fi; float invf; float *cdst, *sdst;
            if (i < 2048 * 16) { pos = i >> 4; fi = i & 15; invf = exp2f(-(float)fi * (1.0f / 16.0f) * 18.931568569324174f); cdst = COSM + i; sdst = SINM + i; }
            else { const int k = i - 2048 * 16; pos = k >> 3; fi = k & 7; invf = exp2f(-(float)fi * (1.0f / 8.0f) * 18.931568569324174f); cdst = COSP + k; sdst = SINP + k; }
            const float ang = (float)pos * invf;
            const double rev = (double)ang * 0.15915494309189535; const float fr_ = (float)(rev - floor(rev));
            *cdst = __builtin_amdgcn_cosf(fr_); *sdst = __builtin_amdgcn_sinf(fr_);
        }
        for (int row0 = gw * 4; row0 < NT; row0 += NGW * 4) {
            f32x4 v[4][4];
#pragma unroll
            for (int q = 0; q < 4; ++q) { const f32x4* xr = (const f32x4*)(x + (size_t)(row0 + q) * DM) + lane;
#pragma unroll
                for (int j = 0; j < 4; ++j) v[q][j] = xr[64 * j]; }
#pragma unroll
            for (int q = 0; q < 4; ++q) {
                float sacc = 0.f; unsigned long long* o8 = (unsigned long long*)(XB + (size_t)(row0 + q) * DM) + lane;
#pragma unroll
                for (int j = 0; j < 4; ++j) { sacc += sq4(v[q][j]); o8[64 * j] = (unsigned long long)cvt_pk_bf16(v[q][j][0], v[q][j][1]) | ((unsigned long long)cvt_pk_bf16(v[q][j][2], v[q][j][3]) << 32); }
                sacc = wave_sum(sacc);
                if (lane < 16) SS0[(size_t)(row0 + q) * 16 + lane] = lane == 0 ? sacc : 0.f;
            }
        }
    }
    grid.sync();
    const XcdBarrier xb = xcd_barrier_post(xb_words, xb_st);
    {
        pg8::Gemm g{XB, W1GU, NT, 2 * FF, DM}; pg8::StaticOrder S; S.init(NT, 2 * FF, G, bx);
        rstd4_fill((LAS float*)(lds + 131072), SS0);
        EpiGateUp E{HB, SS0, (LAS float*)(lds + 131072)};
        pg8::gemm_phase<EpiGateUp, pg8::StaticOrder, true, true>(lds, g, S, E);
    }
    xcd_barrier(xb);
    {
        pg8::Gemm g{HB, W1D, NT, DM, FF}; pg8::StaticOrder S; S.init(NT, DM, G, bx);
        EpiResid E{XB, SS1, 0.5f};
        pg8::gemm_phase<EpiResid, pg8::StaticOrder, true, true>(lds, g, S, E);
    }
    xcd_barrier(xb);
    {
        pg8::Gemm g{XB, WIN, NT, 2304, DM}; pg8::StaticOrder S; S.init(NT, 2304, G, bx);
        rstd4_fill((LAS float*)(lds + 131072), SS1);
        EpiInProj E{SS1, QD, KD, VD, CQ, CKV, KR, SSQ, SSKV, COSM, SINM, COSP, SINP, (LAS float*)(lds + 131072)};
        pg8::gemm_phase<EpiInProj, pg8::StaticOrder, true, true>(lds, g, S, E);
    }
    xcd_barrier(xb);
    {
        { pg8::Gemm g{CQ, WUQ, NT, 768, 384}; pg8::StaticOrder S; S.init(NT, 768, G, bx); EpiQ E{SSQ, QM, COSM, SINM, (LAS float*)(lds + 131072)};
          pg8::gemm_phase<EpiQ, pg8::StaticOrder, true, true>(lds, g, S, E); }
        { pg8::Gemm g{CKV, WUKV, NT, 1024, 256}; pg8::StaticOrder S; S.init(NT, 1024, G, bx); EpiKV E{SSKV, KVM, (LAS float*)(lds + 131072)};
          pg8::gemm_phase<EpiKV, pg8::StaticOrder, true, true>(lds, g, S, E); }
        __syncthreads();
        AttnIO io{QM, KVM, KR, OMIX, QD, KD, VD, OD, LSE};
        dil_phase(lds, io, bx, G);
    }
    xcd_barrier(xb);
    {
        AttnIO io{QM, KVM, KR, OMIX, QD, KD, VD, OD, LSE};
        for (int u = bx; u < 256 * 8; u += G) attn_unit<false>(lds, io, u);
    }
    xcd_barrier(xb);
    for (int rowb = gw * 4; rowb < NT; rowb += NGW * 4) {
        u32x4 wm[4], wd[4][3]; float ls[4][3];
        const int hd = lane >> 3;
#pragma unroll
        for (int q = 0; q < 4; ++q) {
            const int row = rowb + q;
            wm[q] = *(const u32x4*)(OMIX + (size_t)row * 1024 + lane * 8);
#pragma unroll
            for (int n = 0; n < 3; ++n) { ls[q][n] = LSE[((size_t)n * NT + row) * 8 + hd]; wd[q][n] = *(const u32x4*)(OD + (size_t)n * NT * 512 + (size_t)row * 512 + lane * 8); }
        }
#pragma unroll
        for (int q = 0; q < 4; ++q) {
            const int row = rowb + q;
            {
                float v[8];
#pragma unroll
                for (int e = 0; e < 4; ++e) { v[2 * e] = __uint_as_float(wm[q][e] << 16); v[2 * e + 1] = __uint_as_float(wm[q][e] & 0xffff0000u); }
                float s = 0.f;
#pragma unroll
                for (int e = 0; e < 8; ++e) s += v[e] * v[e];
                const float rs = rsqrtf(wave_sum(s) * (1.0f / 512.0f) + EPS);
                u32x4 o; o.x = cvt_pk_bf16(v[0] * rs, v[1] * rs); o.y = cvt_pk_bf16(v[2] * rs, v[3] * rs); o.z = cvt_pk_bf16(v[4] * rs, v[5] * rs); o.w = cvt_pk_bf16(v[6] * rs, v[7] * rs);
                *(u32x4*)(OMIX + (size_t)row * 1024 + lane * 8) = o;
            }
            {
                const float l0 = ls[q][0], l1 = ls[q][1], l2 = ls[q][2];
                const float mx = fmaxf(l0, fmaxf(l1, l2));
                float w0 = fast_exp2(l0 - mx), w1 = fast_exp2(l1 - mx), w2 = fast_exp2(l2 - mx);
                const float inv = 1.0f / (w0 + w1 + w2); w0 *= inv; w1 *= inv; w2 *= inv;
                float v[8];
#pragma unroll
                for (int e = 0; e < 8; ++e) v[e] = 0.f;
#pragma unroll
                for (int n = 0; n < 3; ++n) {
                    const u32x4 w = wd[q][n]; const float wn = n == 0 ? w0 : (n == 1 ? w1 : w2);
#pragma unroll
                    for (int e = 0; e < 4; ++e) { v[2 * e] += wn * __uint_as_float(w[e] << 16); v[2 * e + 1] += wn * __uint_as_float(w[e] & 0xffff0000u); }
                }
                float s = 0.f;
#pragma unroll
                for (int e = 0; e < 8; ++e) s += v[e] * v[e];
                const float rs = rsqrtf(wave_sum(s) * (1.0f / 512.0f) + EPS);
                u32x4 o; o.x = cvt_pk_bf16(v[0] * rs, v[1] * rs); o.y = cvt_pk_bf16(v[2] * rs, v[3] * rs); o.z = cvt_pk_bf16(v[4] * rs, v[5] * rs); o.w = cvt_pk_bf16(v[6] * rs, v[7] * rs);
                *(u32x4*)(OMIX + (size_t)row * 1024 + 512 + lane * 8) = o;
            }
        }
    }
    xcd_barrier(xb);
    {
        pg8::Gemm g{OMIX, WOUT, NT, DM, DM}; pg8::StaticOrder S; S.init(NT, DM, G, bx);
        EpiResid E{XB, SS2, 1.0f};
        pg8::gemm_phase<EpiResid, pg8::StaticOrder, true, true>(lds, g, S, E);
    }
    xcd_barrier(xb);
    {
        pg8::Gemm g{XB, W2GU, NT, 2 * FF, DM}; pg8::StaticOrder S; S.init(NT, 2 * FF, G, bx);
        rstd4_fill((LAS float*)(lds + 131072), SS2);
        EpiGateUp E{HB, SS2, (LAS float*)(lds + 131072)};
        pg8::gemm_phase<EpiGateUp, pg8::StaticOrder, true, true>(lds, g, S, E);
    }
    xcd_barrier(xb);
    {
        pg8::Gemm g{HB, W2D, NT, DM, FF}; pg8::StaticOrder S; S.init(NT, DM, G, bx);
        EpiFinal E{XB, X, SS3, pan_cnt, g_fin, (LAS float*)(lds + 131072)};
        pg8::gemm_phase<EpiFinal, pg8::StaticOrder, true, true>(lds, g, S, E);
    }
}

extern "C" void kernel_launch(void* const* d_in, const int* in_sizes, int n_in, void* d_out, int out_size, void* d_ws, size_t ws_size, hipStream_t stream) {
    constexpr int LDS_BYTES = 147456; static_assert(DIL_LDS + 64 <= LDS_BYTES, "LDS map");
    static int grid = 0;
    if (grid == 0) {
        if (n_in != 19 || in_sizes[0] != NT * DM || out_size != NT * DM || ws_size < WS_END) {
            fprintf(stderr, "kernel_launch: unexpected problem geometry (n_in %d, in0 %d, out %d, ws %zu); nothing launched\n", n_in, n_in > 0 ? in_sizes[0] : -1, out_size, ws_size); grid = -1; return; }
        int dev = 0, cus = 0, per_cu = 0;
        hipGetDevice(&dev); hipDeviceGetAttribute(&cus, hipDeviceAttributeMultiprocessorCount, dev);
        if (hipFuncSetAttribute((const void*)mk_fwd, hipFuncAttributeMaxDynamicSharedMemorySize, LDS_BYTES) != hipSuccess) { fprintf(stderr, "kernel_launch: hipFuncSetAttribute failed\n"); grid = -1; return; }
        if (hipOccupancyMaxActiveBlocksPerMultiprocessor(&per_cu, (const void*)mk_fwd, NWAVES * 64, LDS_BYTES) != hipSuccess || per_cu < 1) { fprintf(stderr, "kernel_launch: occupancy query says %d blocks per CU\n", per_cu); per_cu = 1; }
        (void)hipGetLastError();
        grid = cus >= 256 ? 256 : cus;
        if (cus != 256) fprintf(stderr, "kernel_launch: built for a 256-CU device, found %d CUs\n", cus);
        (void)0;
    }
    if (grid < 0) return;
    Args a{};
    for (int i = 0; i < 19; ++i) a.in[i] = (const float*)d_in[i];
    a.out = (float*)d_out; a.ws = (unsigned char*)d_ws;
    void* args[] = {&a};
    hipError_t e = hipLaunchCooperativeKernel((const void*)mk_fwd, dim3(grid), dim3(NWAVES * 64), args, LDS_BYTES, stream);
    if (e != hipSuccess) fprintf(stderr, "kernel_launch: cooperative launch failed: %s (grid %d)\n", hipGetErrorString(e), grid);
}
```

```cpp
#include <hip/hip_runtime.h>
#include <hip/hip_cooperative_groups.h>
#include <cmath>
#include <cstdio>
#include <cstdint>
namespace pg8 {
#define PG8_LAS __attribute__((address_space(3)))
typedef unsigned short bf16_t;
typedef short bf16x8 __attribute__((ext_vector_type(8)));
typedef float f32x4 __attribute__((ext_vector_type(4)));
typedef unsigned u32x4 __attribute__((ext_vector_type(4)));
constexpr int BM = 256, BK = 64, HALF = 128, HTB = HALF * BK * 2  , STAGE_BYTES = 8 * HTB, NXCD = 8, WGM = 8;

__host__ __device__ __forceinline__ int lds_byte(int r, int c) { const int st = (r >> 4) * 2 + (c >> 5), rr = r & 15, cc = c & 31, ob = rr * 64 + cc * 2; return st * 1024 + (ob ^ (((ob >> 9) & 1) << 5)); }
__host__ __device__ __forceinline__ void stage_rc(int b, int& R, int& C) { const int st = b / 1024, sb = b % 1024, swz = sb ^ (((sb >> 9) & 1) << 5); R = (st >> 1) * 16 + swz / 64; C = (st & 1) * 32 + (swz % 64) / 2; }
__host__ __device__ __forceinline__ int perm32(int rho) { const int n = rho >> 4, i = rho & 15; return 8 * (i >> 2) + 4 * n + (i & 3); }

struct Unit { int pm, pn; };
struct Gemm { const bf16_t* A; const bf16_t* Bt; int M, N, K; };

struct StaticOrder {
    int nM, nN, nwg, G, c;
    __host__ __device__ void init(int M, int N, int G_, int c_) { nM = M / BM; nN = N / BM; nwg = nM * nN; G = G_; c = c_; }
    __host__ __device__ bool next(int i, Unit& u) const {
        const long L = (long)i * G + c; if (L >= nwg) return false;
        int wgid = (int)L; { const int q = nwg / NXCD, r = nwg % NXCD, xcd = wgid % NXCD, off = wgid / NXCD; wgid = (xcd < r ? xcd * (q + 1) : r * (q + 1) + (xcd - r) * q) + off; }
        const int nig = WGM * nN, gid = wgid / nig, fm = gid * WGM, gsz = (nM - fm) < WGM ? (nM - fm) : WGM;
        u.pm = fm + ((wgid % nig) % gsz); u.pn = (wgid % nig) / gsz; return true;
    }
    __device__ __forceinline__ void a_ready(const Unit&) const {}
    __device__ __forceinline__ void done(const Unit&) const {}
};

__device__ __forceinline__ unsigned cvt_pk_bf16(float lo, float hi) { unsigned r; asm volatile("v_cvt_pk_bf16_f32 %0, %1, %2" : "=v"(r) : "v"(lo), "v"(hi)); return r; }

template <class Epi, class Sched, bool ALIGN_EPI = false, bool SP2 = false>
__device__ __forceinline__ void gemm_phase(PG8_LAS unsigned char* lds, const Gemm g, const Sched& S, const Epi& E) {
    int tid_ = threadIdx.x; asm volatile("" : "+v"(tid_));
    const int tid = tid_, wid = __builtin_amdgcn_readfirstlane(tid >> 6), lane = tid & 63, wr = wid >> 2, wc = wid & 3, fr = lane & 15, fq = lane >> 4;
    const int K = g.K, nt = K / BK;
    unsigned voffA[2], voffB[2];
#pragma unroll
    for (int i = 0; i < 2; ++i) { int R, C; stage_rc(tid * 16 + i * 8192, R, C); const int Rb = Epi::PERM ? ((R & ~31) + perm32(R & 31)) : R;
        voffA[i] = (unsigned)(R * K + C) * 2u; voffB[i] = (unsigned)(Rb * K + C) * 2u; }
    const size_t kstep = (size_t)(BK * 2);
    const size_t hstep = (size_t)HALF * K * 2;
    const size_t tstep = 2 * hstep;
    const unsigned ldsw = (unsigned)wid * 1024u;
    const int aoff = lds_byte(wr * 64 + fr, fq * 8), boff = lds_byte(wc * 32 + fr, fq * 8);
#define PG8_SA(b, h) (((b) * 2 + (h)) * HTB)
#define PG8_SB(b, h) ((4 + (b) * 2 + (h)) * HTB)
#define PG8_STAGE(bufoff, gbase, voff) do { _Pragma("unroll") for (int _i = 0; _i < 2; ++_i) \
        __builtin_amdgcn_global_load_lds((const unsigned*)((const char*)(gbase) + (voff)[_i]), (PG8_LAS unsigned*)(lds + (bufoff) + ldsw + _i * 8192), 16, 0, 0); } while (0)
#define PG8_LDA(dst, b, h) do { _Pragma("unroll") for (int m = 0; m < 4; ++m) _Pragma("unroll") for (int k = 0; k < 2; ++k) dst[m][k] = *(const PG8_LAS bf16x8*)(lds + PG8_SA(b, h) + aoff + m * 2048 + k * 1024); } while (0)
#define PG8_LDB(dst, b, h) do { _Pragma("unroll") for (int n = 0; n < 2; ++n) _Pragma("unroll") for (int k = 0; k < 2; ++k) dst[n][k] = *(const PG8_LAS bf16x8*)(lds + PG8_SB(b, h) + boff + n * 2048 + k * 1024); } while (0)
#define PG8_MMA(ai, bj, At, Bt) do { __builtin_amdgcn_s_setprio(1); _Pragma("unroll") for (int m = 0; m < 4; ++m) _Pragma("unroll") for (int n = 0; n < 2; ++n) _Pragma("unroll") for (int k = 0; k < 2; ++k) \
        acc[ai][bj][m][n] = __builtin_amdgcn_mfma_f32_16x16x32_bf16(Bt[n][k], At[m][k], acc[ai][bj][m][n], 0, 0, 0); __builtin_amdgcn_s_setprio(0); } while (0)
#define PG8_WAIT_V(n) asm volatile("s_waitcnt vmcnt(" #n ")" ::: "memory")
#define PG8_WAIT_L(n) asm volatile("s_waitcnt lgkmcnt(" #n ")" ::: "memory")
#define PG8_BAR __builtin_amdgcn_s_barrier()
#define PG8_SCHED __builtin_amdgcn_sched_barrier(0)
    Unit cur, nxt; int ui = 0;
    if (!S.next(0, cur)) return;
    f32x4 acc[2][2][4][2];
#pragma unroll
    for (int a = 0; a < 2; ++a)
#pragma unroll
        for (int b = 0; b < 2; ++b)
#pragma unroll
            for (int m = 0; m < 4; ++m)
#pragma unroll
                for (int n = 0; n < 2; ++n) acc[a][b][m][n] = (f32x4){0.f, 0.f, 0.f, 0.f};
    bf16x8 At[4][2], B0[2][2], B1[2][2];
    const char* cA = (const char*)g.A + (size_t)cur.pm * tstep; const char* cB = (const char*)g.Bt + (size_t)cur.pn * tstep;
    S.a_ready(cur);
    if constexpr (SP2) {
        PG8_STAGE(PG8_SB(0, 0), cB, voffB); PG8_STAGE(PG8_SB(0, 1), cB + hstep, voffB); PG8_STAGE(PG8_SA(0, 0), cA, voffA); PG8_STAGE(PG8_SA(0, 1), cA + hstep, voffA);
        if (wr == 1) PG8_BAR;
        PG8_WAIT_V(2); PG8_BAR;
        PG8_STAGE(PG8_SB(1, 0), cB + kstep, voffB); PG8_STAGE(PG8_SA(1, 0), cA + kstep, voffA); PG8_STAGE(PG8_SB(1, 1), cB + hstep + kstep, voffB);
        PG8_WAIT_V(6); PG8_BAR;
    } else {
        PG8_STAGE(PG8_SB(0, 0), cB, voffB); PG8_STAGE(PG8_SA(0, 0), cA, voffA); PG8_STAGE(PG8_SB(0, 1), cB + hstep, voffB); PG8_STAGE(PG8_SA(0, 1), cA + hstep, voffA);
        if (wr == 1) PG8_BAR;
        PG8_WAIT_V(4); PG8_BAR;
        PG8_STAGE(PG8_SB(1, 0), cB + kstep, voffB); PG8_STAGE(PG8_SA(1, 0), cA + kstep, voffA); PG8_STAGE(PG8_SB(1, 1), cB + hstep + kstep, voffB);
        PG8_WAIT_V(6); PG8_BAR;
    }
    for (;;) {
        const bool has_next = S.next(ui + 1, nxt);
        const char* nA = has_next ? (const char*)g.A + (size_t)nxt.pm * tstep : cA; const char* nB = has_next ? (const char*)g.Bt + (size_t)nxt.pn * tstep : cB;
        for (int t = 0; t < nt; t += 2) {
            const bool last = (t == nt - 2);
            const char* a1 = cA + (size_t)(t + 1) * kstep;
            const char* a2 = last ? nA : cA + (size_t)(t + 2) * kstep; const char* b2 = last ? nB : cB + (size_t)(t + 2) * kstep;
            const char* a3 = a2 + kstep; const char* b3 = b2 + kstep;
            if (last && has_next) S.a_ready(nxt);
            if constexpr (SP2) {
            PG8_LDB(B0, 0, 0); PG8_LDB(B1, 0, 1); PG8_SCHED; PG8_LDA(At, 0, 0); PG8_STAGE(PG8_SA(1, 1), a1 + hstep, voffA);
            PG8_WAIT_V(8); PG8_WAIT_L(0); PG8_BAR; PG8_MMA(0, 0, At, B0); PG8_MMA(0, 1, At, B1); PG8_BAR; PG8_SCHED;
            PG8_LDA(At, 0, 1); PG8_STAGE(PG8_SB(0, 0), b2, voffB); PG8_STAGE(PG8_SB(0, 1), b2 + hstep, voffB); PG8_STAGE(PG8_SA(0, 0), a2, voffA);
            PG8_WAIT_V(8); PG8_WAIT_L(0); PG8_BAR; PG8_MMA(1, 0, At, B0); PG8_MMA(1, 1, At, B1); PG8_BAR; PG8_SCHED;
            PG8_LDB(B0, 1, 0); PG8_LDB(B1, 1, 1); PG8_SCHED; PG8_LDA(At, 1, 0); PG8_STAGE(PG8_SA(0, 1), a2 + hstep, voffA);
            PG8_WAIT_V(8); PG8_WAIT_L(0); PG8_BAR; PG8_MMA(0, 0, At, B0); PG8_MMA(0, 1, At, B1); PG8_BAR; PG8_SCHED;
            PG8_LDA(At, 1, 1); PG8_STAGE(PG8_SB(1, 0), b3, voffB); PG8_STAGE(PG8_SB(1, 1), b3 + hstep, voffB); PG8_STAGE(PG8_SA(1, 0), a3, voffA);
            PG8_WAIT_V(8); PG8_WAIT_L(0); PG8_BAR; PG8_MMA(1, 0, At, B0); PG8_MMA(1, 1, At, B1); PG8_BAR; PG8_SCHED;
            } else {
            PG8_LDB(B0, 0, 0); PG8_SCHED; PG8_LDA(At, 0, 0); PG8_STAGE(PG8_SA(1, 1), a1 + hstep, voffA);
            PG8_WAIT_L(8); PG8_BAR; PG8_WAIT_L(0); PG8_MMA(0, 0, At, B0); PG8_BAR; PG8_SCHED;
            PG8_LDB(B1, 0, 1); PG8_STAGE(PG8_SB(0, 0), b2, voffB);
            PG8_BAR; PG8_WAIT_L(0); PG8_MMA(0, 1, At, B1); PG8_BAR;
            PG8_LDA(At, 0, 1); PG8_STAGE(PG8_SA(0, 0), a2, voffA);
            PG8_BAR; PG8_WAIT_L(0); PG8_MMA(1, 0, At, B0); PG8_BAR; PG8_SCHED;
            PG8_STAGE(PG8_SB(0, 1), b2 + hstep, voffB);
            PG8_WAIT_V(6); PG8_BAR; PG8_MMA(1, 1, At, B1); PG8_BAR;
            PG8_LDB(B0, 1, 0); PG8_SCHED; PG8_LDA(At, 1, 0); PG8_STAGE(PG8_SA(0, 1), a2 + hstep, voffA);
            PG8_WAIT_L(8); PG8_BAR; PG8_WAIT_L(0); PG8_MMA(0, 0, At, B0); PG8_BAR; PG8_SCHED;
            PG8_LDB(B1, 1, 1); PG8_STAGE(PG8_SB(1, 0), b3, voffB);
            PG8_BAR; PG8_WAIT_L(0); PG8_MMA(0, 1, At, B1); PG8_BAR;
            PG8_LDA(At, 1, 1); PG8_STAGE(PG8_SA(1, 0), a3, voffA);
            PG8_BAR; PG8_WAIT_L(0); PG8_MMA(1, 0, At, B0); PG8_BAR; PG8_SCHED;
            PG8_STAGE(PG8_SB(1, 1), b3 + hstep, voffB);
            PG8_WAIT_V(6); PG8_BAR; PG8_MMA(1, 1, At, B1); PG8_BAR;
            }
        }
        if constexpr (ALIGN_EPI) { if (wr == 0) PG8_BAR; }
        if constexpr (!Epi::AFTER_DRAIN) { E(acc, cur, wr, wc, fr, fq); S.done(cur); }
        if (!has_next) break;
#pragma unroll
        for (int a = 0; a < 2; ++a)
#pragma unroll
            for (int b = 0; b < 2; ++b)
#pragma unroll
                for (int m = 0; m < 4; ++m)
#pragma unroll
                    for (int n = 0; n < 2; ++n) acc[a][b][m][n] = (f32x4){0.f, 0.f, 0.f, 0.f};
        cur = nxt; cA = nA; cB = nB; ++ui;
        if constexpr (ALIGN_EPI) { if (wr == 1) PG8_BAR; }
    }
    PG8_WAIT_V(0);
    if constexpr (!ALIGN_EPI) { if (wr == 0) PG8_BAR; }
    PG8_BAR;
    if constexpr (Epi::AFTER_DRAIN) { E.fused(acc, cur, wr, wc, fr, fq, lds, wid, lane); S.done(cur); }
#undef PG8_SA
#undef PG8_SB
#undef PG8_STAGE
#undef PG8_LDA
#undef PG8_LDB
#undef PG8_MMA
#undef PG8_WAIT_V
#undef PG8_WAIT_L
#undef PG8_BAR
#undef PG8_SCHED
}
}

namespace cg = cooperative_groups;

#define LAS __attribute__((address_space(3)))
typedef unsigned short bf16_t;
typedef float f32x4 __attribute__((ext_vector_type(4)));
typedef float f32x16 __attribute__((ext_vector_type(16)));
typedef short bf16x8 __attribute__((ext_vector_type(8)));
typedef short s16x4 __attribute__((ext_vector_type(4)));
typedef unsigned u32x2 __attribute__((ext_vector_type(2)));
typedef unsigned u32x4 __attribute__((ext_vector_type(4)));
using pg8::Unit;
typedef float f32x2_t __attribute__((ext_vector_type(2))); typedef __bf16 bf16x2_t __attribute__((ext_vector_type(2)));
__device__ __forceinline__ unsigned cvt_pk_bf16(float lo, float hi) { const f32x2_t v = {lo, hi}; const bf16x2_t b = __builtin_convertvector(v, bf16x2_t); return __builtin_bit_cast(unsigned, b); }

constexpr int NT = 65536, SEQ = 2048, DM = 1024, FF = 2816, NWAVES = 8;
constexpr float EPS = 1e-6f, LOG2E = 1.4426950408889634f;
constexpr float QSCALE_D = 0.125f * LOG2E;
constexpr float QSCALE_M = 0.10206207261596577f * LOG2E;

constexpr size_t MiB = 1u << 20;
constexpr size_t WS_W1GU = 0, WS_W1D = 11 * MiB, WS_W2GU = 17 * MiB, WS_W2D = 28 * MiB, WS_WIN = 34 * MiB, WS_WUQ = 39 * MiB, WS_WUKV = 40 * MiB, WS_WOUT = 41 * MiB;
constexpr size_t WS_ROPE = 43 * MiB;
constexpr size_t WS_SS0 = 44 * MiB, WS_SS1 = 48 * MiB, WS_SS2 = 52 * MiB, WS_SS3 = 56 * MiB, WS_SSQ = 60 * MiB, WS_SSKV = 62 * MiB;
constexpr size_t WS_BAR = 63 * MiB;
constexpr size_t WS_XB = 64 * MiB;
constexpr size_t WS_KVM = WS_XB;
constexpr size_t WS_H = 192 * MiB;
constexpr size_t WS_OD0 = 192 * MiB, WS_OD1 = 256 * MiB, WS_OD2 = 320 * MiB, WS_OMIX = 384 * MiB, WS_LSE = 512 * MiB;
constexpr size_t WS_QD = 544 * MiB, WS_KD = 608 * MiB, WS_VD = 672 * MiB, WS_CQ = 736 * MiB, WS_CKV = 784 * MiB, WS_KR = 816 * MiB, WS_QM = 820 * MiB, WS_END = 916 * MiB;

__device__ __forceinline__ float fast_exp2(float x) { return __builtin_amdgcn_exp2f(x); }
__device__ __forceinline__ float fast_rcp(float x) { return __builtin_amdgcn_rcpf(x); }
__device__ __forceinline__ float bf2f(unsigned short b) { return __uint_as_float((unsigned)b << 16); }
__device__ __forceinline__ float sum4(f32x4 a) { return (a[0] + a[1]) + (a[2] + a[3]); }
__device__ __forceinline__ float sq4(f32x4 a) { return (a[0] * a[0] + a[1] * a[1]) + (a[2] * a[2] + a[3] * a[3]); }
__device__ __forceinline__ float rstd_parts16(const float* ss, int row, float invn) {
    const f32x4* p = (const f32x4*)(ss + (size_t)row * 16);
    const float s = (sum4(p[0]) + sum4(p[1])) + (sum4(p[2]) + sum4(p[3]));
    return rsqrtf(s * invn + EPS);
}

#define EPI_RELANE() int fr, fq; { int t_ = threadIdx.x; asm volatile("" : "+v"(t_)); fr = t_ & 15; fq = (t_ >> 4) & 3; }
__device__ __forceinline__ void rstd4_fill(LAS float* tab4, const float* ss) {
    int tid = threadIdx.x; asm volatile("" : "+v"(tid));
    const int c = blockIdx.x;
#pragma unroll
    for (int k = 0; k < 2; ++k) { const int idx = tid + 512 * k, slot = idx >> 8, r = idx & 255, pm = 8 * (4 * (c & 7) + slot) + ((c >> 3) & 7); tab4[idx] = rstd_parts16(ss, pm * 256 + r, 1.0f / 1024.0f); }
    __syncthreads();
}
__device__ __forceinline__ int rstd4_slot(int pm) { return (pm >> 3) - 4 * ((int)blockIdx.x & 7); }
struct EpiGateUp {
    static constexpr bool PERM = true, AFTER_DRAIN = false;
    bf16_t* H; const float* ss; LAS float* tab;
    __device__ __forceinline__ void operator()(const f32x4 (&acc)[2][2][4][2], const Unit& u, int wr, int wc, int fr_in, int fq_in) const {
        EPI_RELANE();
        const LAS float* tb = tab + rstd4_slot(u.pm) * 256;
        const int r0 = wr * 64 + fr, col = u.pn * 128 + wc * 32 + 8 * fq;
#pragma unroll
        for (int ai = 0; ai < 2; ++ai)
#pragma unroll
            for (int m = 0; m < 4; ++m) {
                const int r = r0 + ai * 128 + m * 16;
                const float rs = tb[r], nrs = -rs * LOG2E;
                float o[8];
#pragma unroll
                for (int n = 0; n < 2; ++n)
#pragma unroll
                    for (int j = 0; j < 4; ++j) {
                        const float ga = acc[ai][0][m][n][j];
                        o[4 * n + j] = (ga * rs) * fast_rcp(1.0f + fast_exp2(ga * nrs)) * (acc[ai][1][m][n][j] * rs);
                    }
                u32x4 w; w.x = cvt_pk_bf16(o[0], o[1]); w.y = cvt_pk_bf16(o[2], o[3]); w.z = cvt_pk_bf16(o[4], o[5]); w.w = cvt_pk_bf16(o[6], o[7]);
                *(u32x4*)(H + (size_t)(u.pm * 256 + r) * FF + col) = w;
            }
    }
};
struct EpiResid {
    static constexpr bool PERM = true, AFTER_DRAIN = false;
    bf16_t* xb; float* ss; float alpha;
    __device__ __forceinline__ void operator()(const f32x4 (&acc)[2][2][4][2], const Unit& u, int wr, int wc, int fr_in, int fq_in) const {
        EPI_RELANE();
        const int row0 = u.pm * 256 + wr * 64 + fr, col0 = u.pn * 256 + wc * 32 + 8 * fq;
        u32x4 bws[2][4][2];
#pragma unroll
        for (int ai = 0; ai < 2; ++ai)
#pragma unroll
            for (int m = 0; m < 4; ++m)
#pragma unroll
                for (int bj = 0; bj < 2; ++bj) bws[ai][m][bj] = *(const u32x4*)(xb + (size_t)(row0 + ai * 128 + m * 16) * DM + col0 + bj * 128);
#pragma unroll
        for (int ai = 0; ai < 2; ++ai)
#pragma unroll
            for (int m = 0; m < 4; ++m) {
                const int row = row0 + ai * 128 + m * 16; float sq = 0.f;
#pragma unroll
                for (int bj = 0; bj < 2; ++bj) {
                    const u32x4 bw = bws[ai][m][bj];
                    const f32x4 b0 = {__uint_as_float(bw.x << 16), __uint_as_float(bw.x & 0xffff0000u), __uint_as_float(bw.y << 16), __uint_as_float(bw.y & 0xffff0000u)};
                    const f32x4 b1 = {__uint_as_float(bw.z << 16), __uint_as_float(bw.z & 0xffff0000u), __uint_as_float(bw.w << 16), __uint_as_float(bw.w & 0xffff0000u)};
                    const f32x4 v0 = b0 + acc[ai][bj][m][0] * alpha, v1 = b1 + acc[ai][bj][m][1] * alpha; sq += sq4(v0) + sq4(v1);
                    u32x4 w; w.x = cvt_pk_bf16(v0[0], v0[1]); w.y = cvt_pk_bf16(v0[2], v0[3]); w.z = cvt_pk_bf16(v1[0], v1[1]); w.w = cvt_pk_bf16(v1[2], v1[3]);
                    *(u32x4*)(xb + (size_t)row * DM + col0 + bj * 128) = w;
                }
                sq += __shfl_xor(sq, 16); sq += __shfl_xor(sq, 32);
                if (fq == 0) ss[(size_t)row * 16 + u.pn * 4 + wc] = sq;
            }
    }
};
struct EpiFinal {
    static constexpr bool PERM = true, AFTER_DRAIN = false;
    const bf16_t* xb; float* X; float* ss; unsigned* cnt; const float* gfin; LAS float* tab;
    __device__ __forceinline__ void operator()(f32x4 (&acc)[2][2][4][2], const Unit& u, int wr, int wc, int fr_in, int fq_in) const {
        EPI_RELANE();
        int tid = threadIdx.x; asm volatile("" : "+v"(tid));
        const int row0 = u.pm * 256 + wr * 64 + fr, col0 = u.pn * 256 + wc * 32 + 8 * fq;
        u32x4 bws[2][4][2];
#pragma unroll
        for (int ai = 0; ai < 2; ++ai)
#pragma unroll
            for (int m = 0; m < 4; ++m)
#pragma unroll
                for (int bj = 0; bj < 2; ++bj) bws[ai][m][bj] = *(const u32x4*)(xb + (size_t)(row0 + ai * 128 + m * 16) * DM + col0 + bj * 128);
#pragma unroll
        for (int ai = 0; ai < 2; ++ai)
#pragma unroll
            for (int m = 0; m < 4; ++m) {
                const int row = row0 + ai * 128 + m * 16; float sq = 0.f;
#pragma unroll
                for (int bj = 0; bj < 2; ++bj) {
                    const u32x4 bw = bws[ai][m][bj];
                    const f32x4 b0 = {__uint_as_float(bw.x << 16), __uint_as_float(bw.x & 0xffff0000u), __uint_as_float(bw.y << 16), __uint_as_float(bw.y & 0xffff0000u)};
                    const f32x4 b1 = {__uint_as_float(bw.z << 16), __uint_as_float(bw.z & 0xffff0000u), __uint_as_float(bw.w << 16), __uint_as_float(bw.w & 0xffff0000u)};
                    const f32x4 v0 = b0 + acc[ai][bj][m][0] * 0.5f, v1 = b1 + acc[ai][bj][m][1] * 0.5f; acc[ai][bj][m][0] = v0; acc[ai][bj][m][1] = v1; sq += sq4(v0) + sq4(v1);
                }
                sq += __shfl_xor(sq, 16); sq += __shfl_xor(sq, 32);
                if (fq == 0) ss[(size_t)row * 16 + u.pn * 4 + wc] = sq;
            }
        asm volatile("s_waitcnt vmcnt(0)" ::: "memory");
        __syncthreads();
        if (tid == 0) {
            unsigned* c = cnt + 64 * u.pm;
            __builtin_amdgcn_fence(__ATOMIC_RELEASE, "agent"); asm volatile("s_waitcnt vmcnt(0)" ::: "memory");
            __hip_atomic_fetch_add(c, 1u, __ATOMIC_RELAXED, __HIP_MEMORY_SCOPE_AGENT);
            unsigned sp = 0;
            while (__hip_atomic_load(c, __ATOMIC_RELAXED, __HIP_MEMORY_SCOPE_AGENT) < 4u) { __builtin_amdgcn_s_sleep(2); if (++sp > (1u << 22)) break; }
            __builtin_amdgcn_fence(__ATOMIC_ACQUIRE, "agent"); asm volatile("s_waitcnt vmcnt(0)" ::: "memory");
        }
        __syncthreads();
        if (tid < 256) tab[tid] = rstd_parts16(ss, u.pm * 256 + tid, 1.0f / 1024.0f);
        __syncthreads();
#pragma unroll
        for (int ai = 0; ai < 2; ++ai)
#pragma unroll
            for (int m = 0; m < 4; ++m) {
                const int r = ai * 128 + wr * 64 + m * 16 + fr; const float rs = tab[r];
#pragma unroll
                for (int bj = 0; bj < 2; ++bj)
#pragma unroll
                    for (int n = 0; n < 2; ++n) {
                        const int col = col0 + bj * 128 + n * 4;
                        const f32x4 g = *(const f32x4*)(gfin + col);
                        *(f32x4*)(X + (size_t)(u.pm * 256 + r) * DM + col) = acc[ai][bj][m][n] * rs * g;
                    }
            }
    }
};
__device__ __forceinline__ void store8_pair(bf16_t* grp, int fq, u32x2 w0, u32x2 w1) {
    const bool odd = (fq & 1) != 0;
    const u32x2 snd = odd ? w0 : w1;
    u32x2 rcv; rcv.x = __shfl_xor(snd.x, 16); rcv.y = __shfl_xor(snd.y, 16);
    u32x4 o; if (odd) { o.x = rcv.x; o.y = rcv.y; o.z = w1.x; o.w = w1.y; } else { o.x = w0.x; o.y = w0.y; o.z = rcv.x; o.w = rcv.y; }
    *(u32x4*)(grp + (odd ? 16 + 4 * (fq - 1) : 4 * fq)) = o;
}
struct EpiInProj {
    static constexpr bool PERM = false, AFTER_DRAIN = false;
    const float* ss1; bf16_t *QD, *KD, *VD, *CQ, *CKV, *KR; float *SSQ, *SSKV; const float *cosm, *sinm, *cosp, *sinp; LAS float* tab;
    __device__ __forceinline__ void operator()(const f32x4 (&acc)[2][2][4][2], const Unit& u, int wr, int wc, int fr_in, int fq_in) const {
        EPI_RELANE();
        const LAS float* tb = tab + rstd4_slot(u.pm) * 256;
        const int row0 = u.pm * 256 + wr * 64 + fr, pn = u.pn;
        const bool ropeP = (pn < 4) && ((wc & 1) == 0), ropeM = (pn == 7) && (wc == 0);
        f32x4 cs[2][4], sn[2][4];
        if (ropeP || ropeM) {
#pragma unroll
            for (int ai = 0; ai < 2; ++ai)
#pragma unroll
                for (int m = 0; m < 4; ++m) { const int pos = (row0 + ai * 128 + m * 16) & (SEQ - 1);
                    const float* cp = ropeP ? cosp + pos * 8 + 4 * (fq & 1) : cosm + pos * 16 + 4 * fq; const float* sp = ropeP ? sinp + pos * 8 + 4 * (fq & 1) : sinm + pos * 16 + 4 * fq;
                    cs[ai][m] = *(const f32x4*)cp; sn[ai][m] = *(const f32x4*)sp; }
        }
#pragma unroll
        for (int ai = 0; ai < 2; ++ai)
#pragma unroll
            for (int m = 0; m < 4; ++m) {
                const int row = row0 + ai * 128 + m * 16, pos = row & (SEQ - 1);
                const float rs = tb[ai * 128 + wr * 64 + m * 16 + fr];
                if (pn < 6) {
                    bf16_t* dst = QD + (size_t)(pn >> 1) * ((size_t)NT * 512) + (size_t)row * 512 + (pn & 1) * 256 + wc * 32;
                    const float sc = pn < 2 ? rs * QSCALE_D : rs;
                    const bool rope = (pn < 4) && ((wc & 1) == 0);
#pragma unroll
                    for (int bj = 0; bj < 2; ++bj) {
                        u32x2 wp[2];
#pragma unroll
                        for (int n = 0; n < 2; ++n) {
                            f32x4 v = acc[ai][bj][m][n] * sc;
                            if (n == 0 && rope) {
                                f32x4 pv; pv[0] = __shfl_xor(v[0], 32); pv[1] = __shfl_xor(v[1], 32); pv[2] = __shfl_xor(v[2], 32); pv[3] = __shfl_xor(v[3], 32);
                                const f32x4 c = cs[ai][m], s = sn[ai][m];
                                v = (fq < 2) ? (v * c - pv * s) : (v * c + pv * s);
                            }
                            wp[n].x = cvt_pk_bf16(v[0], v[1]); wp[n].y = cvt_pk_bf16(v[2], v[3]);
                        }
                        store8_pair(dst + bj * 128, fq, wp[0], wp[1]);
                    }
                } else if (pn == 6 || pn == 8) {
                    bf16_t* dst = CQ + (pn == 6 ? (size_t)row * 384 : (size_t)NT * 384 + (size_t)row * 256) + wc * 32; float sq = 0.f;
#pragma unroll
                    for (int bj = 0; bj < 2; ++bj) {
                        u32x2 wp[2];
#pragma unroll
                        for (int n = 0; n < 2; ++n) {
                            const f32x4 v = acc[ai][bj][m][n] * rs; sq += sq4(v);
                            wp[n].x = cvt_pk_bf16(v[0], v[1]); wp[n].y = cvt_pk_bf16(v[2], v[3]);
                        }
                        store8_pair(dst + bj * 128, fq, wp[0], wp[1]);
                    }
                    sq += __shfl_xor(sq, 16); sq += __shfl_xor(sq, 32);
                    if (fq == 0) SSQ[(pn == 6 ? (size_t)row * 8 : (size_t)NT * 8 + (size_t)row * 4) + wc] = sq;
                } else {
                    bf16_t* dst = CQ + (size_t)row * 384 + 256 + wc * 32; float sq = 0.f;
                    { u32x2 wp[2];
#pragma unroll
                      for (int n = 0; n < 2; ++n) {
                          const f32x4 v = acc[ai][0][m][n] * rs; sq += sq4(v);
                          wp[n].x = cvt_pk_bf16(v[0], v[1]); wp[n].y = cvt_pk_bf16(v[2], v[3]);
                      }
                      store8_pair(dst, fq, wp[0], wp[1]); }
                    sq += __shfl_xor(sq, 16); sq += __shfl_xor(sq, 32);
                    if (fq == 0) SSQ[(size_t)row * 8 + 4 + wc] = sq;
                    if (wc == 0) {
                        const f32x4 x1 = acc[ai][1][m][0] * rs, x2 = acc[ai][1][m][1] * rs;
                        const f32x4 c = cs[ai][m], s = sn[ai][m];
                        const f32x4 o1 = x1 * c - x2 * s, o2 = x2 * c + x1 * s;
                        u32x2 w1, w2; w1.x = cvt_pk_bf16(o1[0], o1[1]); w1.y = cvt_pk_bf16(o1[2], o1[3]); w2.x = cvt_pk_bf16(o2[0], o2[1]); w2.y = cvt_pk_bf16(o2[2], o2[3]);
                        *(u32x2*)(KR + (size_t)row * 32 + 4 * fq) = w1; *(u32x2*)(KR + (size_t)row * 32 + 16 + 4 * fq) = w2;
                    }
                }
            }
    }
};
struct EpiQ {
    static constexpr bool PERM = false, AFTER_DRAIN = false;
    const float* ssq; bf16_t* QM; const float *cosm, *sinm; LAS float* tab;
    __device__ __forceinline__ void operator()(const f32x4 (&acc)[2][2][4][2], const Unit& u, int wr, int wc, int fr_in, int fq_in) const {
        EPI_RELANE();
        const int row0 = u.pm * 256 + wr * 64 + fr;
        { int tid = threadIdx.x; asm volatile("" : "+v"(tid));
          if (tid < 256) { const f32x4* p = (const f32x4*)(ssq + (size_t)(u.pm * 256 + tid) * 8); tab[tid] = rsqrtf((sum4(p[0]) + sum4(p[1])) * (1.0f / 384.0f) + EPS) * QSCALE_M; } }
        __syncthreads();
#pragma unroll
        for (int ai = 0; ai < 2; ++ai) {
#pragma unroll
            for (int m = 0; m < 4; ++m) {
                const int row = row0 + ai * 128 + m * 16;
                const float rs = tab[ai * 128 + wr * 64 + m * 16 + fr];
#pragma unroll
                for (int bj = 0; bj < 2; ++bj) {
                    const int g32 = 8 * u.pn + 4 * bj + wc;
                    bf16_t* dst = QM + (size_t)row * 768 + 32 * g32 + 4 * fq;
                    f32x4 v0 = acc[ai][bj][m][0] * rs, v1 = acc[ai][bj][m][1] * rs;
                    if (g32 % 3 == 2) {
                        const int pos = row & (SEQ - 1);
                        const f32x4 c = *(const f32x4*)(cosm + pos * 16 + 4 * fq), s = *(const f32x4*)(sinm + pos * 16 + 4 * fq);
                        const f32x4 o1 = v0 * c - v1 * s, o2 = v1 * c + v0 * s; v0 = o1; v1 = o2;
                    }
                    u32x2 w0, w1; w0.x = cvt_pk_bf16(v0[0], v0[1]); w0.y = cvt_pk_bf16(v0[2], v0[3]); w1.x = cvt_pk_bf16(v1[0], v1[1]); w1.y = cvt_pk_bf16(v1[2], v1[3]);
                    *(u32x2*)dst = w0; *(u32x2*)(dst + 16) = w1;
                }
            }
        }
    }
};
struct EpiKV {
    static constexpr bool PERM = true, AFTER_DRAIN = false;
    const float* sskv; bf16_t* KVM; LAS float* tab;
    __device__ __forceinline__ void operator()(const f32x4 (&acc)[2][2][4][2], const Unit& u, int wr, int wc, int fr_in, int fq_in) const {
        EPI_RELANE();
        { int tid = threadIdx.x; asm volatile("" : "+v"(tid)); if (tid < 256) tab[tid] = rsqrtf(sum4(*(const f32x4*)(sskv + (size_t)(u.pm * 256 + tid) * 4)) * (1.0f / 256.0f) + EPS); }
        __syncthreads();
        const int row0 = u.pm * 256 + wr * 64 + fr, col = u.pn * 256 + wc * 32 + 8 * fq;
#pragma unroll
        for (int ai = 0; ai < 2; ++ai)
#pragma unroll
            for (int m = 0; m < 4; ++m) {
                const int row = row0 + ai * 128 + m * 16;
                const float rs = tab[ai * 128 + wr * 64 + m * 16 + fr];
#pragma unroll
                for (int bj = 0; bj < 2; ++bj) {
                    const f32x4 v0 = acc[ai][bj][m][0] * rs, v1 = acc[ai][bj][m][1] * rs;
                    u32x4 w; w.x = cvt_pk_bf16(v0[0], v0[1]); w.y = cvt_pk_bf16(v0[2], v0[3]); w.z = cvt_pk_bf16(v1[0], v1[1]); w.w = cvt_pk_bf16(v1[2], v1[3]);
                    *(u32x4*)(KVM + (size_t)row * 1024 + col + bj * 128) = w;
                }
            }
    }
};

constexpr int ATT_VS = 192;
constexpr int ATT_TILE = 64 * 208 + 64 * ATT_VS;
constexpr int ATT_OST = 2 * ATT_TILE, ATT_WSC = ATT_OST + NWAVES * 4096;
static_assert(ATT_WSC + NWAVES * 256 <= 131072, "attention LDS");
static_assert(WS_KD == WS_QD + (size_t)NT * 512 * 2 && WS_VD == WS_KD + (size_t)NT * 512 * 2 && WS_CKV == WS_CQ + (size_t)NT * 384 * 2 && WS_SSKV == WS_SSQ + (size_t)NT * 8 * 4, "buffers addressed relative to each other");
__device__ __forceinline__ int crow(int r, int hi) { return (r & 3) + 8 * (r >> 2) + 4 * hi; }
__device__ __forceinline__ bf16x8 pack8(const f32x16& p, int b) {
    u32x4 w; w.x = cvt_pk_bf16(p[b], p[b + 1]); w.y = cvt_pk_bf16(p[b + 2], p[b + 3]); w.z = cvt_pk_bf16(p[b + 4], p[b + 5]); w.w = cvt_pk_bf16(p[b + 6], p[b + 7]);
    return __builtin_bit_cast(bf16x8, w);
}
typedef short v4i16_t __attribute__((ext_vector_type(4)));
__device__ __forceinline__ s16x4 vtr(LAS const unsigned char* p) { return __builtin_bit_cast(s16x4, __builtin_amdgcn_ds_read_tr16_b64_v4i16((LAS v4i16_t*)p)); }

struct AttnIO {
    const bf16_t *QM, *KVM, *KR; bf16_t* OMIX;
    const bf16_t *QD, *KD, *VD; bf16_t* OD; float* LSE;
};

template <bool DIL>
__device__ __forceinline__ void attn_unit(LAS unsigned char* lds, const AttnIO& io, int unit) {
    constexpr int DK = DIL ? 64 : 96, KS = DK * 2 + 16, NKS = DK / 16;
    int tid_ = threadIdx.x; asm volatile("" : "+v"(tid_));
    const int tid = tid_, lane = tid & 63, wid = __builtin_amdgcn_readfirstlane(tid >> 6), r32 = lane & 31, hi = lane >> 5;
    int b, h, ntiles, tlo, thi, kofs = 0, L = SEQ, dil = 1, res = 0, resu = 0, br = 0, q0 = 0, pq;
    if constexpr (!DIL) {
        const int bh = unit >> 3, qb = unit & 7; b = bh >> 3; h = bh & 7; ntiles = 32; tlo = 0; thi = 32; q0 = qb * 256; pq = q0 + wid * 32 + r32;
    } else {
        const int bh = unit / 24, k = unit % 24, j = k & 7; br = k >> 3; b = bh >> 3; h = bh & 7;
        if (br == 0) { dil = 1; L = 2048; resu = 0; q0 = 256 * j; }
        else if (br == 1) { dil = 4; L = 512; resu = j >> 1; q0 = 256 * (j & 1); }
        else { dil = 16; L = 128; resu = 2 * j; q0 = 0; }
        if (br < 2) { ntiles = 6; tlo = wid >> 1; thi = tlo + 3; kofs = q0 - 64; pq = q0 + wid * 32 + r32; res = resu; }
        else { const int hw = wid >> 2; ntiles = 4; tlo = 2 * hw; thi = tlo + 2; kofs = -128 * hw; pq = (wid & 3) * 32 + r32; res = resu + hw; }
    }
    const int pq0 = pq - r32;
    const size_t kb = (size_t)b * SEQ;
    bf16x8 qf[NKS];
    {
        const bf16_t* qp = DIL ? io.QD + (kb + (size_t)pq * dil + res) * 512 + h * 64 : io.QM + (kb + pq) * 768 + h * 96;
#pragma unroll
        for (int ks = 0; ks < NKS; ++ks) qf[ks] = *(const bf16x8*)(qp + ks * 16 + hi * 8);
    }
    const int lrow = tid >> 3, lch = tid & 7, rrow = (tid >> 2) & 63, rch = tid & 3;
    u32x4 gkA, gvA, grA = (u32x4){0u, 0u, 0u, 0u}, gkB, gvB, grB = (u32x4){0u, 0u, 0u, 0u};
#define ATT_TOK(t) \
        const int s_ = 64 * (t) + lrow; size_t tok_; \
        if (br < 2) { int p_ = q0 - 64 + s_; p_ = p_ < 0 ? 0 : (p_ > L - 1 ? L - 1 : p_); tok_ = kb + (size_t)p_ * dil + resu; } \
        else { tok_ = kb + (size_t)(s_ & 127) * 16 + (size_t)(resu + (s_ >> 7)); }
#define ATT_GLOADK(t, GK, GR) do { \
        if constexpr (!DIL) { \
            GK = *(const u32x4*)(io.KVM + (kb + 64 * (t) + lrow) * 1024 + h * 128 + lch * 8); \
            GR = *(const u32x4*)(io.KR + (kb + 64 * (t) + rrow) * 32 + rch * 8); \
        } else { ATT_TOK(t) GK = *(const u32x4*)(io.KD + tok_ * 512 + h * 64 + lch * 8); } } while (0)
#define ATT_GLOADV(t, GV) do { \
        if constexpr (!DIL) { GV = *(const u32x4*)(io.KVM + (kb + 64 * (t) + lrow) * 1024 + h * 128 + 64 + lch * 8); } \
        else { ATT_TOK(t) GV = *(const u32x4*)(io.VD + tok_ * 512 + h * 64 + lch * 8); } } while (0)
#define ATT_LSTOREK(buf, GK, GR) do { \
        LAS unsigned char* Kb_ = lds + (buf) * ATT_TILE; \
        *(LAS u32x4*)(Kb_ + lrow * KS + lch * 16) = GK; \
        if constexpr (!DIL) { *(LAS u32x4*)(Kb_ + rrow * KS + 128 + rch * 16) = GR; } } while (0)
#define ATT_LSTOREV(buf, GV) do { *(LAS u32x4*)(lds + (buf) * ATT_TILE + 64 * KS + lrow * ATT_VS + lch * 16) = GV; } while (0)
#define ATT_SB() do {} while (0)
    LAS float* wsc = (LAS float*)(lds + ATT_WSC + wid * 256);
    f32x16 o0 = {}, o1 = {}, negm = {};
    float mref = 0.f, lrun = 0.f; bool started = false;
    const int krow = (r32 & 19) | ((r32 & 4) << 1) | ((r32 & 8) >> 1);
    const int koff = krow * KS + hi * 16;
    const int i16 = lane & 15, g16 = lane >> 4;
    const int voff = 64 * KS + (8 * hi + (i16 >> 2)) * ATT_VS + (16 * (g16 & 1) + 4 * (i16 & 3)) * 2;
    ATT_GLOADK(0, gkA, grA); ATT_GLOADV(0, gvA); ATT_GLOADK(1, gkB, grB); ATT_LSTOREK(0, gkA, grA); ATT_LSTOREV(0, gvA); ATT_LSTOREK(1, gkB, grB);
    ATT_GLOADK(2, gkB, grB); ATT_GLOADV(1, gvB);
    __syncthreads();
    f32x16 c0, c1;
    if (tlo == 0) {
        c0 = negm; c1 = negm;
#pragma unroll
        for (int ks = 0; ks < NKS; ++ks) {
            const bf16x8 a0 = *(LAS const bf16x8*)(lds + koff + ks * 32), a1 = *(LAS const bf16x8*)(lds + koff + 32 * KS + ks * 32);
            c0 = __builtin_amdgcn_mfma_f32_32x32x16_bf16(a0, qf[ks], c0, 0, 0, 0); c1 = __builtin_amdgcn_mfma_f32_32x32x16_bf16(a1, qf[ks], c1, 0, 0, 0);
        }
    } else { c0 = negm; c1 = negm; }
    __syncthreads();
    for (int t2 = 0; t2 < ntiles; t2 += 2) {
      { const int t = t2;
        ATT_GLOADK(min(t + 3, ntiles - 1), gkA, grA);
        ATT_GLOADV(min(t + 2, ntiles - 1), gvA);
        const bool doP = (t >= tlo) && (t < thi), doS = (t + 1 >= tlo) && (t + 1 < thi);
        LAS const unsigned char* Kn = lds + ((t + 1) & 1) * ATT_TILE + koff;
        LAS const unsigned char* Vc = lds + (t & 1) * ATT_TILE + voff;
        f32x16 n0 = negm, n1 = negm;
        if (doP) {
            if constexpr (DIL) {
                const int P0 = 64 * t + kofs;
                const bool full = (P0 >= pq0 - 33) && (P0 + 63 <= pq0 + 64) && (P0 >= 0) && (P0 + 63 < L);
                if (!full) {
                    const int lo = max(pq - 64, 0) - P0 - 8 * hi, span = min(pq + 64, L - 1) - max(pq - 64, 0);
#pragma unroll
                    for (int r = 0; r < 16; ++r) {
                        const int i0 = 16 * (r >> 3) + (r & 7);
                        c0[r] = ((unsigned)(i0 - lo) <= (unsigned)span) ? c0[r] : -INFINITY;
                        c1[r] = ((unsigned)(i0 + 32 - lo) <= (unsigned)span) ? c1[r] : -INFINITY;
                    }
                }
            }
            float ma = fmaxf(fmaxf(c0[0], c0[1]), c1[0]), mb = fmaxf(fmaxf(c0[2], c0[3]), c1[1]);
            ma = fmaxf(fmaxf(ma, c1[2]), c1[3]);
#pragma unroll
            for (int r = 4; r < 16; r += 4) { ma = fmaxf(fmaxf(ma, c0[r]), c0[r + 1]); mb = fmaxf(fmaxf(mb, c0[r + 2]), c0[r + 3]); ma = fmaxf(fmaxf(ma, c1[r]), c1[r + 1]); mb = fmaxf(fmaxf(mb, c1[r + 2]), c1[r + 3]); }
            float rm = fmaxf(ma, mb);
            { auto rr = __builtin_amdgcn_permlane32_swap(__float_as_uint(rm), __float_as_uint(rm), false, false); rm = fmaxf(__uint_as_float(rr[0]), __uint_as_float(rr[1])); }
            const float dl = (rm > -1e30f && (!started || rm > 8.f)) ? rm : 0.f;
            started = started || (rm > -1e30f);
            const bool resc = __any(dl != 0.f);
            if (resc) {
                mref += dl;
#pragma unroll
                for (int r = 0; r < 16; ++r) { c0[r] -= dl; c1[r] -= dl; }
#pragma unroll
                for (int r = 0; r < 16; ++r) negm[r] = -mref;
                const float f = fast_exp2(-fmaxf(dl, 0.f)); lrun *= f;
                if (hi == 0) wsc[r32] = f;
                n0 = negm; n1 = negm;
            }
            float ps0 = 0.f, ps1 = 0.f;
            u32x4 pw0, pw1, pw2, pw3;
#define ATT_EXPU(u) do { c0[u] = fast_exp2(c0[u]); c1[u] = fast_exp2(c1[u]); ps0 += c0[u]; ps1 += c1[u]; } while (0)
#define ATT_PK(u) do { const unsigned x0_ = cvt_pk_bf16(c0[u - 1], c0[u]), x1_ = cvt_pk_bf16(c1[u - 1], c1[u]); \
            if ((u) < 8) { pw0[((u) >> 1) & 3] = x0_; pw2[((u) >> 1) & 3] = x1_; } else { pw1[((u) >> 1) & 3] = x0_; pw3[((u) >> 1) & 3] = x1_; } } while (0)
            if (doS) {
                bf16x8 a0 = *(LAS const bf16x8*)(Kn), a1 = *(LAS const bf16x8*)(Kn + 32 * KS);
#pragma unroll
                for (int ks = 0; ks < NKS; ++ks) {
                    bf16x8 b0 = a0, b1 = a1;
                    if (ks + 1 < NKS) { b0 = *(LAS const bf16x8*)(Kn + (ks + 1) * 32); b1 = *(LAS const bf16x8*)(Kn + 32 * KS + (ks + 1) * 32); }
                    n0 = __builtin_amdgcn_mfma_f32_32x32x16_bf16(a0, qf[ks], n0, 0, 0, 0);
                    n1 = __builtin_amdgcn_mfma_f32_32x32x16_bf16(a1, qf[ks], n1, 0, 0, 0);
                    a0 = b0; a1 = b1;
                    const int u_lo = (16 * ks) / NKS, u_hi = (16 * (ks + 1)) / NKS;
#pragma unroll
                    for (int u = u_lo; u < u_hi; ++u) { ATT_EXPU(u); if (u & 1) ATT_PK(u); }
                    ATT_SB();
                }
            } else {
#pragma unroll
                for (int u = 0; u < 16; ++u) { ATT_EXPU(u); if (u & 1) ATT_PK(u); }
            }
            lrun += ps0 + ps1;
            if (resc) {
#pragma unroll
                for (int g = 0; g < 4; ++g) {
                    const f32x4 av = *(LAS const f32x4*)(wsc + 8 * g + 4 * hi);
#pragma unroll
                    for (int e = 0; e < 4; ++e) { o0[4 * g + e] *= av[e]; o1[4 * g + e] *= av[e]; }
                }
            }
            {
                s16x4 va = vtr(Vc), vb = vtr(Vc + 4 * ATT_VS), vc = vtr(Vc + 64), vd = vtr(Vc + 64 + 4 * ATT_VS);
#pragma unroll
                for (int j = 0; j < 4; ++j) {
                    const bf16x8 pa = __builtin_bit_cast(bf16x8, j == 0 ? pw0 : (j == 1 ? pw1 : (j == 2 ? pw2 : pw3)));
                    const bf16x8 vf0 = (bf16x8){va[0], va[1], va[2], va[3], vb[0], vb[1], vb[2], vb[3]};
                    const bf16x8 vf1 = (bf16x8){vc[0], vc[1], vc[2], vc[3], vd[0], vd[1], vd[2], vd[3]};
                    if (j + 1 < 4) { LAS const unsigned char* vp = Vc + (j + 1) * 16 * ATT_VS; va = vtr(vp); vb = vtr(vp + 4 * ATT_VS); vc = vtr(vp + 64); vd = vtr(vp + 64 + 4 * ATT_VS); }
                    o0 = __builtin_amdgcn_mfma_f32_32x32x16_bf16(pa, vf0, o0, 0, 0, 0);
                    o1 = __builtin_amdgcn_mfma_f32_32x32x16_bf16(pa, vf1, o1, 0, 0, 0);
                }
            }
        } else if (doS) {
#pragma unroll
            for (int ks = 0; ks < NKS; ++ks) {
                const bf16x8 a0 = *(LAS const bf16x8*)(Kn + ks * 32), a1 = *(LAS const bf16x8*)(Kn + 32 * KS + ks * 32);
                n0 = __builtin_amdgcn_mfma_f32_32x32x16_bf16(a0, qf[ks], n0, 0, 0, 0); n1 = __builtin_amdgcn_mfma_f32_32x32x16_bf16(a1, qf[ks], n1, 0, 0, 0);
            }
        }
        c0 = n0; c1 = n1;
        ATT_LSTOREK(t & 1, gkB, grB);
        ATT_LSTOREV((t + 1) & 1, gvB);
        __syncthreads();
          }
      { const int t = t2 + 1;
        ATT_GLOADK(min(t + 3, ntiles - 1), gkB, grB);
        ATT_GLOADV(min(t + 2, ntiles - 1), gvB);
        const bool doP = (t >= tlo) && (t < thi), doS = (t + 1 >= tlo) && (t + 1 < thi);
        LAS const unsigned char* Kn = lds + ((t + 1) & 1) * ATT_TILE + koff;
        LAS const unsigned char* Vc = lds + (t & 1) * ATT_TILE + voff;
        f32x16 n0 = negm, n1 = negm;
        if (doP) {
            if constexpr (DIL) {
                const int P0 = 64 * t + kofs;
                const bool full = (P0 >= pq0 - 33) && (P0 + 63 <= pq0 + 64) && (P0 >= 0) && (P0 + 63 < L);
                if (!full) {
                    const int lo = max(pq - 64, 0) - P0 - 8 * hi, span = min(pq + 64, L - 1) - max(pq - 64, 0);
#pragma unroll
                    for (int r = 0; r < 16; ++r) {
                        const int i0 = 16 * (r >> 3) + (r & 7);
                        c0[r] = ((unsigned)(i0 - lo) <= (unsigned)span) ? c0[r] : -INFINITY;
                        c1[r] = ((unsigned)(i0 + 32 - lo) <= (unsigned)span) ? c1[r] : -INFINITY;
                    }
                }
            }
            float ma = fmaxf(fmaxf(c0[0], c0[1]), c1[0]), mb = fmaxf(fmaxf(c0[2], c0[3]), c1[1]);
            ma = fmaxf(fmaxf(ma, c1[2]), c1[3]);
#pragma unroll
            for (int r = 4; r < 16; r += 4) { ma = fmaxf(fmaxf(ma, c0[r]), c0[r + 1]); mb = fmaxf(fmaxf(mb, c0[r + 2]), c0[r + 3]); ma = fmaxf(fmaxf(ma, c1[r]), c1[r + 1]); mb = fmaxf(fmaxf(mb, c1[r + 2]), c1[r + 3]); }
            float rm = fmaxf(ma, mb);
            { auto rr = __builtin_amdgcn_permlane32_swap(__float_as_uint(rm), __float_as_uint(rm), false, false); rm = fmaxf(__uint_as_float(rr[0]), __uint_as_float(rr[1])); }
            const float dl = (rm > -1e30f && (!started || rm > 8.f)) ? rm : 0.f;
            started = started || (rm > -1e30f);
            const bool resc = __any(dl != 0.f);
            if (resc) {
                mref += dl;
#pragma unroll
                for (int r = 0; r < 16; ++r) { c0[r] -= dl; c1[r] -= dl; }
#pragma unroll
                for (int r = 0; r < 16; ++r) negm[r] = -mref;
                const float f = fast_exp2(-fmaxf(dl, 0.f)); lrun *= f;
                if (hi == 0) wsc[r32] = f;
                n0 = negm; n1 = negm;
            }
            float ps0 = 0.f, ps1 = 0.f;
            u32x4 pw0, pw1, pw2, pw3;
#define ATT_EXPU(u) do { c0[u] = fast_exp2(c0[u]); c1[u] = fast_exp2(c1[u]); ps0 += c0[u]; ps1 += c1[u]; } while (0)
#define ATT_PK(u) do { const unsigned x0_ = cvt_pk_bf16(c0[u - 1], c0[u]), x1_ = cvt_pk_bf16(c1[u - 1], c1[u]); \
            if ((u) < 8) { pw0[((u) >> 1) & 3] = x0_; pw2[((u) >> 1) & 3] = x1_; } else { pw1[((u) >> 1) & 3] = x0_; pw3[((u) >> 1) & 3] = x1_; } } while (0)
            if (doS) {
                bf16x8 a0 = *(LAS const bf16x8*)(Kn), a1 = *(LAS const bf16x8*)(Kn + 32 * KS);
#pragma unroll
                for (int ks = 0; ks < NKS; ++ks) {
                    bf16x8 b0 = a0, b1 = a1;
                    if (ks + 1 < NKS) { b0 = *(LAS const bf16x8*)(Kn + (ks + 1) * 32); b1 = *(LAS const bf16x8*)(Kn + 32 * KS + (ks + 1) * 32); }
                    n0 = __builtin_amdgcn_mfma_f32_32x32x16_bf16(a0, qf[ks], n0, 0, 0, 0);
                    n1 = __builtin_amdgcn_mfma_f32_32x32x16_bf16(a1, qf[ks], n1, 0, 0, 0);
                    a0 = b0; a1 = b1;
                    const int u_lo = (16 * ks) / NKS, u_hi = (16 * (ks + 1)) / NKS;
#pragma unroll
                    for (int u = u_lo; u < u_hi; ++u) { ATT_EXPU(u); if (u & 1) ATT_PK(u); }
                    ATT_SB();
                }
            } else {
#pragma unroll
                for (int u = 0; u < 16; ++u) { ATT_EXPU(u); if (u & 1) ATT_PK(u); }
            }
            lrun += ps0 + ps1;
            if (resc) {
#pragma unroll
                for (int g = 0; g < 4; ++g) {
                    const f32x4 av = *(LAS const f32x4*)(wsc + 8 * g + 4 * hi);
#pragma unroll
                    for (int e = 0; e < 4; ++e) { o0[4 * g + e] *= av[e]; o1[4 * g + e] *= av[e]; }
                }
            }
            {
                s16x4 va = vtr(Vc), vb = vtr(Vc + 4 * ATT_VS), vc = vtr(Vc + 64), vd = vtr(Vc + 64 + 4 * ATT_VS);
#pragma unroll
                for (int j = 0; j < 4; ++j) {
                    const bf16x8 pa = __builtin_bit_cast(bf16x8, j == 0 ? pw0 : (j == 1 ? pw1 : (j == 2 ? pw2 : pw3)));
                    const bf16x8 vf0 = (bf16x8){va[0], va[1], va[2], va[3], vb[0], vb[1], vb[2], vb[3]};
                    const bf16x8 vf1 = (bf16x8){vc[0], vc[1], vc[2], vc[3], vd[0], vd[1], vd[2], vd[3]};
                    if (j + 1 < 4) { LAS const unsigned char* vp = Vc + (j + 1) * 16 * ATT_VS; va = vtr(vp); vb = vtr(vp + 4 * ATT_VS); vc = vtr(vp + 64); vd = vtr(vp + 64 + 4 * ATT_VS); }
                    o0 = __builtin_amdgcn_mfma_f32_32x32x16_bf16(pa, vf0, o0, 0, 0, 0);
                    o1 = __builtin_amdgcn_mfma_f32_32x32x16_bf16(pa, vf1, o1, 0, 0, 0);
                }
            }
        } else if (doS) {
#pragma unroll
            for (int ks = 0; ks < NKS; ++ks) {
                const bf16x8 a0 = *(LAS const bf16x8*)(Kn + ks * 32), a1 = *(LAS const bf16x8*)(Kn + 32 * KS + ks * 32);
                n0 = __builtin_amdgcn_mfma_f32_32x32x16_bf16(a0, qf[ks], n0, 0, 0, 0); n1 = __builtin_amdgcn_mfma_f32_32x32x16_bf16(a1, qf[ks], n1, 0, 0, 0);
            }
        }
        c0 = n0; c1 = n1;
        ATT_LSTOREK(t & 1, gkA, grA);
        ATT_LSTOREV((t + 1) & 1, gvA);
        __syncthreads();
          }
    }
    float ltot;
    { auto rr = __builtin_amdgcn_permlane32_swap(__float_as_uint(lrun), __float_as_uint(lrun), false, false); ltot = __uint_as_float(rr[0]) + __uint_as_float(rr[1]); }
    if (hi == 0) wsc[r32] = fast_rcp(ltot);
    LAS bf16_t* stg = (LAS bf16_t*)(lds + ATT_OST + wid * 4096);
#pragma unroll
    for (int g = 0; g < 4; ++g) {
        const f32x4 iv = *(LAS const f32x4*)(wsc + 8 * g + 4 * hi);
#pragma unroll
        for (int e = 0; e < 4; ++e) {
            const int r = 4 * g + e, orow = crow(r, hi);
            stg[orow * 64 + r32] = (bf16_t)(cvt_pk_bf16(o0[r] * iv[e], 0.f) & 0xffffu);
            stg[orow * 64 + 32 + r32] = (bf16_t)(cvt_pk_bf16(o1[r] * iv[e], 0.f) & 0xffffu);
        }
    }
#pragma unroll
    for (int it = 0; it < 4; ++it) {
        const int row = it * 8 + (lane >> 3), ch = lane & 7;
        const u32x4 v = *(LAS const u32x4*)(stg + row * 64 + ch * 8);
        if constexpr (DIL) { const size_t tok = kb + (size_t)(pq0 + row) * dil + res; *(u32x4*)(io.OD + (size_t)br * NT * 512 + tok * 512 + h * 64 + ch * 8) = v; }
        else *(u32x4*)(io.OMIX + (kb + pq0 + row) * 1024 + h * 64 + ch * 8) = v;
    }
    if constexpr (DIL) { if (hi == 0) { const size_t tok = kb + (size_t)pq * dil + res; io.LSE[((size_t)br * NT + tok) * 8 + h] = mref + __builtin_amdgcn_logf(ltot); } }
}
#undef ATT_TOK
#undef ATT_GLOADK
#undef ATT_GLOADV
#undef ATT_LSTOREK
#undef ATT_LSTOREV
#undef ATT_SB
#undef ATT_EXPU
#undef ATT_PK

constexpr int DIL_RS = 144;
constexpr int DIL_K = 0, DIL_V = 384 * DIL_RS, DIL_OST = 2 * 384 * DIL_RS, DIL_WSC = DIL_OST + NWAVES * 4096, DIL_LDS = DIL_WSC + NWAVES * 256;
struct DilUnit { int b, h, br, dil, L, resu, q0, nrows; };
__device__ __forceinline__ DilUnit dil_decode(int unit) {
    DilUnit d; const int bh = unit / 24, k = unit % 24, j = k & 7; d.br = k >> 3; d.b = bh >> 3; d.h = bh & 7;
    if (d.br == 0) { d.dil = 1; d.L = 2048; d.resu = 0; d.q0 = 256 * j; d.nrows = 384; }
    else if (d.br == 1) { d.dil = 4; d.L = 512; d.resu = j >> 1; d.q0 = 256 * (j & 1); d.nrows = 384; }
    else { d.dil = 16; d.L = 128; d.resu = 2 * j; d.q0 = 0; d.nrows = 256; }
    return d;
}
__device__ __forceinline__ size_t dil_tok(const DilUnit& d, int s) {
    const size_t kb = (size_t)d.b * SEQ;
    if (d.br < 2) { int p = d.q0 - 64 + s; p = p < 0 ? 0 : (p > d.L - 1 ? d.L - 1 : p); return kb + (size_t)p * d.dil + d.resu; }
    return kb + (size_t)(s & 127) * 16 + (size_t)(d.resu + (s >> 7));
}
__device__ __forceinline__ void dil_phase(LAS unsigned char* lds, const AttnIO& io, int bx, int G) {
    int tid_ = threadIdx.x; asm volatile("" : "+v"(tid_));
    const int tid = tid_, lane = tid & 63, wid = __builtin_amdgcn_readfirstlane(tid >> 6), r32 = lane & 31, hi = lane >> 5;
    const int lrow = tid >> 3, lch = tid & 7;
    const int krow = (r32 & 19) | ((r32 & 4) << 1) | ((r32 & 8) >> 1);
    const int i16 = lane & 15, g16 = lane >> 4;
    const int voff = DIL_V + (8 * hi + (i16 >> 2)) * DIL_RS + (16 * (g16 & 1) + 4 * (i16 & 3)) * 2;
    LAS float* wsc = (LAS float*)(lds + DIL_WSC + wid * 256);
    LAS bf16_t* stg = (LAS bf16_t*)(lds + DIL_OST + wid * 4096);
    constexpr int NUNITS = 256 * 24;
    u32x4 gk[6], gv[6]; bf16x8 qn[4];
#define DIL_WAVE(d, TLO, NTW, KOFS, PQ, RES) \
    int TLO, NTW, KOFS, PQ, RES; \
    if ((d).br < 2) { TLO = wid >> 1; NTW = 3; KOFS = (d).q0 - 64; PQ = (d).q0 + wid * 32 + r32; RES = (d).resu; } \
    else { const int hw_ = wid >> 2; TLO = 2 * hw_; NTW = 2; KOFS = -128 * hw_; PQ = (wid & 3) * 32 + r32; RES = (d).resu + hw_; }
#define DIL_PREFETCH(unit) do { \
        const DilUnit d_ = dil_decode(unit); \
        _Pragma("unroll") for (int i = 0; i < 6; ++i) { const int row_ = lrow + 64 * i; \
            if (row_ < d_.nrows) { const size_t tok_ = dil_tok(d_, row_); gk[i] = *(const u32x4*)(io.KD + tok_ * 512 + d_.h * 64 + lch * 8); gv[i] = *(const u32x4*)(io.VD + tok_ * 512 + d_.h * 64 + lch * 8); } } \
        DIL_WAVE(d_, tlo_, ntw_, kofs_, pq_, res_) (void)tlo_; (void)ntw_; (void)kofs_; \
        const bf16_t* qp_ = io.QD + ((size_t)d_.b * SEQ + (size_t)pq_ * d_.dil + res_) * 512 + d_.h * 64; \
        _Pragma("unroll") for (int ks = 0; ks < 4; ++ks) qn[ks] = *(const bf16x8*)(qp_ + ks * 16 + hi * 8); \
    } while (0)
    int unit = bx;
    if (unit < NUNITS) DIL_PREFETCH(unit);
    for (; unit < NUNITS; unit += G) {
        const DilUnit d = dil_decode(unit);
#pragma unroll
        for (int i = 0; i < 6; ++i) { const int row = lrow + 64 * i;
            if (row < d.nrows) { *(LAS u32x4*)(lds + DIL_K + row * DIL_RS + lch * 16) = gk[i]; *(LAS u32x4*)(lds + DIL_V + row * DIL_RS + lch * 16) = gv[i]; } }
        bf16x8 qf[4];
#pragma unroll
        for (int ks = 0; ks < 4; ++ks) qf[ks] = qn[ks];
        __syncthreads();
        if (unit + G < NUNITS) DIL_PREFETCH(unit + G);
        DIL_WAVE(d, tlo, ntw, kofs, pq, res)
        (void)tlo; (void)ntw; (void)kofs;
        const int pq0 = pq - r32;
        const int srow0 = (d.br < 2) ? (pq0 - d.q0) : (128 * (wid >> 2) + pq0 - 64);
        f32x16 sc[5];
#pragma unroll
        for (int i = 0; i < 5; ++i) {
            const int P0 = pq0 - 64 + 32 * i;
            if (P0 >= 0 && P0 < d.L) {
                LAS const unsigned char* Kb = lds + DIL_K + (srow0 + 32 * i + krow) * DIL_RS + hi * 16;
                f32x16 acc = {};
#pragma unroll
                for (int ks = 0; ks < 4; ++ks) acc = __builtin_amdgcn_mfma_f32_32x32x16_bf16(*(LAS const bf16x8*)(Kb + ks * 32), qf[ks], acc, 0, 0, 0);
                if (i == 0 || i == 4) {
                    const int dd = r32 - 8 * hi;
#pragma unroll
                    for (int r = 0; r < 16; ++r) { const int cr = 16 * (r >> 3) + (r & 7); const bool ok = (i == 0) ? (cr >= dd) : (cr <= dd); acc[r] = ok ? acc[r] : -INFINITY; }
                }
                sc[i] = acc;
            } else {
#pragma unroll
                for (int r = 0; r < 16; ++r) sc[i][r] = -INFINITY;
            }
        }
        float mx = sc[2][0];
#pragma unroll
        for (int i = 0; i < 5; ++i)
#pragma unroll
            for (int r = 0; r < 16; r += 2) mx = fmaxf(fmaxf(mx, sc[i][r]), sc[i][r + 1]);
        { auto rr = __builtin_amdgcn_permlane32_swap(__float_as_uint(mx), __float_as_uint(mx), false, false); mx = fmaxf(__uint_as_float(rr[0]), __uint_as_float(rr[1])); }
        const float mrun = mx;
        float lrun = 0.f;
        f32x16 o0 = {}, o1 = {};
#pragma unroll
        for (int i = 0; i < 5; ++i) {
            const int P0 = pq0 - 64 + 32 * i;
            if (P0 >= 0 && P0 < d.L) {
                float ps = 0.f;
#pragma unroll
                for (int r = 0; r < 16; ++r) { sc[i][r] = fast_exp2(sc[i][r] - mrun); ps += sc[i][r]; }
                lrun += ps;
                const bf16x8 pa0 = pack8(sc[i], 0), pa1 = pack8(sc[i], 8);
                LAS const unsigned char* Vb = lds + voff + (srow0 + 32 * i) * DIL_RS;
#pragma unroll
                for (int j = 0; j < 2; ++j) {
                    LAS const unsigned char* vp = Vb + j * 16 * DIL_RS;
                    const s16x4 a = vtr(vp), bq = vtr(vp + 4 * DIL_RS), c = vtr(vp + 64), dq = vtr(vp + 64 + 4 * DIL_RS);
                    const bf16x8 vf0 = (bf16x8){a[0], a[1], a[2], a[3], bq[0], bq[1], bq[2], bq[3]};
                    const bf16x8 vf1 = (bf16x8){c[0], c[1], c[2], c[3], dq[0], dq[1], dq[2], dq[3]};
                    o0 = __builtin_amdgcn_mfma_f32_32x32x16_bf16(j == 0 ? pa0 : pa1, vf0, o0, 0, 0, 0);
                    o1 = __builtin_amdgcn_mfma_f32_32x32x16_bf16(j == 0 ? pa0 : pa1, vf1, o1, 0, 0, 0);
                }
            }
        }
        float ltot;
        { auto rr = __builtin_amdgcn_permlane32_swap(__float_as_uint(lrun), __float_as_uint(lrun), false, false); ltot = __uint_as_float(rr[0]) + __uint_as_float(rr[1]); }
        if (hi == 0) wsc[r32] = fast_rcp(ltot);
#pragma unroll
        for (int g = 0; g < 4; ++g) {
            const f32x4 iv = *(LAS const f32x4*)(wsc + 8 * g + 4 * hi);
#pragma unroll
            for (int e = 0; e < 4; ++e) {
                const int r = 4 * g + e, orow = crow(r, hi);
                stg[orow * 64 + r32] = (bf16_t)(cvt_pk_bf16(o0[r] * iv[e], 0.f) & 0xffffu);
                stg[orow * 64 + 32 + r32] = (bf16_t)(cvt_pk_bf16(o1[r] * iv[e], 0.f) & 0xffffu);
            }
        }
        const size_t kb = (size_t)d.b * SEQ;
#pragma unroll
        for (int it = 0; it < 4; ++it) {
            const int row = it * 8 + (lane >> 3), ch = lane & 7;
            const u32x4 v = *(LAS const u32x4*)(stg + row * 64 + ch * 8);
            const size_t tok = kb + (size_t)(pq0 + row) * d.dil + res;
            *(u32x4*)(io.OD + (size_t)d.br * NT * 512 + tok * 512 + d.h * 64 + ch * 8) = v;
        }
        if (hi == 0) { const size_t tok = kb + (size_t)pq * d.dil + res; io.LSE[((size_t)d.br * NT + tok) * 8 + d.h] = mrun + __builtin_amdgcn_logf(ltot); }
        __syncthreads();
    }
#undef DIL_WAVE
#undef DIL_PREFETCH
}

__device__ __forceinline__ float wave_sum(float v) {
#pragma unroll
    for (int o = 1; o < 64; o <<= 1) v += __shfl_xor(v, o);
    return v;
}
__device__ __forceinline__ void tr_block(const float* W, int K, int N, const float* gain, bf16_t* WT, int k0, int n0, int dst_row0, LAS float* scr, int lane) {
#pragma unroll 8
    for (int i = 0; i < 32; ++i) {
        const int kk = 2 * i + (lane >> 5);
        float v = W[(size_t)(k0 + kk) * N + n0 + (lane & 31)];
        if (gain) v *= gain[k0 + kk];
        scr[kk * 33 + (lane & 31)] = v;
    }
    asm volatile("s_waitcnt lgkmcnt(0)" ::: "memory");
    const int c = lane & 7;
#pragma unroll
    for (int j = 0; j < 4; ++j) {
        const int n = (lane >> 3) + 8 * j; const LAS float* s = scr + (8 * c) * 33 + n;
        u32x4 o; o.x = cvt_pk_bf16(s[0 * 33], s[1 * 33]); o.y = cvt_pk_bf16(s[2 * 33], s[3 * 33]); o.z = cvt_pk_bf16(s[4 * 33], s[5 * 33]); o.w = cvt_pk_bf16(s[6 * 33], s[7 * 33]);
        *(u32x4*)(WT + (size_t)(dst_row0 + n) * K + k0 + 8 * c) = o;
    }
    asm volatile("s_waitcnt lgkmcnt(0)" ::: "memory");
}

__device__ __forceinline__ void tr_block64(const float* W, int K, int N, const float* gain, bf16_t* WT, int k0, int n0, int dst_row0, LAS float* scr, int lane) {
    const int kk = lane >> 4, n4 = lane & 15;
    f32x4 v[16];
#pragma unroll
    for (int i = 0; i < 16; ++i) v[i] = *(const f32x4*)(W + (size_t)(k0 + 4 * i + kk) * N + n0 + 4 * n4);
#pragma unroll
    for (int i = 0; i < 16; ++i) {
        const float g = gain ? gain[k0 + 4 * i + kk] : 1.0f;
        LAS float* d = scr + (4 * i + kk) * 65 + 4 * n4;
        d[0] = v[i][0] * g; d[1] = v[i][1] * g; d[2] = v[i][2] * g; d[3] = v[i][3] * g;
    }
    asm volatile("s_waitcnt lgkmcnt(0)" ::: "memory");
    const int c = lane & 7;
#pragma unroll
    for (int it = 0; it < 8; ++it) {
        const int n = it * 8 + (lane >> 3); const LAS float* s = scr + (8 * c) * 65 + n;
        u32x4 o; o.x = cvt_pk_bf16(s[0 * 65], s[1 * 65]); o.y = cvt_pk_bf16(s[2 * 65], s[3 * 65]); o.z = cvt_pk_bf16(s[4 * 65], s[5 * 65]); o.w = cvt_pk_bf16(s[6 * 65], s[7 * 65]);
        *(u32x4*)(WT + (size_t)(dst_row0 + n) * K + k0 + 8 * c) = o;
    }
    asm volatile("s_waitcnt lgkmcnt(0)" ::: "memory");
}

#define XB_TMO      128
#define XB_XCNT(j)  (256  + 64 * (j))
#define XB_XSUB(j)  (1280 + 64 * (j))
#define XB_XGEN(j)  (2304 + 64 * (j))
#define XB_TOP      3328
#define XB_TOPGEN   3392
#define XCD_BAR_WORDS 3456
#define XB_SPIN_CAP (1u << 18)

__device__ __forceinline__ unsigned xb_ld(unsigned* p)              { return __hip_atomic_load(p, __ATOMIC_RELAXED, __HIP_MEMORY_SCOPE_AGENT); }
__device__ __forceinline__ unsigned xb_add(unsigned* p, unsigned v) { return __hip_atomic_fetch_add(p, v, __ATOMIC_RELAXED, __HIP_MEMORY_SCOPE_AGENT); }
__device__ __forceinline__ unsigned xb_xcc_id() { return (unsigned)__builtin_amdgcn_s_getreg((3 << 11) | 20) & 0xFu; }
#define XB_SPIN(cond, bar) do { unsigned _sp = 0; while (cond) { __builtin_amdgcn_s_sleep(1); \
    if ((++_sp & 255u) == 0u) { if (xb_ld(&(bar)[XB_TMO])) break; if (_sp > XB_SPIN_CAP) { atomicAdd(&(bar)[XB_TMO], 1u); break; } } } } while (0)

struct XcdBarrier {
    unsigned* bar; unsigned x;
    volatile LAS unsigned* st;
};

__device__ __forceinline__ XcdBarrier xcd_barrier_post(unsigned* bar, volatile LAS unsigned* st) {
    XcdBarrier b; b.bar = bar; b.x = xb_xcc_id(); b.st = st;
    if (threadIdx.x == 0) (void)xb_add(&bar[XB_XCNT(b.x)], 1u);
    return b;
}
__device__ __forceinline__ void xcd_barrier_complete(unsigned* bar, unsigned x, unsigned& nloc, unsigned& nx) {
    const unsigned G = gridDim.x * gridDim.y * gridDim.z;
    unsigned sum, cnt, mine, sp = 0u;
    for (;;) {
        sum = 0u; cnt = 0u; mine = 0u;
#pragma unroll
        for (unsigned j = 0; j < 16; ++j) { const unsigned c = xb_ld(&bar[XB_XCNT(j)]); sum += c; cnt += (c > 0u) ? 1u : 0u; mine = (j == x) ? c : mine; }
        if (sum == G) break;
        __builtin_amdgcn_s_sleep(1);
        if ((++sp & 255u) == 0u) { if (xb_ld(&bar[XB_TMO])) break; if (sp > XB_SPIN_CAP) { atomicAdd(&bar[XB_TMO], 1u); break; } }
    }
    nloc = mine > 0u ? mine : 1u; nx = cnt > 0u ? cnt : 1u;
}

__device__ __forceinline__ void xcd_barrier(const XcdBarrier& b) {
    asm volatile("s_waitcnt vmcnt(0)" ::: "memory");
    __syncthreads();
    if (threadIdx.x == 0) {
        unsigned* bar = b.bar;
        __builtin_amdgcn_s_waitcnt(0);
        unsigned nloc = b.st[0], nx = b.st[1];
        if (nloc == 0u) { xcd_barrier_complete(bar, b.x, nloc, nx); b.st[0] = nloc; b.st[1] = nx; }
        const unsigned old = xb_add(&bar[XB_XSUB(b.x)], 1u);
        const unsigned gen = old / nloc;
        if (old + 1u == (gen + 1u) * nloc) {
            __builtin_amdgcn_fence(__ATOMIC_RELEASE, "agent");
            asm volatile("s_waitcnt vmcnt(0)" ::: "memory");
            const unsigned og = xb_add(&bar[XB_TOP], 1u);
            const unsigned tg = og / nx;
            if (og + 1u == (tg + 1u) * nx) xb_add(&bar[XB_TOPGEN], 1u);
            else XB_SPIN(xb_ld(&bar[XB_TOPGEN]) == tg, bar);
            __builtin_amdgcn_fence(__ATOMIC_ACQUIRE, "agent");
            xb_add(&bar[XB_XGEN(b.x)], 1u);
            asm volatile("s_waitcnt vmcnt(0)" ::: "memory");
        } else {
            XB_SPIN(xb_ld(&bar[XB_XGEN(b.x)]) == gen, bar);
            __builtin_amdgcn_fence(__ATOMIC_ACQUIRE, "agent");
            asm volatile("s_waitcnt vmcnt(0)" ::: "memory");
        }
    }
    __syncthreads();
}

struct Args {
    const float* in[19]; float* out; unsigned char* ws;
};

__global__ void __launch_bounds__(NWAVES * 64) mk_fwd(Args a) {
    extern __shared__ __attribute__((aligned(16))) unsigned char lds_raw[];
    LAS unsigned char* lds = (LAS unsigned char*)lds_raw;
    cg::grid_group grid = cg::this_grid();
    const int tid = threadIdx.x, lane = tid & 63, wave = __builtin_amdgcn_readfirstlane(tid >> 6);
    const int G = gridDim.x, bx = blockIdx.x;
    const int gw = bx * NWAVES + wave, NGW = G * NWAVES;
    unsigned char* ws = a.ws;
    const float* x = a.in[0];
    const float *g_ffn1 = a.in[1], *w1g = a.in[2], *w1u = a.in[3], *w1d = a.in[4], *g_mix = a.in[5], *w_in = a.in[6], *g_q = a.in[7], *w_uq = a.in[8], *g_kv = a.in[9], *w_ukv = a.in[10],
                *g_mo = a.in[11], *g_do = a.in[12], *w_out = a.in[13], *g_ffn2 = a.in[14], *w2g = a.in[15], *w2u = a.in[16], *w2d = a.in[17], *g_fin = a.in[18];
    float* X = a.out;
    bf16_t *W1GU = (bf16_t*)(ws + WS_W1GU), *W1D = (bf16_t*)(ws + WS_W1D), *W2GU = (bf16_t*)(ws + WS_W2GU), *W2D = (bf16_t*)(ws + WS_W2D), *WIN = (bf16_t*)(ws + WS_WIN),
           *WUQ = (bf16_t*)(ws + WS_WUQ), *WUKV = (bf16_t*)(ws + WS_WUKV), *WOUT = (bf16_t*)(ws + WS_WOUT);
    float *COSM = (float*)(ws + WS_ROPE), *SINM = COSM + 2048 * 16, *COSP = SINM + 2048 * 16, *SINP = COSP + 2048 * 8;
    float *SS0 = (float*)(ws + WS_SS0), *SS1 = (float*)(ws + WS_SS1), *SS2 = (float*)(ws + WS_SS2), *SS3 = (float*)(ws + WS_SS3), *SSQ = (float*)(ws + WS_SSQ), *SSKV = (float*)(ws + WS_SSKV);
    bf16_t *XB = (bf16_t*)(ws + WS_XB), *KVM = (bf16_t*)a.out, *HB = (bf16_t*)(ws + WS_H), *OD = (bf16_t*)(ws + WS_OD0), *OMIX = (bf16_t*)(ws + WS_OMIX);
    float* LSE = (float*)(ws + WS_LSE);
    bf16_t *QD = (bf16_t*)(ws + WS_QD), *KD = (bf16_t*)(ws + WS_KD), *VD = (bf16_t*)(ws + WS_VD), *CQ = (bf16_t*)(ws + WS_CQ), *CKV = (bf16_t*)(ws + WS_CKV), *KR = (bf16_t*)(ws + WS_KR), *QM = (bf16_t*)(ws + WS_QM);

    volatile LAS unsigned* xb_st = (volatile LAS unsigned*)(lds + DIL_LDS);
    if (tid < 2) xb_st[tid] = 0u;
    unsigned* xb_words = (unsigned*)(ws + WS_BAR);
    unsigned* pan_cnt = xb_words + 4096;
    if (bx == 0) for (int i = tid; i < 4096 + 256 * 64; i += NWAVES * 64) xb_words[i] = 0u;
    {
        LAS float* scr = (LAS float*)(lds + wave * 16640);
        constexpr int J_GU = 16 * 44, J_D = 44 * 16, J_FFN = 2 * J_GU + J_D, J_UQ = 6 * 12, J_UKV = 4 * 16, J_OUT = 16 * 16, I_IN = 16 * 69;
        constexpr int NITEMS = 2 * J_FFN + J_UQ + J_UKV + J_OUT + I_IN;
        for (int it = gw; it < NITEMS; it += NGW) {
            int r = it;
            if (r < 2 * J_FFN) {
                const int f = r / J_FFN; r -= f * J_FFN;
                const float* gg = f ? g_ffn2 : g_ffn1; const float* wg = f ? w2g : w1g; const float* wu = f ? w2u : w1u; const float* wd = f ? w2d : w1d;
                bf16_t* GU = f ? W2GU : W1GU; bf16_t* DD = f ? W2D : W1D;
                if (r < 2 * J_GU) { const int s = r >= J_GU; const int q = s ? r - J_GU : r; const int kb_ = q / 44, nb = q % 44, n0 = 64 * nb;
                    tr_block64(s ? wu : wg, 1024, FF, gg, GU, 64 * kb_, n0, 256 * (n0 >> 7) + 128 * s + (n0 & 127), scr, lane); }
                else { r -= 2 * J_GU; const int kb_ = r / 16, nb = r % 16; tr_block64(wd, FF, 1024, nullptr, DD, 64 * kb_, 64 * nb, 64 * nb, scr, lane); }
                continue;
            }
            r -= 2 * J_FFN;
            if (r < J_UQ) { const int kb_ = r / 12, nb = r % 12; tr_block64(w_uq, 384, 768, g_q, WUQ, 64 * kb_, 64 * nb, 64 * nb, scr, lane); continue; }
            r -= J_UQ;
            if (r < J_UKV) { const int kb_ = r / 16, nb = r % 16; tr_block64(w_ukv, 256, 1024, g_kv, WUKV, 64 * kb_, 64 * nb, 64 * nb, scr, lane); continue; }
            r -= J_UKV;
            if (r < J_OUT) { const int kb_ = r / 16, nb = r % 16, k0 = 64 * kb_; tr_block64(w_out, 1024, 1024, k0 < 512 ? g_mo : g_do - 512, WOUT, k0, 64 * nb, 64 * nb, scr, lane); continue; }
            r -= J_OUT;
            { const int kb_ = r / 69, nb = r % 69, n0 = 32 * nb;
                int dst;
                if (n0 < 384) dst = 1536 + n0; else if (n0 < 640) dst = 2048 + (n0 - 384); else if (n0 < 672) dst = 1920 + (n0 - 640);
                else if (n0 < 1184) dst = n0 - 672; else if (n0 < 1696) dst = 512 + (n0 - 1184); else dst = 1024 + (n0 - 1696);
                tr_block(w_in, 1024, 2208, g_mix, WIN, 64 * kb_, n0, dst, scr, lane); }
        }
        for (int i = bx * 512 + tid; i < 96 * 1024 / 8; i += G * 512) *(u32x4*)(WIN + (size_t)1952 * 1024 + (size_t)i * 8) = (u32x4){0u, 0u, 0u, 0u};
        for (int i = bx * 512 + tid; i < 2048 * 24; i += G * 512) {
            int pos, fi; float invf; float *cdst, *sdst;
            if (i < 2048 * 16) { pos = i >> 4; fi = i & 15; invf = exp2f(-(float)fi * (1.0f / 16.0f) * 18.931568569324174f); cdst = COSM + i; sdst = SINM + i; }
            else { const int k = i - 2048 * 16; pos = k >> 3; fi = k & 7; invf = exp2f(-(float)fi * (1.0f / 8.0f) * 18.931568569324174f); cdst = COSP + k; sdst = SINP + k; }
            const float ang = (float)pos * invf;
            const double rev = (double)ang * 0.15915494309189535; const float fr_ = (float)(rev - floor(rev));
            *cdst = __builtin_amdgcn_cosf(fr_); *sdst = __builtin_amdgcn_sinf(fr_);
        }
        for (int row0 = gw * 4; row0 < NT; row0 += NGW * 4) {
            f32x4 v[4][4];
#pragma unroll
            for (int q = 0; q < 4; ++q) { const f32x4* xr = (const f32x4*)(x + (size_t)(row0 + q) * DM) + lane;
#pragma unroll
                for (int j = 0; j < 4; ++j) v[q][j] = xr[64 * j]; }
#pragma unroll
            for (int q = 0; q < 4; ++q) {
                float sacc = 0.f; unsigned long long* o8 = (unsigned long long*)(XB + (size_t)(row0 + q) * DM) + lane;
#pragma unroll
                for (int j = 0; j < 4; ++j) { sacc += sq4(v[q][j]); o8[64 * j] = (unsigned long long)cvt_pk_bf16(v[q][j][0], v[q][j][1]) | ((unsigned long long)cvt_pk_bf16(v[q][j][2], v[q][j][3]) << 32); }
                sacc = wave_sum(sacc);
                if (lane < 16) SS0[(size_t)(row0 + q) * 16 + lane] = lane == 0 ? sacc : 0.f;
            }
        }
    }
    grid.sync();
    const XcdBarrier xb = xcd_barrier_post(xb_words, xb_st);
    {
        pg8::Gemm g{XB, W1GU, NT, 2 * FF, DM}; pg8::StaticOrder S; S.init(NT, 2 * FF, G, bx);
        rstd4_fill((LAS float*)(lds + 131072), SS0);
        EpiGateUp E{HB, SS0, (LAS float*)(lds + 131072)};
        pg8::gemm_phase<EpiGateUp, pg8::StaticOrder, true, true>(lds, g, S, E);
    }
    xcd_barrier(xb);
    {
        pg8::Gemm g{HB, W1D, NT, DM, FF}; pg8::StaticOrder S; S.init(NT, DM, G, bx);
        EpiResid E{XB, SS1, 0.5f};
        pg8::gemm_phase<EpiResid, pg8::StaticOrder, true, true>(lds, g, S, E);
    }
    xcd_barrier(xb);
    {
        pg8::Gemm g{XB, WIN, NT, 2304, DM}; pg8::StaticOrder S; S.init(NT, 2304, G, bx);
        rstd4_fill((LAS float*)(lds + 131072), SS1);
        EpiInProj E{SS1, QD, KD, VD, CQ, CKV, KR, SSQ, SSKV, COSM, SINM, COSP, SINP, (LAS float*)(lds + 131072)};
        pg8::gemm_phase<EpiInProj, pg8::StaticOrder, true, true>(lds, g, S, E);
    }
    xcd_barrier(xb);
    {
        { pg8::Gemm g{CQ, WUQ, NT, 768, 384}; pg8::StaticOrder S; S.init(NT, 768, G, bx); EpiQ E{SSQ, QM, COSM, SINM, (LAS float*)(lds + 131072)};
          pg8::gemm_phase<EpiQ, pg8::StaticOrder, true, true>(lds, g, S, E); }
        { pg8::Gemm g{CKV, WUKV, NT, 1024, 256}; pg8::StaticOrder S; S.init(NT, 1024, G, bx); EpiKV E{SSKV, KVM, (LAS float*)(lds + 131072)};
          pg8::gemm_phase<EpiKV, pg8::StaticOrder, true, true>(lds, g, S, E); }
        __syncthreads();
        AttnIO io{QM, KVM, KR, OMIX, QD, KD, VD, OD, LSE};
        dil_phase(lds, io, (G % 8 == 0) ? (bx & 7) * (G >> 3) + (bx >> 3) : bx, G);
    }
    xcd_barrier(xb);
    {
        AttnIO io{QM, KVM, KR, OMIX, QD, KD, VD, OD, LSE};
        const int vcu = (G % 8 == 0) ? (bx & 7) * (G >> 3) + (bx >> 3) : bx;
        for (int u = vcu; u < 256 * 8; u += G) attn_unit<false>(lds, io, u);
    }
    xcd_barrier(xb);
    for (int rowb = gw * 4; rowb < NT; rowb += NGW * 4) {
        u32x4 wm[4], wd[4][3]; float ls[4][3];
        const int hd = lane >> 3;
#pragma unroll
        for (int q = 0; q < 4; ++q) {
            const int row = rowb + q;
            wm[q] = *(const u32x4*)(OMIX + (size_t)row * 1024 + lane * 8);
#pragma unroll
            for (int n = 0; n < 3; ++n) { ls[q][n] = LSE[((size_t)n * NT + row) * 8 + hd]; wd[q][n] = *(const u32x4*)(OD + (size_t)n * NT * 512 + (size_t)row * 512 + lane * 8); }
        }
#pragma unroll
        for (int q = 0; q < 4; ++q) {
            const int row = rowb + q;
            {
                float v[8];
#pragma unroll
                for (int e = 0; e < 4; ++e) { v[2 * e] = __uint_as_float(wm[q][e] << 16); v[2 * e + 1] = __uint_as_float(wm[q][e] & 0xffff0000u); }
                float s = 0.f;
#pragma unroll
                for (int e = 0; e < 8; ++e) s += v[e] * v[e];
                const float rs = rsqrtf(wave_sum(s) * (1.0f / 512.0f) + EPS);
                u32x4 o; o.x = cvt_pk_bf16(v[0] * rs, v[1] * rs); o.y = cvt_pk_bf16(v[2] * rs, v[3] * rs); o.z = cvt_pk_bf16(v[4] * rs, v[5] * rs); o.w = cvt_pk_bf16(v[6] * rs, v[7] * rs);
                *(u32x4*)(OMIX + (size_t)row * 1024 + lane * 8) = o;
            }
            {
                const float l0 = ls[q][0], l1 = ls[q][1], l2 = ls[q][2];
                const float mx = fmaxf(l0, fmaxf(l1, l2));
                float w0 = fast_exp2(l0 - mx), w1 = fast_exp2(l1 - mx), w2 = fast_exp2(l2 - mx);
                const float inv = 1.0f / (w0 + w1 + w2); w0 *= inv; w1 *= inv; w2 *= inv;
                float v[8];
#pragma unroll
                for (int e = 0; e < 8; ++e) v[e] = 0.f;
#pragma unroll
                for (int n = 0; n < 3; ++n) {
                    const u32x4 w = wd[q][n]; const float wn = n == 0 ? w0 : (n == 1 ? w1 : w2);
#pragma unroll
                    for (int e = 0; e < 4; ++e) { v[2 * e] += wn * __uint_as_float(w[e] << 16); v[2 * e + 1] += wn * __uint_as_float(w[e] & 0xffff0000u); }
                }
                float s = 0.f;
#pragma unroll
                for (int e = 0; e < 8; ++e) s += v[e] * v[e];
                const float rs = rsqrtf(wave_sum(s) * (1.0f / 512.0f) + EPS);
                u32x4 o; o.x = cvt_pk_bf16(v[0] * rs, v[1] * rs); o.y = cvt_pk_bf16(v[2] * rs, v[3] * rs); o.z = cvt_pk_bf16(v[4] * rs, v[5] * rs); o.w = cvt_pk_bf16(v[6] * rs, v[7] * rs);
                *(u32x4*)(OMIX + (size_t)row * 1024 + 512 + lane * 8) = o;
            }
        }
    }
    xcd_barrier(xb);
    {
        pg8::Gemm g{OMIX, WOUT, NT, DM, DM}; pg8::StaticOrder S; S.init(NT, DM, G, bx);
        EpiResid E{XB, SS2, 1.0f};
        pg8::gemm_phase<EpiResid, pg8::StaticOrder, true, true>(lds, g, S, E);
    }
    xcd_barrier(xb);
    {
        pg8::Gemm g{XB, W2GU, NT, 2 * FF, DM}; pg8::StaticOrder S; S.init(NT, 2 * FF, G, bx);
        rstd4_fill((LAS float*)(lds + 131072), SS2);
        EpiGateUp E{HB, SS2, (LAS float*)(lds + 131072)};
        pg8::gemm_phase<EpiGateUp, pg8::StaticOrder, true, true>(lds, g, S, E);
    }
    xcd_barrier(xb);
    {
        pg8::Gemm g{HB, W2D, NT, DM, FF}; pg8::StaticOrder S; S.init(NT, DM, G, bx);
        EpiFinal E{XB, X, SS3, pan_cnt, g_fin, (LAS float*)(lds + 131072)};
        pg8::gemm_phase<EpiFinal, pg8::StaticOrder, true, true>(lds, g, S, E);
    }
}

extern "C" void kernel_launch(void* const* d_in, const int* in_sizes, int n_in, void* d_out, int out_size, void* d_ws, size_t ws_size, hipStream_t stream) {
    constexpr int LDS_BYTES = 147456; static_assert(DIL_LDS + 64 <= LDS_BYTES, "LDS map");
    static int grid = 0;
    if (grid == 0) {
        if (n_in != 19 || in_sizes[0] != NT * DM || out_size != NT * DM || ws_size < WS_END) {
            fprintf(stderr, "kernel_launch: unexpected problem geometry (n_in %d, in0 %d, out %d, ws %zu); nothing launched\n", n_in, n_in > 0 ? in_sizes[0] : -1, out_size, ws_size); grid = -1; return; }
        int dev = 0, cus = 0, per_cu = 0;
        hipGetDevice(&dev); hipDeviceGetAttribute(&cus, hipDeviceAttributeMultiprocessorCount, dev);
        if (hipFuncSetAttribute((const void*)mk_fwd, hipFuncAttributeMaxDynamicSharedMemorySize, LDS_BYTES) != hipSuccess) { fprintf(stderr, "kernel_launch: hipFuncSetAttribute failed\n"); grid = -1; return; }
        if (hipOccupancyMaxActiveBlocksPerMultiprocessor(&per_cu, (const void*)mk_fwd, NWAVES * 64, LDS_BYTES) != hipSuccess || per_cu < 1) { fprintf(stderr, "kernel_launch: occupancy query says %d blocks per CU\n", per_cu); per_cu = 1; }
        (void)hipGetLastError();
        grid = cus >= 256 ? 256 : cus;
        if (cus != 256) fprintf(stderr, "kernel_launch: built for a 256-CU device, found %d CUs\n", cus);
        (void)0;
    }
    if (grid < 0) return;
    Args a{};
    for (int i = 0; i < 19; ++i) a.in[i] = (const float*)d_in[i];
    a.out = (float*)d_out; a.ws = (unsigned char*)d_ws;
    void* args[] = {&a};
    hipError_t e = hipLaunchCooperativeKernel((const void*)mk_fwd, dim3(grid), dim3(NWAVES * 64), args, LDS_BYTES, stream);
    if (e != hipSuccess) fprintf(stderr, "kernel_launch: cooperative launch failed: %s (grid %d)\n", hipGetErrorString(e), grid);
}
```

```cpp
#include <hip/hip_runtime.h>
#include <hip/hip_cooperative_groups.h>
#include <cmath>
#include <cstdio>
#include <cstdint>
namespace pg8 {
#define PG8_LAS __attribute__((address_space(3)))
typedef unsigned short bf16_t;
typedef short bf16x8 __attribute__((ext_vector_type(8)));
typedef float f32x4 __attribute__((ext_vector_type(4)));
typedef unsigned u32x4 __attribute__((ext_vector_type(4)));
constexpr int BM = 256, BK = 64, HALF = 128, HTB = HALF * BK * 2  , STAGE_BYTES = 8 * HTB, NXCD = 8, WGM = 8;

__host__ __device__ __forceinline__ int lds_byte(int r, int c) { const int st = (r >> 4) * 2 + (c >> 5), rr = r & 15, cc = c & 31, ob = rr * 64 + cc * 2; return st * 1024 + (ob ^ (((ob >> 9) & 1) << 5)); }
__host__ __device__ __forceinline__ void stage_rc(int b, int& R, int& C) { const int st = b / 1024, sb = b % 1024, swz = sb ^ (((sb >> 9) & 1) << 5); R = (st >> 1) * 16 + swz / 64; C = (st & 1) * 32 + (swz % 64) / 2; }
__host__ __device__ __forceinline__ int perm32(int rho) { const int n = rho >> 4, i = rho & 15; return 8 * (i >> 2) + 4 * n + (i & 3); }

struct Unit { int pm, pn; };
struct Gemm { const bf16_t* A; const bf16_t* Bt; int M, N, K; };

struct StaticOrder {
    int nM, nN, nwg, G, c;
    __host__ __device__ void init(int M, int N, int G_, int c_) { nM = M / BM; nN = N / BM; nwg = nM * nN; G = G_; c = c_; }
    __host__ __device__ bool next(int i, Unit& u) const {
        const long L = (long)i * G + c; if (L >= nwg) return false;
        int wgid = (int)L; { const int q = nwg / NXCD, r = nwg % NXCD, xcd = wgid % NXCD, off = wgid / NXCD; wgid = (xcd < r ? xcd * (q + 1) : r * (q + 1) + (xcd - r) * q) + off; }
        const int nig = WGM * nN, gid = wgid / nig, fm = gid * WGM, gsz = (nM - fm) < WGM ? (nM - fm) : WGM;
        u.pm = fm + ((wgid % nig) % gsz); u.pn = (wgid % nig) / gsz; return true;
    }
    __device__ __forceinline__ void a_ready(const Unit&) const {}
    __device__ __forceinline__ void done(const Unit&) const {}
};

__device__ __forceinline__ unsigned cvt_pk_bf16(float lo, float hi) { unsigned r; asm volatile("v_cvt_pk_bf16_f32 %0, %1, %2" : "=v"(r) : "v"(lo), "v"(hi)); return r; }

template <class Epi, class Sched, bool ALIGN_EPI = false, bool SP2 = false>
__device__ __forceinline__ void gemm_phase(PG8_LAS unsigned char* lds, const Gemm g, const Sched& S, const Epi& E) {
    int tid_ = threadIdx.x; asm volatile("" : "+v"(tid_));
    const int tid = tid_, wid = __builtin_amdgcn_readfirstlane(tid >> 6), lane = tid & 63, wr = wid >> 2, wc = wid & 3, fr = lane & 15, fq = lane >> 4;
    const int K = g.K, nt = K / BK;
    unsigned voffA[2], voffB[2];
#pragma unroll
    for (int i = 0; i < 2; ++i) { int R, C; stage_rc(tid * 16 + i * 8192, R, C); const int Rb = Epi::PERM ? ((R & ~31) + perm32(R & 31)) : R;
        voffA[i] = (unsigned)(R * K + C) * 2u; voffB[i] = (unsigned)(Rb * K + C) * 2u; }
    const size_t kstep = (size_t)(BK * 2);
    const size_t hstep = (size_t)HALF * K * 2;
    const size_t tstep = 2 * hstep;
    const unsigned ldsw = (unsigned)wid * 1024u;
    const int aoff = lds_byte(wr * 64 + fr, fq * 8), boff = lds_byte(wc * 32 + fr, fq * 8);
#define PG8_SA(b, h) (((b) * 2 + (h)) * HTB)
#define PG8_SB(b, h) ((4 + (b) * 2 + (h)) * HTB)
#define PG8_STAGE(bufoff, gbase, voff) do { _Pragma("unroll") for (int _i = 0; _i < 2; ++_i) \
        __builtin_amdgcn_global_load_lds((const unsigned*)((const char*)(gbase) + (voff)[_i]), (PG8_LAS unsigned*)(lds + (bufoff) + ldsw + _i * 8192), 16, 0, 0); } while (0)
#define PG8_LDA(dst, b, h) do { _Pragma("unroll") for (int m = 0; m < 4; ++m) _Pragma("unroll") for (int k = 0; k < 2; ++k) dst[m][k] = *(const PG8_LAS bf16x8*)(lds + PG8_SA(b, h) + aoff + m * 2048 + k * 1024); } while (0)
#define PG8_LDB(dst, b, h) do { _Pragma("unroll") for (int n = 0; n < 2; ++n) _Pragma("unroll") for (int k = 0; k < 2; ++k) dst[n][k] = *(const PG8_LAS bf16x8*)(lds + PG8_SB(b, h) + boff + n * 2048 + k * 1024); } while (0)
#define PG8_MMA(ai, bj, At, Bt) do { __builtin_amdgcn_s_setprio(1); _Pragma("unroll") for (int m = 0; m < 4; ++m) _Pragma("unroll") for (int n = 0; n < 2; ++n) _Pragma("unroll") for (int k = 0; k < 2; ++k) \
        acc[ai][bj][m][n] = __builtin_amdgcn_mfma_f32_16x16x32_bf16(Bt[n][k], At[m][k], acc[ai][bj][m][n], 0, 0, 0); __builtin_amdgcn_s_setprio(0); } while (0)
#define PG8_WAIT_V(n) asm volatile("s_waitcnt vmcnt(" #n ")" ::: "memory")
#define PG8_WAIT_L(n) asm volatile("s_waitcnt lgkmcnt(" #n ")" ::: "memory")
#define PG8_BAR __builtin_amdgcn_s_barrier()
#define PG8_SCHED __builtin_amdgcn_sched_barrier(0)
    Unit cur, nxt; int ui = 0;
    if (!S.next(0, cur)) return;
    f32x4 acc[2][2][4][2];
#pragma unroll
    for (int a = 0; a < 2; ++a)
#pragma unroll
        for (int b = 0; b < 2; ++b)
#pragma unroll
            for (int m = 0; m < 4; ++m)
#pragma unroll
                for (int n = 0; n < 2; ++n) acc[a][b][m][n] = (f32x4){0.f, 0.f, 0.f, 0.f};
    bf16x8 At[4][2], B0[2][2], B1[2][2];
    const char* cA = (const char*)g.A + (size_t)cur.pm * tstep; const char* cB = (const char*)g.Bt + (size_t)cur.pn * tstep;
    S.a_ready(cur);
    if constexpr (SP2) {
        PG8_STAGE(PG8_SB(0, 0), cB, voffB); PG8_STAGE(PG8_SB(0, 1), cB + hstep, voffB); PG8_STAGE(PG8_SA(0, 0), cA, voffA); PG8_STAGE(PG8_SA(0, 1), cA + hstep, voffA);
        if (wr == 1) PG8_BAR;
        PG8_WAIT_V(2); PG8_BAR;
        PG8_STAGE(PG8_SB(1, 0), cB + kstep, voffB); PG8_STAGE(PG8_SA(1, 0), cA + kstep, voffA); PG8_STAGE(PG8_SB(1, 1), cB + hstep + kstep, voffB);
        PG8_WAIT_V(6); PG8_BAR;
    } else {
        PG8_STAGE(PG8_SB(0, 0), cB, voffB); PG8_STAGE(PG8_SA(0, 0), cA, voffA); PG8_STAGE(PG8_SB(0, 1), cB + hstep, voffB); PG8_STAGE(PG8_SA(0, 1), cA + hstep, voffA);
        if (wr == 1) PG8_BAR;
        PG8_WAIT_V(4); PG8_BAR;
        PG8_STAGE(PG8_SB(1, 0), cB + kstep, voffB); PG8_STAGE(PG8_SA(1, 0), cA + kstep, voffA); PG8_STAGE(PG8_SB(1, 1), cB + hstep + kstep, voffB);
        PG8_WAIT_V(6); PG8_BAR;
    }
    for (;;) {
        const bool has_next = S.next(ui + 1, nxt);
        const char* nA = has_next ? (const char*)g.A + (size_t)nxt.pm * tstep : cA; const char* nB = has_next ? (const char*)g.Bt + (size_t)nxt.pn * tstep : cB;
        for (int t = 0; t < nt; t += 2) {
            const bool last = (t == nt - 2);
            const char* a1 = cA + (size_t)(t + 1) * kstep;
            const char* a2 = last ? nA : cA + (size_t)(t + 2) * kstep; const char* b2 = last ? nB : cB + (size_t)(t + 2) * kstep;
            const char* a3 = a2 + kstep; const char* b3 = b2 + kstep;
            if (last && has_next) S.a_ready(nxt);
            if constexpr (SP2) {
            PG8_LDB(B0, 0, 0); PG8_LDB(B1, 0, 1); PG8_SCHED; PG8_LDA(At, 0, 0); PG8_STAGE(PG8_SA(1, 1), a1 + hstep, voffA);
            PG8_WAIT_V(8); PG8_WAIT_L(0); PG8_BAR; PG8_MMA(0, 0, At, B0); PG8_MMA(0, 1, At, B1); PG8_BAR; PG8_SCHED;
            PG8_LDA(At, 0, 1); PG8_STAGE(PG8_SB(0, 0), b2, voffB); PG8_STAGE(PG8_SB(0, 1), b2 + hstep, voffB); PG8_STAGE(PG8_SA(0, 0), a2, voffA);
            PG8_WAIT_V(8); PG8_WAIT_L(0); PG8_BAR; PG8_MMA(1, 0, At, B0); PG8_MMA(1, 1, At, B1); PG8_BAR; PG8_SCHED;
            PG8_LDB(B0, 1, 0); PG8_LDB(B1, 1, 1); PG8_SCHED; PG8_LDA(At, 1, 0); PG8_STAGE(PG8_SA(0, 1), a2 + hstep, voffA);
            PG8_WAIT_V(8); PG8_WAIT_L(0); PG8_BAR; PG8_MMA(0, 0, At, B0); PG8_MMA(0, 1, At, B1); PG8_BAR; PG8_SCHED;
            PG8_LDA(At, 1, 1); PG8_STAGE(PG8_SB(1, 0), b3, voffB); PG8_STAGE(PG8_SB(1, 1), b3 + hstep, voffB); PG8_STAGE(PG8_SA(1, 0), a3, voffA);
            PG8_WAIT_V(8); PG8_WAIT_L(0); PG8_BAR; PG8_MMA(1, 0, At, B0); PG8_MMA(1, 1, At, B1); PG8_BAR; PG8_SCHED;
            } else {
            PG8_LDB(B0, 0, 0); PG8_SCHED; PG8_LDA(At, 0, 0); PG8_STAGE(PG8_SA(1, 1), a1 + hstep, voffA);
            PG8_WAIT_L(8); PG8_BAR; PG8_WAIT_L(0); PG8_MMA(0, 0, At, B0); PG8_BAR; PG8_SCHED;
            PG8_LDB(B1, 0, 1); PG8_STAGE(PG8_SB(0, 0), b2, voffB);
            PG8_BAR; PG8_WAIT_L(0); PG8_MMA(0, 1, At, B1); PG8_BAR;
            PG8_LDA(At, 0, 1); PG8_STAGE(PG8_SA(0, 0), a2, voffA);
            PG8_BAR; PG8_WAIT_L(0); PG8_MMA(1, 0, At, B0); PG8_BAR; PG8_SCHED;
            PG8_STAGE(PG8_SB(0, 1), b2 + hstep, voffB);
            PG8_WAIT_V(6); PG8_BAR; PG8_MMA(1, 1, At, B1); PG8_BAR;
            PG8_LDB(B0, 1, 0); PG8_SCHED; PG8_LDA(At, 1, 0); PG8_STAGE(PG8_SA(0, 1), a2 + hstep, voffA);
            PG8_WAIT_L(8); PG8_BAR; PG8_WAIT_L(0); PG8_MMA(0, 0, At, B0); PG8_BAR; PG8_SCHED;
            PG8_LDB(B1, 1, 1); PG8_STAGE(PG8_SB(1, 0), b3, voffB);
            PG8_BAR; PG8_WAIT_L(0); PG8_MMA(0, 1, At, B1); PG8_BAR;
            PG8_LDA(At, 1, 1); PG8_STAGE(PG8_SA(1, 0), a3, voffA);
            PG8_BAR; PG8_WAIT_L(0); PG8_MMA(1, 0, At, B0); PG8_BAR; PG8_SCHED;
            PG8_STAGE(PG8_SB(1, 1), b3 + hstep, voffB);
            PG8_WAIT_V(6); PG8_BAR; PG8_MMA(1, 1, At, B1); PG8_BAR;
            }
        }
        if constexpr (ALIGN_EPI) { if (wr == 0) PG8_BAR; }
        if constexpr (!Epi::AFTER_DRAIN) { E(acc, cur, wr, wc, fr, fq); S.done(cur); }
        if (!has_next) break;
#pragma unroll
        for (int a = 0; a < 2; ++a)
#pragma unroll
            for (int b = 0; b < 2; ++b)
#pragma unroll
                for (int m = 0; m < 4; ++m)
#pragma unroll
                    for (int n = 0; n < 2; ++n) acc[a][b][m][n] = (f32x4){0.f, 0.f, 0.f, 0.f};
        cur = nxt; cA = nA; cB = nB; ++ui;
        if constexpr (ALIGN_EPI) { if (wr == 1) PG8_BAR; }
    }
    PG8_WAIT_V(0);
    if constexpr (!ALIGN_EPI) { if (wr == 0) PG8_BAR; }
    PG8_BAR;
    if constexpr (Epi::AFTER_DRAIN) { E.fused(acc, cur, wr, wc, fr, fq, lds, wid, lane); S.done(cur); }
#undef PG8_SA
#undef PG8_SB
#undef PG8_STAGE
#undef PG8_LDA
#undef PG8_LDB
#undef PG8_MMA
#undef PG8_WAIT_V
#undef PG8_WAIT_L
#undef PG8_BAR
#undef PG8_SCHED
}
}

namespace cg = cooperative_groups;

#define LAS __attribute__((address_space(3)))
typedef unsigned short bf16_t;
typedef float f32x4 __attribute__((ext_vector_type(4)));
typedef float f32x16 __attribute__((ext_vector_type(16)));
typedef short bf16x8 __attribute__((ext_vector_type(8)));
typedef short s16x4 __attribute__((ext_vector_type(4)));
typedef unsigned u32x2 __attribute__((ext_vector_type(2)));
typedef unsigned u32x4 __attribute__((ext_vector_type(4)));
using pg8::Unit;
typedef float f32x2_t __attribute__((ext_vector_type(2))); typedef __bf16 bf16x2_t __attribute__((ext_vector_type(2)));
__device__ __forceinline__ unsigned cvt_pk_bf16(float lo, float hi) { const f32x2_t v = {lo, hi}; const bf16x2_t b = __builtin_convertvector(v, bf16x2_t); return __builtin_bit_cast(unsigned, b); }

constexpr int NT = 65536, SEQ = 2048, DM = 1024, FF = 2816, NWAVES = 8;
constexpr float EPS = 1e-6f, LOG2E = 1.4426950408889634f;
constexpr float QSCALE_D = 0.125f * LOG2E;
constexpr float QSCALE_M = 0.10206207261596577f * LOG2E;

constexpr size_t MiB = 1u << 20;
constexpr size_t WS_W1GU = 0, WS_W1D = 11 * MiB, WS_W2GU = 17 * MiB, WS_W2D = 28 * MiB, WS_WIN = 34 * MiB, WS_WUQ = 39 * MiB, WS_WUKV = 40 * MiB, WS_WOUT = 41 * MiB;
constexpr size_t WS_ROPE = 43 * MiB;
constexpr size_t WS_SS0 = 44 * MiB, WS_SS1 = 48 * MiB, WS_SS2 = 52 * MiB, WS_SS3 = 56 * MiB, WS_SSQ = 60 * MiB, WS_SSKV = 62 * MiB;
constexpr size_t WS_BAR = 63 * MiB;
constexpr size_t WS_XB = 64 * MiB;
constexpr size_t WS_KVM = WS_XB;
constexpr size_t WS_H = 192 * MiB;
constexpr size_t WS_OD0 = 192 * MiB, WS_OD1 = 256 * MiB, WS_OD2 = 320 * MiB, WS_OMIX = 384 * MiB, WS_LSE = 512 * MiB;
constexpr size_t WS_QD = 544 * MiB, WS_KD = 608 * MiB, WS_VD = 672 * MiB, WS_CQ = 736 * MiB, WS_CKV = 784 * MiB, WS_KR = 816 * MiB, WS_QM = 820 * MiB, WS_END = 916 * MiB;

__device__ __forceinline__ float fast_exp2(float x) { return __builtin_amdgcn_exp2f(x); }
__device__ __forceinline__ float fast_rcp(float x) { return __builtin_amdgcn_rcpf(x); }
__device__ __forceinline__ float bf2f(unsigned short b) { return __uint_as_float((unsigned)b << 16); }
__device__ __forceinline__ float sum4(f32x4 a) { return (a[0] + a[1]) + (a[2] + a[3]); }
__device__ __forceinline__ float sq4(f32x4 a) { return (a[0] * a[0] + a[1] * a[1]) + (a[2] * a[2] + a[3] * a[3]); }
__device__ __forceinline__ float rstd_parts16(const float* ss, int row, float invn) {
    const f32x4* p = (const f32x4*)(ss + (size_t)row * 16);
    const float s = (sum4(p[0]) + sum4(p[1])) + (sum4(p[2]) + sum4(p[3]));
    return rsqrtf(s * invn + EPS);
}

#define EPI_RELANE() int fr, fq; { int t_ = threadIdx.x; asm volatile("" : "+v"(t_)); fr = t_ & 15; fq = (t_ >> 4) & 3; }
__device__ __forceinline__ void rstd4_fill(LAS float* tab4, const float* ss) {
    int tid = threadIdx.x; asm volatile("" : "+v"(tid));
    const int c = blockIdx.x;
#pragma unroll
    for (int k = 0; k < 2; ++k) { const int idx = tid + 512 * k, slot = idx >> 8, r = idx & 255, pm = 8 * (4 * (c & 7) + slot) + ((c >> 3) & 7); tab4[idx] = rstd_parts16(ss, pm * 256 + r, 1.0f / 1024.0f); }
    __syncthreads();
}
__device__ __forceinline__ int rstd4_slot(int pm) { return (pm >> 3) - 4 * ((int)blockIdx.x & 7); }
struct EpiGateUp {
    static constexpr bool PERM = true, AFTER_DRAIN = false;
    bf16_t* H; const float* ss; LAS float* tab;
    __device__ __forceinline__ void operator()(const f32x4 (&acc)[2][2][4][2], const Unit& u, int wr, int wc, int fr_in, int fq_in) const {
        EPI_RELANE();
        const LAS float* tb = tab + rstd4_slot(u.pm) * 256;
        const int r0 = wr * 64 + fr, col = u.pn * 128 + wc * 32 + 8 * fq;
#pragma unroll
        for (int ai = 0; ai < 2; ++ai)
#pragma unroll
            for (int m = 0; m < 4; ++m) {
                const int r = r0 + ai * 128 + m * 16;
                const float rs = tb[r], nrs = -rs * LOG2E;
                float o[8];
#pragma unroll
                for (int n = 0; n < 2; ++n)
#pragma unroll
                    for (int j = 0; j < 4; ++j) {
                        const float ga = acc[ai][0][m][n][j];
                        o[4 * n + j] = (ga * rs) * fast_rcp(1.0f + fast_exp2(ga * nrs)) * (acc[ai][1][m][n][j] * rs);
                    }
                u32x4 w; w.x = cvt_pk_bf16(o[0], o[1]); w.y = cvt_pk_bf16(o[2], o[3]); w.z = cvt_pk_bf16(o[4], o[5]); w.w = cvt_pk_bf16(o[6], o[7]);
                *(u32x4*)(H + (size_t)(u.pm * 256 + r) * FF + col) = w;
            }
    }
};
struct EpiResid {
    static constexpr bool PERM = true, AFTER_DRAIN = false;
    bf16_t* xb; float* ss; float alpha;
    __device__ __forceinline__ void operator()(const f32x4 (&acc)[2][2][4][2], const Unit& u, int wr, int wc, int fr_in, int fq_in) const {
        EPI_RELANE();
        const int row0 = u.pm * 256 + wr * 64 + fr, col0 = u.pn * 256 + wc * 32 + 8 * fq;
        u32x4 bws[2][4][2];
#pragma unroll
        for (int ai = 0; ai < 2; ++ai)
#pragma unroll
            for (int m = 0; m < 4; ++m)
#pragma unroll
                for (int bj = 0; bj < 2; ++bj) bws[ai][m][bj] = *(const u32x4*)(xb + (size_t)(row0 + ai * 128 + m * 16) * DM + col0 + bj * 128);
#pragma unroll
        for (int ai = 0; ai < 2; ++ai)
#pragma unroll
            for (int m = 0; m < 4; ++m) {
                const int row = row0 + ai * 128 + m * 16; float sq = 0.f;
#pragma unroll
                for (int bj = 0; bj < 2; ++bj) {
                    const u32x4 bw = bws[ai][m][bj];
                    const f32x4 b0 = {__uint_as_float(bw.x << 16), __uint_as_float(bw.x & 0xffff0000u), __uint_as_float(bw.y << 16), __uint_as_float(bw.y & 0xffff0000u)};
                    const f32x4 b1 = {__uint_as_float(bw.z << 16), __uint_as_float(bw.z & 0xffff0000u), __uint_as_float(bw.w << 16), __uint_as_float(bw.w & 0xffff0000u)};
                    const f32x4 v0 = b0 + acc[ai][bj][m][0] * alpha, v1 = b1 + acc[ai][bj][m][1] * alpha; sq += sq4(v0) + sq4(v1);
                    u32x4 w; w.x = cvt_pk_bf16(v0[0], v0[1]); w.y = cvt_pk_bf16(v0[2], v0[3]); w.z = cvt_pk_bf16(v1[0], v1[1]); w.w = cvt_pk_bf16(v1[2], v1[3]);
                    *(u32x4*)(xb + (size_t)row * DM + col0 + bj * 128) = w;
                }
                sq += __shfl_xor(sq, 16); sq += __shfl_xor(sq, 32);
                if (fq == 0) ss[(size_t)row * 16 + u.pn * 4 + wc] = sq;
            }
    }
};
struct EpiFinal {
    static constexpr bool PERM = true, AFTER_DRAIN = false;
    const bf16_t* xb; float* X; float* ss; unsigned* cnt; const float* gfin; LAS float* tab;
    __device__ __forceinline__ void operator()(f32x4 (&acc)[2][2][4][2], const Unit& u, int wr, int wc, int fr_in, int fq_in) const {
        EPI_RELANE();
        int tid = threadIdx.x; asm volatile("" : "+v"(tid));
        const int row0 = u.pm * 256 + wr * 64 + fr, col0 = u.pn * 256 + wc * 32 + 8 * fq;
        u32x4 bws[2][4][2];
#pragma unroll
        for (int ai = 0; ai < 2; ++ai)
#pragma unroll
            for (int m = 0; m < 4; ++m)
#pragma unroll
                for (int bj = 0; bj < 2; ++bj) bws[ai][m][bj] = *(const u32x4*)(xb + (size_t)(row0 + ai * 128 + m * 16) * DM + col0 + bj * 128);
#pragma unroll
        for (int ai = 0; ai < 2; ++ai)
#pragma unroll
            for (int m = 0; m < 4; ++m) {
                const int row = row0 + ai * 128 + m * 16; float sq = 0.f;
#pragma unroll
                for (int bj = 0; bj < 2; ++bj) {
                    const u32x4 bw = bws[ai][m][bj];
                    const f32x4 b0 = {__uint_as_float(bw.x << 16), __uint_as_float(bw.x & 0xffff0000u), __uint_as_float(bw.y << 16), __uint_as_float(bw.y & 0xffff0000u)};
                    const f32x4 b1 = {__uint_as_float(bw.z << 16), __uint_as_float(bw.z & 0xffff0000u), __uint_as_float(bw.w << 16), __uint_as_float(bw.w & 0xffff0000u)};
                    const f32x4 v0 = b0 + acc[ai][bj][m][0] * 0.5f, v1 = b1 + acc[ai][bj][m][1] * 0.5f; acc[ai][bj][m][0] = v0; acc[ai][bj][m][1] = v1; sq += sq4(v0) + sq4(v1);
                }
                sq += __shfl_xor(sq, 16); sq += __shfl_xor(sq, 32);
                if (fq == 0) ss[(size_t)row * 16 + u.pn * 4 + wc] = sq;
            }
        asm volatile("s_waitcnt vmcnt(0)" ::: "memory");
        __syncthreads();
        if (tid == 0) {
            unsigned* c = cnt + 64 * u.pm;
            __builtin_amdgcn_fence(__ATOMIC_RELEASE, "agent"); asm volatile("s_waitcnt vmcnt(0)" ::: "memory");
            __hip_atomic_fetch_add(c, 1u, __ATOMIC_RELAXED, __HIP_MEMORY_SCOPE_AGENT);
            unsigned sp = 0;
            while (__hip_atomic_load(c, __ATOMIC_RELAXED, __HIP_MEMORY_SCOPE_AGENT) < 4u) { __builtin_amdgcn_s_sleep(2); if (++sp > (1u << 22)) break; }
            __builtin_amdgcn_fence(__ATOMIC_ACQUIRE, "agent"); asm volatile("s_waitcnt vmcnt(0)" ::: "memory");
        }
        __syncthreads();
        if (tid < 256) tab[tid] = rstd_parts16(ss, u.pm * 256 + tid, 1.0f / 1024.0f);
        __syncthreads();
#pragma unroll
        for (int ai = 0; ai < 2; ++ai)
#pragma unroll
            for (int m = 0; m < 4; ++m) {
                const int r = ai * 128 + wr * 64 + m * 16 + fr; const float rs = tab[r];
#pragma unroll
                for (int bj = 0; bj < 2; ++bj)
#pragma unroll
                    for (int n = 0; n < 2; ++n) {
                        const int col = col0 + bj * 128 + n * 4;
                        const f32x4 g = *(const f32x4*)(gfin + col);
                        *(f32x4*)(X + (size_t)(u.pm * 256 + r) * DM + col) = acc[ai][bj][m][n] * rs * g;
                    }
            }
    }
};
__device__ __forceinline__ void store8_pair(bf16_t* grp, int fq, u32x2 w0, u32x2 w1) {
    const bool odd = (fq & 1) != 0;
    const u32x2 snd = odd ? w0 : w1;
    u32x2 rcv; rcv.x = __shfl_xor(snd.x, 16); rcv.y = __shfl_xor(snd.y, 16);
    u32x4 o; if (odd) { o.x = rcv.x; o.y = rcv.y; o.z = w1.x; o.w = w1.y; } else { o.x = w0.x; o.y = w0.y; o.z = rcv.x; o.w = rcv.y; }
    *(u32x4*)(grp + (odd ? 16 + 4 * (fq - 1) : 4 * fq)) = o;
}
struct EpiInProj {
    static constexpr bool PERM = false, AFTER_DRAIN = false;
    const float* ss1; bf16_t *QD, *KD, *VD, *CQ, *CKV, *KR; float *SSQ, *SSKV; const float *cosm, *sinm, *cosp, *sinp; LAS float* tab;
    __device__ __forceinline__ void operator()(const f32x4 (&acc)[2][2][4][2], const Unit& u, int wr, int wc, int fr_in, int fq_in) const {
        EPI_RELANE();
        const LAS float* tb = tab + rstd4_slot(u.pm) * 256;
        const int row0 = u.pm * 256 + wr * 64 + fr, pn = u.pn;
        const bool ropeP = (pn < 4) && ((wc & 1) == 0), ropeM = (pn == 7) && (wc == 0);
        f32x4 cs[2][4], sn[2][4];
        if (ropeP || ropeM) {
#pragma unroll
            for (int ai = 0; ai < 2; ++ai)
#pragma unroll
                for (int m = 0; m < 4; ++m) { const int pos = (row0 + ai * 128 + m * 16) & (SEQ - 1);
                    const float* cp = ropeP ? cosp + pos * 8 + 4 * (fq & 1) : cosm + pos * 16 + 4 * fq; const float* sp = ropeP ? sinp + pos * 8 + 4 * (fq & 1) : sinm + pos * 16 + 4 * fq;
                    cs[ai][m] = *(const f32x4*)cp; sn[ai][m] = *(const f32x4*)sp; }
        }
#pragma unroll
        for (int ai = 0; ai < 2; ++ai)
#pragma unroll
            for (int m = 0; m < 4; ++m) {
                const int row = row0 + ai * 128 + m * 16, pos = row & (SEQ - 1);
                const float rs = tb[ai * 128 + wr * 64 + m * 16 + fr];
                if (pn < 6) {
                    bf16_t* dst = QD + (size_t)(pn >> 1) * ((size_t)NT * 512) + (size_t)row * 512 + (pn & 1) * 256 + wc * 32;
                    const float sc = pn < 2 ? rs * QSCALE_D : rs;
                    const bool rope = (pn < 4) && ((wc & 1) == 0);
#pragma unroll
                    for (int bj = 0; bj < 2; ++bj) {
                        u32x2 wp[2];
#pragma unroll
                        for (int n = 0; n < 2; ++n) {
                            f32x4 v = acc[ai][bj][m][n] * sc;
                            if (n == 0 && rope) {
                                f32x4 pv; pv[0] = __shfl_xor(v[0], 32); pv[1] = __shfl_xor(v[1], 32); pv[2] = __shfl_xor(v[2], 32); pv[3] = __shfl_xor(v[3], 32);
                                const f32x4 c = cs[ai][m], s = sn[ai][m];
                                v = (fq < 2) ? (v * c - pv * s) : (v * c + pv * s);
                            }
                            wp[n].x = cvt_pk_bf16(v[0], v[1]); wp[n].y = cvt_pk_bf16(v[2], v[3]);
                        }
                        store8_pair(dst + bj * 128, fq, wp[0], wp[1]);
                    }
                } else if (pn == 6 || pn == 8) {
                    bf16_t* dst = CQ + (pn == 6 ? (size_t)row * 384 : (size_t)NT * 384 + (size_t)row * 256) + wc * 32; float sq = 0.f;
#pragma unroll
                    for (int bj = 0; bj < 2; ++bj) {
                        u32x2 wp[2];
#pragma unroll
                        for (int n = 0; n < 2; ++n) {
                            const f32x4 v = acc[ai][bj][m][n] * rs; sq += sq4(v);
                            wp[n].x = cvt_pk_bf16(v[0], v[1]); wp[n].y = cvt_pk_bf16(v[2], v[3]);
                        }
                        store8_pair(dst + bj * 128, fq, wp[0], wp[1]);
                    }
                    sq += __shfl_xor(sq, 16); sq += __shfl_xor(sq, 32);
                    if (fq == 0) SSQ[(pn == 6 ? (size_t)row * 8 : (size_t)NT * 8 + (size_t)row * 4) + wc] = sq;
                } else {
                    bf16_t* dst = CQ + (size_t)row * 384 + 256 + wc * 32; float sq = 0.f;
                    { u32x2 wp[2];
#pragma unroll
                      for (int n = 0; n < 2; ++n) {
                          const f32x4 v = acc[ai][0][m][n] * rs; sq += sq4(v);
                          wp[n].x = cvt_pk_bf16(v[0], v[1]); wp[n].y = cvt_pk_bf16(v[2], v[3]);
                      }
                      store8_pair(dst, fq, wp[0], wp[1]); }
                    sq += __shfl_xor(sq, 16); sq += __shfl_xor(sq, 32);
                    if (fq == 0) SSQ[(size_t)row * 8 + 4 + wc] = sq;
                    if (wc == 0) {
                        const f32x4 x1 = acc[ai][1][m][0] * rs, x2 = acc[ai][1][m][1] * rs;
                        const f32x4 c = cs[ai][m], s = sn[ai][m];
                        const f32x4 o1 = x1 * c - x2 * s, o2 = x2 * c + x1 * s;
                        u32x2 w1, w2; w1.x = cvt_pk_bf16(o1[0], o1[1]); w1.y = cvt_pk_bf16(o1[2], o1[3]); w2.x = cvt_pk_bf16(o2[0], o2[1]); w2.y = cvt_pk_bf16(o2[2], o2[3]);
                        *(u32x2*)(KR + (size_t)row * 32 + 4 * fq) = w1; *(u32x2*)(KR + (size_t)row * 32 + 16 + 4 * fq) = w2;
                    }
                }
            }
    }
};
struct EpiQ {
    static constexpr bool PERM = false, AFTER_DRAIN = false;
    const float* ssq; bf16_t* QM; const float *cosm, *sinm; LAS float* tab;
    __device__ __forceinline__ void operator()(const f32x4 (&acc)[2][2][4][2], const Unit& u, int wr, int wc, int fr_in, int fq_in) const {
        EPI_RELANE();
        const int row0 = u.pm * 256 + wr * 64 + fr;
        { int tid = threadIdx.x; asm volatile("" : "+v"(tid));
          if (tid < 256) { const f32x4* p = (const f32x4*)(ssq + (size_t)(u.pm * 256 + tid) * 8); tab[tid] = rsqrtf((sum4(p[0]) + sum4(p[1])) * (1.0f / 384.0f) + EPS) * QSCALE_M; } }
        __syncthreads();
#pragma unroll
        for (int ai = 0; ai < 2; ++ai) {
#pragma unroll
            for (int m = 0; m < 4; ++m) {
                const int row = row0 + ai * 128 + m * 16;
                const float rs = tab[ai * 128 + wr * 64 + m * 16 + fr];
#pragma unroll
                for (int bj = 0; bj < 2; ++bj) {
                    const int g32 = 8 * u.pn + 4 * bj + wc;
                    bf16_t* dst = QM + (size_t)row * 768 + 32 * g32 + 4 * fq;
                    f32x4 v0 = acc[ai][bj][m][0] * rs, v1 = acc[ai][bj][m][1] * rs;
                    if (g32 % 3 == 2) {
                        const int pos = row & (SEQ - 1);
                        const f32x4 c = *(const f32x4*)(cosm + pos * 16 + 4 * fq), s = *(const f32x4*)(sinm + pos * 16 + 4 * fq);
                        const f32x4 o1 = v0 * c - v1 * s, o2 = v1 * c + v0 * s; v0 = o1; v1 = o2;
                    }
                    u32x2 w0, w1; w0.x = cvt_pk_bf16(v0[0], v0[1]); w0.y = cvt_pk_bf16(v0[2], v0[3]); w1.x = cvt_pk_bf16(v1[0], v1[1]); w1.y = cvt_pk_bf16(v1[2], v1[3]);
                    *(u32x2*)dst = w0; *(u32x2*)(dst + 16) = w1;
                }
            }
        }
    }
};
struct EpiKV {
    static constexpr bool PERM = true, AFTER_DRAIN = false;
    const float* sskv; bf16_t* KVM; LAS float* tab;
    __device__ __forceinline__ void operator()(const f32x4 (&acc)[2][2][4][2], const Unit& u, int wr, int wc, int fr_in, int fq_in) const {
        EPI_RELANE();
        { int tid = threadIdx.x; asm volatile("" : "+v"(tid)); if (tid < 256) tab[tid] = rsqrtf(sum4(*(const f32x4*)(sskv + (size_t)(u.pm * 256 + tid) * 4)) * (1.0f / 256.0f) + EPS); }
        __syncthreads();
        const int row0 = u.pm * 256 + wr * 64 + fr, col = u.pn * 256 + wc * 32 + 8 * fq;
#pragma unroll
        for (int ai = 0; ai < 2; ++ai)
#pragma unroll
            for (int m = 0; m < 4; ++m) {
                const int row = row0 + ai * 128 + m * 16;
                const float rs = tab[ai * 128 + wr * 64 + m * 16 + fr];
#pragma unroll
                for (int bj = 0; bj < 2; ++bj) {
                    const f32x4 v0 = acc[ai][bj][m][0] * rs, v1 = acc[ai][bj][m][1] * rs;
                    u32x4 w; w.x = cvt_pk_bf16(v0[0], v0[1]); w.y = cvt_pk_bf16(v0[2], v0[3]); w.z = cvt_pk_bf16(v1[0], v1[1]); w.w = cvt_pk_bf16(v1[2], v1[3]);
                    *(u32x4*)(KVM + (size_t)row * 1024 + col + bj * 128) = w;
                }
            }
    }
};

constexpr int ATT_VS = 192;
constexpr int ATT_TILE = 64 * 208 + 64 * ATT_VS;
constexpr int ATT_OST = 2 * ATT_TILE, ATT_WSC = ATT_OST + NWAVES * 4096;
static_assert(ATT_WSC + NWAVES * 256 <= 131072, "attention LDS");
static_assert(WS_KD == WS_QD + (size_t)NT * 512 * 2 && WS_VD == WS_KD + (size_t)NT * 512 * 2 && WS_CKV == WS_CQ + (size_t)NT * 384 * 2 && WS_SSKV == WS_SSQ + (size_t)NT * 8 * 4, "buffers addressed relative to each other");
__device__ __forceinline__ int crow(int r, int hi) { return (r & 3) + 8 * (r >> 2) + 4 * hi; }
__device__ __forceinline__ bf16x8 pack8(const f32x16& p, int b) {
    u32x4 w; w.x = cvt_pk_bf16(p[b], p[b + 1]); w.y = cvt_pk_bf16(p[b + 2], p[b + 3]); w.z = cvt_pk_bf16(p[b + 4], p[b + 5]); w.w = cvt_pk_bf16(p[b + 6], p[b + 7]);
    return __builtin_bit_cast(bf16x8, w);
}
typedef short v4i16_t __attribute__((ext_vector_type(4)));
__device__ __forceinline__ s16x4 vtr(LAS const unsigned char* p) { return __builtin_bit_cast(s16x4, __builtin_amdgcn_ds_read_tr16_b64_v4i16((LAS v4i16_t*)p)); }

struct AttnIO {
    const bf16_t *QM, *KVM, *KR; bf16_t* OMIX;
    const bf16_t *QD, *KD, *VD; bf16_t* OD; float* LSE;
};

template <bool DIL>
__device__ __forceinline__ void attn_unit(LAS unsigned char* lds, const AttnIO& io, int unit) {
    constexpr int DK = DIL ? 64 : 96, KS = DK * 2 + 16, NKS = DK / 16;
    int tid_ = threadIdx.x; asm volatile("" : "+v"(tid_));
    const int tid = tid_, lane = tid & 63, wid = __builtin_amdgcn_readfirstlane(tid >> 6), r32 = lane & 31, hi = lane >> 5;
    int b, h, ntiles, tlo, thi, kofs = 0, L = SEQ, dil = 1, res = 0, resu = 0, br = 0, q0 = 0, pq;
    if constexpr (!DIL) {
        const int bh = unit >> 3, qb = unit & 7; b = bh >> 3; h = bh & 7; ntiles = 32; tlo = 0; thi = 32; q0 = qb * 256; pq = q0 + wid * 32 + r32;
    } else {
        const int bh = unit / 24, k = unit % 24, j = k & 7; br = k >> 3; b = bh >> 3; h = bh & 7;
        if (br == 0) { dil = 1; L = 2048; resu = 0; q0 = 256 * j; }
        else if (br == 1) { dil = 4; L = 512; resu = j >> 1; q0 = 256 * (j & 1); }
        else { dil = 16; L = 128; resu = 2 * j; q0 = 0; }
        if (br < 2) { ntiles = 6; tlo = wid >> 1; thi = tlo + 3; kofs = q0 - 64; pq = q0 + wid * 32 + r32; res = resu; }
        else { const int hw = wid >> 2; ntiles = 4; tlo = 2 * hw; thi = tlo + 2; kofs = -128 * hw; pq = (wid & 3) * 32 + r32; res = resu + hw; }
    }
    const int pq0 = pq - r32;
    const size_t kb = (size_t)b * SEQ;
    bf16x8 qf[NKS];
    {
        const bf16_t* qp = DIL ? io.QD + (kb + (size_t)pq * dil + res) * 512 + h * 64 : io.QM + (kb + pq) * 768 + h * 96;
#pragma unroll
        for (int ks = 0; ks < NKS; ++ks) qf[ks] = *(const bf16x8*)(qp + ks * 16 + hi * 8);
    }
    const int lrow = tid >> 3, lch = tid & 7, rrow = (tid >> 2) & 63, rch = tid & 3;
    u32x4 gkA, gvA, grA = (u32x4){0u, 0u, 0u, 0u}, gkB, gvB, grB = (u32x4){0u, 0u, 0u, 0u};
#define ATT_TOK(t) \
        const int s_ = 64 * (t) + lrow; size_t tok_; \
        if (br < 2) { int p_ = q0 - 64 + s_; p_ = p_ < 0 ? 0 : (p_ > L - 1 ? L - 1 : p_); tok_ = kb + (size_t)p_ * dil + resu; } \
        else { tok_ = kb + (size_t)(s_ & 127) * 16 + (size_t)(resu + (s_ >> 7)); }
#define ATT_GLOADK(t, GK, GR) do { \
        if constexpr (!DIL) { \
            GK = *(const u32x4*)(io.KVM + (kb + 64 * (t) + lrow) * 1024 + h * 128 + lch * 8); \
            GR = *(const u32x4*)(io.KR + (kb + 64 * (t) + rrow) * 32 + rch * 8); \
        } else { ATT_TOK(t) GK = *(const u32x4*)(io.KD + tok_ * 512 + h * 64 + lch * 8); } } while (0)
#define ATT_GLOADV(t, GV) do { \
        if constexpr (!DIL) { GV = *(const u32x4*)(io.KVM + (kb + 64 * (t) + lrow) * 1024 + h * 128 + 64 + lch * 8); } \
        else { ATT_TOK(t) GV = *(const u32x4*)(io.VD + tok_ * 512 + h * 64 + lch * 8); } } while (0)
#define ATT_LSTOREK(buf, GK, GR) do { \
        LAS unsigned char* Kb_ = lds + (buf) * ATT_TILE; \
        *(LAS u32x4*)(Kb_ + lrow * KS + lch * 16) = GK; \
        if constexpr (!DIL) { *(LAS u32x4*)(Kb_ + rrow * KS + 128 + rch * 16) = GR; } } while (0)
#define ATT_LSTOREV(buf, GV) do { *(LAS u32x4*)(lds + (buf) * ATT_TILE + 64 * KS + lrow * ATT_VS + lch * 16) = GV; } while (0)
#define ATT_SB() do {} while (0)
    LAS float* wsc = (LAS float*)(lds + ATT_WSC + wid * 256);
    f32x16 o0 = {}, o1 = {}, negm = {};
    float mref = 0.f, lrun = 0.f; bool started = false;
    const int krow = (r32 & 19) | ((r32 & 4) << 1) | ((r32 & 8) >> 1);
    const int koff = krow * KS + hi * 16;
    const int i16 = lane & 15, g16 = lane >> 4;
    const int voff = 64 * KS + (8 * hi + (i16 >> 2)) * ATT_VS + (16 * (g16 & 1) + 4 * (i16 & 3)) * 2;
    ATT_GLOADK(0, gkA, grA); ATT_GLOADV(0, gvA); ATT_GLOADK(1, gkB, grB); ATT_LSTOREK(0, gkA, grA); ATT_LSTOREV(0, gvA); ATT_LSTOREK(1, gkB, grB);
    ATT_GLOADK(2, gkB, grB); ATT_GLOADV(1, gvB);
    __syncthreads();
    f32x16 c0, c1;
    if (tlo == 0) {
        c0 = negm; c1 = negm;
#pragma unroll
        for (int ks = 0; ks < NKS; ++ks) {
            const bf16x8 a0 = *(LAS const bf16x8*)(lds + koff + ks * 32), a1 = *(LAS const bf16x8*)(lds + koff + 32 * KS + ks * 32);
            c0 = __builtin_amdgcn_mfma_f32_32x32x16_bf16(a0, qf[ks], c0, 0, 0, 0); c1 = __builtin_amdgcn_mfma_f32_32x32x16_bf16(a1, qf[ks], c1, 0, 0, 0);
        }
    } else { c0 = negm; c1 = negm; }
    __syncthreads();
    for (int t2 = 0; t2 < ntiles; t2 += 2) {
      { const int t = t2;
        ATT_GLOADK(min(t + 3, ntiles - 1), gkA, grA);
        ATT_GLOADV(min(t + 2, ntiles - 1), gvA);
        const bool doP = (t >= tlo) && (t < thi), doS = (t + 1 >= tlo) && (t + 1 < thi);
        LAS const unsigned char* Kn = lds + ((t + 1) & 1) * ATT_TILE + koff;
        LAS const unsigned char* Vc = lds + (t & 1) * ATT_TILE + voff;
        f32x16 n0 = negm, n1 = negm;
        if (doP) {
            if constexpr (DIL) {
                const int P0 = 64 * t + kofs;
                const bool full = (P0 >= pq0 - 33) && (P0 + 63 <= pq0 + 64) && (P0 >= 0) && (P0 + 63 < L);
                if (!full) {
                    const int lo = max(pq - 64, 0) - P0 - 8 * hi, span = min(pq + 64, L - 1) - max(pq - 64, 0);
#pragma unroll
                    for (int r = 0; r < 16; ++r) {
                        const int i0 = 16 * (r >> 3) + (r & 7);
                        c0[r] = ((unsigned)(i0 - lo) <= (unsigned)span) ? c0[r] : -INFINITY;
                        c1[r] = ((unsigned)(i0 + 32 - lo) <= (unsigned)span) ? c1[r] : -INFINITY;
                    }
                }
            }
            float ma = fmaxf(fmaxf(c0[0], c0[1]), c1[0]), mb = fmaxf(fmaxf(c0[2], c0[3]), c1[1]);
            ma = fmaxf(fmaxf(ma, c1[2]), c1[3]);
#pragma unroll
            for (int r = 4; r < 16; r += 4) { ma = fmaxf(fmaxf(ma, c0[r]), c0[r + 1]); mb = fmaxf(fmaxf(mb, c0[r + 2]), c0[r + 3]); ma = fmaxf(fmaxf(ma, c1[r]), c1[r + 1]); mb = fmaxf(fmaxf(mb, c1[r + 2]), c1[r + 3]); }
            float rm = fmaxf(ma, mb);
            { auto rr = __builtin_amdgcn_permlane32_swap(__float_as_uint(rm), __float_as_uint(rm), false, false); rm = fmaxf(__uint_as_float(rr[0]), __uint_as_float(rr[1])); }
            const float dl = (rm > -1e30f && (!started || rm > 8.f)) ? rm : 0.f;
            started = started || (rm > -1e30f);
            const bool resc = __any(dl != 0.f);
            if (resc) {
                mref += dl;
#pragma unroll
                for (int r = 0; r < 16; ++r) { c0[r] -= dl; c1[r] -= dl; }
#pragma unroll
                for (int r = 0; r < 16; ++r) negm[r] = -mref;
                const float f = fast_exp2(-fmaxf(dl, 0.f)); lrun *= f;
                if (hi == 0) wsc[r32] = f;
                n0 = negm; n1 = negm;
            }
            float ps0 = 0.f, ps1 = 0.f;
            u32x4 pw0, pw1, pw2, pw3;
#define ATT_EXPU(u) do { c0[u] = fast_exp2(c0[u]); c1[u] = fast_exp2(c1[u]); ps0 += c0[u]; ps1 += c1[u]; } while (0)
#define ATT_PK(u) do { const unsigned x0_ = cvt_pk_bf16(c0[u - 1], c0[u]), x1_ = cvt_pk_bf16(c1[u - 1], c1[u]); \
            if ((u) < 8) { pw0[((u) >> 1) & 3] = x0_; pw2[((u) >> 1) & 3] = x1_; } else { pw1[((u) >> 1) & 3] = x0_; pw3[((u) >> 1) & 3] = x1_; } } while (0)
            if (doS) {
                bf16x8 a0 = *(LAS const bf16x8*)(Kn), a1 = *(LAS const bf16x8*)(Kn + 32 * KS);
#pragma unroll
                for (int ks = 0; ks < NKS; ++ks) {
                    bf16x8 b0 = a0, b1 = a1;
                    if (ks + 1 < NKS) { b0 = *(LAS const bf16x8*)(Kn + (ks + 1) * 32); b1 = *(LAS const bf16x8*)(Kn + 32 * KS + (ks + 1) * 32); }
                    n0 = __builtin_amdgcn_mfma_f32_32x32x16_bf16(a0, qf[ks], n0, 0, 0, 0);
                    n1 = __builtin_amdgcn_mfma_f32_32x32x16_bf16(a1, qf[ks], n1, 0, 0, 0);
                    a0 = b0; a1 = b1;
                    const int u_lo = (16 * ks) / NKS, u_hi = (16 * (ks + 1)) / NKS;
#pragma unroll
                    for (int u = u_lo; u < u_hi; ++u) { ATT_EXPU(u); if (u & 1) ATT_PK(u); }
                    ATT_SB();
                }
            } else {
#pragma unroll
                for (int u = 0; u < 16; ++u) { ATT_EXPU(u); if (u & 1) ATT_PK(u); }
            }
            lrun += ps0 + ps1;
            if (resc) {
#pragma unroll
                for (int g = 0; g < 4; ++g) {
                    const f32x4 av = *(LAS const f32x4*)(wsc + 8 * g + 4 * hi);
#pragma unroll
                    for (int e = 0; e < 4; ++e) { o0[4 * g + e] *= av[e]; o1[4 * g + e] *= av[e]; }
                }
            }
            {
                s16x4 va = vtr(Vc), vb = vtr(Vc + 4 * ATT_VS), vc = vtr(Vc + 64), vd = vtr(Vc + 64 + 4 * ATT_VS);
#pragma unroll
                for (int j = 0; j < 4; ++j) {
                    const bf16x8 pa = __builtin_bit_cast(bf16x8, j == 0 ? pw0 : (j == 1 ? pw1 : (j == 2 ? pw2 : pw3)));
                    const bf16x8 vf0 = (bf16x8){va[0], va[1], va[2], va[3], vb[0], vb[1], vb[2], vb[3]};
                    const bf16x8 vf1 = (bf16x8){vc[0], vc[1], vc[2], vc[3], vd[0], vd[1], vd[2], vd[3]};
                    if (j + 1 < 4) { LAS const unsigned char* vp = Vc + (j + 1) * 16 * ATT_VS; va = vtr(vp); vb = vtr(vp + 4 * ATT_VS); vc = vtr(vp + 64); vd = vtr(vp + 64 + 4 * ATT_VS); }
                    o0 = __builtin_amdgcn_mfma_f32_32x32x16_bf16(pa, vf0, o0, 0, 0, 0);
                    o1 = __builtin_amdgcn_mfma_f32_32x32x16_bf16(pa, vf1, o1, 0, 0, 0);
                }
            }
        } else if (doS) {
#pragma unroll
            for (int ks = 0; ks < NKS; ++ks) {
                const bf16x8 a0 = *(LAS const bf16x8*)(Kn + ks * 32), a1 = *(LAS const bf16x8*)(Kn + 32 * KS + ks * 32);
                n0 = __builtin_amdgcn_mfma_f32_32x32x16_bf16(a0, qf[ks], n0, 0, 0, 0); n1 = __builtin_amdgcn_mfma_f32_32x32x16_bf16(a1, qf[ks], n1, 0, 0, 0);
            }
        }
        c0 = n0; c1 = n1;
        ATT_LSTOREK(t & 1, gkB, grB);
        ATT_LSTOREV((t + 1) & 1, gvB);
        __syncthreads();
          }
      { const int t = t2 + 1;
        ATT_GLOADK(min(t + 3, ntiles - 1), gkB, grB);
        ATT_GLOADV(min(t + 2, ntiles - 1), gvB);
        const bool doP = (t >= tlo) && (t < thi), doS = (t + 1 >= tlo) && (t + 1 < thi);
        LAS const unsigned char* Kn = lds + ((t + 1) & 1) * ATT_TILE + koff;
        LAS const unsigned char* Vc = lds + (t & 1) * ATT_TILE + voff;
        f32x16 n0 = negm, n1 = negm;
        if (doP) {
            if constexpr (DIL) {
                const int P0 = 64 * t + kofs;
                const bool full = (P0 >= pq0 - 33) && (P0 + 63 <= pq0 + 64) && (P0 >= 0) && (P0 + 63 < L);
                if (!full) {
                    const int lo = max(pq - 64, 0) - P0 - 8 * hi, span = min(pq + 64, L - 1) - max(pq - 64, 0);
#pragma unroll
                    for (int r = 0; r < 16; ++r) {
                        const int i0 = 16 * (r >> 3) + (r & 7);
                        c0[r] = ((unsigned)(i0 - lo) <= (unsigned)span) ? c0[r] : -INFINITY;
                        c1[r] = ((unsigned)(i0 + 32 - lo) <= (unsigned)span) ? c1[r] : -INFINITY;
                    }
                }
            }
            float ma = fmaxf(fmaxf(c0[0], c0[1]), c1[0]), mb = fmaxf(fmaxf(c0[2], c0[3]), c1[1]);
            ma = fmaxf(fmaxf(ma, c1[2]), c1[3]);
#pragma unroll
            for (int r = 4; r < 16; r += 4) { ma = fmaxf(fmaxf(ma, c0[r]), c0[r + 1]); mb = fmaxf(fmaxf(mb, c0[r + 2]), c0[r + 3]); ma = fmaxf(fmaxf(ma, c1[r]), c1[r + 1]); mb = fmaxf(fmaxf(mb, c1[r + 2]), c1[r + 3]); }
            float rm = fmaxf(ma, mb);
            { auto rr = __builtin_amdgcn_permlane32_swap(__float_as_uint(rm), __float_as_uint(rm), false, false); rm = fmaxf(__uint_as_float(rr[0]), __uint_as_float(rr[1])); }
            const float dl = (rm > -1e30f && (!started || rm > 8.f)) ? rm : 0.f;
            started = started || (rm > -1e30f);
            const bool resc = __any(dl != 0.f);
            if (resc) {
                mref += dl;
#pragma unroll
                for (int r = 0; r < 16; ++r) { c0[r] -= dl; c1[r] -= dl; }
#pragma unroll
                for (int r = 0; r < 16; ++r) negm[r] = -mref;
                const float f = fast_exp2(-fmaxf(dl, 0.f)); lrun *= f;
                if (hi == 0) wsc[r32] = f;
                n0 = negm; n1 = negm;
            }
            float ps0 = 0.f, ps1 = 0.f;
            u32x4 pw0, pw1, pw2, pw3;
#define ATT_EXPU(u) do { c0[u] = fast_exp2(c0[u]); c1[u] = fast_exp2(c1[u]); ps0 += c0[u]; ps1 += c1[u]; } while (0)
#define ATT_PK(u) do { const unsigned x0_ = cvt_pk_bf16(c0[u - 1], c0[u]), x1_ = cvt_pk_bf16(c1[u - 1], c1[u]); \
            if ((u) < 8) { pw0[((u) >> 1) & 3] = x0_; pw2[((u) >> 1) & 3] = x1_; } else { pw1[((u) >> 1) & 3] = x0_; pw3[((u) >> 1) & 3] = x1_; } } while (0)
            if (doS) {
                bf16x8 a0 = *(LAS const bf16x8*)(Kn), a1 = *(LAS const bf16x8*)(Kn + 32 * KS);
#pragma unroll
                for (int ks = 0; ks < NKS; ++ks) {
                    bf16x8 b0 = a0, b1 = a1;
                    if (ks + 1 < NKS) { b0 = *(LAS const bf16x8*)(Kn + (ks + 1) * 32); b1 = *(LAS const bf16x8*)(Kn + 32 * KS + (ks + 1) * 32); }
                    n0 = __builtin_amdgcn_mfma_f32_32x32x16_bf16(a0, qf[ks], n0, 0, 0, 0);
                    n1 = __builtin_amdgcn_mfma_f32_32x32x16_bf16(a1, qf[ks], n1, 0, 0, 0);
                    a0 = b0; a1 = b1;
                    const int u_lo = (16 * ks) / NKS, u_hi = (16 * (ks + 1)) / NKS;
#pragma unroll
                    for (int u = u_lo; u < u_hi; ++u) { ATT_EXPU(u); if (u & 1) ATT_PK(u); }
                    ATT_SB();
                }
            } else {
#pragma unroll
                for (int u = 0; u < 16; ++u) { ATT_EXPU(u); if (u & 1) ATT_PK(u); }
            }
            lrun += ps0 + ps1;
            if (resc) {
#pragma unroll
                for (int g = 0; g < 4; ++g) {
                    const f32x4 av = *(LAS const f32x4*)(wsc + 8 * g + 4 * hi);
#pragma unroll
                    for (int e = 0; e < 4; ++e) { o0[4 * g + e] *= av[e]; o1[4 * g + e] *= av[e]; }
                }
            }
            {
                s16x4 va = vtr(Vc), vb = vtr(Vc + 4 * ATT_VS), vc = vtr(Vc + 64), vd = vtr(Vc + 64 + 4 * ATT_VS);
#pragma unroll
                for (int j = 0; j < 4; ++j) {
                    const bf16x8 pa = __builtin_bit_cast(bf16x8, j == 0 ? pw0 : (j == 1 ? pw1 : (j == 2 ? pw2 : pw3)));
                    const bf16x8 vf0 = (bf16x8){va[0], va[1], va[2], va[3], vb[0], vb[1], vb[2], vb[3]};
                    const bf16x8 vf1 = (bf16x8){vc[0], vc[1], vc[2], vc[3], vd[0], vd[1], vd[2], vd[3]};
                    if (j + 1 < 4) { LAS const unsigned char* vp = Vc + (j + 1) * 16 * ATT_VS; va = vtr(vp); vb = vtr(vp + 4 * ATT_VS); vc = vtr(vp + 64); vd = vtr(vp + 64 + 4 * ATT_VS); }
                    o0 = __builtin_amdgcn_mfma_f32_32x32x16_bf16(pa, vf0, o0, 0, 0, 0);
                    o1 = __builtin_amdgcn_mfma_f32_32x32x16_bf16(pa, vf1, o1, 0, 0, 0);
                }
            }
        } else if (doS) {
#pragma unroll
            for (int ks = 0; ks < NKS; ++ks) {
                const bf16x8 a0 = *(LAS const bf16x8*)(Kn + ks * 32), a1 = *(LAS const bf16x8*)(Kn + 32 * KS + ks * 32);
                n0 = __builtin_amdgcn_mfma_f32_32x32x16_bf16(a0, qf[ks], n0, 0, 0, 0); n1 = __builtin_amdgcn_mfma_f32_32x32x16_bf16(a1, qf[ks], n1, 0, 0, 0);
            }
        }
        c0 = n0; c1 = n1;
        ATT_LSTOREK(t & 1, gkA, grA);
        ATT_LSTOREV((t + 1) & 1, gvA);
        __syncthreads();
          }
    }
    float ltot;
    { auto rr = __builtin_amdgcn_permlane32_swap(__float_as_uint(lrun), __float_as_uint(lrun), false, false); ltot = __uint_as_float(rr[0]) + __uint_as_float(rr[1]); }
    if (hi == 0) wsc[r32] = fast_rcp(ltot);
    LAS bf16_t* stg = (LAS bf16_t*)(lds + ATT_OST + wid * 4096);
#pragma unroll
    for (int g = 0; g < 4; ++g) {
        const f32x4 iv = *(LAS const f32x4*)(wsc + 8 * g + 4 * hi);
#pragma unroll
        for (int e = 0; e < 4; ++e) {
            const int r = 4 * g + e, orow = crow(r, hi);
            stg[orow * 64 + r32] = (bf16_t)(cvt_pk_bf16(o0[r] * iv[e], 0.f) & 0xffffu);
            stg[orow * 64 + 32 + r32] = (bf16_t)(cvt_pk_bf16(o1[r] * iv[e], 0.f) & 0xffffu);
        }
    }
#pragma unroll
    for (int it = 0; it < 4; ++it) {
        const int row = it * 8 + (lane >> 3), ch = lane & 7;
        const u32x4 v = *(LAS const u32x4*)(stg + row * 64 + ch * 8);
        if constexpr (DIL) { const size_t tok = kb + (size_t)(pq0 + row) * dil + res; *(u32x4*)(io.OD + (size_t)br * NT * 512 + tok * 512 + h * 64 + ch * 8) = v; }
        else *(u32x4*)(io.OMIX + (kb + pq0 + row) * 1024 + h * 64 + ch * 8) = v;
    }
    if constexpr (DIL) { if (hi == 0) { const size_t tok = kb + (size_t)pq * dil + res; io.LSE[((size_t)br * NT + tok) * 8 + h] = mref + __builtin_amdgcn_logf(ltot); } }
}
#undef ATT_TOK
#undef ATT_GLOADK
#undef ATT_GLOADV
#undef ATT_LSTOREK
#undef ATT_LSTOREV
#undef ATT_SB
#undef ATT_EXPU
#undef ATT_PK

constexpr int DIL_RS = 144;
constexpr int DIL_K = 0, DIL_V = 384 * DIL_RS, DIL_OST = 2 * 384 * DIL_RS, DIL_WSC = DIL_OST + NWAVES * 4096, DIL_LDS = DIL_WSC + NWAVES * 256;
struct DilUnit { int b, h, br, dil, L, resu, q0, nrows; };
__device__ __forceinline__ DilUnit dil_decode(int unit) {
    DilUnit d; const int bh = unit / 24, k = unit % 24, j = k & 7; d.br = k >> 3; d.b = bh >> 3; d.h = bh & 7;
    if (d.br == 0) { d.dil = 1; d.L = 2048; d.resu = 0; d.q0 = 256 * j; d.nrows = 384; }
    else if (d.br == 1) { d.dil = 4; d.L = 512; d.resu = j >> 1; d.q0 = 256 * (j & 1); d.nrows = 384; }
    else { d.dil = 16; d.L = 128; d.resu = 2 * j; d.q0 = 0; d.nrows = 256; }
    return d;
}
__device__ __forceinline__ size_t dil_tok(const DilUnit& d, int s) {
    const size_t kb = (size_t)d.b * SEQ;
    if (d.br < 2) { int p = d.q0 - 64 + s; p = p < 0 ? 0 : (p > d.L - 1 ? d.L - 1 : p); return kb + (size_t)p * d.dil + d.resu; }
    return kb + (size_t)(s & 127) * 16 + (size_t)(d.resu + (s >> 7));
}
__device__ __forceinline__ void dil_phase(LAS unsigned char* lds, const AttnIO& io, int bx, int G) {
    int tid_ = threadIdx.x; asm volatile("" : "+v"(tid_));
    const int tid = tid_, lane = tid & 63, wid = __builtin_amdgcn_readfirstlane(tid >> 6), r32 = lane & 31, hi = lane >> 5;
    const int lrow = tid >> 3, lch = tid & 7;
    const int krow = (r32 & 19) | ((r32 & 4) << 1) | ((r32 & 8) >> 1);
    const int i16 = lane & 15, g16 = lane >> 4;
    const int voff = DIL_V + (8 * hi + (i16 >> 2)) * DIL_RS + (16 * (g16 & 1) + 4 * (i16 & 3)) * 2;
    LAS float* wsc = (LAS float*)(lds + DIL_WSC + wid * 256);
    LAS bf16_t* stg = (LAS bf16_t*)(lds + DIL_OST + wid * 4096);
    constexpr int NUNITS = 256 * 24;
    u32x4 gk[6], gv[6]; bf16x8 qn[4];
#define DIL_WAVE(d, TLO, NTW, KOFS, PQ, RES) \
    int TLO, NTW, KOFS, PQ, RES; \
    if ((d).br < 2) { TLO = wid >> 1; NTW = 3; KOFS = (d).q0 - 64; PQ = (d).q0 + wid * 32 + r32; RES = (d).resu; } \
    else { const int hw_ = wid >> 2; TLO = 2 * hw_; NTW = 2; KOFS = -128 * hw_; PQ = (wid & 3) * 32 + r32; RES = (d).resu + hw_; }
#define DIL_PREFETCH(unit) do { \
        const DilUnit d_ = dil_decode(unit); \
        _Pragma("unroll") for (int i = 0; i < 6; ++i) { const int row_ = lrow + 64 * i; \
            if (row_ < d_.nrows) { const size_t tok_ = dil_tok(d_, row_); gk[i] = *(const u32x4*)(io.KD + tok_ * 512 + d_.h * 64 + lch * 8); gv[i] = *(const u32x4*)(io.VD + tok_ * 512 + d_.h * 64 + lch * 8); } } \
        DIL_WAVE(d_, tlo_, ntw_, kofs_, pq_, res_) (void)tlo_; (void)ntw_; (void)kofs_; \
        const bf16_t* qp_ = io.QD + ((size_t)d_.b * SEQ + (size_t)pq_ * d_.dil + res_) * 512 + d_.h * 64; \
        _Pragma("unroll") for (int ks = 0; ks < 4; ++ks) qn[ks] = *(const bf16x8*)(qp_ + ks * 16 + hi * 8); \
    } while (0)
    int unit = bx;
    if (unit < NUNITS) DIL_PREFETCH(unit);
    for (; unit < NUNITS; unit += G) {
        const DilUnit d = dil_decode(unit);
#pragma unroll
        for (int i = 0; i < 6; ++i) { const int row = lrow + 64 * i;
            if (row < d.nrows) { *(LAS u32x4*)(lds + DIL_K + row * DIL_RS + lch * 16) = gk[i]; *(LAS u32x4*)(lds + DIL_V + row * DIL_RS + lch * 16) = gv[i]; } }
        bf16x8 qf[4];
#pragma unroll
        for (int ks = 0; ks < 4; ++ks) qf[ks] = qn[ks];
        __syncthreads();
        if (unit + G < NUNITS) DIL_PREFETCH(unit + G);
        DIL_WAVE(d, tlo, ntw, kofs, pq, res)
        (void)tlo; (void)ntw; (void)kofs;
        const int pq0 = pq - r32;
        const int srow0 = (d.br < 2) ? (pq0 - d.q0) : (128 * (wid >> 2) + pq0 - 64);
        f32x16 sc[5];
#pragma unroll
        for (int i = 0; i < 5; ++i) {
            const int P0 = pq0 - 64 + 32 * i;
            if (P0 >= 0 && P0 < d.L) {
                LAS const unsigned char* Kb = lds + DIL_K + (srow0 + 32 * i + krow) * DIL_RS + hi * 16;
                f32x16 acc = {};
#pragma unroll
                for (int ks = 0; ks < 4; ++ks) acc = __builtin_amdgcn_mfma_f32_32x32x16_bf16(*(LAS const bf16x8*)(Kb + ks * 32), qf[ks], acc, 0, 0, 0);
                if (i == 0 || i == 4) {
                    const int dd = r32 - 8 * hi;
#pragma unroll
                    for (int r = 0; r < 16; ++r) { const int cr = 16 * (r >> 3) + (r & 7); const bool ok = (i == 0) ? (cr >= dd) : (cr <= dd); acc[r] = ok ? acc[r] : -INFINITY; }
                }
                sc[i] = acc;
            } else {
#pragma unroll
                for (int r = 0; r < 16; ++r) sc[i][r] = -INFINITY;
            }
        }
        float mx = sc[2][0];
#pragma unroll
        for (int i = 0; i < 5; ++i)
#pragma unroll
            for (int r = 0; r < 16; r += 2) mx = fmaxf(fmaxf(mx, sc[i][r]), sc[i][r + 1]);
        { auto rr = __builtin_amdgcn_permlane32_swap(__float_as_uint(mx), __float_as_uint(mx), false, false); mx = fmaxf(__uint_as_float(rr[0]), __uint_as_float(rr[1])); }
        const float mrun = mx;
        float lrun = 0.f;
        f32x16 o0 = {}, o1 = {};
#pragma unroll
        for (int i = 0; i < 5; ++i) {
            const int P0 = pq0 - 64 + 32 * i;
            if (P0 >= 0 && P0 < d.L) {
                float ps = 0.f;
#pragma unroll
                for (int r = 0; r < 16; ++r) { sc[i][r] = fast_exp2(sc[i][r] - mrun); ps += sc[i][r]; }
                lrun += ps;
                const bf16x8 pa0 = pack8(sc[i], 0), pa1 = pack8(sc[i], 8);
                LAS const unsigned char* Vb = lds + voff + (srow0 + 32 * i) * DIL_RS;
#pragma unroll
                for (int j = 0; j < 2; ++j) {
                    LAS const unsigned char* vp = Vb + j * 16 * DIL_RS;
                    const s16x4 a = vtr(vp), bq = vtr(vp + 4 * DIL_RS), c = vtr(vp + 64), dq = vtr(vp + 64 + 4 * DIL_RS);
                    const bf16x8 vf0 = (bf16x8){a[0], a[1], a[2], a[3], bq[0], bq[1], bq[2], bq[3]};
                    const bf16x8 vf1 = (bf16x8){c[0], c[1], c[2], c[3], dq[0], dq[1], dq[2], dq[3]};
                    o0 = __builtin_amdgcn_mfma_f32_32x32x16_bf16(j == 0 ? pa0 : pa1, vf0, o0, 0, 0, 0);
                    o1 = __builtin_amdgcn_mfma_f32_32x32x16_bf16(j == 0 ? pa0 : pa1, vf1, o1, 0, 0, 0);
                }
            }
        }
        float ltot;
        { auto rr = __builtin_amdgcn_permlane32_swap(__float_as_uint(lrun), __float_as_uint(lrun), false, false); ltot = __uint_as_float(rr[0]) + __uint_as_float(rr[1]); }
        if (hi == 0) wsc[r32] = fast_rcp(ltot);
#pragma unroll
        for (int g = 0; g < 4; ++g) {
            const f32x4 iv = *(LAS const f32x4*)(wsc + 8 * g + 4 * hi);
#pragma unroll
            for (int e = 0; e < 4; ++e) {
                const int r = 4 * g + e, orow = crow(r, hi);
                stg[orow * 64 + r32] = (bf16_t)(cvt_pk_bf16(o0[r] * iv[e], 0.f) & 0xffffu);
                stg[orow * 64 + 32 + r32] = (bf16_t)(cvt_pk_bf16(o1[r] * iv[e], 0.f) & 0xffffu);
            }
        }
        const size_t kb = (size_t)d.b * SEQ;
#pragma unroll
        for (int it = 0; it < 4; ++it) {
            const int row = it * 8 + (lane >> 3), ch = lane & 7;
            const u32x4 v = *(LAS const u32x4*)(stg + row * 64 + ch * 8);
            const size_t tok = kb + (size_t)(pq0 + row) * d.dil + res;
            *(u32x4*)(io.OD + (size_t)d.br * NT * 512 + tok * 512 + d.h * 64 + ch * 8) = v;
        }
        if (hi == 0) { const size_t tok = kb + (size_t)pq * d.dil + res; io.LSE[((size_t)d.br * NT + tok) * 8 + d.h] = mrun + __builtin_amdgcn_logf(ltot); }
        __syncthreads();
    }
#undef DIL_WAVE
#undef DIL_PREFETCH
}

__device__ __forceinline__ float wave_sum(float v) {
#pragma unroll
    for (int o = 1; o < 64; o <<= 1) v += __shfl_xor(v, o);
    return v;
}
__device__ __forceinline__ void tr_block(const float* W, int K, int N, const float* gain, bf16_t* WT, int k0, int n0, int dst_row0, LAS float* scr, int lane) {
#pragma unroll 8
    for (int i = 0; i < 32; ++i) {
        const int kk = 2 * i + (lane >> 5);
        float v = W[(size_t)(k0 + kk) * N + n0 + (lane & 31)];
        if (gain) v *= gain[k0 + kk];
        scr[kk * 33 + (lane & 31)] = v;
    }
    asm volatile("s_waitcnt lgkmcnt(0)" ::: "memory");
    const int c = lane & 7;
#pragma unroll
    for (int j = 0; j < 4; ++j) {
        const int n = (lane >> 3) + 8 * j; const LAS float* s = scr + (8 * c) * 33 + n;
        u32x4 o; o.x = cvt_pk_bf16(s[0 * 33], s[1 * 33]); o.y = cvt_pk_bf16(s[2 * 33], s[3 * 33]); o.z = cvt_pk_bf16(s[4 * 33], s[5 * 33]); o.w = cvt_pk_bf16(s[6 * 33], s[7 * 33]);
        *(u32x4*)(WT + (size_t)(dst_row0 + n) * K + k0 + 8 * c) = o;
    }
    asm volatile("s_waitcnt lgkmcnt(0)" ::: "memory");
}

__device__ __forceinline__ void tr_block64(const float* W, int K, int N, const float* gain, bf16_t* WT, int k0, int n0, int dst_row0, LAS float* scr, int lane) {
    const int kk = lane >> 4, n4 = lane & 15;
    f32x4 v[16];
#pragma unroll
    for (int i = 0; i < 16; ++i) v[i] = *(const f32x4*)(W + (size_t)(k0 + 4 * i + kk) * N + n0 + 4 * n4);
#pragma unroll
    for (int i = 0; i < 16; ++i) {
        const float g = gain ? gain[k0 + 4 * i + kk] : 1.0f;
        LAS float* d = scr + (4 * i + kk) * 65 + 4 * n4;
        d[0] = v[i][0] * g; d[1] = v[i][1] * g; d[2] = v[i][2] * g; d[3] = v[i][3] * g;
    }
    asm volatile("s_waitcnt lgkmcnt(0)" ::: "memory");
    const int c = lane & 7;
#pragma unroll
    for (int it = 0; it < 8; ++it) {
        const int n = it * 8 + (lane >> 3); const LAS float* s = scr + (8 * c) * 65 + n;
        u32x4 o; o.x = cvt_pk_bf16(s[0 * 65], s[1 * 65]); o.y = cvt_pk_bf16(s[2 * 65], s[3 * 65]); o.z = cvt_pk_bf16(s[4 * 65], s[5 * 65]); o.w = cvt_pk_bf16(s[6 * 65], s[7 * 65]);
        *(u32x4*)(WT + (size_t)(dst_row0 + n) * K + k0 + 8 * c) = o;
    }
    asm volatile("s_waitcnt lgkmcnt(0)" ::: "memory");
}

#define XB_TMO      128
#define XB_XCNT(j)  (256  + 64 * (j))
#define XB_XSUB(j)  (1280 + 64 * (j))
#define XB_XGEN(j)  (2304 + 64 * (j))
#define XB_TOP      3328
#define XB_TOPGEN   3392
#define XCD_BAR_WORDS 3456
#define XB_SPIN_CAP (1u << 18)

__device__ __forceinline__ unsigned xb_ld(unsigned* p)              { return __hip_atomic_load(p, __ATOMIC_RELAXED, __HIP_MEMORY_SCOPE_AGENT); }
__device__ __forceinline__ unsigned xb_add(unsigned* p, unsigned v) { return __hip_atomic_fetch_add(p, v, __ATOMIC_RELAXED, __HIP_MEMORY_SCOPE_AGENT); }
__device__ __forceinline__ unsigned xb_xcc_id() { return (unsigned)__builtin_amdgcn_s_getreg((3 << 11) | 20) & 0xFu; }
#define XB_SPIN(cond, bar) do { unsigned _sp = 0; while (cond) { __builtin_amdgcn_s_sleep(1); \
    if ((++_sp & 255u) == 0u) { if (xb_ld(&(bar)[XB_TMO])) break; if (_sp > XB_SPIN_CAP) { atomicAdd(&(bar)[XB_TMO], 1u); break; } } } } while (0)

struct XcdBarrier {
    unsigned* bar; unsigned x;
    volatile LAS unsigned* st;
};

__device__ __forceinline__ XcdBarrier xcd_barrier_post(unsigned* bar, volatile LAS unsigned* st) {
    XcdBarrier b; b.bar = bar; b.x = xb_xcc_id(); b.st = st;
    if (threadIdx.x == 0) (void)xb_add(&bar[XB_XCNT(b.x)], 1u);
    return b;
}
__device__ __forceinline__ void xcd_barrier_complete(unsigned* bar, unsigned x, unsigned& nloc, unsigned& nx) {
    const unsigned G = gridDim.x * gridDim.y * gridDim.z;
    unsigned sum, cnt, mine, sp = 0u;
    for (;;) {
        sum = 0u; cnt = 0u; mine = 0u;
#pragma unroll
        for (unsigned j = 0; j < 16; ++j) { const unsigned c = xb_ld(&bar[XB_XCNT(j)]); sum += c; cnt += (c > 0u) ? 1u : 0u; mine = (j == x) ? c : mine; }
        if (sum == G) break;
        __builtin_amdgcn_s_sleep(1);
        if ((++sp & 255u) == 0u) { if (xb_ld(&bar[XB_TMO])) break; if (sp > XB_SPIN_CAP) { atomicAdd(&bar[XB_TMO], 1u); break; } }
    }
    nloc = mine > 0u ? mine : 1u; nx = cnt > 0u ? cnt : 1u;
}

__device__ __forceinline__ void xcd_barrier(const XcdBarrier& b) {
    asm volatile("s_waitcnt vmcnt(0)" ::: "memory");
    __syncthreads();
    if (threadIdx.x == 0) {
        unsigned* bar = b.bar;
        __builtin_amdgcn_s_waitcnt(0);
        unsigned nloc = b.st[0], nx = b.st[1];
        if (nloc == 0u) { xcd_barrier_complete(bar, b.x, nloc, nx); b.st[0] = nloc; b.st[1] = nx; }
        const unsigned old = xb_add(&bar[XB_XSUB(b.x)], 1u);
        const unsigned gen = old / nloc;
        if (old + 1u == (gen + 1u) * nloc) {
            __builtin_amdgcn_fence(__ATOMIC_RELEASE, "agent");
            asm volatile("s_waitcnt vmcnt(0)" ::: "memory");
            const unsigned og = xb_add(&bar[XB_TOP], 1u);
            const unsigned tg = og / nx;
            if (og + 1u == (tg + 1u) * nx) xb_add(&bar[XB_TOPGEN], 1u);
            else XB_SPIN(xb_ld(&bar[XB_TOPGEN]) == tg, bar);
            __builtin_amdgcn_fence(__ATOMIC_ACQUIRE, "agent");
            xb_add(&bar[XB_XGEN(b.x)], 1u);
            asm volatile("s_waitcnt vmcnt(0)" ::: "memory");
        } else {
            XB_SPIN(xb_ld(&bar[XB_XGEN(b.x)]) == gen, bar);
            __builtin_amdgcn_fence(__ATOMIC_ACQUIRE, "agent");
            asm volatile("s_waitcnt vmcnt(0)" ::: "memory");
        }
    }
    __syncthreads();
}

struct RevOrder {
    pg8::StaticOrder S; int R;
    __device__ __forceinline__ bool next(int i, pg8::Unit& u) const { return i < R && S.next(R - 1 - i, u); }
    __device__ __forceinline__ void a_ready(const pg8::Unit&) const {}
    __device__ __forceinline__ void done(const pg8::Unit&) const {}
};
struct Args {
    const float* in[19]; float* out; unsigned char* ws;
};

__global__ void __launch_bounds__(NWAVES * 64) mk_fwd(Args a) {
    extern __shared__ __attribute__((aligned(16))) unsigned char lds_raw[];
    LAS unsigned char* lds = (LAS unsigned char*)lds_raw;
    cg::grid_group grid = cg::this_grid();
    const int tid = threadIdx.x, lane = tid & 63, wave = __builtin_amdgcn_readfirstlane(tid >> 6);
    const int G = gridDim.x, bx = blockIdx.x;
    const int gw = bx * NWAVES + wave, NGW = G * NWAVES;
    unsigned char* ws = a.ws;
    const float* x = a.in[0];
    const float *g_ffn1 = a.in[1], *w1g = a.in[2], *w1u = a.in[3], *w1d = a.in[4], *g_mix = a.in[5], *w_in = a.in[6], *g_q = a.in[7], *w_uq = a.in[8], *g_kv = a.in[9], *w_ukv = a.in[10],
                *g_mo = a.in[11], *g_do = a.in[12], *w_out = a.in[13], *g_ffn2 = a.in[14], *w2g = a.in[15], *w2u = a.in[16], *w2d = a.in[17], *g_fin = a.in[18];
    float* X = a.out;
    bf16_t *W1GU = (bf16_t*)(ws + WS_W1GU), *W1D = (bf16_t*)(ws + WS_W1D), *W2GU = (bf16_t*)(ws + WS_W2GU), *W2D = (bf16_t*)(ws + WS_W2D), *WIN = (bf16_t*)(ws + WS_WIN),
           *WUQ = (bf16_t*)(ws + WS_WUQ), *WUKV = (bf16_t*)(ws + WS_WUKV), *WOUT = (bf16_t*)(ws + WS_WOUT);
    float *COSM = (float*)(ws + WS_ROPE), *SINM = COSM + 2048 * 16, *COSP = SINM + 2048 * 16, *SINP = COSP + 2048 * 8;
    float *SS0 = (float*)(ws + WS_SS0), *SS1 = (float*)(ws + WS_SS1), *SS2 = (float*)(ws + WS_SS2), *SS3 = (float*)(ws + WS_SS3), *SSQ = (float*)(ws + WS_SSQ), *SSKV = (float*)(ws + WS_SSKV);
    bf16_t *XB = (bf16_t*)(ws + WS_XB), *KVM = (bf16_t*)a.out, *HB = (bf16_t*)(ws + WS_H), *OD = (bf16_t*)(ws + WS_OD0), *OMIX = (bf16_t*)(ws + WS_OMIX);
    float* LSE = (float*)(ws + WS_LSE);
    bf16_t *QD = (bf16_t*)(ws + WS_QD), *KD = (bf16_t*)(ws + WS_KD), *VD = (bf16_t*)(ws + WS_VD), *CQ = (bf16_t*)(ws + WS_CQ), *CKV = (bf16_t*)(ws + WS_CKV), *KR = (bf16_t*)(ws + WS_KR), *QM = (bf16_t*)(ws + WS_QM);

    volatile LAS unsigned* xb_st = (volatile LAS unsigned*)(lds + DIL_LDS);
    if (tid < 2) xb_st[tid] = 0u;
    unsigned* xb_words = (unsigned*)(ws + WS_BAR);
    unsigned* pan_cnt = xb_words + 4096;
    if (bx == 0) for (int i = tid; i < 4096 + 256 * 64; i += NWAVES * 64) xb_words[i] = 0u;
    {
        LAS float* scr = (LAS float*)(lds + wave * 16640);
        constexpr int J_GU = 16 * 44, J_D = 44 * 16, J_FFN = 2 * J_GU + J_D, J_UQ = 6 * 12, J_UKV = 4 * 16, J_OUT = 16 * 16, I_IN = 16 * 69;
        constexpr int NITEMS = 2 * J_FFN + J_UQ + J_UKV + J_OUT + I_IN;
        for (int it = gw; it < NITEMS; it += NGW) {
            int r = it;
            if (r < 2 * J_FFN) {
                const int f = r / J_FFN; r -= f * J_FFN;
                const float* gg = f ? g_ffn2 : g_ffn1; const float* wg = f ? w2g : w1g; const float* wu = f ? w2u : w1u; const float* wd = f ? w2d : w1d;
                bf16_t* GU = f ? W2GU : W1GU; bf16_t* DD = f ? W2D : W1D;
                if (r < 2 * J_GU) { const int s = r >= J_GU; const int q = s ? r - J_GU : r; const int kb_ = q / 44, nb = q % 44, n0 = 64 * nb;
                    tr_block64(s ? wu : wg, 1024, FF, gg, GU, 64 * kb_, n0, 256 * (n0 >> 7) + 128 * s + (n0 & 127), scr, lane); }
                else { r -= 2 * J_GU; const int kb_ = r / 16, nb = r % 16; tr_block64(wd, FF, 1024, nullptr, DD, 64 * kb_, 64 * nb, 64 * nb, scr, lane); }
                continue;
            }
            r -= 2 * J_FFN;
            if (r < J_UQ) { const int kb_ = r / 12, nb = r % 12; tr_block64(w_uq, 384, 768, g_q, WUQ, 64 * kb_, 64 * nb, 64 * nb, scr, lane); continue; }
            r -= J_UQ;
            if (r < J_UKV) { const int kb_ = r / 16, nb = r % 16; tr_block64(w_ukv, 256, 1024, g_kv, WUKV, 64 * kb_, 64 * nb, 64 * nb, scr, lane); continue; }
            r -= J_UKV;
            if (r < J_OUT) { const int kb_ = r / 16, nb = r % 16, k0 = 64 * kb_; tr_block64(w_out, 1024, 1024, k0 < 512 ? g_mo : g_do - 512, WOUT, k0, 64 * nb, 64 * nb, scr, lane); continue; }
            r -= J_OUT;
            { const int kb_ = r / 69, nb = r % 69, n0 = 32 * nb;
                int dst;
                if (n0 < 384) dst = 1536 + n0; else if (n0 < 640) dst = 2048 + (n0 - 384); else if (n0 < 672) dst = 1920 + (n0 - 640);
                else if (n0 < 1184) dst = n0 - 672; else if (n0 < 1696) dst = 512 + (n0 - 1184); else dst = 1024 + (n0 - 1696);
                tr_block(w_in, 1024, 2208, g_mix, WIN, 64 * kb_, n0, dst, scr, lane); }
        }
        for (int i = bx * 512 + tid; i < 96 * 1024 / 8; i += G * 512) *(u32x4*)(WIN + (size_t)1952 * 1024 + (size_t)i * 8) = (u32x4){0u, 0u, 0u, 0u};
        for (int i = bx * 512 + tid; i < 2048 * 24; i += G * 512) {
            int pos, fi; float invf; float *cdst, *sdst;
            if (i < 2048 * 16) { pos = i >> 4; fi = i & 15; invf = exp2f(-(float)fi * (1.0f / 16.0f) * 18.931568569324174f); cdst = COSM + i; sdst = SINM + i; }
            else { const int k = i - 2048 * 16; pos = k >> 3; fi = k & 7; invf = exp2f(-(float)fi * (1.0f / 8.0f) * 18.931568569324174f); cdst = COSP + k; sdst = SINP + k; }
            const float ang = (float)pos * invf;
            const double rev = (double)ang * 0.15915494309189535; const float fr_ = (float)(rev - floor(rev));
            *cdst = __builtin_amdgcn_cosf(fr_); *sdst = __builtin_amdgcn_sinf(fr_);
        }
        for (int row0 = gw * 4; row0 < NT; row0 += NGW * 4) {
            f32x4 v[4][4];
#pragma unroll
            for (int q = 0; q < 4; ++q) { const f32x4* xr = (const f32x4*)(x + (size_t)(row0 + q) * DM) + lane;
#pragma unroll
                for (int j = 0; j < 4; ++j) v[q][j] = xr[64 * j]; }
#pragma unroll
            for (int q = 0; q < 4; ++q) {
                float sacc = 0.f; unsigned long long* o8 = (unsigned long long*)(XB + (size_t)(row0 + q) * DM) + lane;
#pragma unroll
                for (int j = 0; j < 4; ++j) { sacc += sq4(v[q][j]); o8[64 * j] = (unsigned long long)cvt_pk_bf16(v[q][j][0], v[q][j][1]) | ((unsigned long long)cvt_pk_bf16(v[q][j][2], v[q][j][3]) << 32); }
                sacc = wave_sum(sacc);
                if (lane < 16) SS0[(size_t)(row0 + q) * 16 + lane] = lane == 0 ? sacc : 0.f;
            }
        }
    }
    grid.sync();
    const XcdBarrier xb = xcd_barrier_post(xb_words, xb_st);
    {
        pg8::Gemm g{XB, W1GU, NT, 2 * FF, DM}; pg8::StaticOrder S; S.init(NT, 2 * FF, G, bx);
        rstd4_fill((LAS float*)(lds + 131072), SS0);
        EpiGateUp E{HB, SS0, (LAS float*)(lds + 131072)};
        pg8::gemm_phase<EpiGateUp, pg8::StaticOrder, true, true>(lds, g, S, E);
    }
    xcd_barrier(xb);
    {
        pg8::Gemm g{HB, W1D, NT, DM, FF}; RevOrder S; S.S.init(NT, DM, G, bx); S.R = (NT / 256) * (DM / 256) / G;
        EpiResid E{XB, SS1, 0.5f};
        pg8::gemm_phase<EpiResid, RevOrder, true, true>(lds, g, S, E);
    }
    xcd_barrier(xb);
    {
        pg8::Gemm g{XB, WIN, NT, 2304, DM}; pg8::StaticOrder S; S.init(NT, 2304, G, bx);
        rstd4_fill((LAS float*)(lds + 131072), SS1);
        EpiInProj E{SS1, QD, KD, VD, CQ, CKV, KR, SSQ, SSKV, COSM, SINM, COSP, SINP, (LAS float*)(lds + 131072)};
        pg8::gemm_phase<EpiInProj, pg8::StaticOrder, true, true>(lds, g, S, E);
    }
    xcd_barrier(xb);
    {
        { pg8::Gemm g{CQ, WUQ, NT, 768, 384}; pg8::StaticOrder S; S.init(NT, 768, G, bx); EpiQ E{SSQ, QM, COSM, SINM, (LAS float*)(lds + 131072)};
          pg8::gemm_phase<EpiQ, pg8::StaticOrder, true, true>(lds, g, S, E); }
        { pg8::Gemm g{CKV, WUKV, NT, 1024, 256}; pg8::StaticOrder S; S.init(NT, 1024, G, bx); EpiKV E{SSKV, KVM, (LAS float*)(lds + 131072)};
          pg8::gemm_phase<EpiKV, pg8::StaticOrder, true, true>(lds, g, S, E); }
        __syncthreads();
        AttnIO io{QM, KVM, KR, OMIX, QD, KD, VD, OD, LSE};
        dil_phase(lds, io, (G % 8 == 0) ? (bx & 7) * (G >> 3) + (bx >> 3) : bx, G);
    }
    xcd_barrier(xb);
    {
        AttnIO io{QM, KVM, KR, OMIX, QD, KD, VD, OD, LSE};
        const int vcu = (G % 8 == 0) ? (bx & 7) * (G >> 3) + (bx >> 3) : bx;
        for (int u = vcu; u < 256 * 8; u += G) attn_unit<false>(lds, io, u);
    }
    xcd_barrier(xb);
    for (int rowb = gw * 4; rowb < NT; rowb += NGW * 4) {
        u32x4 wm[4], wd[4][3]; float ls[4][3];
        const int hd = lane >> 3;
#pragma unroll
        for (int q = 0; q < 4; ++q) {
            const int row = rowb + q;
            wm[q] = *(const u32x4*)(OMIX + (size_t)row * 1024 + lane * 8);
#pragma unroll
            for (int n = 0; n < 3; ++n) { ls[q][n] = LSE[((size_t)n * NT + row) * 8 + hd]; wd[q][n] = *(const u32x4*)(OD + (size_t)n * NT * 512 + (size_t)row * 512 + lane * 8); }
        }
#pragma unroll
        for (int q = 0; q < 4; ++q) {
            const int row = rowb + q;
            {
                float v[8];
#pragma unroll
                for (int e = 0; e < 4; ++e) { v[2 * e] = __uint_as_float(wm[q][e] << 16); v[2 * e + 1] = __uint_as_float(wm[q][e] & 0xffff0000u); }
                float s = 0.f;
#pragma unroll
                for (int e = 0; e < 8; ++e) s += v[e] * v[e];
                const float rs = rsqrtf(wave_sum(s) * (1.0f / 512.0f) + EPS);
                u32x4 o; o.x = cvt_pk_bf16(v[0] * rs, v[1] * rs); o.y = cvt_pk_bf16(v[2] * rs, v[3] * rs); o.z = cvt_pk_bf16(v[4] * rs, v[5] * rs); o.w = cvt_pk_bf16(v[6] * rs, v[7] * rs);
                *(u32x4*)(OMIX + (size_t)row * 1024 + lane * 8) = o;
            }
            {
                const float l0 = ls[q][0], l1 = ls[q][1], l2 = ls[q][2];
                const float mx = fmaxf(l0, fmaxf(l1, l2));
                float w0 = fast_exp2(l0 - mx), w1 = fast_exp2(l1 - mx), w2 = fast_exp2(l2 - mx);
                const float inv = 1.0f / (w0 + w1 + w2); w0 *= inv; w1 *= inv; w2 *= inv;
                float v[8];
#pragma unroll
                for (int e = 0; e < 8; ++e) v[e] = 0.f;
#pragma unroll
                for (int n = 0; n < 3; ++n) {
                    const u32x4 w = wd[q][n]; const float wn = n == 0 ? w0 : (n == 1 ? w1 : w2);
#pragma unroll
                    for (int e = 0; e < 4; ++e) { v[2 * e] += wn * __uint_as_float(w[e] << 16); v[2 * e + 1] += wn * __uint_as_float(w[e] & 0xffff0000u); }
                }
                float s = 0.f;
#pragma unroll
                for (int e = 0; e < 8; ++e) s += v[e] * v[e];
                const float rs = rsqrtf(wave_sum(s) * (1.0f / 512.0f) + EPS);
                u32x4 o; o.x = cvt_pk_bf16(v[0] * rs, v[1] * rs); o.y = cvt_pk_bf16(v[2] * rs, v[3] * rs); o.z = cvt_pk_bf16(v[4] * rs, v[5] * rs); o.w = cvt_pk_bf16(v[6] * rs, v[7] * rs);
                *(u32x4*)(OMIX + (size_t)row * 1024 + 512 + lane * 8) = o;
            }
        }
    }
    xcd_barrier(xb);
    {
        pg8::Gemm g{OMIX, WOUT, NT, DM, DM}; pg8::StaticOrder S; S.init(NT, DM, G, bx);
        EpiResid E{XB, SS2, 1.0f};
        pg8::gemm_phase<EpiResid, pg8::StaticOrder, true, true>(lds, g, S, E);
    }
    xcd_barrier(xb);
    {
        pg8::Gemm g{XB, W2GU, NT, 2 * FF, DM}; pg8::StaticOrder S; S.init(NT, 2 * FF, G, bx);
        rstd4_fill((LAS float*)(lds + 131072), SS2);
        EpiGateUp E{HB, SS2, (LAS float*)(lds + 131072)};
        pg8::gemm_phase<EpiGateUp, pg8::StaticOrder, true, true>(lds, g, S, E);
    }
    xcd_barrier(xb);
    {
        pg8::Gemm g{HB, W2D, NT, DM, FF}; RevOrder S; S.S.init(NT, DM, G, bx); S.R = (NT / 256) * (DM / 256) / G;
        EpiFinal E{XB, X, SS3, pan_cnt, g_fin, (LAS float*)(lds + 131072)};
        pg8::gemm_phase<EpiFinal, RevOrder, true, true>(lds, g, S, E);
    }
}

extern "C" void kernel_launch(void* const* d_in, const int* in_sizes, int n_in, void* d_out, int out_size, void* d_ws, size_t ws_size, hipStream_t stream) {
    constexpr int LDS_BYTES = 147456; static_assert(DIL_LDS + 64 <= LDS_BYTES, "LDS map");
    static int grid = 0;
    if (grid == 0) {
        if (n_in != 19 || in_sizes[0] != NT * DM || out_size != NT * DM || ws_size < WS_END) {
            fprintf(stderr, "kernel_launch: unexpected problem geometry (n_in %d, in0 %d, out %d, ws %zu); nothing launched\n", n_in, n_in > 0 ? in_sizes[0] : -1, out_size, ws_size); grid = -1; return; }
        int dev = 0, cus = 0, per_cu = 0;
        hipGetDevice(&dev); hipDeviceGetAttribute(&cus, hipDeviceAttributeMultiprocessorCount, dev);
        if (hipFuncSetAttribute((const void*)mk_fwd, hipFuncAttributeMaxDynamicSharedMemorySize, LDS_BYTES) != hipSuccess) { fprintf(stderr, "kernel_launch: hipFuncSetAttribute failed\n"); grid = -1; return; }
        if (hipOccupancyMaxActiveBlocksPerMultiprocessor(&per_cu, (const void*)mk_fwd, NWAVES * 64, LDS_BYTES) != hipSuccess || per_cu < 1) { fprintf(stderr, "kernel_launch: occupancy query says %d blocks per CU\n", per_cu); per_cu = 1; }
        (void)hipGetLastError();
        grid = cus >= 256 ? 256 : cus;
        if (cus != 256) fprintf(stderr, "kernel_launch: built for a 256-CU device, found %d CUs\n", cus);
        (void)0;
    }
    if (grid < 0) return;
    Args a{};
    for (int i = 0; i < 19; ++i) a.in[i] = (const float*)d_in[i];
    a.out = (float*)d_out; a.ws = (unsigned char*)d_ws;
    void* args[] = {&a};
    hipError_t e = hipLaunchCooperativeKernel((const void*)mk_fwd, dim3(grid), dim3(NWAVES * 64), args, LDS_BYTES, stream);
    if (e != hipSuccess) fprintf(stderr, "kernel_launch: cooperative launch failed: %s (grid %d)\n", hipGetErrorString(e), grid);
}
```
